# Optimizing an MI355X kernel written in HIP

```python
import math
import jax
import jax.numpy as jnp
from jax import lax
import numpy as np

D_MODEL = 1024
BATCH = 8
SEQ = 4096
DEPTH = 1
DEC_BATCH = 2
DEC_SEQ = 8192
PAST_LEN = 128

D_MIX = D_MODEL
ATT_WIDTH = D_MIX // 2
FNET_WIDTH = D_MIX - ATT_WIDTH
N_ATT_HEADS = 4
DV = ATT_WIDTH // N_ATT_HEADS
DK = DV // 2
N_FGROUPS = 4
FG_DIM = FNET_WIDTH // N_FGROUPS
PLE_DIM = 256
NUM_BUCKETS = 32
MAX_DISTANCE = 128
Q_BLOCK = 128
NORM_EPS = 1e-6
SUBLN_EPS = 1e-5
Q_COLS = N_ATT_HEADS * 2 * DK
K_COLS = N_ATT_HEADS * 2 * DK
V_COLS = ATT_WIDTH
GA_COLS = ATT_WIDTH
U_COLS = FNET_WIDTH
GF_COLS = FNET_WIDTH
IN_COLS = Q_COLS + K_COLS + V_COLS + GA_COLS + U_COLS + GF_COLS

kernel_name = "hymba_diffattn_fnet_encoder"


def rmsnorm(x, g, eps=NORM_EPS):
    xf = x.astype(jnp.float32)
    y = xf * lax.rsqrt(jnp.mean(xf * xf, axis=-1, keepdims=True) + eps)
    return (y * g.astype(jnp.float32)).astype(x.dtype)


def rel_buckets(q_pos, k_pos):
    rel = k_pos[None, :] - q_pos[:, None]
    half = NUM_BUCKETS // 2
    ret = jnp.where(rel > 0, half, 0)
    n = jnp.abs(rel)
    max_exact = half // 2
    nf = jnp.maximum(n, 1).astype(jnp.float32)
    large = max_exact + (jnp.log(nf / max_exact) / math.log(MAX_DISTANCE / max_exact)
                         * (half - max_exact)).astype(jnp.int32)
    large = jnp.minimum(large, half - 1)
    return ret + jnp.where(n < max_exact, n, large)


def diff_attention(q, k, v, lam, rel_bias):
    b, s = q.shape[0], q.shape[1]
    nblk = s // Q_BLOCK
    qb = q.reshape(b, nblk, Q_BLOCK, N_ATT_HEADS, 2, DK).transpose(1, 0, 2, 3, 4, 5)
    starts = jnp.arange(nblk, dtype=jnp.int32) * Q_BLOCK
    k_pos = jnp.arange(s, dtype=jnp.int32)
    table = rel_bias.astype(jnp.float32)
    scale = 1.0 / math.sqrt(DK)

    def block(args):
        qi, s0 = args
        q_pos = s0 + jnp.arange(Q_BLOCK, dtype=jnp.int32)
        bias = table[rel_buckets(q_pos, k_pos)].transpose(2, 0, 1)
        logits = (jnp.einsum('bqhcd,bkhcd->bhcqk', qi, k).astype(jnp.float32) * scale
                  + bias[None, :, None])
        probs = jax.nn.softmax(logits, axis=-1)
        w = probs[:, :, 0] - lam * probs[:, :, 1]
        return jnp.einsum('bhqk,bkhd->bqhd', w.astype(v.dtype), v)

    o = lax.map(block, (qb, starts))
    return o.transpose(1, 0, 2, 3, 4).reshape(b, s, N_ATT_HEADS, DV)


def fourier_mix(u, w_f):
    b, s = u.shape[0], u.shape[1]
    ug = u.reshape(b, s, N_FGROUPS, FG_DIM).astype(jnp.float32)
    f = jnp.real(jnp.fft.fft2(ug, axes=(1, 3), norm='ortho')).astype(u.dtype)
    out = jnp.einsum('bsgc,gcd->bsgd', f, w_f)
    return out.reshape(b, s, FNET_WIDTH)


def layer(h, p_i, i, norm_mix_g, w_in, lambda_params, subln_g, rel_bias,
          w_fourier, w_out, ple_norm_g, w_ple_gate, w_ple_proj):
    b, s = h.shape[0], h.shape[1]
    xn = rmsnorm(h, norm_mix_g)
    z = xn @ w_in
    o0 = 0
    q = z[..., o0:o0 + Q_COLS]; o0 += Q_COLS
    k = z[..., o0:o0 + K_COLS]; o0 += K_COLS
    v = z[..., o0:o0 + V_COLS]; o0 += V_COLS
    g_att = z[..., o0:o0 + GA_COLS]; o0 += GA_COLS
    u = z[..., o0:o0 + U_COLS]; o0 += U_COLS
    g_f = z[..., o0:o0 + GF_COLS]

    lambda_init = 0.8 - 0.6 * math.exp(-0.3 * i)
    lp = lambda_params.astype(jnp.float32)
    lam = jnp.exp(jnp.sum(lp[0] * lp[1])) - jnp.exp(jnp.sum(lp[2] * lp[3])) + lambda_init
    q = q.reshape(b, s, N_ATT_HEADS, 2, DK)
    k = k.reshape(b, s, N_ATT_HEADS, 2, DK)
    v = v.reshape(b, s, N_ATT_HEADS, DV)
    att = diff_attention(q, k, v, lam, rel_bias)
    att = rmsnorm(att, subln_g, SUBLN_EPS) * (1.0 - lambda_init)
    att = att.reshape(b, s, ATT_WIDTH) * jax.nn.silu(g_att)

    fno = fourier_mix(u, w_fourier) * jax.nn.silu(g_f)

    h = h + jnp.concatenate([att, fno], axis=-1) @ w_out

    gate = jax.nn.sigmoid(rmsnorm(h, ple_norm_g) @ w_ple_gate)
    h = h + gate * (p_i @ w_ple_proj)
    return h


def trunk(x, p, norm_mix_g, w_in, lambda_params, subln_g, rel_bias, w_fourier,
          w_out, ple_norm_g, w_ple_gate, w_ple_proj, final_norm_g):
    h = x
    for i in range(DEPTH):
        h = layer(h, p[i], i, norm_mix_g[i], w_in[i], lambda_params[i], subln_g[i],
                  rel_bias, w_fourier[i], w_out[i], ple_norm_g[i], w_ple_gate[i],
                  w_ple_proj[i])
    return rmsnorm(h, final_norm_g)


def setup_inputs(seed: int = 0) -> dict:
    key = jax.random.key(seed)
    ks = jax.random.split(key, 16)
    f32 = jnp.float32
    nrm = lambda k, shape, sc: jax.random.normal(k, shape, f32) * sc
    return {
        "x_prompt": nrm(ks[0], (BATCH, SEQ, D_MODEL), 1.0),
        "x_sample": nrm(ks[1], (DEC_BATCH, DEC_SEQ, D_MODEL), 1.0),
        "p_prompt": nrm(ks[2], (DEPTH, BATCH, SEQ, PLE_DIM), 1.0),
        "p_sample": nrm(ks[3], (DEPTH, DEC_BATCH, DEC_SEQ, PLE_DIM), 1.0),
        "norm_mix_g": 1.0 + nrm(ks[4], (DEPTH, D_MODEL), 0.05),
        "w_in": nrm(ks[5], (DEPTH, D_MODEL, IN_COLS), D_MODEL ** -0.5),
        "lambda_params": nrm(ks[6], (DEPTH, 4, DK), 0.1),
        "subln_g": 1.0 + nrm(ks[7], (DEPTH, DV), 0.05),
        "rel_bias": nrm(ks[8], (NUM_BUCKETS, N_ATT_HEADS), 0.5),
        "w_fourier": nrm(ks[9], (DEPTH, N_FGROUPS, FG_DIM, FG_DIM), FG_DIM ** -0.5),
        "w_out": nrm(ks[10], (DEPTH, D_MIX, D_MODEL), D_MIX ** -0.5),
        "ple_norm_g": 1.0 + nrm(ks[11], (DEPTH, D_MODEL), 0.05),
        "w_ple_gate": nrm(ks[12], (DEPTH, D_MODEL, D_MODEL), D_MODEL ** -0.5),
        "w_ple_proj": nrm(ks[13], (DEPTH, PLE_DIM, D_MODEL), PLE_DIM ** -0.5),
        "final_norm_g": 1.0 + nrm(ks[14], (D_MODEL,), 0.05),
    }


def reference(x_prompt, x_sample, p_prompt, p_sample, norm_mix_g, w_in, lambda_params,
              subln_g, rel_bias, w_fourier, w_out, ple_norm_g, w_ple_gate, w_ple_proj,
              final_norm_g):
    y_prompt = trunk(x_prompt, p_prompt, norm_mix_g, w_in, lambda_params, subln_g,
                     rel_bias, w_fourier, w_out, ple_norm_g, w_ple_gate, w_ple_proj,
                     final_norm_g)
    y_sample = trunk(x_sample, p_sample, norm_mix_g, w_in, lambda_params, subln_g,
                     rel_bias, w_fourier, w_out, ple_norm_g, w_ple_gate, w_ple_proj,
                     final_norm_g)
    return (y_prompt, y_sample)
```

```cpp
#include <hip/hip_runtime.h>
#include <cstdio>
#include <cstdint>
__device__ __forceinline__ int opq_tid(int wave) { int l; asm volatile("v_mbcnt_lo_u32_b32 %0, -1, 0\n\tv_mbcnt_hi_u32_b32 %0, -1, %0" : "=v"(l)); return wave * 64 + l; }
__device__ __forceinline__ float bperm_f(int srclane, float v) { return __int_as_float(__builtin_amdgcn_ds_bpermute(srclane << 2, __float_as_int(v))); }
namespace pg8 {
#define PG8_LAS __attribute__((address_space(3)))
typedef unsigned short bf16_t;
typedef short bf16x8 __attribute__((ext_vector_type(8)));
typedef float f32x4 __attribute__((ext_vector_type(4)));
typedef unsigned u32x4 __attribute__((ext_vector_type(4)));
constexpr int BM = 256, BK = 64, HALF = 128, HTB = HALF * BK * 2  , STAGE_BYTES = 8 * HTB, NXCD = 8, WGM = 8;

__host__ __device__ __forceinline__ int lds_byte(int r, int c) { const int st = (r >> 4) * 2 + (c >> 5), rr = r & 15, cc = c & 31, ob = rr * 64 + cc * 2; return st * 1024 + (ob ^ (((ob >> 9) & 1) << 5)); }
__host__ __device__ __forceinline__ void stage_rc(int b, int& R, int& C) { const int st = b / 1024, sb = b % 1024, swz = sb ^ (((sb >> 9) & 1) << 5); R = (st >> 1) * 16 + swz / 64; C = (st & 1) * 32 + (swz % 64) / 2; }
__host__ __device__ __forceinline__ int perm32(int rho) { const int n = rho >> 4, i = rho & 15; return 8 * (i >> 2) + 4 * n + (i & 3); }

struct Unit { int pm, pn; };
struct Gemm { const bf16_t* A; const bf16_t* Bt; int M, N, K; };

struct StaticOrder {
    int nM, nN, nwg, G, c;
    __host__ __device__ void init(int M, int N, int G_, int c_) { nM = M / BM; nN = N / BM; nwg = nM * nN; G = G_; c = c_; }
    __host__ __device__ bool next(int i, Unit& u) const {
        const long L = (long)i * G + c; if (L >= nwg) return false;
        int wgid = (int)L; { const int q = nwg / NXCD, r = nwg % NXCD, xcd = wgid % NXCD, off = wgid / NXCD; wgid = (xcd < r ? xcd * (q + 1) : r * (q + 1) + (xcd - r) * q) + off; }
        const int nig = WGM * nN, gid = wgid / nig, fm = gid * WGM, gsz = (nM - fm) < WGM ? (nM - fm) : WGM;
        u.pm = fm + ((wgid % nig) % gsz); u.pn = (wgid % nig) / gsz; return true;
    }
    __device__ __forceinline__ void a_ready(const Unit&) const {}
    __device__ __forceinline__ void done(const Unit&) const {}
};

__device__ __forceinline__ unsigned cvt_pk_bf16(float lo, float hi) { unsigned r; asm volatile("v_cvt_pk_bf16_f32 %0, %1, %2" : "=v"(r) : "v"(lo), "v"(hi)); return r; }
typedef float f32x2 __attribute__((ext_vector_type(2)));
typedef unsigned u32x2 __attribute__((ext_vector_type(2)));
__device__ __forceinline__ float bflo(unsigned w) { return __uint_as_float(w << 16); }
__device__ __forceinline__ float bfhi(unsigned w) { return __uint_as_float(w & 0xffff0000u); }
__device__ __forceinline__ float sigm(float a) { return __builtin_amdgcn_rcpf(1.f + __expf(-a)); }
__device__ __forceinline__ float silu(float a) { return a * sigm(a); }

struct EpiInProj {
    static constexpr bool PERM = true, AFTER_DRAIN = false;
    bf16_t* qu; bf16_t* kb; bf16_t* vb; bf16_t* ga; bf16_t* gf; float qscale;
    __device__ __forceinline__ void operator()(const f32x4 (&acc)[2][2][4][2], const Unit& u, int wr, int wc, int fr, int fq) const {
        const int seg = u.pn >> 1, colt = (u.pn & 1) * BM;
        bf16_t* base; int ld = 512; float sc = 1.f;
        if (seg == 0) { base = qu; ld = 1024; sc = qscale; } else if (seg == 1) base = kb; else if (seg == 2) base = vb; else if (seg == 3) base = ga;
        else if (seg == 4) { base = qu + 512; ld = 1024; } else base = gf;
        const int row0 = u.pm * BM + wr * 64 + fr, col0 = colt + wc * 32 + 8 * fq;
#pragma unroll
        for (int ai = 0; ai < 2; ++ai)
#pragma unroll
            for (int m = 0; m < 4; ++m) { bf16_t* rowp = base + (size_t)(row0 + ai * HALF + m * 16) * ld + col0;
#pragma unroll
                for (int bj = 0; bj < 2; ++bj) { const f32x4 v0 = acc[ai][bj][m][0] * sc, v1 = acc[ai][bj][m][1] * sc;
                    u32x4 w; w.x = cvt_pk_bf16(v0[0], v0[1]); w.y = cvt_pk_bf16(v0[2], v0[3]); w.z = cvt_pk_bf16(v1[0], v1[1]); w.w = cvt_pk_bf16(v1[2], v1[3]);
                    *(u32x4*)(rowp + bj * HALF) = w; } }
    }
};
struct EpiPlainBf16 {
    static constexpr bool PERM = true, AFTER_DRAIN = false;
    bf16_t* O; int ldc;
    __device__ __forceinline__ void operator()(const f32x4 (&acc)[2][2][4][2], const Unit& u, int wr, int wc, int fr, int fq) const {
        const int row0 = u.pm * BM + wr * 64 + fr, col0 = u.pn * BM + wc * 32 + 8 * fq;
#pragma unroll
        for (int ai = 0; ai < 2; ++ai)
#pragma unroll
            for (int m = 0; m < 4; ++m) { bf16_t* rowp = O + (size_t)(row0 + ai * HALF + m * 16) * ldc + col0;
#pragma unroll
                for (int bj = 0; bj < 2; ++bj) { const f32x4 v0 = acc[ai][bj][m][0], v1 = acc[ai][bj][m][1];
                    u32x4 w; w.x = cvt_pk_bf16(v0[0], v0[1]); w.y = cvt_pk_bf16(v0[2], v0[3]); w.z = cvt_pk_bf16(v1[0], v1[1]); w.w = cvt_pk_bf16(v1[2], v1[3]);
                    *(u32x4*)(rowp + bj * HALF) = w; } }
    }
};
struct EpiFno {
    static constexpr bool PERM = true, AFTER_DRAIN = false;
    const bf16_t* gf; bf16_t* qu;
    __device__ __forceinline__ void operator()(const f32x4 (&acc)[2][2][4][2], const Unit& u, int wr, int wc, int fr, int fq) const {
        const int row0 = u.pm * BM + wr * 64 + fr, col0 = u.pn * BM + wc * 32 + 8 * fq;
#pragma unroll
        for (int ai = 0; ai < 2; ++ai)
#pragma unroll
            for (int m = 0; m < 4; ++m) { const size_t r = (size_t)(row0 + ai * HALF + m * 16);
#pragma unroll
                for (int bj = 0; bj < 2; ++bj) { const int c = col0 + bj * HALF; const u32x4 g = *(const u32x4*)(gf + r * 512 + c);
                    const f32x4 v0 = acc[ai][bj][m][0], v1 = acc[ai][bj][m][1];
                    u32x4 w; w.x = cvt_pk_bf16(v0[0] * silu(bflo(g.x)), v0[1] * silu(bfhi(g.x))); w.y = cvt_pk_bf16(v0[2] * silu(bflo(g.y)), v0[3] * silu(bfhi(g.y)));
                    w.z = cvt_pk_bf16(v1[0] * silu(bflo(g.z)), v1[1] * silu(bfhi(g.z))); w.w = cvt_pk_bf16(v1[2] * silu(bflo(g.w)), v1[3] * silu(bfhi(g.w)));
                    *(u32x4*)(qu + r * 1024 + 512 + c) = w; } }
    }
};
struct EpiOutProj {
    static constexpr bool PERM = false, AFTER_DRAIN = false;
    const float* xp; const float* xs; float* out; bf16_t* h1b; float* ssq;
    __device__ __forceinline__ void operator()(const f32x4 (&acc)[2][2][4][2], const Unit& u, int wr, int wc, int fr, int fq) const {
        const int row0 = u.pm * BM + wr * 64 + fr, col0 = u.pn * BM + wc * 32 + 4 * fq;
        const bool pr = u.pm < 128;
#pragma unroll
        for (int ai = 0; ai < 2; ++ai)
#pragma unroll
            for (int m = 0; m < 4; ++m) { const int r = row0 + ai * HALF + m * 16; const size_t off = (size_t)r * 1024 + col0;
                const float* xrow = pr ? xp + off : xs + (off - (size_t)32768 * 1024); float ss = 0.f;
#pragma unroll
                for (int bj = 0; bj < 2; ++bj)
#pragma unroll
                    for (int n = 0; n < 2; ++n) { const f32x4 xv = *(const f32x4*)(xrow + bj * HALF + n * 16); const f32x4 h = xv + acc[ai][bj][m][n];
                        *(f32x4*)(out + off + bj * HALF + n * 16) = h; ss += (h[0] * h[0] + h[1] * h[1]) + (h[2] * h[2] + h[3] * h[3]);
                        u32x2 w; w.x = cvt_pk_bf16(h[0], h[1]); w.y = cvt_pk_bf16(h[2], h[3]); *(u32x2*)(h1b + off + bj * HALF + n * 16) = w; }
                ss += bperm_f(((fq ^ 1) << 4) | fr, ss); ss += bperm_f(((fq ^ 2) << 4) | fr, ss);
                if (fq == 0) ssq[(size_t)r * 16 + u.pn * 4 + wc] = ss; }
    }
};
struct EpiGate {
    static constexpr bool PERM = false, AFTER_DRAIN = false;
    float* out; const bf16_t* proj; const float* ssq1; float* ssq2;
    __device__ __forceinline__ void operator()(const f32x4 (&acc)[2][2][4][2], const Unit& u, int wr, int wc, int fr, int fq) const {
        const int row0 = u.pm * BM + wr * 64 + fr, col0 = u.pn * BM + wc * 32 + 4 * fq;
#pragma unroll
        for (int ai = 0; ai < 2; ++ai)
#pragma unroll
            for (int m = 0; m < 4; ++m) { const int r = row0 + ai * HALF + m * 16; const size_t off = (size_t)r * 1024 + col0;
                const f32x4* sp = (const f32x4*)(ssq1 + (size_t)r * 16); const f32x4 s0 = sp[0], s1 = sp[1], s2 = sp[2], s3 = sp[3];
                const float st = ((s0[0] + s0[1]) + (s0[2] + s0[3])) + ((s1[0] + s1[1]) + (s1[2] + s1[3])) + ((s2[0] + s2[1]) + (s2[2] + s2[3])) + ((s3[0] + s3[1]) + (s3[2] + s3[3]));
                const float rr = __builtin_amdgcn_rsqf(st * (1.f / 1024.f) + 1e-6f); float ss = 0.f;
#pragma unroll
                for (int bj = 0; bj < 2; ++bj)
#pragma unroll
                    for (int n = 0; n < 2; ++n) { const f32x4 a = acc[ai][bj][m][n] * rr; const u32x2 pw = *(const u32x2*)(proj + off + bj * HALF + n * 16);
                        const f32x4 h1 = *(const f32x4*)(out + off + bj * HALF + n * 16); f32x4 h;
                        h[0] = h1[0] + sigm(a[0]) * bflo(pw.x); h[1] = h1[1] + sigm(a[1]) * bfhi(pw.x); h[2] = h1[2] + sigm(a[2]) * bflo(pw.y); h[3] = h1[3] + sigm(a[3]) * bfhi(pw.y);
                        *(f32x4*)(out + off + bj * HALF + n * 16) = h; ss += (h[0] * h[0] + h[1] * h[1]) + (h[2] * h[2] + h[3] * h[3]); }
                ss += bperm_f(((fq ^ 1) << 4) | fr, ss); ss += bperm_f(((fq ^ 2) << 4) | fr, ss);
                if (fq == 0) ssq2[(size_t)r * 16 + u.pn * 4 + wc] = ss; }
    }
};
template <class Epi, class Sched, bool ALIGN_EPI = false, bool SP2 = false>
__device__ __forceinline__ void gemm_phase(PG8_LAS unsigned char* lds, const Gemm g, const Sched& S, const Epi& E, const int wave_) {
    const int tid = opq_tid(wave_), wid = __builtin_amdgcn_readfirstlane(tid >> 6), lane = tid & 63, wr = wid >> 2, wc = wid & 3, fr = lane & 15, fq = lane >> 4;
    const int K = g.K, nt = K / BK;
    unsigned voffA[2], voffB[2];
#pragma unroll
    for (int i = 0; i < 2; ++i) { int R, C; stage_rc(tid * 16 + i * 8192, R, C); const int Rb = Epi::PERM ? ((R & ~31) + perm32(R & 31)) : R;
        voffA[i] = (unsigned)(R * K + C) * 2u; voffB[i] = (unsigned)(Rb * K + C) * 2u; }
    const size_t kstep = (size_t)(BK * 2);
    const size_t hstep = (size_t)HALF * K * 2;
    const size_t tstep = 2 * hstep;
    const unsigned ldsw = (unsigned)wid * 1024u;
    const int aoff = lds_byte(wr * 64 + fr, fq * 8), boff = lds_byte(wc * 32 + fr, fq * 8);
#define PG8_SA(b, h) (((b) * 2 + (h)) * HTB)
#define PG8_SB(b, h) ((4 + (b) * 2 + (h)) * HTB)
#define PG8_STAGE(bufoff, gbase, voff) do { _Pragma("unroll") for (int _i = 0; _i < 2; ++_i) \
        __builtin_amdgcn_global_load_lds((const unsigned*)((const char*)(gbase) + (voff)[_i]), (PG8_LAS unsigned*)(lds + (bufoff) + ldsw + _i * 8192), 16, 0, 0); } while (0)
#define PG8_LDA(dst, b, h) do { _Pragma("unroll") for (int m = 0; m < 4; ++m) _Pragma("unroll") for (int k = 0; k < 2; ++k) dst[m][k] = *(const PG8_LAS bf16x8*)(lds + PG8_SA(b, h) + aoff + m * 2048 + k * 1024); } while (0)
#define PG8_LDB(dst, b, h) do { _Pragma("unroll") for (int n = 0; n < 2; ++n) _Pragma("unroll") for (int k = 0; k < 2; ++k) dst[n][k] = *(const PG8_LAS bf16x8*)(lds + PG8_SB(b, h) + boff + n * 2048 + k * 1024); } while (0)
#define PG8_MMA(ai, bj, At, Bt) do { __builtin_amdgcn_s_setprio(1); _Pragma("unroll") for (int m = 0; m < 4; ++m) _Pragma("unroll") for (int n = 0; n < 2; ++n) _Pragma("unroll") for (int k = 0; k < 2; ++k) \
        acc[ai][bj][m][n] = __builtin_amdgcn_mfma_f32_16x16x32_bf16(Bt[n][k], At[m][k], acc[ai][bj][m][n], 0, 0, 0); __builtin_amdgcn_s_setprio(0); } while (0)
#define PG8_WAIT_V(n) asm volatile("s_waitcnt vmcnt(" #n ")" ::: "memory")
#define PG8_WAIT_L(n) asm volatile("s_waitcnt lgkmcnt(" #n ")" ::: "memory")
#define PG8_BAR __builtin_amdgcn_s_barrier()
#define PG8_SCHED __builtin_amdgcn_sched_barrier(0)
    Unit cur, nxt; int ui = 0;
    if (!S.next(0, cur)) return;
    f32x4 acc[2][2][4][2];
#pragma unroll
    for (int a = 0; a < 2; ++a)
#pragma unroll
        for (int b = 0; b < 2; ++b)
#pragma unroll
            for (int m = 0; m < 4; ++m)
#pragma unroll
                for (int n = 0; n < 2; ++n) acc[a][b][m][n] = (f32x4){0.f, 0.f, 0.f, 0.f};
    bf16x8 At[4][2], B0[2][2], B1[2][2];
    const char* cA = (const char*)g.A + (size_t)cur.pm * tstep; const char* cB = (const char*)g.Bt + (size_t)cur.pn * tstep;
    S.a_ready(cur);
    if constexpr (SP2) {
        PG8_STAGE(PG8_SB(0, 0), cB, voffB); PG8_STAGE(PG8_SB(0, 1), cB + hstep, voffB); PG8_STAGE(PG8_SA(0, 0), cA, voffA); PG8_STAGE(PG8_SA(0, 1), cA + hstep, voffA);
        if (wr == 1) PG8_BAR;
        PG8_WAIT_V(2); PG8_BAR;
        PG8_STAGE(PG8_SB(1, 0), cB + kstep, voffB); PG8_STAGE(PG8_SA(1, 0), cA + kstep, voffA); PG8_STAGE(PG8_SB(1, 1), cB + hstep + kstep, voffB);
        PG8_WAIT_V(6); PG8_BAR;
    } else {
        PG8_STAGE(PG8_SB(0, 0), cB, voffB); PG8_STAGE(PG8_SA(0, 0), cA, voffA); PG8_STAGE(PG8_SB(0, 1), cB + hstep, voffB); PG8_STAGE(PG8_SA(0, 1), cA + hstep, voffA);
        if (wr == 1) PG8_BAR;
        PG8_WAIT_V(4); PG8_BAR;
        PG8_STAGE(PG8_SB(1, 0), cB + kstep, voffB); PG8_STAGE(PG8_SA(1, 0), cA + kstep, voffA); PG8_STAGE(PG8_SB(1, 1), cB + hstep + kstep, voffB);
        PG8_WAIT_V(6); PG8_BAR;
    }
    for (;;) {
        const bool has_next = S.next(ui + 1, nxt);
        const char* nA = has_next ? (const char*)g.A + (size_t)nxt.pm * tstep : cA; const char* nB = has_next ? (const char*)g.Bt + (size_t)nxt.pn * tstep : cB;
        for (int t = 0; t < nt; t += 2) {
            const bool last = (t == nt - 2);
            const char* a1 = cA + (size_t)(t + 1) * kstep;
            const char* a2 = last ? nA : cA + (size_t)(t + 2) * kstep; const char* b2 = last ? nB : cB + (size_t)(t + 2) * kstep;
            const char* a3 = a2 + kstep; const char* b3 = b2 + kstep;
            if (last && has_next) S.a_ready(nxt);
            if constexpr (SP2) {
            PG8_LDB(B0, 0, 0); PG8_LDB(B1, 0, 1); PG8_SCHED; PG8_LDA(At, 0, 0); PG8_STAGE(PG8_SA(1, 1), a1 + hstep, voffA);
            PG8_WAIT_V(8); PG8_WAIT_L(0); PG8_BAR; PG8_MMA(0, 0, At, B0); PG8_MMA(0, 1, At, B1); PG8_BAR; PG8_SCHED;
            PG8_LDA(At, 0, 1); PG8_STAGE(PG8_SB(0, 0), b2, voffB); PG8_STAGE(PG8_SB(0, 1), b2 + hstep, voffB); PG8_STAGE(PG8_SA(0, 0), a2, voffA);
            PG8_WAIT_V(8); PG8_WAIT_L(0); PG8_BAR; PG8_MMA(1, 0, At, B0); PG8_MMA(1, 1, At, B1); PG8_BAR; PG8_SCHED;
            PG8_LDB(B0, 1, 0); PG8_LDB(B1, 1, 1); PG8_SCHED; PG8_LDA(At, 1, 0); PG8_STAGE(PG8_SA(0, 1), a2 + hstep, voffA);
            PG8_WAIT_V(8); PG8_WAIT_L(0); PG8_BAR; PG8_MMA(0, 0, At, B0); PG8_MMA(0, 1, At, B1); PG8_BAR; PG8_SCHED;
            PG8_LDA(At, 1, 1); PG8_STAGE(PG8_SB(1, 0), b3, voffB); PG8_STAGE(PG8_SB(1, 1), b3 + hstep, voffB); PG8_STAGE(PG8_SA(1, 0), a3, voffA);
            PG8_WAIT_V(8); PG8_WAIT_L(0); PG8_BAR; PG8_MMA(1, 0, At, B0); PG8_MMA(1, 1, At, B1); PG8_BAR; PG8_SCHED;
            } else {
            PG8_LDB(B0, 0, 0); PG8_SCHED; PG8_LDA(At, 0, 0); PG8_STAGE(PG8_SA(1, 1), a1 + hstep, voffA);
            PG8_WAIT_L(8); PG8_BAR; PG8_WAIT_L(0); PG8_MMA(0, 0, At, B0); PG8_BAR; PG8_SCHED;
            PG8_LDB(B1, 0, 1); PG8_STAGE(PG8_SB(0, 0), b2, voffB);
            PG8_BAR; PG8_WAIT_L(0); PG8_MMA(0, 1, At, B1); PG8_BAR;
            PG8_LDA(At, 0, 1); PG8_STAGE(PG8_SA(0, 0), a2, voffA);
            PG8_BAR; PG8_WAIT_L(0); PG8_MMA(1, 0, At, B0); PG8_BAR; PG8_SCHED;
            PG8_STAGE(PG8_SB(0, 1), b2 + hstep, voffB);
            PG8_WAIT_V(6); PG8_BAR; PG8_MMA(1, 1, At, B1); PG8_BAR;
            PG8_LDB(B0, 1, 0); PG8_SCHED; PG8_LDA(At, 1, 0); PG8_STAGE(PG8_SA(0, 1), a2 + hstep, voffA);
            PG8_WAIT_L(8); PG8_BAR; PG8_WAIT_L(0); PG8_MMA(0, 0, At, B0); PG8_BAR; PG8_SCHED;
            PG8_LDB(B1, 1, 1); PG8_STAGE(PG8_SB(1, 0), b3, voffB);
            PG8_BAR; PG8_WAIT_L(0); PG8_MMA(0, 1, At, B1); PG8_BAR;
            PG8_LDA(At, 1, 1); PG8_STAGE(PG8_SA(1, 0), a3, voffA);
            PG8_BAR; PG8_WAIT_L(0); PG8_MMA(1, 0, At, B0); PG8_BAR; PG8_SCHED;
            PG8_STAGE(PG8_SB(1, 1), b3 + hstep, voffB);
            PG8_WAIT_V(6); PG8_BAR; PG8_MMA(1, 1, At, B1); PG8_BAR;
            }
        }
        if constexpr (ALIGN_EPI) { if (wr == 0) PG8_BAR; }
        if constexpr (!Epi::AFTER_DRAIN) { E(acc, cur, wr, wc, fr, fq); S.done(cur); }
        if (!has_next) break;
#pragma unroll
        for (int a = 0; a < 2; ++a)
#pragma unroll
            for (int b = 0; b < 2; ++b)
#pragma unroll
                for (int m = 0; m < 4; ++m)
#pragma unroll
                    for (int n = 0; n < 2; ++n) acc[a][b][m][n] = (f32x4){0.f, 0.f, 0.f, 0.f};
        cur = nxt; cA = nA; cB = nB; ++ui;
        if constexpr (ALIGN_EPI) { if (wr == 1) PG8_BAR; }
    }
    PG8_WAIT_V(0);
    if constexpr (!ALIGN_EPI) { if (wr == 0) PG8_BAR; }
    PG8_BAR;
    if constexpr (Epi::AFTER_DRAIN) { E.fused(acc, cur, wr, wc, fr, fq, lds, wid, lane); S.done(cur); }
#undef PG8_SA
#undef PG8_SB
#undef PG8_STAGE
#undef PG8_LDA
#undef PG8_LDB
#undef PG8_MMA
#undef PG8_WAIT_V
#undef PG8_WAIT_L
#undef PG8_BAR
#undef PG8_SCHED
}
}
constexpr int NWAVES = 8;
constexpr int DM = 1024, NTOK = 49152, TPR = 32768, SEQP = 4096, SEQS = 8192, NBP = 8, NBS = 2, NIN = 3072, PLED = 256;
constexpr float LOG2E = 1.4426950408889634f;
constexpr float QSCALE = 0.125f * LOG2E;
constexpr size_t MiB = 1u << 20;
constexpr size_t WS_CTL = 0, CTL_ZERO_BYTES = 64 * 1024;
constexpr size_t WS_TAB = 1 * MiB;
constexpr size_t WS_WIN = 2 * MiB;
constexpr size_t WS_WOUT = 8 * MiB;
constexpr size_t WS_WG = 10 * MiB;
constexpr size_t WS_WP = 12 * MiB;
constexpr size_t WS_GT = 12 * MiB + 512 * 1024;
constexpr size_t WS_H1A = 13 * MiB + 512 * 1024;
constexpr size_t WS_H1B = WS_H1A + 64 * 1024;
constexpr size_t WS_M2A = 14 * MiB;
constexpr size_t WS_M2B = 15 * MiB + 256 * 1024;
constexpr size_t WS_SSQ1 = 18 * MiB, WS_SSQ2 = 21 * MiB;
constexpr size_t WS_XN = 24 * MiB;
constexpr size_t WS_QU = 120 * MiB;
constexpr size_t WS_K = 216 * MiB, WS_V = 264 * MiB;
constexpr size_t WS_GA = 312 * MiB, WS_GF = 360 * MiB;
constexpr size_t WS_PROJ = 408 * MiB;
constexpr size_t WS_END = 504 * MiB;
static_assert(WS_M2A + 33 * 32768 <= WS_M2B && WS_M2B + 65 * 32768 <= WS_SSQ1 && WS_SSQ2 + (size_t)NTOK * 64 <= WS_XN, "d_ws map");
constexpr int RING_BYTES = 131072, LDSCTL_OFF = RING_BYTES, MISC_OFF = LDSCTL_OFF + 320, LDS_BYTES = 147456;
#define GAS __attribute__((address_space(1)))
#define LAS __attribute__((address_space(3)))
typedef unsigned short bf16;
typedef unsigned v4u __attribute__((ext_vector_type(4)));
typedef unsigned v2u __attribute__((ext_vector_type(2)));
typedef float f32x4 __attribute__((ext_vector_type(4)));
typedef short bf16x8 __attribute__((ext_vector_type(8)));
#define LDS_WAIT() asm volatile("s_waitcnt lgkmcnt(0)" ::: "memory")
#define VM_WAIT() asm volatile("s_waitcnt vmcnt(0)" ::: "memory")
__device__ __forceinline__ unsigned f2bf(float f) { unsigned u = __builtin_bit_cast(unsigned, f); return (u + 0x7fffu + ((u >> 16) & 1u)) >> 16; }
__device__ __forceinline__ unsigned pk2(float lo, float hi) { return f2bf(lo) | (f2bf(hi) << 16); }
#define XB_TMO      128
#define XB_XCNT(j)  (256  + 64 * (j))
#define XB_XSUB(j)  (1280 + 64 * (j))
#define XB_XGEN(j)  (2304 + 64 * (j))
#define XB_TOP      3328
#define XB_TOPGEN   3392
#define XCD_BAR_WORDS 3456
#define XB_SPIN_CAP (1u << 18)

__device__ __forceinline__ unsigned xb_ld(unsigned* p)              { return __hip_atomic_load(p, __ATOMIC_RELAXED, __HIP_MEMORY_SCOPE_AGENT); }
__device__ __forceinline__ unsigned xb_add(unsigned* p, unsigned v) { return __hip_atomic_fetch_add(p, v, __ATOMIC_RELAXED, __HIP_MEMORY_SCOPE_AGENT); }
__device__ __forceinline__ unsigned xb_xcc_id() { return (unsigned)__builtin_amdgcn_s_getreg((3 << 11) | 20) & 0xFu; }
#define XB_SPIN(cond, bar) do { unsigned _sp = 0; while (cond) { __builtin_amdgcn_s_sleep(1); \
    if ((++_sp & 255u) == 0u) { if (xb_ld(&(bar)[XB_TMO])) break; if (_sp > XB_SPIN_CAP) { atomicAdd(&(bar)[XB_TMO], 1u); break; } } } } while (0)

struct XcdBarrier {
    unsigned* bar; unsigned x;
    volatile LAS unsigned* st;
};

__device__ __forceinline__ XcdBarrier xcd_barrier_post(unsigned* bar, volatile LAS unsigned* st) {
    XcdBarrier b; b.bar = bar; b.x = xb_xcc_id(); b.st = st;
    if (threadIdx.x == 0) (void)xb_add(&bar[XB_XCNT(b.x)], 1u);
    return b;
}
__device__ __forceinline__ void xcd_barrier_complete(unsigned* bar, unsigned x, unsigned& nloc, unsigned& nx) {
    const unsigned G = gridDim.x * gridDim.y * gridDim.z;
    unsigned sum, cnt, mine, sp = 0u;
    for (;;) {
        sum = 0u; cnt = 0u; mine = 0u;
#pragma unroll
        for (unsigned j = 0; j < 16; ++j) { const unsigned c = xb_ld(&bar[XB_XCNT(j)]); sum += c; cnt += (c > 0u) ? 1u : 0u; mine = (j == x) ? c : mine; }
        if (sum == G) break;
        __builtin_amdgcn_s_sleep(1);
        if ((++sp & 255u) == 0u) { if (xb_ld(&bar[XB_TMO])) break; if (sp > XB_SPIN_CAP) { atomicAdd(&bar[XB_TMO], 1u); break; } }
    }
    nloc = mine > 0u ? mine : 1u; nx = cnt > 0u ? cnt : 1u;
}

__device__ __forceinline__ void xcd_barrier(const XcdBarrier& b) {
    asm volatile("s_waitcnt vmcnt(0)" ::: "memory");
    __syncthreads();
    if (threadIdx.x == 0) {
        unsigned* bar = b.bar;
        __builtin_amdgcn_s_waitcnt(0);
        unsigned nloc = b.st[0], nx = b.st[1];
        if (nloc == 0u) { xcd_barrier_complete(bar, b.x, nloc, nx); b.st[0] = nloc; b.st[1] = nx; }
        const unsigned old = xb_add(&bar[XB_XSUB(b.x)], 1u);
        const unsigned gen = old / nloc;
        if (old + 1u == (gen + 1u) * nloc) {
            __builtin_amdgcn_fence(__ATOMIC_RELEASE, "agent");
            asm volatile("s_waitcnt vmcnt(0)" ::: "memory");
            const unsigned og = xb_add(&bar[XB_TOP], 1u);
            const unsigned tg = og / nx;
            if (og + 1u == (tg + 1u) * nx) xb_add(&bar[XB_TOPGEN], 1u);
            else XB_SPIN(xb_ld(&bar[XB_TOPGEN]) == tg, bar);
            __builtin_amdgcn_fence(__ATOMIC_ACQUIRE, "agent");
            xb_add(&bar[XB_XGEN(b.x)], 1u);
            asm volatile("s_waitcnt vmcnt(0)" ::: "memory");
        } else {
            XB_SPIN(xb_ld(&bar[XB_XGEN(b.x)]) == gen, bar);
            __builtin_amdgcn_fence(__ATOMIC_ACQUIRE, "agent");
            asm volatile("s_waitcnt vmcnt(0)" ::: "memory");
        }
    }
    __syncthreads();
}
namespace att {
typedef unsigned short bf16_t;
typedef short bf16x8 __attribute__((ext_vector_type(8)));
typedef short s16x4 __attribute__((ext_vector_type(4)));
typedef float f32x16 __attribute__((ext_vector_type(16)));
typedef float f32x4 __attribute__((ext_vector_type(4)));
typedef unsigned u32x4 __attribute__((ext_vector_type(4)));
#define ATT_LAS __attribute__((address_space(3)))
constexpr int KVBLK = 64, SHM_V = 16384, SHM_K = 16384;
constexpr int OFF_V = 0, OFF_K = 2 * SHM_V, OFF_WS = OFF_K + 2 * SHM_K, OFF_TAB = OFF_WS + 8 * 256, ATT_LDS_END = OFF_TAB + 1024;
constexpr float THR2 = 11.5f;
#define KSWZ(row, colB) ((row) * 256 + ((colB) ^ (((row) & 7) << 4)))
#define SBAR() __builtin_amdgcn_sched_barrier(0)
__device__ __forceinline__ int crow(int r, int hi) { return (r & 3) + 8 * (r >> 2) + 4 * hi; }
__device__ __forceinline__ unsigned cvtpk(float lo, float hi) { unsigned r; asm volatile("v_cvt_pk_bf16_f32 %0, %1, %2" : "=v"(r) : "v"(lo), "v"(hi)); return r; }
__device__ __forceinline__ float bflo(unsigned w) { return __uint_as_float(w << 16); }
__device__ __forceinline__ float bfhi(unsigned w) { return __uint_as_float(w & 0xffff0000u); }
__device__ __forceinline__ float silu(float a) { return a * __builtin_amdgcn_rcpf(1.f + __expf(-a)); }

template <bool NEAR>
__device__ __forceinline__ void partialSM(f32x16& p0, f32x16& p1, float& m_reg, float& mn, float& alpha, float bl2, const ATT_LAS float* tab, int idx0, int hi) {
  if (NEAR) {
#pragma unroll
    for (int r = 0; r < 16; ++r) { const int i0 = idx0 + crow(r, hi); const int a = min(max(i0, 0), 255), b = min(max(i0 + 32, 0), 255); p0[r] += tab[a]; p1[r] += tab[b]; }
  }
  float pmax = p0[0];
#pragma unroll
  for (int r = 1; r < 16; ++r) pmax = fmaxf(pmax, p0[r]);
#pragma unroll
  for (int r = 0; r < 16; ++r) pmax = fmaxf(pmax, p1[r]);
  { auto rr = __builtin_amdgcn_permlane32_swap(__float_as_uint(pmax), __float_as_uint(pmax), false, false);
    pmax = fmaxf(__uint_as_float(rr[0]), __uint_as_float(rr[1])); }
  if (!NEAR) pmax += bl2;
  if (__builtin_expect(__all(pmax - m_reg <= THR2), 1)) { mn = m_reg; alpha = 1.f; }
  else { mn = fmaxf(m_reg, pmax); alpha = __builtin_amdgcn_exp2f(m_reg - mn); m_reg = mn; }
  const float sh = (NEAR ? 0.f : bl2) - mn;
#pragma unroll
  for (int r = 0; r < 16; ++r) { p0[r] += sh; p1[r] += sh; }
#pragma unroll
  for (int r = 0; r < 16; ++r) p0[r] = __builtin_amdgcn_exp2f(p0[r]);
}
__device__ __forceinline__ void finishSM(f32x16& p0, f32x16& p1, float alpha, float& l_reg, bf16x8& pa0, bf16x8& pa1, bf16x8& pa2, bf16x8& pa3) {
#pragma unroll
  for (int r = 0; r < 16; ++r) p1[r] = __builtin_amdgcn_exp2f(p1[r]);
  float ps = 0;
#pragma unroll
  for (int r = 0; r < 16; ++r) ps += p0[r];
#pragma unroll
  for (int r = 0; r < 16; ++r) ps += p1[r];
  { auto rr = __builtin_amdgcn_permlane32_swap(__float_as_uint(ps), __float_as_uint(ps), false, false);
    ps = __uint_as_float(rr[0]) + __uint_as_float(rr[1]); }
  l_reg = l_reg * alpha + ps;
#define PK4(P, BASE, OUT) do { unsigned a0 = cvtpk(P[BASE + 0], P[BASE + 1]), a1 = cvtpk(P[BASE + 2], P[BASE + 3]);   \
    unsigned b0 = cvtpk(P[BASE + 4], P[BASE + 5]), b1 = cvtpk(P[BASE + 6], P[BASE + 7]);                              \
    auto r0 = __builtin_amdgcn_permlane32_swap(a0, b0, false, false); auto r1 = __builtin_amdgcn_permlane32_swap(a1, b1, false, false); \
    u32x4 w = {r0[0], r1[0], r0[1], r1[1]}; OUT = *reinterpret_cast<bf16x8*>(&w); } while (0)
  PK4(p0, 0, pa0); PK4(p0, 8, pa1); PK4(p1, 0, pa2); PK4(p1, 8, pa3);
#undef PK4
}
__device__ __forceinline__ void qkt(f32x16& p0, f32x16& p1, const char* Ks, const bf16x8* qr, int r32, int hi, int comp) {
  p0 = f32x16{}; p1 = f32x16{};
#pragma unroll
  for (int d0 = 0; d0 < 4; ++d0) { const int cb = ((comp * 4 + d0) * 16 + hi * 8) * 2;
    bf16x8 b0 = *reinterpret_cast<const bf16x8*>(Ks + KSWZ(r32, cb));
    bf16x8 b1 = *reinterpret_cast<const bf16x8*>(Ks + KSWZ(32 + r32, cb));
    p0 = __builtin_amdgcn_mfma_f32_32x32x16_bf16(b0, qr[d0], p0, 0, 0, 0);
    p1 = __builtin_amdgcn_mfma_f32_32x32x16_bf16(b1, qr[d0], p1, 0, 0, 0); }
}
__device__ __forceinline__ int v_st(int k, int c) { const int kk = (k & ~0xC) | ((k & 4) << 1) | ((k & 8) >> 1); return ((kk >> 3) * 4 + (c >> 5)) * 512 + ((kk & 7) * 32 + (c & 31)) * 2; }
__device__ __forceinline__ int v_rd_base(int lane) { return ((lane & 3) << 3) | (((lane >> 2) & 3) << 6) | (((lane >> 4) & 1) << 5) | (((lane >> 5) & 1) << 8); }
constexpr int v_rd_off(int d0, int ks, int half) { return d0 * 512 + ks * 4096 + half * 2048; }
template <int OFF> __device__ __forceinline__ s16x4 tr_read(int vb) {
  s16x4 r; asm volatile("ds_read_b64_tr_b16 %0, %1 offset:%2" : "=&v"(r) : "v"(vb), "i"(OFF) : "memory"); return r;
}
template <int D0> __device__ __forceinline__ void pv_one(f32x16& od, int vb, bf16x8 pa0, bf16x8 pa1, bf16x8 pa2, bf16x8 pa3) {
  const s16x4 l0 = tr_read<v_rd_off(D0, 0, 0)>(vb), h0 = tr_read<v_rd_off(D0, 0, 1)>(vb), l1 = tr_read<v_rd_off(D0, 1, 0)>(vb), h1 = tr_read<v_rd_off(D0, 1, 1)>(vb);
  const s16x4 l2 = tr_read<v_rd_off(D0, 2, 0)>(vb), h2 = tr_read<v_rd_off(D0, 2, 1)>(vb), l3 = tr_read<v_rd_off(D0, 3, 0)>(vb), h3 = tr_read<v_rd_off(D0, 3, 1)>(vb);
  asm volatile("s_waitcnt lgkmcnt(0)" ::: "memory"); SBAR();
#define PK(L, H) (bf16x8){L[0], L[1], L[2], L[3], H[0], H[1], H[2], H[3]}
  od = __builtin_amdgcn_mfma_f32_32x32x16_bf16(pa0, PK(l0, h0), od, 0, 0, 0);
  od = __builtin_amdgcn_mfma_f32_32x32x16_bf16(pa1, PK(l1, h1), od, 0, 0, 0);
  od = __builtin_amdgcn_mfma_f32_32x32x16_bf16(pa2, PK(l2, h2), od, 0, 0, 0);
  od = __builtin_amdgcn_mfma_f32_32x32x16_bf16(pa3, PK(l3, h3), od, 0, 0, 0);
#undef PK
}
__device__ __forceinline__ void pv_d0(f32x16* o, int vb, bf16x8 pa0, bf16x8 pa1, bf16x8 pa2, bf16x8 pa3) {
  pv_one<0>(o[0], vb, pa0, pa1, pa2, pa3); pv_one<1>(o[1], vb, pa0, pa1, pa2, pa3); pv_one<2>(o[2], vb, pa0, pa1, pa2, pa3); pv_one<3>(o[3], vb, pa0, pa1, pa2, pa3);
}

__device__ __forceinline__ void attn_unit(bf16_t* QU, const bf16_t* __restrict__ KB, const bf16_t* __restrict__ VB, const bf16_t* __restrict__ GA,
                                          const float* __restrict__ tabg, const float* __restrict__ subg, float lam, int tok0, int seq, int h, int q0, char* lds, const int wave_) {
  const int tid = opq_tid(wave_), lane = tid & 63, r32 = lane & 31, hi = lane >> 5; const int wid = __builtin_amdgcn_readfirstlane(tid >> 6);
  const int comp = wid >> 2, rb = wid & 3;
  char* V_lds = lds + OFF_V; char* K_lds = lds + OFF_K;
  float* wsf = (float*)(lds + OFF_WS) + wid * 64; float* li_l = wsf; float* al_l = wsf + 32;
  const ATT_LAS float* tab = (const ATT_LAS float*)(ATT_LAS char*)(lds + OFF_TAB);
  if (tid < 256) ((float*)(lds + OFF_TAB))[tid] = tabg[h * 256 + tid];
  float m_reg = -1e30f, l_reg = 0; f32x16 o[4] = {}; bf16x8 qr[4];
  const bf16_t* Qw = QU + (size_t)(tok0 + q0 + rb * 32 + r32) * 1024 + h * 128 + comp * 64 + hi * 8;
#pragma unroll
  for (int d0 = 0; d0 < 4; ++d0) qr[d0] = *reinterpret_cast<const bf16x8*>(Qw + d0 * 16);
  const bf16_t* Kh = KB + (size_t)tok0 * 512 + h * 128; const bf16_t* Vh = VB + (size_t)tok0 * 512 + h * 128;
  const int sr = tid >> 4, sc = (tid & 15) * 8, vst0 = v_st(sr, sc), vst1 = v_st(32 + sr, sc);
  const int vb0 = (int)(uintptr_t)V_lds + v_rd_base(lane);
  const int qw0 = q0 + rb * 32, qpos = qw0 + r32;
  struct { bf16x8 vs0, vs1, ks0, ks1; } sr_[2];
#define LD8(p) (*reinterpret_cast<const bf16x8*>(p))
#define SLOAD(i, k0) do { sr_[i].vs0 = LD8(&Vh[(size_t)((k0) + sr) * 512 + sc]); sr_[i].vs1 = LD8(&Vh[(size_t)((k0) + 32 + sr) * 512 + sc]); \
    sr_[i].ks0 = LD8(&Kh[(size_t)((k0) + sr) * 512 + sc]); sr_[i].ks1 = LD8(&Kh[(size_t)((k0) + 32 + sr) * 512 + sc]); } while (0)
#define SWRITE(b, i) do { *(bf16x8*)(V_lds + (b) * SHM_V + vst0) = sr_[i].vs0;          \
    *(bf16x8*)(V_lds + (b) * SHM_V + vst1) = sr_[i].vs1; int kc = sc * 2;               \
    *(bf16x8*)(K_lds + (b) * SHM_K + KSWZ(sr, kc)) = sr_[i].ks0;                       \
    *(bf16x8*)(K_lds + (b) * SHM_K + KSWZ(32 + sr, kc)) = sr_[i].ks1; } while (0)
#define SWAIT() asm volatile("s_waitcnt vmcnt(4)" ::: "memory")
#define RESC(a) do { if (__any((a) < 1.f)) { if (hi == 0) al_l[r32] = (a); asm volatile("s_waitcnt lgkmcnt(0)" ::: "memory"); \
    _Pragma("unroll") for (int d = 0; d < 4; ++d) _Pragma("unroll") for (int r = 0; r < 16; ++r) o[d][r] *= al_l[crow(r, hi)]; } } while (0)
#define PSM(P0, P1, MN, AL, k0) do { const int lo_ = (k0) - qw0 - 31, hi_ = (k0) + 63 - qw0; \
    if (hi_ <= -91) partialSM<false>(P0, P1, m_reg, MN, AL, tabL, tab, 0, hi); \
    else if (lo_ >= 91) partialSM<false>(P0, P1, m_reg, MN, AL, tabR, tab, 0, hi); \
    else partialSM<true>(P0, P1, m_reg, MN, AL, 0.f, tab, (k0) - qpos + 128, hi); } while (0)
  f32x16 pA0, pA1, pB0, pB1; float mnA, mnB, alA, alB; bf16x8 pa0, pa1, pa2, pa3; const int NT = seq / KVBLK;
  constexpr int SE = 0, SO = 1;
  SLOAD(SE, 0); asm volatile("s_waitcnt vmcnt(0)" ::: "memory"); SWRITE(0, SE); __syncthreads();
  const float tabL = tab[0], tabR = tab[255];
  qkt(pA0, pA1, K_lds, qr, r32, hi, comp); PSM(pA0, pA1, mnA, alA, 0);
  SLOAD(SO, KVBLK); if (2 < NT) SLOAD(SE, 2 * KVBLK);
  SWAIT(); SWRITE(1, SO); __syncthreads();
  for (int j = 1; j + 1 < NT; j += 2) {
    SBAR(); qkt(pB0, pB1, K_lds + SHM_K, qr, r32, hi, comp);
    finishSM(pA0, pA1, alA, l_reg, pa0, pa1, pa2, pa3); SBAR();
    SLOAD(SO, (j + 2) * KVBLK); SBAR();
    pv_d0(o, vb0, pa0, pa1, pa2, pa3); PSM(pB0, pB1, mnB, alB, j * KVBLK);
    __syncthreads(); SWAIT(); SWRITE(0, SE);
    RESC(alB); __syncthreads();
    SBAR(); qkt(pA0, pA1, K_lds, qr, r32, hi, comp);
    finishSM(pB0, pB1, alB, l_reg, pa0, pa1, pa2, pa3); SBAR();
    if (j + 3 < NT) SLOAD(SE, (j + 3) * KVBLK); SBAR();
    pv_d0(o, vb0 + SHM_V, pa0, pa1, pa2, pa3); PSM(pA0, pA1, mnA, alA, (j + 1) * KVBLK);
    __syncthreads(); SWAIT(); SWRITE(1, SO);
    RESC(alA); __syncthreads();
  }
  SBAR(); qkt(pB0, pB1, K_lds + SHM_K, qr, r32, hi, comp);
  finishSM(pA0, pA1, alA, l_reg, pa0, pa1, pa2, pa3); SBAR();
  pv_d0(o, vb0, pa0, pa1, pa2, pa3); PSM(pB0, pB1, mnB, alB, (NT - 1) * KVBLK);
  __syncthreads(); RESC(alB);
  finishSM(pB0, pB1, alB, l_reg, pa0, pa1, pa2, pa3); SBAR();
  pv_d0(o, vb0 + SHM_V, pa0, pa1, pa2, pa3);
  if (hi == 0) li_l[r32] = l_reg; asm volatile("s_waitcnt lgkmcnt(0)" ::: "memory");
  float rli[16];
#pragma unroll
  for (int r = 0; r < 16; ++r) rli[r] = __builtin_amdgcn_rcpf(li_l[crow(r, hi)]);
  __syncthreads();
  float* OC = (float*)lds;
  if (comp == 0) {
#pragma unroll
    for (int r = 0; r < 16; ++r) { const int orow = rb * 32 + crow(r, hi);
#pragma unroll
      for (int d0 = 0; d0 < 4; ++d0) OC[orow * 128 + d0 * 32 + r32] = o[d0][r] * rli[r]; }
  }
  __syncthreads();
  if (comp == 1) {
#pragma unroll
    for (int r = 0; r < 16; ++r) { const int orow = rb * 32 + crow(r, hi); const float s = lam * rli[r];
#pragma unroll
      for (int d0 = 0; d0 < 4; ++d0) OC[orow * 128 + d0 * 32 + r32] -= o[d0][r] * s; }
  }
  __syncthreads();
  { const int row = tid >> 2, qt = tid & 3; const float* rp = OC + row * 128 + qt * 32;
    f32x4 v[8]; float ss = 0.f;
#pragma unroll
    for (int i = 0; i < 8; ++i) { v[i] = *(const f32x4*)(rp + 4 * i); ss += (v[i][0] * v[i][0] + v[i][1] * v[i][1]) + (v[i][2] * v[i][2] + v[i][3] * v[i][3]); }
    ss += bperm_f(lane ^ 1, ss); ss += bperm_f(lane ^ 2, ss);
    const float rstd = __builtin_amdgcn_rsqf(ss * (1.f / 128.f) + 1e-5f) * 0.8f;
    const size_t t = (size_t)(tok0 + q0 + row); const bf16_t* gp = GA + t * 512 + h * 128 + qt * 32; bf16_t* op = QU + t * 1024 + h * 128 + qt * 32; const float* sg = subg + qt * 32;
#pragma unroll
    for (int i = 0; i < 4; ++i) { const u32x4 g = *(const u32x4*)(gp + 8 * i); const f32x4 s0 = *(const f32x4*)(sg + 8 * i), s1 = *(const f32x4*)(sg + 8 * i + 4);
      const f32x4 a = v[2 * i] * rstd * s0, b = v[2 * i + 1] * rstd * s1; u32x4 w;
      w.x = cvtpk(a[0] * silu(bflo(g.x)), a[1] * silu(bfhi(g.x))); w.y = cvtpk(a[2] * silu(bflo(g.y)), a[3] * silu(bfhi(g.y)));
      w.z = cvtpk(b[0] * silu(bflo(g.z)), b[1] * silu(bfhi(g.z))); w.w = cvtpk(b[2] * silu(bflo(g.w)), b[3] * silu(bfhi(g.w)));
      *(u32x4*)(op + 8 * i) = w; }
  }
  __syncthreads();
#undef LD8
#undef SLOAD
#undef SWRITE
#undef SWAIT
#undef RESC
#undef PSM
}
#undef KSWZ
#undef SBAR
}
struct Frame {
    LAS unsigned char* lds;
    volatile LAS unsigned* MISC;
    unsigned* ctl;
    int wave;
    int vcu, G;
};
__device__ __forceinline__ float wave_sum(float v, int lane) {
#pragma unroll
    for (int o = 1; o < 64; o <<= 1) v += bperm_f(lane ^ o, v);
    return v;
}
__device__ __forceinline__ void p0_transpose_item(const float* W, int K, int N, bf16* WT, const float* kscale, LAS float* scr, int item, int lane) {
    const int nblk = N / 32, kb = item / nblk, nb = item % nblk, k0 = 64 * kb, n0 = 32 * nb;
#pragma unroll 8
    for (int i = 0; i < 32; ++i) { const int kk = 2 * i + (lane >> 5); float w = W[(size_t)(k0 + kk) * N + n0 + (lane & 31)]; if (kscale) w *= kscale[k0 + kk]; scr[kk * 33 + (lane & 31)] = w; }
    LDS_WAIT(); asm volatile("" ::: "memory");
    const int c = lane & 7;
#pragma unroll
    for (int j = 0; j < 4; ++j) { const int n = (lane >> 3) + 8 * j; const LAS float* s = scr + (8 * c) * 33 + n;
        v4u o; o.x = pk2(s[0 * 33], s[1 * 33]); o.y = pk2(s[2 * 33], s[3 * 33]); o.z = pk2(s[4 * 33], s[5 * 33]); o.w = pk2(s[6 * 33], s[7 * 33]);
        *(GAS v4u*)(WT + (size_t)(n0 + n) * K + k0 + 8 * c) = o; }
    LDS_WAIT(); asm volatile("" ::: "memory");
}
__device__ __forceinline__ void rms_row_to_bf16(const float* xrow, const float* g, bf16* orow, int lane) {
    const GAS f32x4* xr = (const GAS f32x4*)xrow + lane; const GAS f32x4* gr = (const GAS f32x4*)g + lane;
    f32x4 v[4]; float s = 0.f;
#pragma unroll
    for (int j = 0; j < 4; ++j) { v[j] = xr[64 * j]; s += (v[j].x * v[j].x + v[j].y * v[j].y) + (v[j].z * v[j].z + v[j].w * v[j].w); }
    const float r = __builtin_amdgcn_rsqf(wave_sum(s, lane) * (1.f / 1024.f) + 1e-6f);
    GAS unsigned long long* o8 = (GAS unsigned long long*)orow + lane;
#pragma unroll
    for (int j = 0; j < 4; ++j) { const f32x4 gg = gr[64 * j]; o8[64 * j] = (unsigned long long)pk2(v[j].x * r * gg.x, v[j].y * r * gg.y) | ((unsigned long long)pk2(v[j].z * r * gg.z, v[j].w * r * gg.w) << 32); }
}
__device__ __forceinline__ int t5_bucket(int rel) {
    const int n = rel < 0 ? -rel : rel; int b;
    if (n < 8) b = n; else b = 8 + (n >= 12) + (n >= 16) + (n >= 23) + (n >= 32) + (n >= 46) + (n >= 64) + (n >= 91);
    return b + (rel > 0 ? 16 : 0);
}
struct Args { const float* in[15]; float* out; unsigned char* ws; };
__device__ __forceinline__ void p0_prologue(Frame& F, const Args& a) {
    const int tid_ = opq_tid(F.wave), lane_ = tid_ & 63;
    const float* xp = a.in[0]; const float* xs = a.in[1]; const float* pp = a.in[2]; const float* ps = a.in[3]; const float* g_mix = a.in[4]; const float* w_in = a.in[5];
    const float* lamp = a.in[6]; const float* relb = a.in[8]; const float* wf = a.in[9]; const float* w_out = a.in[10]; const float* g_ple = a.in[11];
    const float* w_gate = a.in[12]; const float* w_proj = a.in[13];
    unsigned char* ws = a.ws;
    LAS float* scr = (LAS float*)(F.lds + F.wave * 16384);
    const int gw = F.vcu * NWAVES + F.wave, NGW = F.G * NWAVES;
    constexpr int I_IN = (DM / 64) * (NIN / 32), I_SQ = (DM / 64) * (DM / 32), I_P = (PLED / 64) * (DM / 32);
    for (int it = gw; it < I_IN + 2 * I_SQ + I_P; it += NGW) {
        int r = it;
        if (r < I_IN) { p0_transpose_item(w_in, DM, NIN, (bf16*)(ws + WS_WIN), nullptr, scr, r, lane_); continue; } r -= I_IN;
        if (r < I_SQ) { p0_transpose_item(w_out, DM, DM, (bf16*)(ws + WS_WOUT), nullptr, scr, r, lane_); continue; } r -= I_SQ;
        if (r < I_SQ) { p0_transpose_item(w_gate, DM, DM, (bf16*)(ws + WS_WG), g_ple, scr, r, lane_); continue; } r -= I_SQ;
        p0_transpose_item(w_proj, PLED, DM, (bf16*)(ws + WS_WP), nullptr, scr, r, lane_);
    }
    for (int m = gw; m < NTOK; m += NGW) { const float* xrow = m < TPR ? xp + (size_t)m * DM : xs + (size_t)(m - TPR) * DM; rms_row_to_bf16(xrow, g_mix, (bf16*)(ws + WS_XN) + (size_t)m * DM, lane_); }
    const int gt = F.vcu * (NWAVES * 64) + tid_, NGT = F.G * NWAVES * 64;
    { bf16* PB = (bf16*)a.out;
      for (int i = gt; i < NTOK * (PLED / 8); i += NGT) { const int row = i >> 5, c8 = (i & 31) * 8; const float* src = (row < TPR ? pp + (size_t)row * PLED : ps + (size_t)(row - TPR) * PLED) + c8;
          const f32x4 v0 = *(const f32x4*)src, v1 = *(const f32x4*)(src + 4); v4u o; o.x = pk2(v0.x, v0.y); o.y = pk2(v0.z, v0.w); o.z = pk2(v1.x, v1.y); o.w = pk2(v1.z, v1.w);
          *(v4u*)(PB + (size_t)row * PLED + c8) = o; } }
    { constexpr int E_H1A = 64 * 64, E_H1B = 128 * 128, E_M2A = 33 * 16384, E_M2B = 65 * 16384;
      for (int i = gt; i < E_H1A + E_H1B + E_M2A + E_M2B; i += NGT) {
          int e = i; float val; bf16* dst;
          if (e < E_H1A + E_H1B) {
              int N1, r, s1; if (e < E_H1A) { N1 = 64; r = e >> 6; s1 = e & 63; dst = (bf16*)(ws + WS_H1A) + e; } else { e -= E_H1A; N1 = 128; r = e >> 7; s1 = e & 127; dst = (bf16*)(ws + WS_H1B) + e; }
              if (r == 0) val = 1.f; else if (r == 1) val = (s1 & 1) ? -1.f : 1.f;
              else { const int k = r >> 1, j = (k * s1) & (N1 - 1); const float x = 2.f * (float)j / (float)N1; val = (r & 1) ? -sinpif(x) : cospif(x); }
          } else {
              e -= E_H1A + E_H1B; int S, N1; float norm;
              if (e < E_M2A) { S = 4096; N1 = 64; norm = 0.0013810679320049757f; dst = (bf16*)(ws + WS_M2A) + e; } else { e -= E_M2A; S = 8192; N1 = 128; norm = 0.0009765625f; dst = (bf16*)(ws + WS_M2B) + e; }
              const int kt = e >> 14, m = (e >> 7) & 127, kp = e & 127, ro = m >> 6, k2 = m & 63, ri = kp >> 6, s2 = kp & 63;
              const int sp = kt + N1 * k2, j = (s2 * sp) & (S - 1); const float x = 2.f * (float)j / (float)S; const float c = cospif(x), s = sinpif(x);
              if (kt == 0) val = (ri == 0) ? (ro == 0 ? c : -s) : 0.f;
              else if (kt == N1 / 2) val = (ri == 1) ? (ro == 0 ? c : -s) : 0.f;
              else val = (ro == ri) ? c : (ro == 0 ? s : -s);
              val *= norm;
          }
          *dst = (bf16)f2bf(val);
      } }
    { bf16* Gt = (bf16*)(ws + WS_GT);
      for (int i = gt; i < 512 * 1024 / 8; i += NGT) { const int n = i >> 7, k8 = (i & 127) * 8; if ((k8 >> 8) != (n >> 7)) *(v4u*)(Gt + (size_t)n * 1024 + k8) = (v4u){0u, 0u, 0u, 0u}; }
      for (int i = gt; i < 4 * 256 * 128; i += NGT) { const int g = i >> 15, kk = (i >> 7) & 255, d = i & 127, ri = kk >> 7, c = kk & 127; float acc = 0.f;
          for (int cp = 0; cp < 128; ++cp) { const int j = (c * cp) & 127; const float x = (float)j * (1.f / 64.f); const float t = ri ? sinpif(x) : cospif(x); acc += t * wf[(size_t)(g * 128 + cp) * 128 + d]; }
          Gt[(size_t)(g * 128 + d) * 1024 + g * 256 + kk] = (bf16)f2bf(acc); } }
    if (F.vcu == 0) {
        float* tab = (float*)(ws + WS_TAB);
        for (int i = tid_; i < 1024; i += NWAVES * 64) { const int h = i >> 8, rel = (i & 255) - 128; tab[i] = relb[t5_bucket(rel) * 4 + h] * LOG2E; }
        if (tid_ == 0) { float s01 = 0.f, s23 = 0.f; for (int d = 0; d < 64; ++d) { s01 += lamp[d] * lamp[64 + d]; s23 += lamp[128 + d] * lamp[192 + d]; }
            tab[1024] = __expf(s01) - __expf(s23) + 0.2f; }
    }
}
template <int MK>
__device__ __forceinline__ void nn_tile(LAS unsigned char* lds, const bf16* A, const bf16* B, size_t ldb, int tid, f32x4 (&acc)[MK / 16]) {
    constexpr int AST = MK + 8, BST = 136;
    LAS bf16* As = (LAS bf16*)lds; LAS bf16* Bs = (LAS bf16*)(lds + 40960);
    __syncthreads();
    for (int idx = tid; idx < MK * MK / 8; idx += NWAVES * 64) { const int r = idx / (MK / 8), c = idx % (MK / 8); *(LAS v4u*)(As + r * AST + c * 8) = *(const v4u*)(A + r * MK + c * 8); }
    for (int idx = tid; idx < MK * 16; idx += NWAVES * 64) { const int r = idx >> 4, c = idx & 15; *(LAS v4u*)(Bs + r * BST + c * 8) = *(const v4u*)(B + (size_t)r * ldb + c * 8); }
    __syncthreads();
    const int w = tid >> 6, l = tid & 63, lr = l & 15, lq = l >> 4;
#pragma unroll
    for (int mt = 0; mt < MK / 16; ++mt) acc[mt] = (f32x4){0.f, 0.f, 0.f, 0.f};
#pragma unroll
    for (int ks = 0; ks < MK / 32; ++ks) {
        bf16x8 bfr;
#pragma unroll
        for (int j = 0; j < 8; ++j) bfr[j] = (short)Bs[(ks * 32 + 8 * lq + j) * BST + 16 * w + lr];
#pragma unroll
        for (int mt = 0; mt < MK / 16; ++mt) { const bf16x8 afr = *(const LAS bf16x8*)(As + (mt * 16 + lr) * AST + ks * 32 + 8 * lq);
            acc[mt] = __builtin_amdgcn_mfma_f32_16x16x32_bf16(afr, bfr, acc[mt], 0, 0, 0); }
    }
}
template <int MK>
__device__ __forceinline__ void fft_stage1_item(LAS unsigned char* lds, const bf16* H1, const bf16* QU, bf16* Y, int tok0, int nt, int tid) {
    const int s2 = nt >> 2, ch0 = (nt & 3) * 128;
    f32x4 acc[MK / 16];
    nn_tile<MK>(lds, H1, QU + (size_t)(tok0 + s2) * 1024 + 512 + ch0, (size_t)64 * 1024, tid, acc);
    const int w = tid >> 6, l = tid & 63, lr = l & 15, lq = l >> 4;
    bf16* yb = Y + (size_t)tok0 * 512 + (size_t)s2 * 512 + ch0 + 16 * w + lr;
#pragma unroll
    for (int mt = 0; mt < MK / 16; ++mt)
#pragma unroll
        for (int i = 0; i < 4; ++i) { const int r = mt * 16 + lq * 4 + i; yb[(size_t)r * (64 * 512)] = (bf16)f2bf(acc[mt][i]); }
}
__device__ __forceinline__ void fft_stage2_item(LAS unsigned char* lds, const bf16* M2, const bf16* Y, bf16* XP, int tok0, int S, int N1, int kt, int g, int tid) {
    const int p = (kt == 0 || kt == N1 / 2) ? 0 : kt;
    f32x4 acc[8];
    nn_tile<128>(lds, M2 + (size_t)kt * 16384, Y + (size_t)tok0 * 512 + (size_t)(2 * p * 64) * 512 + g * 128, (size_t)512, tid, acc);
    const int w = tid >> 6, l = tid & 63, lr = l & 15, lq = l >> 4; const int c = 16 * w + lr; const bool mir = (kt != 0 && kt != N1 / 2);
#pragma unroll
    for (int mt = 0; mt < 8; ++mt)
#pragma unroll
        for (int i = 0; i < 4; ++i) { const int m = mt * 16 + lq * 4 + i, ro = m >> 6, k2 = m & 63, sp = kt + N1 * k2; const float v = acc[mt][i];
            XP[(size_t)(tok0 + sp) * 1024 + g * 256 + ro * 128 + c] = (bf16)f2bf(v);
            if (mir) XP[(size_t)(tok0 + S - sp) * 1024 + g * 256 + ro * 128 + c] = (bf16)f2bf(ro ? -v : v); }
}
__global__ void __launch_bounds__(NWAVES * 64, 2) mk_fwd(Args args) {
    extern __shared__ __attribute__((aligned(16))) unsigned char lds[];
    Frame F;
    F.lds = (LAS unsigned char*)lds;
    F.MISC = (volatile LAS unsigned*)(F.lds + MISC_OFF);
    F.wave = __builtin_amdgcn_readfirstlane((int)threadIdx.x >> 6);
    F.G = gridDim.x; { const int bx = blockIdx.x; F.vcu = (F.G % 8 == 0) ? (bx % 8) * (F.G / 8) + bx / 8 : bx; }
    unsigned char* ws = args.ws;
    F.ctl = (unsigned*)(ws + WS_CTL);
    for (int u = threadIdx.x; u < (LDS_BYTES - LDSCTL_OFF) / 4; u += NWAVES * 64) ((LAS unsigned*)(F.lds + LDSCTL_OFF))[u] = 0u;
    __syncthreads();
    XcdBarrier bar = xcd_barrier_post(F.ctl + 1024, F.MISC + 8);
#define GRID_BAR() xcd_barrier(bar)
    bf16* const Win_t = (bf16*)(ws + WS_WIN); bf16* const Wout_t = (bf16*)(ws + WS_WOUT); bf16* const Wg_t = (bf16*)(ws + WS_WG); bf16* const Wp_t = (bf16*)(ws + WS_WP);
    bf16* const Gt = (bf16*)(ws + WS_GT); bf16* const XN = (bf16*)(ws + WS_XN); bf16* const XP = (bf16*)(ws + WS_XN); bf16* const QU = (bf16*)(ws + WS_QU);
    bf16* const KB = (bf16*)(ws + WS_K); bf16* const VB = (bf16*)(ws + WS_V); bf16* const H1B = (bf16*)(ws + WS_K); bf16* const GA = (bf16*)(ws + WS_GA); bf16* const GF = (bf16*)(ws + WS_GF);
    bf16* const PROJ = (bf16*)(ws + WS_PROJ); bf16* const PB = (bf16*)args.out; bf16* const Y = (bf16*)args.out;
    float* const SSQ1 = (float*)(ws + WS_SSQ1); float* const SSQ2 = (float*)(ws + WS_SSQ2); const float* const TAB = (const float*)(ws + WS_TAB);

    p0_prologue(F, args);
    GRID_BAR();
    { pg8::Gemm g{XN, Win_t, NTOK, NIN, DM}; pg8::StaticOrder S; S.init(NTOK, NIN, F.G, (int)blockIdx.x);
      pg8::EpiInProj E{QU, KB, VB, GA, GF, QSCALE};
      pg8::gemm_phase<pg8::EpiInProj, pg8::StaticOrder, true, true>(F.lds, g, S, E, F.wave); }
    { pg8::Gemm g{PB, Wp_t, NTOK, DM, PLED}; pg8::StaticOrder S; S.init(NTOK, DM, F.G, (int)blockIdx.x);
      pg8::EpiPlainBf16 E{PROJ, DM};
      pg8::gemm_phase<pg8::EpiPlainBf16, pg8::StaticOrder, true, true>(F.lds, g, S, E, F.wave); }
    GRID_BAR();
    { constexpr int NIT_P = NBP * 256, NIT_S = NBS * 256;
      for (int it = F.vcu; it < NIT_P + NIT_S; it += F.G) {
          if (it < NIT_P) fft_stage1_item<64>(F.lds, (const bf16*)(ws + WS_H1A), QU, Y, (it >> 8) * SEQP, it & 255, opq_tid(F.wave));
          else { const int r = it - NIT_P; fft_stage1_item<128>(F.lds, (const bf16*)(ws + WS_H1B), QU, Y, TPR + (r >> 8) * SEQS, r & 255, opq_tid(F.wave)); } } }
    GRID_BAR();
    { constexpr int NIT_P = NBP * 33 * 4, NIT_S = NBS * 65 * 4;
      for (int it = F.vcu; it < NIT_P + NIT_S; it += F.G) {
          if (it < NIT_P) { const int b = it / 132, r = it % 132; fft_stage2_item(F.lds, (const bf16*)(ws + WS_M2A), Y, XP, b * SEQP, SEQP, 64, r >> 2, r & 3, opq_tid(F.wave)); }
          else { const int q = it - NIT_P, b = q / 260, r = q % 260; fft_stage2_item(F.lds, (const bf16*)(ws + WS_M2B), Y, XP, TPR + b * SEQS, SEQS, 128, r >> 2, r & 3, opq_tid(F.wave)); } } }
    GRID_BAR();
    { pg8::Gemm g{XP, Gt, NTOK, 512, DM}; pg8::StaticOrder S; S.init(NTOK, 512, F.G, (int)blockIdx.x);
      pg8::EpiFno E{GF, QU};
      pg8::gemm_phase<pg8::EpiFno, pg8::StaticOrder, true, true>(F.lds, g, S, E, F.wave); }
    { const float lam = TAB[1024]; const float* subg = args.in[7];
      const int xl = F.vcu >> 5, cu = F.vcu & 31;
      for (int i = 0; i < 6; ++i) {
          int tok0, seq, h, q0;
          if (i < 2) { const int pr = xl; tok0 = TPR + (pr >> 2) * SEQS; seq = SEQS; h = pr & 3; q0 = (cu + 32 * i) * 128; }
          else { const int pr = xl + 8 * (i - 2); tok0 = (pr >> 2) * SEQP; seq = SEQP; h = pr & 3; q0 = cu * 128; }
          att::attn_unit(QU, KB, VB, GA, TAB, subg, lam, tok0, seq, h, q0, (char*)lds, F.wave);
      } }
    GRID_BAR();
    { pg8::Gemm g{QU, Wout_t, NTOK, DM, DM}; pg8::StaticOrder S; S.init(NTOK, DM, F.G, (int)blockIdx.x);
      pg8::EpiOutProj E{args.in[0], args.in[1], args.out, H1B, SSQ1};
      pg8::gemm_phase<pg8::EpiOutProj, pg8::StaticOrder, true, true>(F.lds, g, S, E, F.wave); }
    GRID_BAR();
    { pg8::Gemm g{H1B, Wg_t, NTOK, DM, DM}; pg8::StaticOrder S; S.init(NTOK, DM, F.G, (int)blockIdx.x);
      pg8::EpiGate E{args.out, PROJ, SSQ1, SSQ2};
      pg8::gemm_phase<pg8::EpiGate, pg8::StaticOrder, true, true>(F.lds, g, S, E, F.wave); }
    GRID_BAR();
    { const float* gfin = args.in[14]; const int gw = F.vcu * NWAVES + F.wave, NGW = F.G * NWAVES; const int lane5 = opq_tid(F.wave) & 63;
      for (int m = gw; m < NTOK; m += NGW) {
          float s = (lane5 < 16) ? SSQ2[(size_t)m * 16 + lane5] : 0.f; s = wave_sum(s, lane5);
          const float r = __builtin_amdgcn_rsqf(s * (1.f / 1024.f) + 1e-6f);
          f32x4* row = (f32x4*)(args.out + (size_t)m * DM) + lane5; const f32x4* gr = (const f32x4*)gfin + lane5;
#pragma unroll
          for (int j = 0; j < 4; ++j) { const f32x4 v = row[64 * j], gg = gr[64 * j]; row[64 * j] = v * r * gg; }
      } }
#undef GRID_BAR
}

extern "C" void kernel_launch(void* const* d_in, const int* in_sizes, int n_in, void* d_out, int out_size, void* d_ws, size_t ws_size, hipStream_t stream) {
    static int grid = 0;
    if (grid == 0) {
        if (n_in != 15 || in_sizes[0] != TPR * DM || out_size != NTOK * DM || ws_size < WS_END) {
            fprintf(stderr, "kernel_launch: shape mismatch: n_in %d in0 %d out %d ws %zu (need %zu)\n", n_in, n_in > 0 ? in_sizes[0] : -1, out_size, ws_size, (size_t)WS_END); grid = -1; return; }
        int dev = 0, cus = 0;
        if (hipGetDevice(&dev) != hipSuccess || hipDeviceGetAttribute(&cus, hipDeviceAttributeMultiprocessorCount, dev) != hipSuccess) { fprintf(stderr, "kernel_launch: device query failed\n"); grid = -1; return; }
        if (hipFuncSetAttribute((const void*)mk_fwd, hipFuncAttributeMaxDynamicSharedMemorySize, LDS_BYTES) != hipSuccess) { fprintf(stderr, "kernel_launch: hipFuncSetAttribute failed\n"); grid = -1; return; }
        (void)hipGetLastError();
        grid = cus;
        if (grid != 256) fprintf(stderr, "kernel_launch: %d CUs; this kernel's attention schedule assumes 256\n", grid);
    }
    if (grid < 0) return;
    if (hipMemsetAsync((char*)d_ws + WS_CTL, 0, CTL_ZERO_BYTES, stream) != hipSuccess) { fprintf(stderr, "kernel_launch: memset failed\n"); return; }
    Args a{};
    for (int i = 0; i < 15; ++i) a.in[i] = (const float*)d_in[i];
    a.out = (float*)d_out; a.ws = (unsigned char*)d_ws;
    hipLaunchKernelGGL(mk_fwd, dim3(grid), dim3(NWAVES * 64), LDS_BYTES, stream, a);
    const hipError_t le = hipPeekAtLastError();
    if (le != hipSuccess) fprintf(stderr, "kernel_launch: launch failed: %s\n", hipGetErrorName(le));
}
```

```cpp
#include <hip/hip_runtime.h>
#include <cstdio>
#include <cstdint>
#define PRIO_MODE 2
#define ATTNS att3
#define STG_P1 0
#define PROJ_FIRST_MASK 0
#define STG_P3 0
#define P3_ALIGN true
#define STG_P4 0
__device__ __forceinline__ int opq_tid(int wave) { int l; asm volatile("v_mbcnt_lo_u32_b32 %0, -1, 0\n\tv_mbcnt_hi_u32_b32 %0, -1, %0" : "=v"(l)); return wave * 64 + l; }
__device__ __forceinline__ float bperm_f(int srclane, float v) { return __int_as_float(__builtin_amdgcn_ds_bpermute(srclane << 2, __float_as_int(v))); }
namespace pg8 {
#define PG8_LAS __attribute__((address_space(3)))
typedef unsigned short bf16_t;
typedef short bf16x8 __attribute__((ext_vector_type(8)));
typedef float f32x4 __attribute__((ext_vector_type(4)));
typedef unsigned u32x4 __attribute__((ext_vector_type(4)));
constexpr int BM = 256, BK = 64, HALF = 128, HTB = HALF * BK * 2  , STAGE_BYTES = 8 * HTB, NXCD = 8, WGM = 8;

__host__ __device__ __forceinline__ int lds_byte(int r, int c) { const int st = (r >> 4) * 2 + (c >> 5), rr = r & 15, cc = c & 31, ob = rr * 64 + cc * 2; return st * 1024 + (ob ^ (((ob >> 9) & 1) << 5)); }
__host__ __device__ __forceinline__ void stage_rc(int b, int& R, int& C) { const int st = b / 1024, sb = b % 1024, swz = sb ^ (((sb >> 9) & 1) << 5); R = (st >> 1) * 16 + swz / 64; C = (st & 1) * 32 + (swz % 64) / 2; }
__host__ __device__ __forceinline__ int perm32(int rho) { const int n = rho >> 4, i = rho & 15; return 8 * (i >> 2) + 4 * n + (i & 3); }

struct Unit { int pm, pn; };
struct Gemm { const bf16_t* A; const bf16_t* Bt; int M, N, K, ld, koff_pn; };

struct StaticOrder {
    int nM, nN, nwg, G, c;
    __host__ __device__ void init(int M, int N, int G_, int c_) { nM = M / BM; nN = N / BM; nwg = nM * nN; G = G_; c = c_; }
    __host__ __device__ bool next(int i, Unit& u) const {
        const long L = (long)i * G + c; if (L >= nwg) return false;
        int wgid = (int)L; { const int q = nwg / NXCD, r = nwg % NXCD, xcd = wgid % NXCD, off = wgid / NXCD; wgid = (xcd < r ? xcd * (q + 1) : r * (q + 1) + (xcd - r) * q) + off; }
        const int nig = WGM * nN, gid = wgid / nig, fm = gid * WGM, gsz = (nM - fm) < WGM ? (nM - fm) : WGM;
        u.pm = fm + ((wgid % nig) % gsz); u.pn = (wgid % nig) / gsz; return true;
    }
    __device__ __forceinline__ void a_ready(const Unit&) const {}
    __device__ __forceinline__ void done(const Unit&) const {}
};

__device__ __forceinline__ unsigned cvt_pk_bf16(float lo, float hi) { unsigned r; asm volatile("v_cvt_pk_bf16_f32 %0, %1, %2" : "=v"(r) : "v"(lo), "v"(hi)); return r; }
typedef float f32x2 __attribute__((ext_vector_type(2)));
typedef unsigned u32x2 __attribute__((ext_vector_type(2)));
__device__ __forceinline__ float bflo(unsigned w) { return __uint_as_float(w << 16); }
__device__ __forceinline__ float bfhi(unsigned w) { return __uint_as_float(w & 0xffff0000u); }
__device__ __forceinline__ float sigm(float a) { return __builtin_amdgcn_rcpf(1.f + __expf(-a)); }
__device__ __forceinline__ float silu(float a) { return a * sigm(a); }

struct EpiInProj {
    static constexpr bool PERM = true, AFTER_DRAIN = false;
    bf16_t* qu; bf16_t* kb; bf16_t* vb; bf16_t* ga; bf16_t* gf; float qscale; int nostore;
    __device__ __forceinline__ void operator()(const f32x4 (&acc)[2][2][4][2], const Unit& u, int wr, int wc, int fr, int fq) const {
        const int seg = u.pn >> 1, colt = (u.pn & 1) * BM;
        bf16_t* base; int ld = 512; float sc = 1.f;
        if (seg == 0) { base = qu; ld = 1024; sc = qscale; } else if (seg == 1) base = kb; else if (seg == 2) base = vb; else if (seg == 3) base = ga;
        else if (seg == 4) { base = qu + 512; ld = 1024; } else base = gf;
        const int row0 = u.pm * BM + wr * 64 + fr, col0 = colt + wc * 32 + 8 * fq;
#pragma unroll
        for (int ai = 0; ai < 2; ++ai)
#pragma unroll
            for (int m = 0; m < 4; ++m) { bf16_t* rowp = base + (size_t)(row0 + ai * HALF + m * 16) * ld + col0;
#pragma unroll
                for (int bj = 0; bj < 2; ++bj) { const f32x4 v0 = acc[ai][bj][m][0] * sc, v1 = acc[ai][bj][m][1] * sc;
                    u32x4 w; w.x = cvt_pk_bf16(v0[0], v0[1]); w.y = cvt_pk_bf16(v0[2], v0[3]); w.z = cvt_pk_bf16(v1[0], v1[1]); w.w = cvt_pk_bf16(v1[2], v1[3]);
                    if (nostore == 0) __builtin_nontemporal_store(w, (u32x4*)(rowp + bj * HALF)); else if (nostore == 3) { const int wid_ = wr * 4 + wc, lane_ = fq * 16 + fr, ins_ = (ai * 4 + m) * 2 + bj;
                        *(u32x4*)(base + (size_t)(u.pm * BM) * ld + (size_t)((wid_ * 16 + ins_) * 64 + lane_) * 8) = w; } else asm volatile("" :: "v"(w)); } }
    }
};
struct EpiPlainBf16 {
    static constexpr bool PERM = true, AFTER_DRAIN = false;
    bf16_t* O; int ldc;
    __device__ __forceinline__ void operator()(const f32x4 (&acc)[2][2][4][2], const Unit& u, int wr, int wc, int fr, int fq) const {
        const int row0 = u.pm * BM + wr * 64 + fr, col0 = u.pn * BM + wc * 32 + 8 * fq;
#pragma unroll
        for (int ai = 0; ai < 2; ++ai)
#pragma unroll
            for (int m = 0; m < 4; ++m) { bf16_t* rowp = O + (size_t)(row0 + ai * HALF + m * 16) * ldc + col0;
#pragma unroll
                for (int bj = 0; bj < 2; ++bj) { const f32x4 v0 = acc[ai][bj][m][0], v1 = acc[ai][bj][m][1];
                    u32x4 w; w.x = cvt_pk_bf16(v0[0], v0[1]); w.y = cvt_pk_bf16(v0[2], v0[3]); w.z = cvt_pk_bf16(v1[0], v1[1]); w.w = cvt_pk_bf16(v1[2], v1[3]);
                    __builtin_nontemporal_store(w, (u32x4*)(rowp + bj * HALF)); } }
    }
};
struct EpiFno {
    static constexpr bool PERM = true, AFTER_DRAIN = false;
    const bf16_t* gf; bf16_t* qu;
    __device__ __forceinline__ void operator()(const f32x4 (&acc)[2][2][4][2], const Unit& u, int wr, int wc, int fr, int fq) const {
        const int row0 = u.pm * BM + wr * 64 + fr, col0 = u.pn * BM + wc * 32 + 8 * fq;
#pragma unroll
        for (int ai = 0; ai < 2; ++ai)
#pragma unroll
            for (int m = 0; m < 4; ++m) { const size_t r = (size_t)(row0 + ai * HALF + m * 16);
#pragma unroll
                for (int bj = 0; bj < 2; ++bj) { const int c = col0 + bj * HALF; const u32x4 g = *(const u32x4*)(gf + r * 512 + c);
                    const f32x4 v0 = acc[ai][bj][m][0], v1 = acc[ai][bj][m][1];
                    u32x4 w; w.x = cvt_pk_bf16(v0[0] * silu(bflo(g.x)), v0[1] * silu(bfhi(g.x))); w.y = cvt_pk_bf16(v0[2] * silu(bflo(g.y)), v0[3] * silu(bfhi(g.y)));
                    w.z = cvt_pk_bf16(v1[0] * silu(bflo(g.z)), v1[1] * silu(bfhi(g.z))); w.w = cvt_pk_bf16(v1[2] * silu(bflo(g.w)), v1[3] * silu(bfhi(g.w)));
                    *(u32x4*)(qu + r * 1024 + 512 + c) = w; } }
    }
};
struct EpiOutProj {
    static constexpr bool PERM = false, AFTER_DRAIN = false;
    const float* xp; const float* xs; float* out; bf16_t* h1b; float* ssq;
    __device__ __forceinline__ void operator()(const f32x4 (&acc)[2][2][4][2], const Unit& u, int wr, int wc, int fr, int fq) const {
        const int row0 = u.pm * BM + wr * 64 + fr, col0 = u.pn * BM + wc * 32 + 4 * fq;
        const float* xb = (u.pm < 128) ? xp : xs - (size_t)32768 * 1024;
        f32x4 xv[8][4]; float ssv[8];
#define EOP_LD(g) do { const float* xrow_ = xb + (size_t)(row0 + ((g) >> 2) * HALF + ((g) & 3) * 16) * 1024 + col0; \
            xv[g][0] = *(const f32x4*)(xrow_); xv[g][1] = *(const f32x4*)(xrow_ + 16); xv[g][2] = *(const f32x4*)(xrow_ + HALF); xv[g][3] = *(const f32x4*)(xrow_ + HALF + 16); } while (0)
        EOP_LD(0); EOP_LD(1); EOP_LD(2);
#pragma unroll
        for (int g = 0; g < 8; ++g) { const int ai = g >> 2, m = g & 3;
            if (g + 3 < 8) EOP_LD(g + 3);
            const size_t off = (size_t)(row0 + ai * HALF + m * 16) * 1024 + col0; float ss = 0.f;
#pragma unroll
            for (int bj = 0; bj < 2; ++bj)
#pragma unroll
                for (int n = 0; n < 2; ++n) { const f32x4 h = xv[g][bj * 2 + n] + acc[ai][bj][m][n];
                    ss += (h[0] * h[0] + h[1] * h[1]) + (h[2] * h[2] + h[3] * h[3]);
                    u32x2 w; w.x = cvt_pk_bf16(h[0], h[1]); w.y = cvt_pk_bf16(h[2], h[3]); *(u32x2*)(h1b + off + bj * HALF + n * 16) = w; }
            ss += bperm_f(((fq ^ 1) << 4) | fr, ss); ss += bperm_f(((fq ^ 2) << 4) | fr, ss); ssv[g] = ss; }
#undef EOP_LD
        if (fq == 0) {
#pragma unroll
            for (int g = 0; g < 8; ++g) ssq[(size_t)(row0 + (g >> 2) * HALF + (g & 3) * 16) * 16 + u.pn * 4 + wc] = ssv[g]; }
    }
};
struct EpiGate {
    static constexpr bool PERM = false, AFTER_DRAIN = false;
    float* out; const bf16_t* proj; const float* ssq1; float* ssq2;
    __device__ __forceinline__ void operator()(const f32x4 (&acc)[2][2][4][2], const Unit& u, int wr, int wc, int fr, int fq) const {
        const int row0 = u.pm * BM + wr * 64 + fr, col0 = u.pn * BM + wc * 32 + 4 * fq;
#pragma unroll
        for (int ai = 0; ai < 2; ++ai)
#pragma unroll
            for (int m = 0; m < 4; ++m) { const int r = row0 + ai * HALF + m * 16; const size_t off = (size_t)r * 1024 + col0;
                const f32x4* sp = (const f32x4*)(ssq1 + (size_t)r * 16); const f32x4 s0 = sp[0], s1 = sp[1], s2 = sp[2], s3 = sp[3];
                const float st = ((s0[0] + s0[1]) + (s0[2] + s0[3])) + ((s1[0] + s1[1]) + (s1[2] + s1[3])) + ((s2[0] + s2[1]) + (s2[2] + s2[3])) + ((s3[0] + s3[1]) + (s3[2] + s3[3]));
                const float rr = __builtin_amdgcn_rsqf(st * (1.f / 1024.f) + 1e-6f); float ss = 0.f;
#pragma unroll
                for (int bj = 0; bj < 2; ++bj)
#pragma unroll
                    for (int n = 0; n < 2; ++n) { const f32x4 a = acc[ai][bj][m][n] * rr; const u32x2 pw = *(const u32x2*)(proj + off + bj * HALF + n * 16);
                        const f32x4 h1 = *(const f32x4*)(out + off + bj * HALF + n * 16); f32x4 h;
                        h[0] = h1[0] + sigm(a[0]) * bflo(pw.x); h[1] = h1[1] + sigm(a[1]) * bfhi(pw.x); h[2] = h1[2] + sigm(a[2]) * bflo(pw.y); h[3] = h1[3] + sigm(a[3]) * bfhi(pw.y);
                        *(f32x4*)(out + off + bj * HALF + n * 16) = h; ss += (h[0] * h[0] + h[1] * h[1]) + (h[2] * h[2] + h[3] * h[3]); }
                ss += bperm_f(((fq ^ 1) << 4) | fr, ss); ss += bperm_f(((fq ^ 2) << 4) | fr, ss);
                if (fq == 0) ssq2[(size_t)r * 16 + u.pn * 4 + wc] = ss; }
    }
};

struct EpiGateNorm {
    static constexpr bool PERM = false, AFTER_DRAIN = false;
    float* out; const bf16_t* h1b; const bf16_t* proj; const float* ssq1; const float* gfin; float* slots; unsigned* cnt; PG8_LAS unsigned char* xl;
    __device__ __forceinline__ void operator()(f32x4 (&acc)[2][2][4][2], const Unit& u, int wr, int wc, int fr, int fq) const {
        const int row0 = u.pm * BM + wr * 64 + fr, col0 = u.pn * BM + wc * 32 + 4 * fq; const int wid = wr * 4 + wc, lane = fq * 16 + fr;
        PG8_LAS float* P = (PG8_LAS float*)xl; PG8_LAS float* S = (PG8_LAS float*)(xl + 4096); PG8_LAS float* R1 = (PG8_LAS float*)(xl + 5120);
        u32x2 pwv[8][4], hwv[8][4];
#define EGN_LD(g) do { const size_t off_ = (size_t)(row0 + ((g) >> 2) * HALF + ((g) & 3) * 16) * 1024 + col0; \
            pwv[g][0] = *(const u32x2*)(proj + off_); pwv[g][1] = *(const u32x2*)(proj + off_ + 16); pwv[g][2] = *(const u32x2*)(proj + off_ + HALF); pwv[g][3] = *(const u32x2*)(proj + off_ + HALF + 16); \
            hwv[g][0] = *(const u32x2*)(h1b + off_); hwv[g][1] = *(const u32x2*)(h1b + off_ + 16); hwv[g][2] = *(const u32x2*)(h1b + off_ + HALF); hwv[g][3] = *(const u32x2*)(h1b + off_ + HALF + 16); } while (0)
        EGN_LD(0); EGN_LD(1); EGN_LD(2); EGN_LD(3);
        { const int t_ = wid * 64 + lane; if (t_ < 256) { const f32x4* sp = (const f32x4*)(ssq1 + (size_t)(u.pm * BM + t_) * 16); const f32x4 s0 = sp[0], s1 = sp[1], s2 = sp[2], s3 = sp[3];
            const float st = ((s0[0] + s0[1]) + (s0[2] + s0[3])) + ((s1[0] + s1[1]) + (s1[2] + s1[3])) + ((s2[0] + s2[1]) + (s2[2] + s2[3])) + ((s3[0] + s3[1]) + (s3[2] + s3[3]));
            R1[t_] = __builtin_amdgcn_rsqf(st * (1.f / 1024.f) + 1e-6f); } }
        asm volatile("s_waitcnt vmcnt(0) lgkmcnt(0)" ::: "memory"); __builtin_amdgcn_s_barrier(); asm volatile("" ::: "memory");
#pragma unroll
        for (int g = 0; g < 8; ++g) { const int ai = g >> 2, m = g & 3;
            if (g + 4 < 8) EGN_LD(g + 4);
            const float rr = R1[ai * HALF + wr * 64 + m * 16 + fr]; float ss = 0.f;
#pragma unroll
            for (int bj = 0; bj < 2; ++bj)
#pragma unroll
                for (int n = 0; n < 2; ++n) { const f32x4 a = acc[ai][bj][m][n] * rr; const u32x2 pw = pwv[g][bj * 2 + n], hw = hwv[g][bj * 2 + n]; f32x4 h;
                    h[0] = bflo(hw.x) + sigm(a[0]) * bflo(pw.x); h[1] = bfhi(hw.x) + sigm(a[1]) * bfhi(pw.x); h[2] = bflo(hw.y) + sigm(a[2]) * bflo(pw.y); h[3] = bfhi(hw.y) + sigm(a[3]) * bfhi(pw.y);
                    acc[ai][bj][m][n] = h; ss += (h[0] * h[0] + h[1] * h[1]) + (h[2] * h[2] + h[3] * h[3]); }
            ss += bperm_f(((fq ^ 1) << 4) | fr, ss); ss += bperm_f(((fq ^ 2) << 4) | fr, ss);
            if (fq == 0) P[(ai * HALF + wr * 64 + m * 16 + fr) * 4 + wc] = ss; }
#undef EGN_LD
        asm volatile("s_waitcnt lgkmcnt(0)" ::: "memory"); __builtin_amdgcn_s_barrier(); asm volatile("" ::: "memory");
        const int row = wid * 32 + (lane & 31);
        if (lane < 32) { const float t = (P[row * 4 + 0] + P[row * 4 + 1]) + (P[row * 4 + 2] + P[row * 4 + 3]);
            __hip_atomic_store(slots + ((size_t)(u.pm * BM + row) * 4 + u.pn), t, __ATOMIC_RELAXED, __HIP_MEMORY_SCOPE_AGENT); }
        asm volatile("s_waitcnt vmcnt(0)" ::: "memory");
        if (lane == 0) __hip_atomic_fetch_add(cnt + 64 * u.pm, 1u, __ATOMIC_RELAXED, __HIP_MEMORY_SCOPE_AGENT);
        if (wid == 0) { unsigned spins = 0;
            while ((unsigned)__builtin_amdgcn_readfirstlane(__hip_atomic_load(cnt + 64 * u.pm, __ATOMIC_RELAXED, __HIP_MEMORY_SCOPE_AGENT)) < 32u) { __builtin_amdgcn_s_sleep(2); if (++spins > (1u << 22)) break; }
            __builtin_amdgcn_fence(__ATOMIC_ACQUIRE, "agent"); }
        asm volatile("s_waitcnt vmcnt(0) lgkmcnt(0)" ::: "memory"); __builtin_amdgcn_s_barrier(); asm volatile("" ::: "memory");
        if (lane < 32) { const float* sl = slots + (size_t)(u.pm * BM + row) * 4; float t = 0.f;
#pragma unroll
            for (int k = 0; k < 4; ++k) t += __hip_atomic_load(sl + k, __ATOMIC_RELAXED, __HIP_MEMORY_SCOPE_AGENT);
            S[row] = __builtin_amdgcn_rsqf(t * (1.f / 1024.f) + 1e-6f); }
        asm volatile("s_waitcnt vmcnt(0) lgkmcnt(0)" ::: "memory"); __builtin_amdgcn_s_barrier(); asm volatile("" ::: "memory");
        f32x4 gv[2][2];
#pragma unroll
        for (int bj = 0; bj < 2; ++bj)
#pragma unroll
            for (int n = 0; n < 2; ++n) gv[bj][n] = *(const f32x4*)(gfin + col0 + bj * HALF + n * 16);
#pragma unroll
        for (int ai = 0; ai < 2; ++ai)
#pragma unroll
            for (int m = 0; m < 4; ++m) { const int rl = ai * HALF + wr * 64 + m * 16 + fr; const float rs = S[rl]; const size_t off = (size_t)(u.pm * BM + rl) * 1024 + col0;
#pragma unroll
                for (int bj = 0; bj < 2; ++bj)
#pragma unroll
                    for (int n = 0; n < 2; ++n) __builtin_nontemporal_store(acc[ai][bj][m][n] * rs * gv[bj][n], (f32x4*)(out + off + bj * HALF + n * 16)); }
        asm volatile("s_waitcnt lgkmcnt(0)" ::: "memory"); __builtin_amdgcn_s_barrier(); asm volatile("" ::: "memory");
    }
};
template <class Epi, class Sched, bool ALIGN_EPI = false, bool SP2 = false>
__device__ __forceinline__ void gemm_phase(PG8_LAS unsigned char* lds, const Gemm g, const Sched& S, const Epi& E, const int wave_) {
    const int tid = opq_tid(wave_), wid = __builtin_amdgcn_readfirstlane(tid >> 6), lane = tid & 63, wr = wid >> 2, wc = wid & 3, fr = lane & 15, fq = lane >> 4;
    const int K = g.K, nt = K / BK;
    unsigned voffA[2], voffB[2];
#pragma unroll
    for (int i = 0; i < 2; ++i) { int R, C; stage_rc(tid * 16 + i * 8192, R, C); const int Rb = Epi::PERM ? ((R & ~31) + perm32(R & 31)) : R;
        voffA[i] = (unsigned)(R * g.ld + C) * 2u; voffB[i] = (unsigned)(Rb * g.ld + C) * 2u; }
    const size_t kstep = (size_t)(BK * 2);
    const size_t hstep = (size_t)HALF * g.ld * 2;
    const size_t tstep = 2 * hstep;
    const unsigned ldsw = (unsigned)wid * 1024u;
    const int aoff = lds_byte(wr * 64 + fr, fq * 8), boff = lds_byte(wc * 32 + fr, fq * 8);
#define PG8_SA(b, h) (((b) * 2 + (h)) * HTB)
#define PG8_SB(b, h) ((4 + (b) * 2 + (h)) * HTB)
#define PG8_STAGE(bufoff, gbase, voff) do { unsigned long long gb_ = (unsigned long long)(gbase); asm volatile("" : "+s"(gb_)); _Pragma("unroll") for (int _i = 0; _i < 2; ++_i) { asm volatile("" : "+v"((voff)[_i])); \
        __builtin_amdgcn_global_load_lds((const unsigned*)((const char*)gb_ + (voff)[_i]), (PG8_LAS unsigned*)(lds + (bufoff) + ldsw + _i * 8192), 16, 0, 0); } } while (0)
#define PG8_LDA(dst, b, h) do { _Pragma("unroll") for (int m = 0; m < 4; ++m) _Pragma("unroll") for (int k = 0; k < 2; ++k) dst[m][k] = *(const PG8_LAS bf16x8*)(lds + PG8_SA(b, h) + aoff + m * 2048 + k * 1024); } while (0)
#define PG8_LDB(dst, b, h) do { _Pragma("unroll") for (int n = 0; n < 2; ++n) _Pragma("unroll") for (int k = 0; k < 2; ++k) dst[n][k] = *(const PG8_LAS bf16x8*)(lds + PG8_SB(b, h) + boff + n * 2048 + k * 1024); } while (0)
#define PG8_MMA(ai, bj, At, Bt) do { __builtin_amdgcn_s_setprio(1); _Pragma("unroll") for (int m = 0; m < 4; ++m) _Pragma("unroll") for (int n = 0; n < 2; ++n) _Pragma("unroll") for (int k = 0; k < 2; ++k) \
        acc[ai][bj][m][n] = __builtin_amdgcn_mfma_f32_16x16x32_bf16(Bt[n][k], At[m][k], acc[ai][bj][m][n], 0, 0, 0); __builtin_amdgcn_s_setprio(0); } while (0)
#define PG8_WAIT_V(n) asm volatile("s_waitcnt vmcnt(" #n ")" ::: "memory")
#define PG8_WAIT_L(n) asm volatile("s_waitcnt lgkmcnt(" #n ")" ::: "memory")
#define PG8_BAR __builtin_amdgcn_s_barrier()
#define PG8_SCHED __builtin_amdgcn_sched_barrier(0)
    Unit cur, nxt; int ui = 0;
    if (!S.next(0, cur)) return;
    f32x4 acc[2][2][4][2];
#pragma unroll
    for (int a = 0; a < 2; ++a)
#pragma unroll
        for (int b = 0; b < 2; ++b)
#pragma unroll
            for (int m = 0; m < 4; ++m)
#pragma unroll
                for (int n = 0; n < 2; ++n) acc[a][b][m][n] = (f32x4){0.f, 0.f, 0.f, 0.f};
    bf16x8 At[4][2], B0[2][2], B1[2][2];
    const char* cA = (const char*)g.A + (size_t)cur.pm * tstep + (size_t)(cur.pn * g.koff_pn) * 2; const char* cB = (const char*)g.Bt + (size_t)cur.pn * tstep + (size_t)(cur.pn * g.koff_pn) * 2;
    S.a_ready(cur);
    if constexpr (SP2) {
        PG8_STAGE(PG8_SB(0, 0), cB, voffB); PG8_STAGE(PG8_SB(0, 1), cB + hstep, voffB); PG8_STAGE(PG8_SA(0, 0), cA, voffA); PG8_STAGE(PG8_SA(0, 1), cA + hstep, voffA);
        if (wr == 1) PG8_BAR;
        PG8_WAIT_V(2); PG8_BAR;
        PG8_STAGE(PG8_SB(1, 0), cB + kstep, voffB); PG8_STAGE(PG8_SA(1, 0), cA + kstep, voffA); PG8_STAGE(PG8_SB(1, 1), cB + hstep + kstep, voffB);
        PG8_WAIT_V(6); PG8_BAR;
    } else {
        PG8_STAGE(PG8_SB(0, 0), cB, voffB); PG8_STAGE(PG8_SA(0, 0), cA, voffA); PG8_STAGE(PG8_SB(0, 1), cB + hstep, voffB); PG8_STAGE(PG8_SA(0, 1), cA + hstep, voffA);
        if (wr == 1) PG8_BAR;
        PG8_WAIT_V(4); PG8_BAR;
        PG8_STAGE(PG8_SB(1, 0), cB + kstep, voffB); PG8_STAGE(PG8_SA(1, 0), cA + kstep, voffA); PG8_STAGE(PG8_SB(1, 1), cB + hstep + kstep, voffB);
        PG8_WAIT_V(6); PG8_BAR;
    }
    for (;;) {
        const bool has_next = S.next(ui + 1, nxt);
        const char* nA = has_next ? (const char*)g.A + (size_t)nxt.pm * tstep + (size_t)(nxt.pn * g.koff_pn) * 2 : cA; const char* nB = has_next ? (const char*)g.Bt + (size_t)nxt.pn * tstep + (size_t)(nxt.pn * g.koff_pn) * 2 : cB;
        for (int t = 0; t < nt; t += 2) {
            const bool last = (t == nt - 2);
            const char* a1 = cA + (size_t)(t + 1) * kstep;
            const char* a2 = last ? nA : cA + (size_t)(t + 2) * kstep; const char* b2 = last ? nB : cB + (size_t)(t + 2) * kstep;
            const char* a3 = a2 + kstep; const char* b3 = b2 + kstep;
            if (last && has_next) S.a_ready(nxt);
            if constexpr (SP2) {
            PG8_LDB(B0, 0, 0); PG8_LDB(B1, 0, 1); PG8_SCHED; PG8_LDA(At, 0, 0); PG8_STAGE(PG8_SA(1, 1), a1 + hstep, voffA);
            PG8_WAIT_V(8); PG8_WAIT_L(0); PG8_BAR; PG8_MMA(0, 0, At, B0); PG8_MMA(0, 1, At, B1); PG8_BAR; PG8_SCHED;
            PG8_LDA(At, 0, 1); PG8_STAGE(PG8_SB(0, 0), b2, voffB); PG8_STAGE(PG8_SB(0, 1), b2 + hstep, voffB); PG8_STAGE(PG8_SA(0, 0), a2, voffA);
            PG8_WAIT_V(8); PG8_WAIT_L(0); PG8_BAR; PG8_MMA(1, 0, At, B0); PG8_MMA(1, 1, At, B1); PG8_BAR; PG8_SCHED;
            PG8_LDB(B0, 1, 0); PG8_LDB(B1, 1, 1); PG8_SCHED; PG8_LDA(At, 1, 0); PG8_STAGE(PG8_SA(0, 1), a2 + hstep, voffA);
            PG8_WAIT_V(8); PG8_WAIT_L(0); PG8_BAR; PG8_MMA(0, 0, At, B0); PG8_MMA(0, 1, At, B1); PG8_BAR; PG8_SCHED;
            PG8_LDA(At, 1, 1); PG8_STAGE(PG8_SB(1, 0), b3, voffB); PG8_STAGE(PG8_SB(1, 1), b3 + hstep, voffB); PG8_STAGE(PG8_SA(1, 0), a3, voffA);
            PG8_WAIT_V(8); PG8_WAIT_L(0); PG8_BAR; PG8_MMA(1, 0, At, B0); PG8_MMA(1, 1, At, B1); PG8_BAR; PG8_SCHED;
            } else {
            PG8_LDB(B0, 0, 0); PG8_SCHED; PG8_LDA(At, 0, 0); PG8_STAGE(PG8_SA(1, 1), a1 + hstep, voffA);
            PG8_WAIT_L(8); PG8_BAR; PG8_WAIT_L(0); PG8_MMA(0, 0, At, B0); PG8_BAR; PG8_SCHED;
            PG8_LDB(B1, 0, 1); PG8_STAGE(PG8_SB(0, 0), b2, voffB);
            PG8_BAR; PG8_WAIT_L(0); PG8_MMA(0, 1, At, B1); PG8_BAR;
            PG8_LDA(At, 0, 1); PG8_STAGE(PG8_SA(0, 0), a2, voffA);
            PG8_BAR; PG8_WAIT_L(0); PG8_MMA(1, 0, At, B0); PG8_BAR; PG8_SCHED;
            PG8_STAGE(PG8_SB(0, 1), b2 + hstep, voffB);
            PG8_WAIT_V(6); PG8_BAR; PG8_MMA(1, 1, At, B1); PG8_BAR;
            PG8_LDB(B0, 1, 0); PG8_SCHED; PG8_LDA(At, 1, 0); PG8_STAGE(PG8_SA(0, 1), a2 + hstep, voffA);
            PG8_WAIT_L(8); PG8_BAR; PG8_WAIT_L(0); PG8_MMA(0, 0, At, B0); PG8_BAR; PG8_SCHED;
            PG8_LDB(B1, 1, 1); PG8_STAGE(PG8_SB(1, 0), b3, voffB);
            PG8_BAR; PG8_WAIT_L(0); PG8_MMA(0, 1, At, B1); PG8_BAR;
            PG8_LDA(At, 1, 1); PG8_STAGE(PG8_SA(1, 0), a3, voffA);
            PG8_BAR; PG8_WAIT_L(0); PG8_MMA(1, 0, At, B0); PG8_BAR; PG8_SCHED;
            PG8_STAGE(PG8_SB(1, 1), b3 + hstep, voffB);
            PG8_WAIT_V(6); PG8_BAR; PG8_MMA(1, 1, At, B1); PG8_BAR;
            }
        }
        if constexpr (ALIGN_EPI) { if (wr == 0) PG8_BAR; }
        if constexpr (!Epi::AFTER_DRAIN) { const int l2_ = opq_tid(wave_) & 63; E(acc, cur, wr, wc, l2_ & 15, l2_ >> 4); S.done(cur); }
        if (!has_next) break;
#pragma unroll
        for (int a = 0; a < 2; ++a)
#pragma unroll
            for (int b = 0; b < 2; ++b)
#pragma unroll
                for (int m = 0; m < 4; ++m)
#pragma unroll
                    for (int n = 0; n < 2; ++n) acc[a][b][m][n] = (f32x4){0.f, 0.f, 0.f, 0.f};
        cur = nxt; cA = nA; cB = nB; ++ui;
        if constexpr (ALIGN_EPI) { if (wr == 1) PG8_BAR; }
    }
    PG8_WAIT_V(0);
    if constexpr (!ALIGN_EPI) { if (wr == 0) PG8_BAR; }
    PG8_BAR;
    if constexpr (Epi::AFTER_DRAIN) { E.fused(acc, cur, wr, wc, fr, fq, lds, wid, lane); S.done(cur); }
#undef PG8_SA
#undef PG8_SB
#undef PG8_STAGE
#undef PG8_LDA
#undef PG8_LDB
#undef PG8_MMA
#undef PG8_WAIT_V
#undef PG8_WAIT_L
#undef PG8_BAR
#undef PG8_SCHED
}
}
constexpr int NWAVES = 8;
constexpr int DM = 1024, NTOK = 49152, TPR = 32768, SEQP = 4096, SEQS = 8192, NBP = 8, NBS = 2, NIN = 3072, PLED = 256;
constexpr float LOG2E = 1.4426950408889634f;
constexpr float QSCALE = 0.125f * LOG2E;
constexpr size_t MiB = 1u << 20;
constexpr size_t WS_CTL = 0, CTL_ZERO_BYTES = 128 * 1024;
constexpr size_t WS_TAB = 1 * MiB;
constexpr size_t WS_GINV = 1 * MiB + 8192;
constexpr size_t WS_RINV = 1 * MiB + 16384;
constexpr size_t WS_WIN = 2 * MiB;
constexpr size_t WS_WOUT = 8 * MiB;
constexpr size_t WS_WG = 10 * MiB;
constexpr size_t WS_WP = 12 * MiB;
constexpr size_t WS_GT = 12 * MiB + 512 * 1024;
constexpr size_t WS_H1A = 13 * MiB + 512 * 1024;
constexpr size_t WS_H1B = WS_H1A + 64 * 1024;
constexpr size_t WS_M2A = 14 * MiB;
constexpr size_t WS_M2B = 15 * MiB + 256 * 1024;
constexpr size_t WS_SSQ1 = 18 * MiB, WS_SSQ2 = 21 * MiB;
constexpr size_t WS_XN = 24 * MiB;
constexpr size_t WS_QU = 120 * MiB;
constexpr size_t WS_K = 216 * MiB, WS_V = 264 * MiB;
constexpr size_t WS_GA = 312 * MiB, WS_GF = 360 * MiB;
constexpr size_t WS_PROJ = 408 * MiB;
constexpr size_t WS_END = 504 * MiB;
static_assert(WS_M2A + 33 * 32768 <= WS_M2B && WS_M2B + 65 * 32768 <= WS_SSQ1 && WS_SSQ2 + (size_t)NTOK * 64 <= WS_XN, "d_ws map");
constexpr int RING_BYTES = 131072, LDSCTL_OFF = RING_BYTES, MISC_OFF = LDSCTL_OFF + 320, LDS_BYTES = 147456;
#define GAS __attribute__((address_space(1)))
#define LAS __attribute__((address_space(3)))
typedef unsigned short bf16;
typedef unsigned v4u __attribute__((ext_vector_type(4)));
typedef unsigned v2u __attribute__((ext_vector_type(2)));
typedef float f32x4 __attribute__((ext_vector_type(4)));
typedef short bf16x8 __attribute__((ext_vector_type(8)));
#define LDS_WAIT() asm volatile("s_waitcnt lgkmcnt(0)" ::: "memory")
#define VM_WAIT() asm volatile("s_waitcnt vmcnt(0)" ::: "memory")
__device__ __forceinline__ unsigned f2bf(float f) { unsigned u = __builtin_bit_cast(unsigned, f); return (u + 0x7fffu + ((u >> 16) & 1u)) >> 16; }
__device__ __forceinline__ unsigned pk2(float lo, float hi) { return f2bf(lo) | (f2bf(hi) << 16); }
#define XB_TMO      128
#define XB_XCNT(j)  (256  + 64 * (j))
#define XB_XSUB(j)  (1280 + 64 * (j))
#define XB_XGEN(j)  (2304 + 64 * (j))
#define XB_TOP      3328
#define XB_TOPGEN   3392
#define XCD_BAR_WORDS 3456
#define XB_SPIN_CAP (1u << 18)

__device__ __forceinline__ unsigned xb_ld(unsigned* p)              { return __hip_atomic_load(p, __ATOMIC_RELAXED, __HIP_MEMORY_SCOPE_AGENT); }
__device__ __forceinline__ unsigned xb_add(unsigned* p, unsigned v) { return __hip_atomic_fetch_add(p, v, __ATOMIC_RELAXED, __HIP_MEMORY_SCOPE_AGENT); }
__device__ __forceinline__ unsigned xb_xcc_id() { return (unsigned)__builtin_amdgcn_s_getreg((3 << 11) | 20) & 0xFu; }
#define XB_SPIN(cond, bar) do { unsigned _sp = 0; while (cond) { __builtin_amdgcn_s_sleep(1); \
    if ((++_sp & 255u) == 0u) { if (xb_ld(&(bar)[XB_TMO])) break; if (_sp > XB_SPIN_CAP) { atomicAdd(&(bar)[XB_TMO], 1u); break; } } } } while (0)

struct XcdBarrier {
    unsigned* bar; unsigned x;
    volatile LAS unsigned* st;
};

__device__ __forceinline__ XcdBarrier xcd_barrier_post(unsigned* bar, volatile LAS unsigned* st) {
    XcdBarrier b; b.bar = bar; b.x = xb_xcc_id(); b.st = st;
    if (threadIdx.x == 0) (void)xb_add(&bar[XB_XCNT(b.x)], 1u);
    return b;
}
__device__ __forceinline__ void xcd_barrier_complete(unsigned* bar, unsigned x, unsigned& nloc, unsigned& nx) {
    const unsigned G = gridDim.x * gridDim.y * gridDim.z;
    unsigned sum, cnt, mine, sp = 0u;
    for (;;) {
        sum = 0u; cnt = 0u; mine = 0u;
#pragma unroll
        for (unsigned j = 0; j < 16; ++j) { const unsigned c = xb_ld(&bar[XB_XCNT(j)]); sum += c; cnt += (c > 0u) ? 1u : 0u; mine = (j == x) ? c : mine; }
        if (sum == G) break;
        __builtin_amdgcn_s_sleep(1);
        if ((++sp & 255u) == 0u) { if (xb_ld(&bar[XB_TMO])) break; if (sp > XB_SPIN_CAP) { atomicAdd(&bar[XB_TMO], 1u); break; } }
    }
    nloc = mine > 0u ? mine : 1u; nx = cnt > 0u ? cnt : 1u;
}

__device__ __forceinline__ void xcd_barrier(const XcdBarrier& b) {
    asm volatile("s_waitcnt vmcnt(0)" ::: "memory");
    __syncthreads();
    if (threadIdx.x == 0) {
        unsigned* bar = b.bar;
        __builtin_amdgcn_s_waitcnt(0);
        unsigned nloc = b.st[0], nx = b.st[1];
        if (nloc == 0u) { xcd_barrier_complete(bar, b.x, nloc, nx); b.st[0] = nloc; b.st[1] = nx; }
        const unsigned old = xb_add(&bar[XB_XSUB(b.x)], 1u);
        const unsigned gen = old / nloc;
        if (old + 1u == (gen + 1u) * nloc) {
            __builtin_amdgcn_fence(__ATOMIC_RELEASE, "agent");
            asm volatile("s_waitcnt vmcnt(0)" ::: "memory");
            const unsigned og = xb_add(&bar[XB_TOP], 1u);
            const unsigned tg = og / nx;
            if (og + 1u == (tg + 1u) * nx) xb_add(&bar[XB_TOPGEN], 1u);
            else XB_SPIN(xb_ld(&bar[XB_TOPGEN]) == tg, bar);
            __builtin_amdgcn_fence(__ATOMIC_ACQUIRE, "agent");
            xb_add(&bar[XB_XGEN(b.x)], 1u);
            asm volatile("s_waitcnt vmcnt(0)" ::: "memory");
        } else {
            XB_SPIN(xb_ld(&bar[XB_XGEN(b.x)]) == gen, bar);
            __builtin_amdgcn_fence(__ATOMIC_ACQUIRE, "agent");
            asm volatile("s_waitcnt vmcnt(0)" ::: "memory");
        }
    }
    __syncthreads();
}
namespace att3 {
#ifndef ATT_REGSTAGE
#define ATT_REGSTAGE 0
#endif
#ifndef DMA_IN_VSEG
#define DMA_IN_VSEG 0
#endif
#ifndef QK_IN_VSEG
#define QK_IN_VSEG 0
#endif
#ifndef ATT_ONEBAR
#define ATT_ONEBAR 1
#endif
#ifndef ATT_LOCKSTEP
#define ATT_LOCKSTEP 0
#endif
typedef unsigned short bf16_t;
typedef short bf16x8 __attribute__((ext_vector_type(8)));
typedef short s16x4 __attribute__((ext_vector_type(4)));
typedef float f32x16 __attribute__((ext_vector_type(16)));
typedef float f32x4 __attribute__((ext_vector_type(4)));
typedef unsigned u32x4 __attribute__((ext_vector_type(4)));
#define A2_LAS __attribute__((address_space(3)))
#ifndef PRIO_MODE
#define PRIO_MODE 0
#endif
#if PRIO_MODE == 1
#define A3_PRIO_M(x) __builtin_amdgcn_s_setprio(x)
#define A3_PRIO_V(x) do { } while (0)
#elif PRIO_MODE == 2
#define A3_PRIO_M(x) do { } while (0)
#define A3_PRIO_V(x) __builtin_amdgcn_s_setprio(x)
#else
#define A3_PRIO_M(x) do { } while (0)
#define A3_PRIO_V(x) do { } while (0)
#endif
constexpr int KVBLK = 64, TILEB = 16384, KRING = 4, VRING = 3;
constexpr int OFF_K = 0, OFF_V = KRING * TILEB, OFF_WS = (KRING + VRING) * TILEB, OFF_TAB = OFF_WS + 8 * 256, A2_LDS_END = OFF_TAB + 2048;
constexpr float THR2 = 11.5f;
#define KSWZ(row, colB) ((row) * 256 + ((colB) ^ (((row) & 15) << 4)))
__device__ __forceinline__ int crow(int r, int hi) { return (r & 3) + 8 * (r >> 2) + 4 * hi; }
__device__ __forceinline__ unsigned cvtpk(float lo, float hi) { unsigned r; asm volatile("v_cvt_pk_bf16_f32 %0, %1, %2" : "=v"(r) : "v"(lo), "v"(hi)); return r; }
__device__ __forceinline__ float bflo(unsigned w) { return __uint_as_float(w << 16); }
__device__ __forceinline__ float bfhi(unsigned w) { return __uint_as_float(w & 0xffff0000u); }
__device__ __forceinline__ float silu(float a) { return a * __builtin_amdgcn_rcpf(1.f + __expf(-a)); }
__device__ __forceinline__ float max3f(float a, float b, float c) { float r; asm("v_max3_f32 %0, %1, %2, %3" : "=v"(r) : "v"(a), "v"(b), "v"(c)); return r; }
__device__ __forceinline__ float max2f(float a, float b) { float r; asm("v_max_f32_e32 %0, %1, %2" : "=v"(r) : "v"(a), "v"(b)); return r; }
__device__ __forceinline__ float fadd_s(float a, float b) { float r; asm("v_add_f32_e32 %0, %1, %2" : "=v"(r) : "v"(a), "v"(b)); return r; }
__device__ __forceinline__ float exp2_s(float a) { float r; asm("v_exp_f32_e32 %0, %1" : "=v"(r) : "v"(a)); return r; }
typedef short v4i16_t __attribute__((ext_vector_type(4)));
__device__ __forceinline__ s16x4 vtr(const A2_LAS char* p) { return __builtin_bit_cast(s16x4, __builtin_amdgcn_ds_read_tr16_b64_v4i16((A2_LAS v4i16_t*)p)); }
__device__ __forceinline__ int v_rd_base(int lane) { return ((lane & 3) << 3) | (((lane >> 2) & 3) << 6) | (((lane >> 4) & 1) << 5) | (((lane >> 5) & 1) << 11); }
constexpr int v_rd_off(int d0, int ks, int half) { return d0 * 512 + ks * 4096 + half * 256; }

#ifndef MFMA_GAP
#define MFMA_GAP 0
#endif
#if MFMA_GAP > 0
#define MGAP_STR2(x) #x
#define MGAP_STR(x) MGAP_STR2(x)
#define MGAP() asm volatile("s_nop " MGAP_STR(MFMA_GAP))
#else
#define MGAP() do { } while (0)
#endif
__device__ __forceinline__ void kload(bf16x8* kf, const A2_LAS char* Ks, int r32, int hi, int comp) {
#pragma unroll
  for (int d0 = 0; d0 < 4; ++d0) { const int cb = ((comp * 4 + d0) * 16 + hi * 8) * 2;
    kf[2 * d0] = *reinterpret_cast<const A2_LAS bf16x8*>(Ks + KSWZ(r32, cb)); kf[2 * d0 + 1] = *reinterpret_cast<const A2_LAS bf16x8*>(Ks + KSWZ(32 + r32, cb)); }
}
__device__ __forceinline__ void qkt_a(f32x16& p0, f32x16& p1, const bf16x8* kf, const bf16x8* qr, const f32x16& negm) {
  p0 = __builtin_amdgcn_mfma_f32_32x32x16_bf16(kf[0], qr[0], negm, 0, 0, 0); MGAP(); p1 = __builtin_amdgcn_mfma_f32_32x32x16_bf16(kf[1], qr[0], negm, 0, 0, 0); MGAP();
  p0 = __builtin_amdgcn_mfma_f32_32x32x16_bf16(kf[2], qr[1], p0, 0, 0, 0); MGAP(); p1 = __builtin_amdgcn_mfma_f32_32x32x16_bf16(kf[3], qr[1], p1, 0, 0, 0); MGAP();
}
__device__ __forceinline__ void qkt_b(f32x16& p0, f32x16& p1, const bf16x8* kf, const bf16x8* qr) {
  p0 = __builtin_amdgcn_mfma_f32_32x32x16_bf16(kf[4], qr[2], p0, 0, 0, 0); MGAP(); p1 = __builtin_amdgcn_mfma_f32_32x32x16_bf16(kf[5], qr[2], p1, 0, 0, 0); MGAP();
  p0 = __builtin_amdgcn_mfma_f32_32x32x16_bf16(kf[6], qr[3], p0, 0, 0, 0); MGAP(); p1 = __builtin_amdgcn_mfma_f32_32x32x16_bf16(kf[7], qr[3], p1, 0, 0, 0); MGAP();
}
struct VFrag { s16x4 lo[4], hh[4]; };
template <int D0> __device__ __forceinline__ void vload(VFrag& f, const A2_LAS char* vp) {
#pragma unroll
  for (int ks = 0; ks < 4; ++ks) { f.lo[ks] = vtr(vp + v_rd_off(D0, ks, 0)); f.hh[ks] = vtr(vp + v_rd_off(D0, ks, 1)); }
}
template <int D0> __device__ __forceinline__ void vload_a(VFrag& f, unsigned va) {
#define VTR_A(dst, off) asm volatile("ds_read_b64_tr_b16 %0, %1 offset:%2" : "=v"(dst) : "v"(va), "n"(off))
  VTR_A(f.lo[0], v_rd_off(D0, 0, 0)); VTR_A(f.hh[0], v_rd_off(D0, 0, 1)); VTR_A(f.lo[1], v_rd_off(D0, 1, 0)); VTR_A(f.hh[1], v_rd_off(D0, 1, 1));
  VTR_A(f.lo[2], v_rd_off(D0, 2, 0)); VTR_A(f.hh[2], v_rd_off(D0, 2, 1)); VTR_A(f.lo[3], v_rd_off(D0, 3, 0)); VTR_A(f.hh[3], v_rd_off(D0, 3, 1));
#undef VTR_A
}
#define VWAIT(n, f) asm volatile("s_waitcnt lgkmcnt(" #n ")" : "+v"(f.lo[0]), "+v"(f.lo[1]), "+v"(f.lo[2]), "+v"(f.lo[3]), "+v"(f.hh[0]), "+v"(f.hh[1]), "+v"(f.hh[2]), "+v"(f.hh[3]))
__device__ __forceinline__ void pvmma(f32x16& od, const VFrag& f, bf16x8 pa0, bf16x8 pa1, bf16x8 pa2, bf16x8 pa3) {
#define PK(k) (bf16x8){f.lo[k][0], f.lo[k][1], f.lo[k][2], f.lo[k][3], f.hh[k][0], f.hh[k][1], f.hh[k][2], f.hh[k][3]}
  od = __builtin_amdgcn_mfma_f32_32x32x16_bf16(PK(0), pa0, od, 0, 0, 0); MGAP();
  od = __builtin_amdgcn_mfma_f32_32x32x16_bf16(PK(1), pa1, od, 0, 0, 0); MGAP();
  od = __builtin_amdgcn_mfma_f32_32x32x16_bf16(PK(2), pa2, od, 0, 0, 0); MGAP();
  od = __builtin_amdgcn_mfma_f32_32x32x16_bf16(PK(3), pa3, od, 0, 0, 0); MGAP();
#undef PK
}
__device__ __forceinline__ float vtail(const f32x16& p0, const f32x16& p1, bf16x8& pa0, bf16x8& pa1, bf16x8& pa2, bf16x8& pa3) {
  float sa, sb, e0, e1, e2, e3, e4, e5, e6, e7; u32x4 w0, w1, w2, w3;
#define VT_BODY(ADD0, ADD1) "v_exp_f32_e32 %6, %14\n\tv_exp_f32_e32 %7, %15\n\tv_exp_f32_e32 %8, %16\n\tv_exp_f32_e32 %9, %17\n\t" ADD0 "v_exp_f32_e32 %10, %18\n\t" ADD1 "v_exp_f32_e32 %11, %19\n\t" \
    "v_cvt_pk_bf16_f32 %2, %6, %7\n\tv_exp_f32_e32 %12, %20\n\tv_cvt_pk_bf16_f32 %3, %8, %9\n\tv_exp_f32_e32 %13, %21\n\tv_add_f32_e32 %0, %0, %10\n\tv_add_f32_e32 %1, %1, %11\n\t" \
    "v_cvt_pk_bf16_f32 %4, %10, %11\n\tv_add_f32_e32 %0, %0, %12\n\tv_add_f32_e32 %1, %1, %13\n\tv_cvt_pk_bf16_f32 %5, %12, %13"
#define VT_OUT(W) "=&v"(W.x), "=&v"(W.y), "=&v"(W.z), "=&v"(W.w), "=&v"(e0), "=&v"(e1), "=&v"(e2), "=&v"(e3), "=&v"(e4), "=&v"(e5), "=&v"(e6), "=&v"(e7)
#define VT_IN(P, B) "v"(P[B + 0]), "v"(P[B + 1]), "v"(P[B + 2]), "v"(P[B + 3]), "v"(P[B + 4]), "v"(P[B + 5]), "v"(P[B + 6]), "v"(P[B + 7])
  asm(VT_BODY("v_add_f32_e32 %0, %6, %7\n\t", "v_add_f32_e32 %1, %8, %9\n\t") : "=&v"(sa), "=&v"(sb), VT_OUT(w0) : VT_IN(p0, 0));
  asm(VT_BODY("v_add_f32_e32 %0, %0, %6\n\tv_add_f32_e32 %1, %1, %7\n\t", "v_add_f32_e32 %0, %0, %8\n\tv_add_f32_e32 %1, %1, %9\n\t") : "+v"(sa), "+v"(sb), VT_OUT(w1) : VT_IN(p0, 8));
  asm(VT_BODY("v_add_f32_e32 %0, %0, %6\n\tv_add_f32_e32 %1, %1, %7\n\t", "v_add_f32_e32 %0, %0, %8\n\tv_add_f32_e32 %1, %1, %9\n\t") : "+v"(sa), "+v"(sb), VT_OUT(w2) : VT_IN(p1, 0));
  asm(VT_BODY("v_add_f32_e32 %0, %0, %6\n\tv_add_f32_e32 %1, %1, %7\n\t", "v_add_f32_e32 %0, %0, %8\n\tv_add_f32_e32 %1, %1, %9\n\t") : "+v"(sa), "+v"(sb), VT_OUT(w3) : VT_IN(p1, 8));
#undef VT_BODY
#undef VT_OUT
#undef VT_IN
  pa0 = *reinterpret_cast<bf16x8*>(&w0); pa1 = *reinterpret_cast<bf16x8*>(&w1); pa2 = *reinterpret_cast<bf16x8*>(&w2); pa3 = *reinterpret_cast<bf16x8*>(&w3);
  return sa + sb;
}
__device__ __forceinline__ float rowmax64(const f32x16& p0, const f32x16& p1) {
  float a, b;
  asm("v_max3_f32 %0, %2, %3, %4\n\tv_max3_f32 %1, %5, %6, %7\n\tv_max3_f32 %0, %0, %8, %9" : "=&v"(a), "=&v"(b) : "v"(p0[0]), "v"(p0[1]), "v"(p1[0]), "v"(p0[2]), "v"(p0[3]), "v"(p1[1]), "v"(p1[2]), "v"(p1[3]));
#define MAX8(r) asm("v_max3_f32 %0, %0, %2, %3\n\tv_max3_f32 %1, %1, %4, %5\n\tv_max3_f32 %0, %0, %6, %7\n\tv_max3_f32 %1, %1, %8, %9" : "+v"(a), "+v"(b) : "v"(p0[r]), "v"(p0[r + 1]), "v"(p0[r + 2]), "v"(p0[r + 3]), "v"(p1[r]), "v"(p1[r + 1]), "v"(p1[r + 2]), "v"(p1[r + 3]))
  MAX8(4); MAX8(8);
  asm("v_max3_f32 %0, %0, %2, %3\n\tv_max3_f32 %1, %1, %4, %5\n\tv_max3_f32 %0, %0, %6, %7\n\tv_max3_f32 %1, %1, %8, %9\n\tv_max_f32_e32 %0, %0, %1" : "+v"(a), "+v"(b) : "v"(p0[12]), "v"(p0[13]), "v"(p0[14]), "v"(p0[15]), "v"(p1[12]), "v"(p1[13]), "v"(p1[14]), "v"(p1[15]));
#undef MAX8
  float rm = a;
  { auto rr = __builtin_amdgcn_permlane32_swap(__float_as_uint(rm), __float_as_uint(rm), false, false); rm = max2f(__uint_as_float(rr[0]), __uint_as_float(rr[1])); }
  return rm;
}
constexpr float REFOFF = THR2 - 1.f;
template <bool NEAR>
__device__ __forceinline__ bool vseg(f32x16& p0, f32x16& p1, float& mhat, float& l_reg, const bool first, const A2_LAS float* tabp, float& fsc, int r32, int hi,
                                     bf16x8& pa0, bf16x8& pa1, bf16x8& pa2, bf16x8& pa3) {
  if (NEAR) {
#pragma unroll
    for (int r = 0; r < 16; ++r) { const int o_ = (r & 3) + 8 * (r >> 2); p0[r] = fadd_s(p0[r], tabp[o_]); p1[r] = fadd_s(p1[r], tabp[o_ + 32]); }
  }
  if (first) { const float d = rowmax64(p0, p1) + REFOFF; mhat += d;
#pragma unroll
    for (int r = 0; r < 16; ++r) { p0[r] -= d; p1[r] -= d; }
    l_reg += vtail(p0, p1, pa0, pa1, pa2, pa3); return false;
  }
  const float ts = vtail(p0, p1, pa0, pa1, pa2, pa3);
  if (__builtin_expect(__any(!(ts < 2.f)), 0)) {
    const float dl = __builtin_fmaxf(rowmax64(p0, p1) + REFOFF, 0.f); mhat += dl;
#pragma unroll
    for (int r = 0; r < 16; ++r) { p0[r] -= dl; p1[r] -= dl; }
    const float f = __builtin_amdgcn_exp2f(-dl); l_reg *= f; fsc = f;
    l_reg += vtail(p0, p1, pa0, pa1, pa2, pa3); return true;
  }
  l_reg += ts; return false;
}

template <int VAR>
__device__ __forceinline__ void attn_unit(const bf16_t* QU, bf16_t* OQ, const bf16_t* __restrict__ KB, const bf16_t* __restrict__ VB, const bf16_t* __restrict__ GA,
                                          const float* __restrict__ tabg, const float* __restrict__ subg, float lam, int tok0, int seq, int h, int q0, A2_LAS unsigned char* lds, const int wave_, const int role_,
                                          const bool pre = false, const int ntok0 = -1, const int nh = 0) {
  const int tid = opq_tid(wave_), lane = tid & 63, r32 = lane & 31, hi = lane >> 5; const int wid = wave_;
  const int comp = role_ >> 2, rb = role_ & 3;
  const A2_LAS char* Kr = (const A2_LAS char*)lds + OFF_K; const A2_LAS char* Vr = (const A2_LAS char*)lds + OFF_V;
  A2_LAS float* wsf = (A2_LAS float*)(lds + OFF_WS) + wid * 64; A2_LAS float* li_l = wsf; A2_LAS float* al_l = wsf + 32;
  A2_LAS float* tab = (A2_LAS float*)(lds + OFF_TAB);
  unsigned koff[2], voff[2];
#pragma unroll
  for (int i = 0; i < 2; ++i) { const int pc = 2 * wid + i;
    { const int row = 4 * pc + (lane >> 4), c = (lane & 15) ^ (row & 15); koff[i] = (unsigned)(row * 1024 + c * 16); }
    { const int st = 2 * pc + (lane >> 5), kk = (st >> 2) * 8 + ((lane & 31) >> 2), key = (kk & ~0xC) | ((kk & 4) << 1) | ((kk & 8) >> 1), col = (st & 3) * 32 + (lane & 3) * 8;
      voff[i] = (unsigned)(key * 1024 + col * 2); } }
  const char* Kh = (const char*)(KB + (size_t)tok0 * 512 + h * 128); const char* Vh = (const char*)(VB + (size_t)tok0 * 512 + h * 128);
  const int NT = seq / KVBLK;
#define DMA_K(t, slot) do { const int t_ = (t) < NT ? (t) : NT - 1; const char* g_ = Kh + (size_t)t_ * (KVBLK * 1024); \
    __builtin_amdgcn_global_load_lds((const unsigned*)(g_ + koff[0]), (A2_LAS unsigned*)(lds + OFF_K + (slot) * TILEB + (2 * wid) * 1024), 16, 0, 0); \
    __builtin_amdgcn_global_load_lds((const unsigned*)(g_ + koff[1]), (A2_LAS unsigned*)(lds + OFF_K + (slot) * TILEB + (2 * wid + 1) * 1024), 16, 0, 0); } while (0)
#define DMA_V(t, slot) do { const int t_ = (t) < NT ? (t) : NT - 1; const char* g_ = Vh + (size_t)t_ * (KVBLK * 1024); \
    __builtin_amdgcn_global_load_lds((const unsigned*)(g_ + voff[0]), (A2_LAS unsigned*)(lds + OFF_V + (slot) * TILEB + (2 * wid) * 1024), 16, 0, 0); \
    __builtin_amdgcn_global_load_lds((const unsigned*)(g_ + voff[1]), (A2_LAS unsigned*)(lds + OFF_V + (slot) * TILEB + (2 * wid + 1) * 1024), 16, 0, 0); } while (0)
#define STG_GEOM() int tid_s = tid; asm volatile("" : "+v"(tid_s)); const int sr = tid_s >> 4, sc = (tid_s & 15) * 8
#define STG_KOFF() const int kst0 = KSWZ(sr, sc * 2), kst1 = KSWZ(32 + sr, sc * 2)
#define STG_VOFF() const int kk0 = (sr & ~0xC) | ((sr & 4) << 1) | ((sr & 8) >> 1), kk1 = kk0 + 32; \
    const int vst0 = ((kk0 >> 3) * 4 + (sc >> 5)) * 512 + ((kk0 & 7) * 32 + (sc & 31)) * 2, vst1 = ((kk1 >> 3) * 4 + (sc >> 5)) * 512 + ((kk1 & 7) * 32 + (sc & 31)) * 2
#define STG_SOFF() const unsigned soff0 = (unsigned)(sr * 1024 + sc * 2), soff1 = soff0 + 32 * 1024
  bf16x8 kq0, kq1, vq0, vq1;
#define LD16(base, off) (*reinterpret_cast<const bf16x8*>((base) + (off)))
#define LOADK(t) do { STG_GEOM(); STG_SOFF(); const int t_ = (t) < NT ? (t) : NT - 1; const char* g_ = Kh + (size_t)t_ * (KVBLK * 1024); kq0 = LD16(g_, soff0); kq1 = LD16(g_, soff1); } while (0)
#define LOADV(t) do { STG_GEOM(); STG_SOFF(); const int t_ = (t) < NT ? (t) : NT - 1; const char* g_ = Vh + (size_t)t_ * (KVBLK * 1024); vq0 = LD16(g_, soff0); vq1 = LD16(g_, soff1); } while (0)
#define WRITEK(slot) do { STG_GEOM(); STG_KOFF(); A2_LAS char* d_ = (A2_LAS char*)lds + OFF_K + (slot) * TILEB; *(A2_LAS bf16x8*)(d_ + kst0) = kq0; *(A2_LAS bf16x8*)(d_ + kst1) = kq1; } while (0)
#define WRITEV(slot) do { STG_GEOM(); STG_VOFF(); A2_LAS char* d_ = (A2_LAS char*)lds + OFF_V + (slot) * TILEB; *(A2_LAS bf16x8*)(d_ + vst0) = vq0; *(A2_LAS bf16x8*)(d_ + vst1) = vq1; } while (0)
#define BAR() __builtin_amdgcn_s_barrier()
#define WAITV(n) asm volatile("s_waitcnt vmcnt(" #n ")" ::: "memory")
#define WAITL() asm volatile("s_waitcnt lgkmcnt(0)" ::: "memory")
  bf16x8 qr[4];
  { const bf16_t* Qw = QU + (size_t)(tok0 + q0 + rb * 32 + r32) * 1024 + h * 128 + comp * 64 + hi * 8;
#pragma unroll
    for (int d0 = 0; d0 < 4; ++d0) qr[d0] = *reinterpret_cast<const bf16x8*>(Qw + d0 * 16); }
  { const int i = tid; int rel = i - 256; rel = rel < -128 ? -128 : (rel > 127 ? 127 : rel); tab[i] = tabg[h * 256 + rel + 128]; }
#if ATT_REGSTAGE
  { LOADK(0); LOADV(0); const bf16x8 a0 = kq0, a1 = kq1; LOADK(1); const bf16x8 b0 = kq0, b1 = kq1; LOADK(2); STG_GEOM(); STG_KOFF();
    A2_LAS char* d_ = (A2_LAS char*)lds + OFF_K; *(A2_LAS bf16x8*)(d_ + kst0) = a0; *(A2_LAS bf16x8*)(d_ + kst1) = a1; *(A2_LAS bf16x8*)(d_ + TILEB + kst0) = b0; *(A2_LAS bf16x8*)(d_ + TILEB + kst1) = b1;
    WRITEK(2); WRITEV(0); }
#else
  if (!pre) { DMA_K(0, 0); DMA_K(1, 1); }
  DMA_V(0, 0); DMA_K(2, 2);
#endif
  const int qw0 = q0 + rb * 32, qpos = qw0 + r32;
  float mhat = 0.f, l_reg = 0.f; f32x16 o[4];
#pragma unroll
  for (int d = 0; d < 4; ++d) o[d] = f32x16{};
  f32x16 p0, p1, negm; bf16x8 pa0, pa1, pa2, pa3; bf16x8 kf[8]; VFrag vfa, vfb;
#define SBAR() __builtin_amdgcn_sched_barrier(0)
  const int vbase = v_rd_base(lane);
  if (!ATT_REGSTAGE) WAITV(4);
  WAITL(); BAR();
  const float tabL = tab[128], tabR = tab[383];
  if (!ATT_LOCKSTEP && !ATT_ONEBAR && comp == 1) BAR();
#define CLS(j) ((64 * (j) + 63 - qw0 <= -91) ? 0 : ((64 * (j) - qw0 - 31 >= 91) ? 1 : 2))
#define CCONST(c) ((c) == 0 ? tabL : ((c) == 1 ? tabR : 0.f))
#define SETNEGM(c) do { const float v_ = CCONST(c) - mhat; _Pragma("unroll") for (int r = 0; r < 16; ++r) negm[r] = v_; } while (0)
#define RESC() do { _Pragma("unroll") for (int d = 0; d < 4; ++d) _Pragma("unroll") for (int r = 0; r < 16; ++r) o[d][r] *= fsc_; } while (0)
#define VSEG(j, FIRST) do { const int c_ = cls; bool rs_; float fsc_ = 1.f; \
    if (c_ == 2) rs_ = vseg<true>(p0, p1, mhat, l_reg, FIRST, tab + (64 * (j) - qpos + 256 + 4 * hi), fsc_, r32, hi, pa0, pa1, pa2, pa3); \
    else rs_ = vseg<false>(p0, p1, mhat, l_reg, FIRST, tab, fsc_, r32, hi, pa0, pa1, pa2, pa3); \
    if (rs_) RESC(); \
    const int cn_ = CLS((j) + 1); if (__builtin_expect(rs_ || (FIRST) || cn_ != c_, 0)) { SETNEGM(cn_); asm volatile("" : "+v"(negm)); } cls = cn_; } while (0)
#define PKONLY() do { u32x4 w0 = {cvtpk(p0[0], p0[1]), cvtpk(p0[2], p0[3]), cvtpk(p0[4], p0[5]), cvtpk(p0[6], p0[7])}, w1 = {cvtpk(p0[8], p0[9]), cvtpk(p0[10], p0[11]), cvtpk(p0[12], p0[13]), cvtpk(p0[14], p0[15])}; \
    u32x4 w2 = {cvtpk(p1[0], p1[1]), cvtpk(p1[2], p1[3]), cvtpk(p1[4], p1[5]), cvtpk(p1[6], p1[7])}, w3 = {cvtpk(p1[8], p1[9]), cvtpk(p1[10], p1[11]), cvtpk(p1[12], p1[13]), cvtpk(p1[14], p1[15])}; \
    pa0 = *reinterpret_cast<bf16x8*>(&w0); pa1 = *reinterpret_cast<bf16x8*>(&w1); pa2 = *reinterpret_cast<bf16x8*>(&w2); pa3 = *reinterpret_cast<bf16x8*>(&w3); } while (0)
  int cls = CLS(0); SETNEGM(cls);
  kload(kf, Kr, r32, hi, comp);
  A3_PRIO_M(1);
  qkt_a(p0, p1, kf, qr, negm); qkt_b(p0, p1, kf, qr);
  A3_PRIO_M(0);
  if (ATT_REGSTAGE) { SBAR(); LOADK(3); LOADV(1); } else if (!DMA_IN_VSEG) { DMA_K(3, 3); DMA_V(1, 1); }
  if (!ATT_LOCKSTEP && (!ATT_ONEBAR || comp == 1)) { if (comp == 1 && !ATT_REGSTAGE) { if (DMA_IN_VSEG) WAITV(0); else WAITV(4); } WAITL(); BAR(); }
  if (DMA_IN_VSEG && !ATT_REGSTAGE) { DMA_K(3, 3); DMA_V(1, 1); }
  A3_PRIO_V(1); kload(kf, Kr + TILEB, r32, hi, comp); SBAR();
  VSEG(0, true); A3_PRIO_V(0);
  if (QK_IN_VSEG) { qkt_a(p0, p1, kf, qr, negm); qkt_b(p0, p1, kf, qr); }
  if (ATT_REGSTAGE) { WRITEK(3); WRITEV(1); WAITL(); } else if (ATT_LOCKSTEP || comp == 0) WAITV(4);
  if (!ATT_ONEBAR || ATT_LOCKSTEP || comp == 0) BAR();
  int sk = 2, sv = 0;
  for (int j = 1; j < NT; ++j) {
    asm volatile("" : "+v"(koff[0]), "+v"(koff[1]), "+v"(voff[0]), "+v"(voff[1]));
    const A2_LAS char* vp = Vr + sv * TILEB + vbase;
    A3_PRIO_M(1);
    if (VAR == 8) {
#define FILL() do { fx0 = __builtin_amdgcn_exp2f(fx0); fy0 += fx1; fy1 += fx0; fy2 += fy0; asm volatile("" : "+v"(fx0), "+v"(fy0), "+v"(fy1), "+v"(fy2)); } while (0)
#define MF(dst, a, b, c) do { dst = __builtin_amdgcn_mfma_f32_32x32x16_bf16(a, b, c, 0, 0, 0); FILL(); } while (0)
      float fx0 = (float)j, fx1 = 1.f, fy0 = 0.f, fy1 = 0.f, fy2 = 0.f;
      MF(p0, kf[0], qr[0], negm); MF(p1, kf[1], qr[0], negm); MF(p0, kf[2], qr[1], p0); MF(p1, kf[3], qr[1], p1); MF(p0, kf[4], qr[2], p0); MF(p1, kf[5], qr[2], p1); MF(p0, kf[6], qr[3], p0); MF(p1, kf[7], qr[3], p1);
      const bf16x8 vb_ = kf[0];
      _Pragma("unroll") for (int d = 0; d < 4; ++d) { MF(o[d], pa0, vb_, o[d]); MF(o[d], pa1, vb_, o[d]); MF(o[d], pa2, vb_, o[d]); MF(o[d], pa3, vb_, o[d]); }
      l_reg += fy1 + fy2;
#undef MF
#undef FILL
    } else if (VAR == 4 || VAR == 6 || VAR == 7) {
      asm volatile("" : "+v"(vfa.lo[0]), "+v"(vfa.hh[0]), "+v"(vfb.lo[0]), "+v"(vfb.hh[0]));
      qkt_a(p0, p1, kf, qr, negm); qkt_b(p0, p1, kf, qr);
      pvmma(o[0], vfa, pa0, pa1, pa2, pa3); pvmma(o[1], vfb, pa0, pa1, pa2, pa3); pvmma(o[2], vfa, pa0, pa1, pa2, pa3); pvmma(o[3], vfb, pa0, pa1, pa2, pa3);
    } else if (VAR == 5) {
      vload<0>(vfa, vp); vload<1>(vfb, vp); asm volatile("" : "+v"(vfa.lo[0]), "+v"(vfa.lo[1]), "+v"(vfa.lo[2]), "+v"(vfa.lo[3]), "+v"(vfa.hh[0]), "+v"(vfa.hh[1]), "+v"(vfa.hh[2]), "+v"(vfa.hh[3]), "+v"(vfb.lo[0]), "+v"(vfb.lo[1]), "+v"(vfb.lo[2]), "+v"(vfb.lo[3]), "+v"(vfb.hh[0]), "+v"(vfb.hh[1]), "+v"(vfb.hh[2]), "+v"(vfb.hh[3]));
      vload<2>(vfa, vp); vload<3>(vfb, vp); asm volatile("" : "+v"(vfa.lo[0]), "+v"(vfa.lo[1]), "+v"(vfa.lo[2]), "+v"(vfa.lo[3]), "+v"(vfa.hh[0]), "+v"(vfa.hh[1]), "+v"(vfa.hh[2]), "+v"(vfa.hh[3]), "+v"(vfb.lo[0]), "+v"(vfb.lo[1]), "+v"(vfb.lo[2]), "+v"(vfb.lo[3]), "+v"(vfb.hh[0]), "+v"(vfb.hh[1]), "+v"(vfb.hh[2]), "+v"(vfb.hh[3]));
      asm volatile("" : "+v"(kf[0]), "+v"(kf[1]), "+v"(kf[2]), "+v"(kf[3]), "+v"(kf[4]), "+v"(kf[5]), "+v"(kf[6]), "+v"(kf[7]));
      p0 = negm; p1 = negm;
    } else {
    const unsigned va = (unsigned)(size_t)vp;
    if (!QK_IN_VSEG) { qkt_a(p0, p1, kf, qr, negm); SBAR(); }
    vload_a<0>(vfa, va); SBAR();
    if (!QK_IN_VSEG) qkt_b(p0, p1, kf, qr);
    vload_a<1>(vfb, va); SBAR();
    VWAIT(8, vfa); pvmma(o[0], vfa, pa0, pa1, pa2, pa3);
    vload_a<2>(vfa, va); SBAR();
    VWAIT(8, vfb); pvmma(o[1], vfb, pa0, pa1, pa2, pa3);
    vload_a<3>(vfb, va); SBAR();
    VWAIT(8, vfa); pvmma(o[2], vfa, pa0, pa1, pa2, pa3);
    VWAIT(0, vfb); pvmma(o[3], vfb, pa0, pa1, pa2, pa3);
    }
    A3_PRIO_M(0);
    { const int s3 = (sk + 2) & 3  , s1 = sv == 0 ? 2 : sv - 1  ; if (VAR != 3 && VAR != 7 && VAR != 8) { if (ATT_REGSTAGE) { SBAR(); LOADK(j + 3); LOADV(j + 1); } else if (!DMA_IN_VSEG) { DMA_K(j + 3, s3); DMA_V(j + 1, s1); } } }
    if (!ATT_LOCKSTEP && (!ATT_ONEBAR || comp == 1)) { if (comp == 1 && VAR != 3 && VAR != 7 && VAR != 8 && !ATT_REGSTAGE) { if (DMA_IN_VSEG) WAITV(0); else WAITV(4); } WAITL(); BAR(); }
    if (DMA_IN_VSEG && !ATT_REGSTAGE && VAR != 3 && VAR != 7 && VAR != 8) { const int s3 = (sk + 2) & 3, s1 = sv == 0 ? 2 : sv - 1; DMA_K(j + 3, s3); DMA_V(j + 1, s1); }
    A3_PRIO_V(1); if (VAR != 4 && VAR != 6 && VAR != 7 && VAR != 8) { kload(kf, Kr + sk * TILEB, r32, hi, comp); } SBAR();
    if (VAR != 1 && VAR != 6 && VAR != 7 && VAR != 8) { VSEG(j, false); } else { PKONLY(); } A3_PRIO_V(0);
    if (QK_IN_VSEG && VAR == 0) { qkt_a(p0, p1, kf, qr, negm); qkt_b(p0, p1, kf, qr); }
    if (ATT_REGSTAGE) { if (VAR != 3 && VAR != 7 && VAR != 8) { WRITEK((sk + 2) & 3); WRITEV(sv == 0 ? 2 : sv - 1); WAITL(); } }
    else if ((ATT_LOCKSTEP || comp == 0) && VAR != 3 && VAR != 7 && VAR != 8) WAITV(4);
    if (!ATT_ONEBAR || ATT_LOCKSTEP || comp == 0) BAR();
    sk = (sk + 1) & 3; sv = sv == 2 ? 0 : sv + 1;
  }
  { const A2_LAS char* vp = Vr + sv * TILEB + vbase;
    A3_PRIO_M(1);
    const unsigned va = (unsigned)(size_t)vp;
    vload_a<0>(vfa, va); vload_a<1>(vfb, va); SBAR(); VWAIT(8, vfa); pvmma(o[0], vfa, pa0, pa1, pa2, pa3); vload_a<2>(vfa, va); SBAR(); VWAIT(8, vfb); pvmma(o[1], vfb, pa0, pa1, pa2, pa3); vload_a<3>(vfb, va); SBAR();
    VWAIT(8, vfa); pvmma(o[2], vfa, pa0, pa1, pa2, pa3); VWAIT(0, vfb); pvmma(o[3], vfb, pa0, pa1, pa2, pa3);
    A3_PRIO_M(0); }
  WAITV(0); WAITL();
  if (!ATT_LOCKSTEP && !ATT_ONEBAR && comp == 0) BAR();
  { auto rr = __builtin_amdgcn_permlane32_swap(__float_as_uint(l_reg), __float_as_uint(l_reg), false, false); l_reg = __uint_as_float(rr[0]) + __uint_as_float(rr[1]); }
  const float rl = __builtin_amdgcn_rcpf(l_reg);
  u32x4 gq[4]; f32x4 sq[8];
  { const int row = tid >> 2, qt = tid & 3; const bf16_t* gp = GA + (size_t)(tok0 + q0 + row) * 512 + h * 128 + qt * 32; const float* sg = subg + qt * 32;
#pragma unroll
    for (int i = 0; i < 4; ++i) { gq[i] = *(const u32x4*)(gp + 8 * i); sq[2 * i] = *(const f32x4*)(sg + 8 * i); sq[2 * i + 1] = *(const f32x4*)(sg + 8 * i + 4); } }
  WAITL(); BAR(); asm volatile("" ::: "memory");
  if (ntok0 >= 0) { const char* Kn = (const char*)(KB + (size_t)ntok0 * 512 + nh * 128);
#pragma unroll
    for (int t = 0; t < 2; ++t)
#pragma unroll
      for (int i = 0; i < 2; ++i) __builtin_amdgcn_global_load_lds((const unsigned*)(Kn + (size_t)t * (KVBLK * 1024) + koff[i]), (A2_LAS unsigned*)(lds + OFF_K + t * TILEB + (2 * wid + i) * 1024), 16, 0, 0); }
  A2_LAS float* OC = (A2_LAS float*)(lds + OFF_K + 2 * TILEB); constexpr int OST = 129;
  static_assert(OFF_K + 2 * TILEB + 128 * OST * 4 <= OFF_WS, "the exchange tile must end below the per-wave scratch and the bias table");
  if (comp == 0) {
#pragma unroll
    for (int r = 0; r < 16; ++r) {
#pragma unroll
      for (int d0 = 0; d0 < 4; ++d0) OC[(32 * d0 + crow(r, hi)) * OST + rb * 32 + r32] = o[d0][r] * rl; }
  }
  WAITL(); BAR(); asm volatile("" ::: "memory");
  if (comp == 1) { const float sl = lam * rl;
#pragma unroll
    for (int r = 0; r < 16; ++r) {
#pragma unroll
      for (int d0 = 0; d0 < 4; ++d0) OC[(32 * d0 + crow(r, hi)) * OST + rb * 32 + r32] -= o[d0][r] * sl; }
  }
  WAITL(); BAR(); asm volatile("" ::: "memory");
  { const int row = tid >> 2, qt = tid & 3; const A2_LAS float* rp = OC + (qt * 32) * OST + row;
    f32x4 v[8]; float ss = 0.f;
#pragma unroll
    for (int i = 0; i < 8; ++i) { v[i] = (f32x4){rp[(4 * i) * OST], rp[(4 * i + 1) * OST], rp[(4 * i + 2) * OST], rp[(4 * i + 3) * OST]}; ss += (v[i][0] * v[i][0] + v[i][1] * v[i][1]) + (v[i][2] * v[i][2] + v[i][3] * v[i][3]); }
    ss += bperm_f(lane ^ 1, ss); ss += bperm_f(lane ^ 2, ss);
    const float rstd = __builtin_amdgcn_rsqf(ss * (1.f / 128.f) + 1e-5f) * 0.8f;
    const size_t t = (size_t)(tok0 + q0 + row); bf16_t* op = OQ + t * 1024 + h * 128 + qt * 32;
#pragma unroll
    for (int i = 0; i < 4; ++i) { const u32x4 g = gq[i]; const f32x4 s0 = sq[2 * i], s1 = sq[2 * i + 1];
      const f32x4 a = v[2 * i] * rstd * s0, b = v[2 * i + 1] * rstd * s1; u32x4 w;
      w.x = cvtpk(a[0] * silu(bflo(g.x)), a[1] * silu(bfhi(g.x))); w.y = cvtpk(a[2] * silu(bflo(g.y)), a[3] * silu(bfhi(g.y)));
      w.z = cvtpk(b[0] * silu(bflo(g.z)), b[1] * silu(bfhi(g.z))); w.w = cvtpk(b[2] * silu(bflo(g.w)), b[3] * silu(bfhi(g.w)));
      *(u32x4*)(op + 8 * i) = w; }
  }
  asm volatile("s_waitcnt vmcnt(0)" ::: "memory");
  __syncthreads();
#undef DMA_K
#undef LD16
#undef STG_GEOM
#undef STG_KOFF
#undef STG_VOFF
#undef STG_SOFF
#undef LOADK
#undef LOADV
#undef WRITEK
#undef WRITEV
#undef DMA_V
#undef BAR
#undef WAITV
#undef WAITL
#undef CLS
#undef CCONST
#undef SETNEGM
#undef RESC
#undef VSEG
#undef PKONLY
#undef SBAR
#undef VWAIT
}
#undef KSWZ
}
struct Frame {
    LAS unsigned char* lds;
    volatile LAS unsigned* MISC;
    unsigned* ctl;
    int wave;
    int role;
    int vcu, G;
};
__device__ __forceinline__ float wave_sum(float v, int lane) {
#pragma unroll
    for (int o = 1; o < 64; o <<= 1) v += bperm_f(lane ^ o, v);
    return v;
}
__device__ __forceinline__ void p0_transpose_item(const float* W, int K, int N, bf16* WT, const float* kscale, LAS float* scr, int item, int lane) {
    const int nblk = N / 32, kb = item / nblk, nb = item % nblk, k0 = 64 * kb, n0 = 32 * nb;
#pragma unroll 8
    for (int i = 0; i < 32; ++i) { const int kk = 2 * i + (lane >> 5); float w = W[(size_t)(k0 + kk) * N + n0 + (lane & 31)]; if (kscale) w *= kscale[k0 + kk]; scr[kk * 33 + (lane & 31)] = w; }
    LDS_WAIT(); asm volatile("" ::: "memory");
    const int c = lane & 7;
#pragma unroll
    for (int j = 0; j < 4; ++j) { const int n = (lane >> 3) + 8 * j; const LAS float* s = scr + (8 * c) * 33 + n;
        v4u o; o.x = pk2(s[0 * 33], s[1 * 33]); o.y = pk2(s[2 * 33], s[3 * 33]); o.z = pk2(s[4 * 33], s[5 * 33]); o.w = pk2(s[6 * 33], s[7 * 33]);
        *(GAS v4u*)(WT + (size_t)(n0 + n) * K + k0 + 8 * c) = o; }
    LDS_WAIT(); asm volatile("" ::: "memory");
}
__device__ __forceinline__ void rms_row2_to_bf16(const float* xrow0, const float* xrow1, const float* g, bf16* orow0, bf16* orow1, int lane) {
    const GAS f32x4* xr0 = (const GAS f32x4*)xrow0 + lane; const GAS f32x4* xr1 = (const GAS f32x4*)xrow1 + lane; const GAS f32x4* gr = (const GAS f32x4*)g + lane;
    f32x4 v[4], u[4]; float s = 0.f, t = 0.f;
#pragma unroll
    for (int j = 0; j < 4; ++j) { v[j] = xr0[64 * j]; u[j] = xr1[64 * j]; }
#pragma unroll
    for (int j = 0; j < 4; ++j) { s += (v[j].x * v[j].x + v[j].y * v[j].y) + (v[j].z * v[j].z + v[j].w * v[j].w); t += (u[j].x * u[j].x + u[j].y * u[j].y) + (u[j].z * u[j].z + u[j].w * u[j].w); }
#pragma unroll
    for (int o = 1; o < 64; o <<= 1) { s += bperm_f(lane ^ o, s); t += bperm_f(lane ^ o, t); }
    const float r0 = __builtin_amdgcn_rsqf(s * (1.f / 1024.f) + 1e-6f), r1 = __builtin_amdgcn_rsqf(t * (1.f / 1024.f) + 1e-6f);
    GAS unsigned long long* o0 = (GAS unsigned long long*)orow0 + lane; GAS unsigned long long* o1 = (GAS unsigned long long*)orow1 + lane;
#pragma unroll
    for (int j = 0; j < 4; ++j) { const f32x4 gg = gr[64 * j];
        o0[64 * j] = (unsigned long long)pk2(v[j].x * r0 * gg.x, v[j].y * r0 * gg.y) | ((unsigned long long)pk2(v[j].z * r0 * gg.z, v[j].w * r0 * gg.w) << 32);
        o1[64 * j] = (unsigned long long)pk2(u[j].x * r1 * gg.x, u[j].y * r1 * gg.y) | ((unsigned long long)pk2(u[j].z * r1 * gg.z, u[j].w * r1 * gg.w) << 32); }
}
__device__ __forceinline__ int t5_bucket(int rel) {
    const int n = rel < 0 ? -rel : rel; int b;
    if (n < 8) b = n; else b = 8 + (n >= 12) + (n >= 16) + (n >= 23) + (n >= 32) + (n >= 46) + (n >= 64) + (n >= 91);
    return b + (rel > 0 ? 16 : 0);
}
struct Args { const float* in[15]; float* out; unsigned char* ws; };
__device__ __forceinline__ void rms_row4_to_bf16(const float* xrow0, const float* g, bf16* orow0, int lane) {
    const GAS f32x4* gr = (const GAS f32x4*)g + lane;
    f32x4 v[4][4]; float s[4];
#pragma unroll
    for (int r = 0; r < 4; ++r) { const GAS f32x4* xr = (const GAS f32x4*)(xrow0 + (size_t)r * 1024) + lane;
#pragma unroll
        for (int j = 0; j < 4; ++j) v[r][j] = xr[64 * j]; }
#pragma unroll
    for (int r = 0; r < 4; ++r) { s[r] = 0.f;
#pragma unroll
        for (int j = 0; j < 4; ++j) s[r] += (v[r][j].x * v[r][j].x + v[r][j].y * v[r][j].y) + (v[r][j].z * v[r][j].z + v[r][j].w * v[r][j].w); }
#pragma unroll
    for (int o = 1; o < 64; o <<= 1) {
#pragma unroll
        for (int r = 0; r < 4; ++r) s[r] += bperm_f(lane ^ o, s[r]); }
    f32x4 gg[4];
#pragma unroll
    for (int j = 0; j < 4; ++j) gg[j] = gr[64 * j];
#pragma unroll
    for (int r = 0; r < 4; ++r) { const float rs = __builtin_amdgcn_rsqf(s[r] * (1.f / 1024.f) + 1e-6f); GAS unsigned long long* o8 = (GAS unsigned long long*)(orow0 + (size_t)r * 1024) + lane;
#pragma unroll
        for (int j = 0; j < 4; ++j) o8[64 * j] = (unsigned long long)pk2(v[r][j].x * rs * gg[j].x, v[r][j].y * rs * gg[j].y) | ((unsigned long long)pk2(v[r][j].z * rs * gg[j].z, v[r][j].w * rs * gg[j].w) << 32); }
}
__device__ __forceinline__ void p0_prologue(Frame& F, const Args& a, const int parts = 3) {
    const int tid_ = opq_tid(F.wave), lane_ = tid_ & 63;
    const float* xp = a.in[0]; const float* xs = a.in[1]; const float* pp = a.in[2]; const float* ps = a.in[3]; const float* g_mix = a.in[4]; const float* w_in = a.in[5];
    const float* lamp = a.in[6]; const float* relb = a.in[8]; const float* wf = a.in[9]; const float* w_out = a.in[10]; const float* g_ple = a.in[11];
    const float* w_gate = a.in[12]; const float* w_proj = a.in[13];
    unsigned char* ws = a.ws;
    if (parts & 2) {
        LAS float* scr = (LAS float*)(F.lds + F.wave * 16384);
        const int gw = F.vcu * NWAVES + F.wave, NGW = F.G * NWAVES;
        constexpr int I_IN = (DM / 64) * (NIN / 32), I_SQ = (DM / 64) * (DM / 32), I_P = (PLED / 64) * (DM / 32);
        for (int it = gw; it < I_IN + 2 * I_SQ + I_P; it += NGW) {
            int r = it;
            if (r < I_IN) { p0_transpose_item(w_in, DM, NIN, (bf16*)(ws + WS_WIN), nullptr, scr, r, lane_); continue; } r -= I_IN;
            if (r < I_SQ) { p0_transpose_item(w_out, DM, DM, (bf16*)(ws + WS_WOUT), nullptr, scr, r, lane_); continue; } r -= I_SQ;
            if (r < I_SQ) { p0_transpose_item(w_gate, DM, DM, (bf16*)(ws + WS_WG), g_ple, scr, r, lane_); continue; } r -= I_SQ;
            p0_transpose_item(w_proj, PLED, DM, (bf16*)(ws + WS_WP), nullptr, scr, r, lane_);
        }
        const int gt = F.vcu * (NWAVES * 64) + tid_, NGT = F.G * (NWAVES * 64);
        { constexpr int E_H1A = 64 * 64, E_H1B = 128 * 128, E_M2A = 33 * 16384, E_M2B = 65 * 16384;
          for (int i = gt; i < E_H1A + E_H1B + E_M2A + E_M2B; i += NGT) {
              int e = i; float val; bf16* dst;
              if (e < E_H1A + E_H1B) {
                  int N1, r, s1; if (e < E_H1A) { N1 = 64; r = e >> 6; s1 = e & 63; dst = (bf16*)(ws + WS_H1A) + e; } else { e -= E_H1A; N1 = 128; r = e >> 7; s1 = e & 127; dst = (bf16*)(ws + WS_H1B) + e; }
                  if (r == 0) val = 1.f; else if (r == 1) val = (s1 & 1) ? -1.f : 1.f;
                  else { const int k = r >> 1, j = (k * s1) & (N1 - 1); const float x = 2.f * (float)j / (float)N1; val = (r & 1) ? -sinpif(x) : cospif(x); }
              } else {
                  e -= E_H1A + E_H1B; int S, N1; float norm;
                  if (e < E_M2A) { S = 4096; N1 = 64; norm = 0.0013810679320049757f; dst = (bf16*)(ws + WS_M2A) + e; } else { e -= E_M2A; S = 8192; N1 = 128; norm = 0.0009765625f; dst = (bf16*)(ws + WS_M2B) + e; }
                  const int kt = e >> 14, m = (e >> 7) & 127, kp = e & 127, ro = m >> 6, k2 = m & 63, ri = kp >> 6, s2 = kp & 63;
                  const int sp = kt + N1 * k2, j = (s2 * sp) & (S - 1); const float x = 2.f * (float)j / (float)S; const float c = cospif(x), s = sinpif(x);
                  if (kt == 0) val = (ri == 0) ? (ro == 0 ? c : -s) : 0.f;
                  else if (kt == N1 / 2) val = (ri == 1) ? (ro == 0 ? c : -s) : 0.f;
                  else val = (ro == ri) ? c : (ro == 0 ? s : -s);
                  val *= norm;
              }
              *dst = (bf16)f2bf(val);
          } }
        { bf16* Gt = (bf16*)(ws + WS_GT); LAS float* ct = scr + 2304; LAS float* st = ct + 128;
          for (int i = lane_; i < 128; i += 64) { const float x = (float)i * (1.f / 64.f); ct[i] = cospif(x); st[i] = sinpif(x); }
          LDS_WAIT(); asm volatile("" ::: "memory");
          for (int i = gt; i < 512 * 1024 / 8; i += NGT) { const int n = i >> 7, k8 = (i & 127) * 8; if ((k8 >> 8) != (n >> 7)) *(v4u*)(Gt + (size_t)n * 1024 + k8) = (v4u){0u, 0u, 0u, 0u}; }
          for (int i = gt; i < 4 * 128 * 128; i += NGT) { const int g = i >> 14, c = (i >> 7) & 127, d = i & 127; float are = 0.f, aim = 0.f; const float* wp = wf + (size_t)g * 16384 + d;
#pragma unroll 8
              for (int cp = 0; cp < 128; ++cp) { const int j = (c * cp) & 127; const float w = wp[cp * 128]; are += ct[j] * w; aim += st[j] * w; }
              bf16* o = Gt + (size_t)(g * 128 + d) * 1024 + g * 256 + c; o[0] = (bf16)f2bf(are); o[128] = (bf16)f2bf(aim); } }
        if (F.vcu == 0) {
            float* tab = (float*)(ws + WS_TAB);
            for (int i = tid_; i < 1024; i += NWAVES * 64) { const int h = i >> 8, rel = (i & 255) - 128; tab[i] = relb[t5_bucket(rel) * 4 + h] * LOG2E; }
            if (tid_ == 0) { float s01 = 0.f, s23 = 0.f; for (int d = 0; d < 64; ++d) { s01 += lamp[d] * lamp[64 + d]; s23 += lamp[128 + d] * lamp[192 + d]; }
                tab[1024] = __expf(s01) - __expf(s23) + 0.2f; }
        }
    }
    if (parts & 1) {
        const int gw = F.vcu * NWAVES + F.wave, NGW = F.G * NWAVES;
        for (int m = 4 * gw; m < NTOK; m += 4 * NGW) { const float* xrow0 = m < TPR ? xp + (size_t)m * DM : xs + (size_t)(m - TPR) * DM;
            rms_row4_to_bf16(xrow0, g_mix, (bf16*)(ws + WS_XN) + (size_t)m * DM, lane_); }
        const int gt = F.vcu * (NWAVES * 64) + tid_, NGT = F.G * (NWAVES * 64); bf16* PB = (bf16*)a.out;
        for (int i0 = gt; i0 + 3 * NGT < NTOK * (PLED / 8); i0 += 4 * NGT) { f32x4 v0[4], v1[4];
#pragma unroll
            for (int k = 0; k < 4; ++k) { const int i = i0 + k * NGT, row = i >> 5, c8 = (i & 31) * 8; const float* src = (row < TPR ? pp + (size_t)row * PLED : ps + (size_t)(row - TPR) * PLED) + c8;
                v0[k] = *(const f32x4*)src; v1[k] = *(const f32x4*)(src + 4); }
#pragma unroll
            for (int k = 0; k < 4; ++k) { const int i = i0 + k * NGT, row = i >> 5, c8 = (i & 31) * 8; v4u o; o.x = pk2(v0[k].x, v0[k].y); o.y = pk2(v0[k].z, v0[k].w); o.z = pk2(v1[k].x, v1[k].y); o.w = pk2(v1[k].z, v1[k].w);
                *(v4u*)(PB + (size_t)row * PLED + c8) = o; } }
    }
}
typedef short s16x4_t __attribute__((ext_vector_type(4)));
__device__ __forceinline__ s16x4_t trd(const LAS bf16* p) { return __builtin_bit_cast(s16x4_t, __builtin_amdgcn_ds_read_tr16_b64_v4i16((LAS s16x4_t*)p)); }
template <int MK> struct NNRegs { v4u ra[MK * MK / 8 / (NWAVES * 64)], rb[MK * 16 / (NWAVES * 64)]; };
template <int MK>
__device__ __forceinline__ void nn_load(NNRegs<MK>& R, const bf16* A, const bf16* B, size_t ldb, int tid) {
    constexpr int NA = MK * MK / 8 / (NWAVES * 64), NB = MK * 16 / (NWAVES * 64);
    static_assert(NA * NWAVES * 64 * 8 == MK * MK && NB * NWAVES * 64 == MK * 16, "staging trip counts");
#pragma unroll
    for (int i = 0; i < NA; ++i) { const int idx = tid + i * (NWAVES * 64), r = idx / (MK / 8), c = idx % (MK / 8); R.ra[i] = *(const v4u*)(A + r * MK + c * 8); }
#pragma unroll
    for (int i = 0; i < NB; ++i) { const int idx = tid + i * (NWAVES * 64), r = idx >> 4, c = idx & 15; R.rb[i] = *(const v4u*)(B + (size_t)r * ldb + c * 8); }
}
template <int MK>
__device__ __forceinline__ void nn_stage(LAS unsigned char* lds, const NNRegs<MK>& R, int tid) {
    constexpr int AST = MK + 8, BST = 136, NA = MK * MK / 8 / (NWAVES * 64), NB = MK * 16 / (NWAVES * 64);
    LAS bf16* As = (LAS bf16*)lds; LAS bf16* Bs = (LAS bf16*)(lds + 40960);
    LDS_WAIT(); __builtin_amdgcn_s_barrier(); asm volatile("" ::: "memory");
#pragma unroll
    for (int i = 0; i < NA; ++i) { const int idx = tid + i * (NWAVES * 64), r = idx / (MK / 8), c = idx % (MK / 8); *(LAS v4u*)(As + r * AST + c * 8) = R.ra[i]; }
#pragma unroll
    for (int i = 0; i < NB; ++i) { const int idx = tid + i * (NWAVES * 64), r = idx >> 4, c = idx & 15; *(LAS v4u*)(Bs + r * BST + c * 8) = R.rb[i]; }
    LDS_WAIT(); __builtin_amdgcn_s_barrier(); asm volatile("" ::: "memory");
}
template <int MK>
__device__ __forceinline__ void nn_mfma(LAS unsigned char* lds, int tid, f32x4 (&acc)[MK / 16]) {
    constexpr int AST = MK + 8, BST = 136;
    const LAS bf16* As = (const LAS bf16*)lds; const LAS bf16* Bs = (const LAS bf16*)(lds + 40960);
    const int w = tid >> 6, l = tid & 63, lr = l & 15, lq = l >> 4;
#pragma unroll
    for (int mt = 0; mt < MK / 16; ++mt) acc[mt] = (f32x4){0.f, 0.f, 0.f, 0.f};
#pragma unroll
    for (int ks = 0; ks < MK / 32; ++ks) {
        const LAS bf16* bp = Bs + (ks * 32 + 8 * lq + (lr >> 2)) * BST + 16 * w + 4 * (lr & 3);
        const s16x4_t blo = trd(bp), bhi = trd(bp + 4 * BST);
        const bf16x8 bfr = {blo[0], blo[1], blo[2], blo[3], bhi[0], bhi[1], bhi[2], bhi[3]};
#pragma unroll
        for (int mt = 0; mt < MK / 16; ++mt) { const bf16x8 afr = *(const LAS bf16x8*)(As + (mt * 16 + lr) * AST + ks * 32 + 8 * lq);
            acc[mt] = __builtin_amdgcn_mfma_f32_16x16x32_bf16(bfr, afr, acc[mt], 0, 0, 0); }
    }
}
template <int MK>
__device__ __forceinline__ void nn_tile(LAS unsigned char* lds, const bf16* A, const bf16* B, size_t ldb, int tid, f32x4 (&acc)[MK / 16]) {
    NNRegs<MK> R; nn_load<MK>(R, A, B, ldb, tid); nn_stage<MK>(lds, R, tid); nn_mfma<MK>(lds, tid, acc);
}
template <int MK>
__device__ __forceinline__ void fft_stage1_run(LAS unsigned char* lds, const bf16* H1, const bf16* QU, bf16* Y, int tokbase, int seqlen, int first, int nitems, int G, int tid) {
    if (first >= nitems) return;
    NNRegs<MK> R;
#define S1_SRC(it) (QU + (size_t)(tokbase + ((it) >> 8) * seqlen + (((it) & 255) >> 2)) * 1024 + 512 + (((it) & 255) & 3) * 128)
    nn_load<MK>(R, H1, S1_SRC(first), (size_t)64 * 1024, tid);
    for (int it = first; it < nitems; it += G) {
        nn_stage<MK>(lds, R, tid);
        if (it + G < nitems) nn_load<MK>(R, H1, S1_SRC(it + G), (size_t)64 * 1024, tid);
        f32x4 acc[MK / 16]; nn_mfma<MK>(lds, tid, acc);
        const int tok0 = tokbase + (it >> 8) * seqlen, nt = it & 255, s2 = nt >> 2, ch0 = (nt & 3) * 128;
        const int w = tid >> 6, l = tid & 63, lr = l & 15, lq = l >> 4;
        bf16* yb = Y + (size_t)tok0 * 512 + (size_t)s2 * 512 + ch0 + 16 * w + 4 * lq;
#pragma unroll
        for (int mt = 0; mt < MK / 16; ++mt) { const int r = mt * 16 + lr; v2u o; o.x = pk2(acc[mt][0], acc[mt][1]); o.y = pk2(acc[mt][2], acc[mt][3]); *(v2u*)(yb + (size_t)r * (64 * 512)) = o; }
    }
#undef S1_SRC
}
template <int MK>
__device__ __forceinline__ void fft_stage1_item(LAS unsigned char* lds, const bf16* H1, const bf16* QU, bf16* Y, int tok0, int nt, int tid) {
    const int s2 = nt >> 2, ch0 = (nt & 3) * 128;
    f32x4 acc[MK / 16];
    nn_tile<MK>(lds, H1, QU + (size_t)(tok0 + s2) * 1024 + 512 + ch0, (size_t)64 * 1024, tid, acc);
    const int w = tid >> 6, l = tid & 63, lr = l & 15, lq = l >> 4;
    bf16* yb = Y + (size_t)tok0 * 512 + (size_t)s2 * 512 + ch0 + 16 * w + 4 * lq;
#pragma unroll
    for (int mt = 0; mt < MK / 16; ++mt) { const int r = mt * 16 + lr; v2u o; o.x = pk2(acc[mt][0], acc[mt][1]); o.y = pk2(acc[mt][2], acc[mt][3]); *(v2u*)(yb + (size_t)r * (64 * 512)) = o; }
}
__device__ __forceinline__ void fft_stage2_item(LAS unsigned char* lds, const bf16* M2, const bf16* Y, bf16* XP, int tok0, int S, int N1, int kt, int g, int tid) {
    const int p = (kt == 0 || kt == N1 / 2) ? 0 : kt;
    f32x4 acc[8];
    nn_tile<128>(lds, M2 + (size_t)kt * 16384, Y + (size_t)tok0 * 512 + (size_t)(2 * p * 64) * 512 + g * 128, (size_t)512, tid, acc);
    const int w = tid >> 6, l = tid & 63, lr = l & 15, lq = l >> 4; const int c = 16 * w + 4 * lq; const bool mir = (kt != 0 && kt != N1 / 2);
#pragma unroll
    for (int mt = 0; mt < 8; ++mt) { const int m = mt * 16 + lr, ro = m >> 6, k2 = m & 63, sp = kt + N1 * k2;
        v2u o; o.x = pk2(acc[mt][0], acc[mt][1]); o.y = pk2(acc[mt][2], acc[mt][3]);
        *(v2u*)(XP + (size_t)(tok0 + sp) * 1024 + g * 256 + ro * 128 + c) = o;
        if (mir) { if (ro) { o.x ^= 0x80008000u; o.y ^= 0x80008000u; } *(v2u*)(XP + (size_t)(tok0 + S - sp) * 1024 + g * 256 + ro * 128 + c) = o; } }
}

__device__ __forceinline__ void fft_stage2c_item(LAS unsigned char* lds, const bf16* M2, const bf16* Y, const bf16* Gt, const bf16* GF, bf16* QU, int tok0, int S, int N1, int kt, int g, int tid) {
    const int p = (kt == 0 || kt == N1 / 2) ? 0 : kt;
    const int w = tid >> 6, l = tid & 63, lr = l & 15, lq = l >> 4; const bool mir = (kt != 0 && kt != N1 / 2);
    bf16x8 gre[4], gim[4];
    { const bf16* gp = Gt + (size_t)(g * 128 + 16 * w + lr) * 1024 + g * 256 + 8 * lq;
#pragma unroll
      for (int ks = 0; ks < 4; ++ks) { gre[ks] = *(const bf16x8*)(gp + ks * 32); gim[ks] = *(const bf16x8*)(gp + 128 + ks * 32); } }
    const int d0 = g * 128 + 16 * w + 4 * lq;
    v2u gwa[4], gwb[4];
#pragma unroll
    for (int tb = 0; tb < 4; ++tb) { const int sp = kt + N1 * (16 * tb + lr); gwa[tb] = *(const v2u*)(GF + (size_t)(tok0 + sp) * 512 + d0);
        if (mir) gwb[tb] = *(const v2u*)(GF + (size_t)(tok0 + S - sp) * 512 + d0); else gwb[tb] = (v2u){0u, 0u}; }
    f32x4 acc[8];
    nn_tile<128>(lds, M2 + (size_t)kt * 16384, Y + (size_t)tok0 * 512 + (size_t)(2 * p * 64) * 512 + g * 128, (size_t)512, tid, acc);
    constexpr int XST = 136; LAS bf16* XL = (LAS bf16*)(lds + 81920);
#pragma unroll
    for (int mt = 0; mt < 8; ++mt) { v2u o; o.x = pk2(acc[mt][0], acc[mt][1]); o.y = pk2(acc[mt][2], acc[mt][3]); *(LAS v2u*)(XL + (mt * 16 + lr) * XST + 16 * w + 4 * lq) = o; }
    __syncthreads();
    f32x4 P[4], Q[4];
#pragma unroll
    for (int tb = 0; tb < 4; ++tb) { P[tb] = (f32x4){0.f, 0.f, 0.f, 0.f}; Q[tb] = (f32x4){0.f, 0.f, 0.f, 0.f};
#pragma unroll
        for (int ks = 0; ks < 4; ++ks) { const bf16x8 xre = *(const LAS bf16x8*)(XL + (16 * tb + lr) * XST + ks * 32 + 8 * lq), xim = *(const LAS bf16x8*)(XL + (64 + 16 * tb + lr) * XST + ks * 32 + 8 * lq);
            P[tb] = __builtin_amdgcn_mfma_f32_16x16x32_bf16(gre[ks], xre, P[tb], 0, 0, 0); Q[tb] = __builtin_amdgcn_mfma_f32_16x16x32_bf16(gim[ks], xim, Q[tb], 0, 0, 0); } }
#pragma unroll
    for (int tb = 0; tb < 4; ++tb) { const int sp = kt + N1 * (16 * tb + lr);
        { const size_t t = (size_t)(tok0 + sp); const v2u gw = gwa[tb]; const f32x4 f = P[tb] + Q[tb]; v2u o;
          o.x = pk2(f[0] * pg8::silu(pg8::bflo(gw.x)), f[1] * pg8::silu(pg8::bfhi(gw.x))); o.y = pk2(f[2] * pg8::silu(pg8::bflo(gw.y)), f[3] * pg8::silu(pg8::bfhi(gw.y)));
          *(v2u*)(QU + t * 1024 + 512 + d0) = o; }
        if (mir) { const size_t t = (size_t)(tok0 + S - sp); const v2u gw = gwb[tb]; const f32x4 f = P[tb] - Q[tb]; v2u o;
          o.x = pk2(f[0] * pg8::silu(pg8::bflo(gw.x)), f[1] * pg8::silu(pg8::bfhi(gw.x))); o.y = pk2(f[2] * pg8::silu(pg8::bflo(gw.y)), f[3] * pg8::silu(pg8::bfhi(gw.y)));
          *(v2u*)(QU + t * 1024 + 512 + d0) = o; } }
}
struct S2Regs { NNRegs<128> T; bf16x8 gre[4], gim[4]; v2u gwa[4], gwb[4]; };
__device__ __forceinline__ void s2c_load(S2Regs& R, const bf16* M2, const bf16* Y, const bf16* Gt, const bf16* GF, int tok0, int S, int N1, int kt, int g, int tid) {
    const int p = (kt == 0 || kt == N1 / 2) ? 0 : kt;
    const int w = tid >> 6, l = tid & 63, lr = l & 15, lq = l >> 4; const bool mir = (kt != 0 && kt != N1 / 2);
    { const bf16* gp = Gt + (size_t)(g * 128 + 16 * w + lr) * 1024 + g * 256 + 8 * lq;
#pragma unroll
      for (int ks = 0; ks < 4; ++ks) { R.gre[ks] = *(const bf16x8*)(gp + ks * 32); R.gim[ks] = *(const bf16x8*)(gp + 128 + ks * 32); } }
    const int d0 = g * 128 + 16 * w + 4 * lq;
#pragma unroll
    for (int tb = 0; tb < 4; ++tb) { const int sp = kt + N1 * (16 * tb + lr); R.gwa[tb] = *(const v2u*)(GF + (size_t)(tok0 + sp) * 512 + d0);
        if (mir) R.gwb[tb] = *(const v2u*)(GF + (size_t)(tok0 + S - sp) * 512 + d0); else R.gwb[tb] = (v2u){0u, 0u}; }
    nn_load<128>(R.T, M2 + (size_t)kt * 16384, Y + (size_t)tok0 * 512 + (size_t)(2 * p * 64) * 512 + g * 128, (size_t)512, tid);
}
__device__ __forceinline__ void fft_stage2c_run(LAS unsigned char* lds, const bf16* M2, const bf16* Y, const bf16* Gt, const bf16* GF, bf16* QU, int tokbase, int S, int N1, int perb, int first, int nitems, int G, int tid) {
    if (first >= nitems) return;
    S2Regs R;
#define S2_ARGS(it) tokbase + ((it) / perb) * S, S, N1, ((it) % perb) >> 2, ((it) % perb) & 3
    s2c_load(R, M2, Y, Gt, GF, S2_ARGS(first), tid);
    for (int it = first; it < nitems; it += G) {
        const int tok0 = tokbase + (it / perb) * S, kt = (it % perb) >> 2, g = (it % perb) & 3;
        const int w = tid >> 6, l = tid & 63, lr = l & 15, lq = l >> 4; const bool mir = (kt != 0 && kt != N1 / 2);
        nn_stage<128>(lds, R.T, tid);
        bf16x8 gre[4], gim[4]; v2u gwa[4], gwb[4];
#pragma unroll
        for (int k = 0; k < 4; ++k) { gre[k] = R.gre[k]; gim[k] = R.gim[k]; gwa[k] = R.gwa[k]; gwb[k] = R.gwb[k]; }
        if (it + G < nitems) s2c_load(R, M2, Y, Gt, GF, S2_ARGS(it + G), tid);
        f32x4 acc[8]; nn_mfma<128>(lds, tid, acc);
        constexpr int XST = 136; LAS bf16* XL = (LAS bf16*)(lds + 81920);
#pragma unroll
        for (int mt = 0; mt < 8; ++mt) { v2u o; o.x = pk2(acc[mt][0], acc[mt][1]); o.y = pk2(acc[mt][2], acc[mt][3]); *(LAS v2u*)(XL + (mt * 16 + lr) * XST + 16 * w + 4 * lq) = o; }
        LDS_WAIT(); __builtin_amdgcn_s_barrier(); asm volatile("" ::: "memory");
        f32x4 P[4], Q[4];
#pragma unroll
        for (int tb = 0; tb < 4; ++tb) { P[tb] = (f32x4){0.f, 0.f, 0.f, 0.f}; Q[tb] = (f32x4){0.f, 0.f, 0.f, 0.f};
#pragma unroll
            for (int ks = 0; ks < 4; ++ks) { const bf16x8 xre = *(const LAS bf16x8*)(XL + (16 * tb + lr) * XST + ks * 32 + 8 * lq), xim = *(const LAS bf16x8*)(XL + (64 + 16 * tb + lr) * XST + ks * 32 + 8 * lq);
                P[tb] = __builtin_amdgcn_mfma_f32_16x16x32_bf16(gre[ks], xre, P[tb], 0, 0, 0); Q[tb] = __builtin_amdgcn_mfma_f32_16x16x32_bf16(gim[ks], xim, Q[tb], 0, 0, 0); } }
        const int d0 = g * 128 + 16 * w + 4 * lq;
#pragma unroll
        for (int tb = 0; tb < 4; ++tb) { const int sp = kt + N1 * (16 * tb + lr);
            { const size_t t = (size_t)(tok0 + sp); const v2u gw = gwa[tb]; const f32x4 f = P[tb] + Q[tb]; v2u o;
              o.x = pk2(f[0] * pg8::silu(pg8::bflo(gw.x)), f[1] * pg8::silu(pg8::bfhi(gw.x))); o.y = pk2(f[2] * pg8::silu(pg8::bflo(gw.y)), f[3] * pg8::silu(pg8::bfhi(gw.y)));
              *(v2u*)(QU + t * 1024 + 512 + d0) = o; }
            if (mir) { const size_t t = (size_t)(tok0 + S - sp); const v2u gw = gwb[tb]; const f32x4 f = P[tb] - Q[tb]; v2u o;
              o.x = pk2(f[0] * pg8::silu(pg8::bflo(gw.x)), f[1] * pg8::silu(pg8::bfhi(gw.x))); o.y = pk2(f[2] * pg8::silu(pg8::bflo(gw.y)), f[3] * pg8::silu(pg8::bfhi(gw.y)));
              *(v2u*)(QU + t * 1024 + 512 + d0) = o; } }
    }
#undef S2_ARGS
}
__global__ void __launch_bounds__(NWAVES * 64, 2) mk_fwd(Args args) {
    extern __shared__ __attribute__((aligned(16))) unsigned char lds[];
    Frame F;
    F.lds = (LAS unsigned char*)lds;
    F.MISC = (volatile LAS unsigned*)(F.lds + MISC_OFF);
    F.wave = __builtin_amdgcn_readfirstlane((int)threadIdx.x >> 6);
    F.G = gridDim.x; { const int bx = blockIdx.x; F.vcu = (F.G % 8 == 0) ? (bx % 8) * (F.G / 8) + bx / 8 : bx; }
    unsigned char* ws = args.ws;
    F.ctl = (unsigned*)(ws + WS_CTL);
    for (int u = threadIdx.x; u < (LDS_BYTES - LDSCTL_OFF) / 4; u += NWAVES * 64) ((LAS unsigned*)(F.lds + LDSCTL_OFF))[u] = 0u;
    __syncthreads();
    XcdBarrier bar = xcd_barrier_post(F.ctl + 1024, F.MISC + 8);
    { const unsigned simd = (unsigned)__builtin_amdgcn_s_getreg((1 << 11) | (4 << 6) | 4) & 3u;
      if ((threadIdx.x & 63) == 0) F.MISC[48 + F.wave] = simd;
      __syncthreads();
      unsigned cnt0 = 0, cnt1 = 0, cnt2 = 0, cnt3 = 0, rank = 0;
#pragma unroll
      for (int w = 0; w < NWAVES; ++w) { const unsigned sw = F.MISC[48 + w]; cnt0 += sw == 0u; cnt1 += sw == 1u; cnt2 += sw == 2u; cnt3 += sw == 3u; rank += (w < F.wave && sw == simd) ? 1u : 0u; }
      const bool ok = cnt0 == 2u && cnt1 == 2u && cnt2 == 2u && cnt3 == 2u;
      F.role = __builtin_amdgcn_readfirstlane(ok ? (int)((rank << 2) | simd) : (((F.wave >> 2) << 2) | (F.wave & 3)));
#if defined(ROLE_PARITY)
      F.role = ((F.wave & 1) << 2) | (F.wave >> 1);
#endif
    }
#define GRID_BAR() xcd_barrier(bar)
#define STAGGER(ticks) do { if ((ticks) > 0) { const unsigned long long t0_ = __builtin_amdgcn_s_memrealtime(); const unsigned long long d_ = (unsigned long long)(F.vcu & 3) * (unsigned long long)(ticks); \
    while (__builtin_amdgcn_s_memrealtime() - t0_ < d_) __builtin_amdgcn_s_sleep(8); } } while (0)
#if defined(PROBE_A)
#define STAMP(k) do { if (blockIdx.x == 0 && threadIdx.x == 0) { const unsigned long long t_ = __builtin_amdgcn_s_memrealtime(); F.MISC[16 + 2 * (k)] = (unsigned)t_; F.MISC[17 + 2 * (k)] = (unsigned)(t_ >> 32); } } while (0)
#else
#define STAMP(k) do { } while (0)
#endif
    STAMP(0);
    bf16* const Win_t = (bf16*)(ws + WS_WIN); bf16* const Wout_t = (bf16*)(ws + WS_WOUT); bf16* const Wg_t = (bf16*)(ws + WS_WG); bf16* const Wp_t = (bf16*)(ws + WS_WP);
    bf16* const Gt = (bf16*)(ws + WS_GT); bf16* const XN = (bf16*)(ws + WS_XN); bf16* const XP = (bf16*)(ws + WS_XN); bf16* const QU = (bf16*)(ws + WS_QU);
    bf16* const KB = (bf16*)(ws + WS_K); bf16* const VB = (bf16*)(ws + WS_V); bf16* const H1B = (bf16*)(ws + WS_K); bf16* const GA = (bf16*)(ws + WS_GA); bf16* const GF = (bf16*)(ws + WS_GF);
    bf16* const PROJ = (bf16*)(ws + WS_PROJ); bf16* const PB = (bf16*)args.out; bf16* const Y = (bf16*)args.out;
    float* const SSQ1 = (float*)(ws + WS_SSQ1); float* const SSQ2 = (float*)(ws + WS_SSQ2); const float* const TAB = (const float*)(ws + WS_TAB);

    p0_prologue(F, args);
#if defined(DUP_P0)
    p0_prologue(F, args, (DUP_P0 + 0) ? (DUP_P0 + 0) : 3);
#endif
    GRID_BAR(); STAMP(1);
#if defined(DUP_BAR)
    GRID_BAR(); GRID_BAR(); GRID_BAR(); GRID_BAR(); GRID_BAR();
#endif
#if defined(DUP_P1)
    if ((DUP_P1 + 0) == 4) { const unsigned long long t0_ = __builtin_amdgcn_s_memrealtime(); const unsigned long long d_ = (unsigned long long)(F.vcu & 3) * 800ull;
        while (__builtin_amdgcn_s_memrealtime() - t0_ < d_) __builtin_amdgcn_s_sleep(8); }
    { pg8::Gemm g{XN, Win_t, NTOK, NIN, DM, DM, 0}; pg8::StaticOrder S; S.init(NTOK, NIN, F.G, (int)blockIdx.x);
      pg8::EpiInProj E{QU, KB, VB, GA, GF, QSCALE, ((DUP_P1 + 0) >= 2) ? (DUP_P1 + 0) : 0};
      pg8::gemm_phase<pg8::EpiInProj, pg8::StaticOrder, true, true>(F.lds, g, S, E, F.wave); }
    { pg8::Gemm g{PB, Wp_t, NTOK, DM, PLED, PLED, 0}; pg8::StaticOrder S; S.init(NTOK, DM, F.G, (int)blockIdx.x);
      pg8::EpiPlainBf16 E{PROJ, DM};
      pg8::gemm_phase<pg8::EpiPlainBf16, pg8::StaticOrder, true, true>(F.lds, g, S, E, F.wave); }
#endif
    STAGGER(STG_P1);
#if defined(DUP_PROJ)
    { pg8::Gemm g{PB, Wp_t, NTOK, DM, PLED, PLED, 0}; pg8::StaticOrder S; S.init(NTOK, DM, F.G, (int)blockIdx.x);
      pg8::EpiPlainBf16 E{PROJ, DM};
      pg8::gemm_phase<pg8::EpiPlainBf16, pg8::StaticOrder, true, true>(F.lds, g, S, E, F.wave); }
#endif
    if (PROJ_FIRST_MASK && (F.vcu & PROJ_FIRST_MASK) == 0) {
    { pg8::Gemm g{PB, Wp_t, NTOK, DM, PLED, PLED, 0}; pg8::StaticOrder S; S.init(NTOK, DM, F.G, (int)blockIdx.x);
      pg8::EpiPlainBf16 E{PROJ, DM};
      pg8::gemm_phase<pg8::EpiPlainBf16, pg8::StaticOrder, true, true>(F.lds, g, S, E, F.wave); }
    { pg8::Gemm g{XN, Win_t, NTOK, NIN, DM, DM, 0}; pg8::StaticOrder S; S.init(NTOK, NIN, F.G, (int)blockIdx.x);
      pg8::EpiInProj E{QU, KB, VB, GA, GF, QSCALE, 0};
      pg8::gemm_phase<pg8::EpiInProj, pg8::StaticOrder, true, true>(F.lds, g, S, E, F.wave); }
    } else {
    { pg8::Gemm g{XN, Win_t, NTOK, NIN, DM, DM, 0}; pg8::StaticOrder S; S.init(NTOK, NIN, F.G, (int)blockIdx.x);
      pg8::EpiInProj E{QU, KB, VB, GA, GF, QSCALE, 0};
      pg8::gemm_phase<pg8::EpiInProj, pg8::StaticOrder, true, true>(F.lds, g, S, E, F.wave); }
    { pg8::Gemm g{PB, Wp_t, NTOK, DM, PLED, PLED, 0}; pg8::StaticOrder S; S.init(NTOK, DM, F.G, (int)blockIdx.x);
      pg8::EpiPlainBf16 E{PROJ, DM};
      pg8::gemm_phase<pg8::EpiPlainBf16, pg8::StaticOrder, true, true>(F.lds, g, S, E, F.wave); }
    }
    GRID_BAR(); STAMP(2);
#if defined(DUP_FFT)
    { constexpr int NIT_P = NBP * 256, NIT_S = NBS * 256;
      for (int it = F.vcu; it < NIT_P + NIT_S; it += F.G) {
          if (it < NIT_P) fft_stage1_item<64>(F.lds, (const bf16*)(ws + WS_H1A), QU, Y, (it >> 8) * SEQP, it & 255, opq_tid(F.wave));
          else { const int r = it - NIT_P; fft_stage1_item<128>(F.lds, (const bf16*)(ws + WS_H1B), QU, Y, TPR + (r >> 8) * SEQS, r & 255, opq_tid(F.wave)); } } }
    GRID_BAR(); STAMP(10);
    { constexpr int NIT_P = NBP * 33 * 4, NIT_S = NBS * 65 * 4;
      for (int it = F.vcu; it < NIT_P + NIT_S; it += F.G) {
          if (it < NIT_P) { const int b = it / 132, r = it % 132; fft_stage2_item(F.lds, (const bf16*)(ws + WS_M2A), Y, XP, b * SEQP, SEQP, 64, r >> 2, r & 3, opq_tid(F.wave)); }
          else { const int q = it - NIT_P, b = q / 260, r = q % 260; fft_stage2_item(F.lds, (const bf16*)(ws + WS_M2B), Y, XP, TPR + b * SEQS, SEQS, 128, r >> 2, r & 3, opq_tid(F.wave)); } } }
    GRID_BAR(); STAMP(11);
#endif
    { constexpr int NIT_P = NBP * 256, NIT_S = NBS * 256;
      const int nP = F.vcu < NIT_P ? (NIT_P - F.vcu + F.G - 1) / F.G : 0, firstS = F.vcu + nP * F.G - NIT_P;
      fft_stage1_run<64>(F.lds, (const bf16*)(ws + WS_H1A), QU, Y, 0, SEQP, F.vcu, NIT_P, F.G, opq_tid(F.wave));
      fft_stage1_run<128>(F.lds, (const bf16*)(ws + WS_H1B), QU, Y, TPR, SEQS, firstS, NIT_S, F.G, opq_tid(F.wave)); }
    GRID_BAR(); STAMP(3);
    { constexpr int NIT_P = NBP * 33 * 4, NIT_S = NBS * 65 * 4;
      const int nP = F.vcu < NIT_P ? (NIT_P - F.vcu + F.G - 1) / F.G : 0, firstS = F.vcu + nP * F.G - NIT_P;
      fft_stage2c_run(F.lds, (const bf16*)(ws + WS_M2A), Y, Gt, GF, QU, 0, SEQP, 64, 132, F.vcu, NIT_P, F.G, opq_tid(F.wave));
      fft_stage2c_run(F.lds, (const bf16*)(ws + WS_M2B), Y, Gt, GF, QU, TPR, SEQS, 128, 260, firstS, NIT_S, F.G, opq_tid(F.wave));
      __syncthreads(); }
    STAMP(4); STAMP(5);
#if defined(PROBE_CLK)
    unsigned long long ck_c0 = 0, ck_r0 = 0, ck_c1 = 0, ck_r1 = 0;
    if (PROBE_CLK == 2) { ck_c0 = __builtin_amdgcn_s_memtime(); ck_r0 = __builtin_amdgcn_s_memrealtime(); }
#endif
    { const float lam = TAB[1024]; const float* subg = args.in[7];
      const int xl = F.vcu >> 5, cu = F.vcu & 31;
#if defined(DUP_ATT)
      for (int rep = 0; rep < 2; ++rep)
#endif
      for (int i = 0; i < 6; ++i) {
          int tok0, seq, h, q0, ntok0 = -1, nh = 0;
          if (i < 2) { const int pr = xl; tok0 = TPR + (pr >> 2) * SEQS; seq = SEQS; h = pr & 3; q0 = (cu + 32 * i) * 128; }
          else { const int pr = xl + 8 * (i - 2); tok0 = (pr >> 2) * SEQP; seq = SEQP; h = pr & 3; q0 = cu * 128; }
          if (i + 1 < 2) { ntok0 = tok0; nh = h; } else if (i + 1 < 6) { const int pr = xl + 8 * (i + 1 - 2); ntok0 = (pr >> 2) * SEQP; nh = pr & 3; }
#if defined(DUP_ATT)
          if (rep == 0) ATTNS::attn_unit<DUP_ATT>(QU, XP, KB, VB, GA, TAB, subg, lam, tok0, seq, h, q0, F.lds, F.wave, F.role); else ATTNS::attn_unit<0>(QU, QU, KB, VB, GA, TAB, subg, lam, tok0, seq, h, q0, F.lds, F.wave, F.role);
#else
          ATTNS::attn_unit<0>(QU, QU, KB, VB, GA, TAB, subg, lam, tok0, seq, h, q0, F.lds, F.wave, F.role, i > 0, ntok0, nh);
#endif
      } }
#if defined(PROBE_CLK)
    if (PROBE_CLK == 2) { ck_c1 = __builtin_amdgcn_s_memtime(); ck_r1 = __builtin_amdgcn_s_memrealtime(); }
#endif
    GRID_BAR(); STAMP(6);
#if defined(DUP_P3)
    { pg8::Gemm g{QU, Wout_t, NTOK, DM, DM, DM, 0}; pg8::StaticOrder S; S.init(NTOK, DM, F.G, (int)blockIdx.x);
      pg8::EpiOutProj E{args.in[0], args.in[1], args.out, H1B, SSQ1};
      pg8::gemm_phase<pg8::EpiOutProj, pg8::StaticOrder, P3_ALIGN, true>(F.lds, g, S, E, F.wave); }
#endif
    STAGGER(STG_P3);
    { pg8::Gemm g{QU, Wout_t, NTOK, DM, DM, DM, 0}; pg8::StaticOrder S; S.init(NTOK, DM, F.G, (int)blockIdx.x);
      pg8::EpiOutProj E{args.in[0], args.in[1], args.out, H1B, SSQ1};
      pg8::gemm_phase<pg8::EpiOutProj, pg8::StaticOrder, P3_ALIGN, true>(F.lds, g, S, E, F.wave); }
    GRID_BAR(); STAMP(7);
    STAGGER(STG_P4);
    { pg8::Gemm g{H1B, Wg_t, NTOK, DM, DM, DM, 0}; pg8::StaticOrder S; S.init(NTOK, DM, F.G, (int)blockIdx.x);
      pg8::EpiGateNorm E{args.out, H1B, PROJ, SSQ1, args.in[14], SSQ2, F.ctl + 16384, F.lds + RING_BYTES + 1024};
      pg8::gemm_phase<pg8::EpiGateNorm, pg8::StaticOrder, true, true>(F.lds, g, S, E, F.wave); }
    STAMP(8);
    STAMP(9);
#if defined(PROBE_CLK)
    GRID_BAR();
    if (blockIdx.x == 0 && threadIdx.x == 0) { const float ghz = 0.1f * (float)(ck_c1 - ck_c0) / (float)(ck_r1 - ck_r0); const float v = 20.f * rintf(ghz * 5.f); for (int i = 0; i < 8; ++i) args.out[i] = v; }
#endif
#if defined(PROBE_A)
    if (blockIdx.x == 0) { asm volatile("s_waitcnt vmcnt(0) lgkmcnt(0)" ::: "memory"); __syncthreads();
        const unsigned long long ta = ((unsigned long long)F.MISC[17 + 2 * PROBE_A] << 32) | F.MISC[16 + 2 * PROBE_A], tb = ((unsigned long long)F.MISC[17 + 2 * PROBE_B] << 32) | F.MISC[16 + 2 * PROBE_B];
        const float v = (float)(tb - ta) * 0.0001f; for (int i = 0; i < 8; ++i) args.out[threadIdx.x * 8 + i] = v; }
#endif
#undef GRID_BAR
}

extern "C" void kernel_launch(void* const* d_in, const int* in_sizes, int n_in, void* d_out, int out_size, void* d_ws, size_t ws_size, hipStream_t stream) {
    static int grid = 0;
    if (grid == 0) {
        if (n_in != 15 || in_sizes[0] != TPR * DM || out_size != NTOK * DM || ws_size < WS_END) {
            fprintf(stderr, "kernel_launch: shape mismatch: n_in %d in0 %d out %d ws %zu (need %zu)\n", n_in, n_in > 0 ? in_sizes[0] : -1, out_size, ws_size, (size_t)WS_END); grid = -1; return; }
        int dev = 0, cus = 0;
        if (hipGetDevice(&dev) != hipSuccess || hipDeviceGetAttribute(&cus, hipDeviceAttributeMultiprocessorCount, dev) != hipSuccess) { fprintf(stderr, "kernel_launch: device query failed\n"); grid = -1; return; }
        if (hipFuncSetAttribute((const void*)mk_fwd, hipFuncAttributeMaxDynamicSharedMemorySize, LDS_BYTES) != hipSuccess) { fprintf(stderr, "kernel_launch: hipFuncSetAttribute failed\n"); grid = -1; return; }
        (void)hipGetLastError();
        grid = cus;
        if (grid != 256) fprintf(stderr, "kernel_launch: %d CUs; this kernel's attention schedule assumes 256\n", grid);
    }
    if (grid < 0) return;
    if (hipMemsetAsync((char*)d_ws + WS_CTL, 0, CTL_ZERO_BYTES, stream) != hipSuccess) { fprintf(stderr, "kernel_launch: memset failed\n"); return; }
    Args a{};
    for (int i = 0; i < 15; ++i) a.in[i] = (const float*)d_in[i];
    a.out = (float*)d_out; a.ws = (unsigned char*)d_ws;
    hipLaunchKernelGGL(mk_fwd, dim3(grid), dim3(NWAVES * 64), LDS_BYTES, stream, a);
    const hipError_t le = hipPeekAtLastError();
    if (le != hipSuccess) fprintf(stderr, "kernel_launch: launch failed: %s\n", hipGetErrorName(le));
}
```

```cpp
#include <hip/hip_runtime.h>
#include <cstdio>
#include <cstdint>
#define PRIO_MODE 2
#define ATTNS att3
#define STG_P1 0
#define PROJ_FIRST_MASK 0
#define STG_P3 0
#define P3_ALIGN true
#define STG_P4 0
__device__ __forceinline__ int opq_tid(int wave) { int l; asm volatile("v_mbcnt_lo_u32_b32 %0, -1, 0\n\tv_mbcnt_hi_u32_b32 %0, -1, %0" : "=v"(l)); return wave * 64 + l; }
__device__ __forceinline__ float bperm_f(int srclane, float v) { return __int_as_float(__builtin_amdgcn_ds_bpermute(srclane << 2, __float_as_int(v))); }
__device__ __forceinline__ size_t blk512(int row, int col) { return ((size_t)(((row >> 4) << 4) + (col >> 5)) << 9) + (size_t)(((row & 15) << 5) + (col & 31)); }
namespace pg8 {
#define PG8_LAS __attribute__((address_space(3)))
typedef unsigned short bf16_t;
typedef short bf16x8 __attribute__((ext_vector_type(8)));
typedef float f32x4 __attribute__((ext_vector_type(4)));
typedef unsigned u32x4 __attribute__((ext_vector_type(4)));
constexpr int BM = 256, BK = 64, HALF = 128, HTB = HALF * BK * 2  , STAGE_BYTES = 8 * HTB, NXCD = 8, WGM = 8;

__host__ __device__ __forceinline__ int lds_byte(int r, int c) { const int st = (r >> 4) * 2 + (c >> 5), rr = r & 15, cc = c & 31, ob = rr * 64 + cc * 2; return st * 1024 + (ob ^ (((ob >> 9) & 1) << 5)); }
__host__ __device__ __forceinline__ void stage_rc(int b, int& R, int& C) { const int st = b / 1024, sb = b % 1024, swz = sb ^ (((sb >> 9) & 1) << 5); R = (st >> 1) * 16 + swz / 64; C = (st & 1) * 32 + (swz % 64) / 2; }
__host__ __device__ __forceinline__ int perm32(int rho) { const int n = rho >> 4, i = rho & 15; return 8 * (i >> 2) + 4 * n + (i & 3); }

struct Unit { int pm, pn; };
struct Gemm { const bf16_t* A; const bf16_t* Bt; int M, N, K, ld, koff_pn; };

struct StaticOrder {
    int nM, nN, nwg, G, c;
    __host__ __device__ void init(int M, int N, int G_, int c_) { nM = M / BM; nN = N / BM; nwg = nM * nN; G = G_; c = c_; }
    __host__ __device__ bool next(int i, Unit& u) const {
        const long L = (long)i * G + c; if (L >= nwg) return false;
        int wgid = (int)L; { const int q = nwg / NXCD, r = nwg % NXCD, xcd = wgid % NXCD, off = wgid / NXCD; wgid = (xcd < r ? xcd * (q + 1) : r * (q + 1) + (xcd - r) * q) + off; }
        const int nig = WGM * nN, gid = wgid / nig, fm = gid * WGM, gsz = (nM - fm) < WGM ? (nM - fm) : WGM;
        u.pm = fm + ((wgid % nig) % gsz); u.pn = (wgid % nig) / gsz; return true;
    }
    __device__ __forceinline__ void a_ready(const Unit&) const {}
    __device__ __forceinline__ void done(const Unit&) const {}
};

__device__ __forceinline__ unsigned cvt_pk_bf16(float lo, float hi) { unsigned r; asm volatile("v_cvt_pk_bf16_f32 %0, %1, %2" : "=v"(r) : "v"(lo), "v"(hi)); return r; }
typedef float f32x2 __attribute__((ext_vector_type(2)));
typedef unsigned u32x2 __attribute__((ext_vector_type(2)));
__device__ __forceinline__ float bflo(unsigned w) { return __uint_as_float(w << 16); }
__device__ __forceinline__ float bfhi(unsigned w) { return __uint_as_float(w & 0xffff0000u); }
__device__ __forceinline__ float sigm(float a) { return __builtin_amdgcn_rcpf(1.f + __expf(-a)); }
__device__ __forceinline__ float silu(float a) { return a * sigm(a); }

struct EpiInProj {
    static constexpr bool PERM = true, AFTER_DRAIN = false;
    bf16_t* qb; bf16_t* kb; bf16_t* vb; bf16_t* ga; bf16_t* ub; bf16_t* gf; float qscale; int nostore;
    __device__ __forceinline__ void operator()(const f32x4 (&acc)[2][2][4][2], const Unit& u, int wr, int wc, int fr, int fq) const {
        const int seg = u.pn >> 1, colt = (u.pn & 1) * BM;
        bf16_t* base; float sc = 1.f;
        if (seg == 0) { base = qb; sc = qscale; } else if (seg == 1) base = kb; else if (seg == 2) base = vb; else if (seg == 3) base = ga; else if (seg == 4) base = ub; else base = gf;
        const int row0 = u.pm * BM + wr * 64 + fr, col0 = colt + wc * 32 + 8 * fq;
#pragma unroll
        for (int ai = 0; ai < 2; ++ai)
#pragma unroll
            for (int m = 0; m < 4; ++m) { const int row = row0 + ai * HALF + m * 16;
#pragma unroll
                for (int bj = 0; bj < 2; ++bj) { const f32x4 v0 = acc[ai][bj][m][0] * sc, v1 = acc[ai][bj][m][1] * sc;
                    u32x4 w; w.x = cvt_pk_bf16(v0[0], v0[1]); w.y = cvt_pk_bf16(v0[2], v0[3]); w.z = cvt_pk_bf16(v1[0], v1[1]); w.w = cvt_pk_bf16(v1[2], v1[3]);
                    if (nostore == 0) __builtin_nontemporal_store(w, (u32x4*)(base + blk512(row, col0 + bj * HALF))); else asm volatile("" :: "v"(w)); } }
    }
};
struct EpiPlainBf16 {
    static constexpr bool PERM = true, AFTER_DRAIN = false;
    bf16_t* O; int ldc;
    __device__ __forceinline__ void operator()(const f32x4 (&acc)[2][2][4][2], const Unit& u, int wr, int wc, int fr, int fq) const {
        const int row0 = u.pm * BM + wr * 64 + fr, col0 = u.pn * BM + wc * 32 + 8 * fq;
#pragma unroll
        for (int ai = 0; ai < 2; ++ai)
#pragma unroll
            for (int m = 0; m < 4; ++m) { bf16_t* rowp = O + (size_t)(row0 + ai * HALF + m * 16) * ldc + col0;
#pragma unroll
                for (int bj = 0; bj < 2; ++bj) { const f32x4 v0 = acc[ai][bj][m][0], v1 = acc[ai][bj][m][1];
                    u32x4 w; w.x = cvt_pk_bf16(v0[0], v0[1]); w.y = cvt_pk_bf16(v0[2], v0[3]); w.z = cvt_pk_bf16(v1[0], v1[1]); w.w = cvt_pk_bf16(v1[2], v1[3]);
                    __builtin_nontemporal_store(w, (u32x4*)(rowp + bj * HALF)); } }
    }
};
struct EpiFno {
    static constexpr bool PERM = true, AFTER_DRAIN = false;
    const bf16_t* gf; bf16_t* qu;
    __device__ __forceinline__ void operator()(const f32x4 (&acc)[2][2][4][2], const Unit& u, int wr, int wc, int fr, int fq) const {
        const int row0 = u.pm * BM + wr * 64 + fr, col0 = u.pn * BM + wc * 32 + 8 * fq;
#pragma unroll
        for (int ai = 0; ai < 2; ++ai)
#pragma unroll
            for (int m = 0; m < 4; ++m) { const size_t r = (size_t)(row0 + ai * HALF + m * 16);
#pragma unroll
                for (int bj = 0; bj < 2; ++bj) { const int c = col0 + bj * HALF; const u32x4 g = *(const u32x4*)(gf + r * 512 + c);
                    const f32x4 v0 = acc[ai][bj][m][0], v1 = acc[ai][bj][m][1];
                    u32x4 w; w.x = cvt_pk_bf16(v0[0] * silu(bflo(g.x)), v0[1] * silu(bfhi(g.x))); w.y = cvt_pk_bf16(v0[2] * silu(bflo(g.y)), v0[3] * silu(bfhi(g.y)));
                    w.z = cvt_pk_bf16(v1[0] * silu(bflo(g.z)), v1[1] * silu(bfhi(g.z))); w.w = cvt_pk_bf16(v1[2] * silu(bflo(g.w)), v1[3] * silu(bfhi(g.w)));
                    *(u32x4*)(qu + r * 1024 + 512 + c) = w; } }
    }
};
struct EpiOutProj {
    static constexpr bool PERM = false, AFTER_DRAIN = false;
    const float* xp; const float* xs; float* out; bf16_t* h1b; float* ssq;
    __device__ __forceinline__ void operator()(const f32x4 (&acc)[2][2][4][2], const Unit& u, int wr, int wc, int fr, int fq) const {
        const int row0 = u.pm * BM + wr * 64 + fr, col0 = u.pn * BM + wc * 32 + 4 * fq;
        const float* xb = (u.pm < 128) ? xp : xs - (size_t)32768 * 1024;
        f32x4 xv[8][4]; float ssv[8];
#define EOP_LD(g) do { const float* xrow_ = xb + (size_t)(row0 + ((g) >> 2) * HALF + ((g) & 3) * 16) * 1024 + col0; \
            xv[g][0] = *(const f32x4*)(xrow_); xv[g][1] = *(const f32x4*)(xrow_ + 16); xv[g][2] = *(const f32x4*)(xrow_ + HALF); xv[g][3] = *(const f32x4*)(xrow_ + HALF + 16); } while (0)
        EOP_LD(0); EOP_LD(1); EOP_LD(2);
#pragma unroll
        for (int g = 0; g < 8; ++g) { const int ai = g >> 2, m = g & 3;
            if (g + 3 < 8) EOP_LD(g + 3);
            const size_t off = (size_t)(row0 + ai * HALF + m * 16) * 1024 + col0; float ss = 0.f;
#pragma unroll
            for (int bj = 0; bj < 2; ++bj)
#pragma unroll
                for (int n = 0; n < 2; ++n) { const f32x4 h = xv[g][bj * 2 + n] + acc[ai][bj][m][n];
                    ss += (h[0] * h[0] + h[1] * h[1]) + (h[2] * h[2] + h[3] * h[3]);
                    u32x2 w; w.x = cvt_pk_bf16(h[0], h[1]); w.y = cvt_pk_bf16(h[2], h[3]); *(u32x2*)(h1b + off + bj * HALF + n * 16) = w; }
            ss += bperm_f(((fq ^ 1) << 4) | fr, ss); ss += bperm_f(((fq ^ 2) << 4) | fr, ss); ssv[g] = ss; }
#undef EOP_LD
        if (fq == 0) {
#pragma unroll
            for (int g = 0; g < 8; ++g) ssq[(size_t)(row0 + (g >> 2) * HALF + (g & 3) * 16) * 16 + u.pn * 4 + wc] = ssv[g]; }
    }
};
struct EpiGate {
    static constexpr bool PERM = false, AFTER_DRAIN = false;
    float* out; const bf16_t* proj; const float* ssq1; float* ssq2;
    __device__ __forceinline__ void operator()(const f32x4 (&acc)[2][2][4][2], const Unit& u, int wr, int wc, int fr, int fq) const {
        const int row0 = u.pm * BM + wr * 64 + fr, col0 = u.pn * BM + wc * 32 + 4 * fq;
#pragma unroll
        for (int ai = 0; ai < 2; ++ai)
#pragma unroll
            for (int m = 0; m < 4; ++m) { const int r = row0 + ai * HALF + m * 16; const size_t off = (size_t)r * 1024 + col0;
                const f32x4* sp = (const f32x4*)(ssq1 + (size_t)r * 16); const f32x4 s0 = sp[0], s1 = sp[1], s2 = sp[2], s3 = sp[3];
                const float st = ((s0[0] + s0[1]) + (s0[2] + s0[3])) + ((s1[0] + s1[1]) + (s1[2] + s1[3])) + ((s2[0] + s2[1]) + (s2[2] + s2[3])) + ((s3[0] + s3[1]) + (s3[2] + s3[3]));
                const float rr = __builtin_amdgcn_rsqf(st * (1.f / 1024.f) + 1e-6f); float ss = 0.f;
#pragma unroll
                for (int bj = 0; bj < 2; ++bj)
#pragma unroll
                    for (int n = 0; n < 2; ++n) { const f32x4 a = acc[ai][bj][m][n] * rr; const u32x2 pw = *(const u32x2*)(proj + off + bj * HALF + n * 16);
                        const f32x4 h1 = *(const f32x4*)(out + off + bj * HALF + n * 16); f32x4 h;
                        h[0] = h1[0] + sigm(a[0]) * bflo(pw.x); h[1] = h1[1] + sigm(a[1]) * bfhi(pw.x); h[2] = h1[2] + sigm(a[2]) * bflo(pw.y); h[3] = h1[3] + sigm(a[3]) * bfhi(pw.y);
                        *(f32x4*)(out + off + bj * HALF + n * 16) = h; ss += (h[0] * h[0] + h[1] * h[1]) + (h[2] * h[2] + h[3] * h[3]); }
                ss += bperm_f(((fq ^ 1) << 4) | fr, ss); ss += bperm_f(((fq ^ 2) << 4) | fr, ss);
                if (fq == 0) ssq2[(size_t)r * 16 + u.pn * 4 + wc] = ss; }
    }
};

struct EpiGateNorm {
    static constexpr bool PERM = false, AFTER_DRAIN = false;
    float* out; const bf16_t* h1b; const bf16_t* proj; const float* ssq1; const float* gfin; float* slots; unsigned* cnt; PG8_LAS unsigned char* xl;
    __device__ __forceinline__ void operator()(f32x4 (&acc)[2][2][4][2], const Unit& u, int wr, int wc, int fr, int fq) const {
        const int row0 = u.pm * BM + wr * 64 + fr, col0 = u.pn * BM + wc * 32 + 4 * fq; const int wid = wr * 4 + wc, lane = fq * 16 + fr;
        PG8_LAS float* P = (PG8_LAS float*)xl; PG8_LAS float* S = (PG8_LAS float*)(xl + 4096); PG8_LAS float* R1 = (PG8_LAS float*)(xl + 5120);
        u32x2 pwv[8][4], hwv[8][4];
#define EGN_LD(g) do { const size_t off_ = (size_t)(row0 + ((g) >> 2) * HALF + ((g) & 3) * 16) * 1024 + col0; \
            pwv[g][0] = *(const u32x2*)(proj + off_); pwv[g][1] = *(const u32x2*)(proj + off_ + 16); pwv[g][2] = *(const u32x2*)(proj + off_ + HALF); pwv[g][3] = *(const u32x2*)(proj + off_ + HALF + 16); \
            hwv[g][0] = *(const u32x2*)(h1b + off_); hwv[g][1] = *(const u32x2*)(h1b + off_ + 16); hwv[g][2] = *(const u32x2*)(h1b + off_ + HALF); hwv[g][3] = *(const u32x2*)(h1b + off_ + HALF + 16); } while (0)
        EGN_LD(0); EGN_LD(1); EGN_LD(2); EGN_LD(3);
        { const int t_ = wid * 64 + lane; if (t_ < 256) { const f32x4* sp = (const f32x4*)(ssq1 + (size_t)(u.pm * BM + t_) * 16); const f32x4 s0 = sp[0], s1 = sp[1], s2 = sp[2], s3 = sp[3];
            const float st = ((s0[0] + s0[1]) + (s0[2] + s0[3])) + ((s1[0] + s1[1]) + (s1[2] + s1[3])) + ((s2[0] + s2[1]) + (s2[2] + s2[3])) + ((s3[0] + s3[1]) + (s3[2] + s3[3]));
            R1[t_] = __builtin_amdgcn_rsqf(st * (1.f / 1024.f) + 1e-6f); } }
        asm volatile("s_waitcnt vmcnt(0) lgkmcnt(0)" ::: "memory"); __builtin_amdgcn_s_barrier(); asm volatile("" ::: "memory");
#pragma unroll
        for (int g = 0; g < 8; ++g) { const int ai = g >> 2, m = g & 3;
            if (g + 4 < 8) EGN_LD(g + 4);
            const float rr = R1[ai * HALF + wr * 64 + m * 16 + fr]; float ss = 0.f;
#pragma unroll
            for (int bj = 0; bj < 2; ++bj)
#pragma unroll
                for (int n = 0; n < 2; ++n) { const f32x4 a = acc[ai][bj][m][n] * rr; const u32x2 pw = pwv[g][bj * 2 + n], hw = hwv[g][bj * 2 + n]; f32x4 h;
                    h[0] = bflo(hw.x) + sigm(a[0]) * bflo(pw.x); h[1] = bfhi(hw.x) + sigm(a[1]) * bfhi(pw.x); h[2] = bflo(hw.y) + sigm(a[2]) * bflo(pw.y); h[3] = bfhi(hw.y) + sigm(a[3]) * bfhi(pw.y);
                    acc[ai][bj][m][n] = h; ss += (h[0] * h[0] + h[1] * h[1]) + (h[2] * h[2] + h[3] * h[3]); }
            ss += bperm_f(((fq ^ 1) << 4) | fr, ss); ss += bperm_f(((fq ^ 2) << 4) | fr, ss);
            if (fq == 0) P[(ai * HALF + wr * 64 + m * 16 + fr) * 4 + wc] = ss; }
#undef EGN_LD
        asm volatile("s_waitcnt lgkmcnt(0)" ::: "memory"); __builtin_amdgcn_s_barrier(); asm volatile("" ::: "memory");
        const int row = wid * 32 + (lane & 31);
        if (lane < 32) { const float t = (P[row * 4 + 0] + P[row * 4 + 1]) + (P[row * 4 + 2] + P[row * 4 + 3]);
            __hip_atomic_store(slots + ((size_t)(u.pm * BM + row) * 4 + u.pn), t, __ATOMIC_RELAXED, __HIP_MEMORY_SCOPE_AGENT); }
        asm volatile("s_waitcnt vmcnt(0)" ::: "memory");
        if (lane == 0) __hip_atomic_fetch_add(cnt + 64 * u.pm, 1u, __ATOMIC_RELAXED, __HIP_MEMORY_SCOPE_AGENT);
        if (wid == 0) { unsigned spins = 0;
            while ((unsigned)__builtin_amdgcn_readfirstlane(__hip_atomic_load(cnt + 64 * u.pm, __ATOMIC_RELAXED, __HIP_MEMORY_SCOPE_AGENT)) < 32u) { __builtin_amdgcn_s_sleep(2); if (++spins > (1u << 22)) break; }
            __builtin_amdgcn_fence(__ATOMIC_ACQUIRE, "agent"); }
        asm volatile("s_waitcnt vmcnt(0) lgkmcnt(0)" ::: "memory"); __builtin_amdgcn_s_barrier(); asm volatile("" ::: "memory");
        if (lane < 32) { const float* sl = slots + (size_t)(u.pm * BM + row) * 4; float t = 0.f;
#pragma unroll
            for (int k = 0; k < 4; ++k) t += __hip_atomic_load(sl + k, __ATOMIC_RELAXED, __HIP_MEMORY_SCOPE_AGENT);
            S[row] = __builtin_amdgcn_rsqf(t * (1.f / 1024.f) + 1e-6f); }
        asm volatile("s_waitcnt vmcnt(0) lgkmcnt(0)" ::: "memory"); __builtin_amdgcn_s_barrier(); asm volatile("" ::: "memory");
        f32x4 gv[2][2];
#pragma unroll
        for (int bj = 0; bj < 2; ++bj)
#pragma unroll
            for (int n = 0; n < 2; ++n) gv[bj][n] = *(const f32x4*)(gfin + col0 + bj * HALF + n * 16);
#pragma unroll
        for (int ai = 0; ai < 2; ++ai)
#pragma unroll
            for (int m = 0; m < 4; ++m) { const int rl = ai * HALF + wr * 64 + m * 16 + fr; const float rs = S[rl]; const size_t off = (size_t)(u.pm * BM + rl) * 1024 + col0;
#pragma unroll
                for (int bj = 0; bj < 2; ++bj)
#pragma unroll
                    for (int n = 0; n < 2; ++n) __builtin_nontemporal_store(acc[ai][bj][m][n] * rs * gv[bj][n], (f32x4*)(out + off + bj * HALF + n * 16)); }
        asm volatile("s_waitcnt lgkmcnt(0)" ::: "memory"); __builtin_amdgcn_s_barrier(); asm volatile("" ::: "memory");
    }
};
template <class Epi, class Sched, bool ALIGN_EPI = false, bool SP2 = false>
__device__ __forceinline__ void gemm_phase(PG8_LAS unsigned char* lds, const Gemm g, const Sched& S, const Epi& E, const int wave_) {
    const int tid = opq_tid(wave_), wid = __builtin_amdgcn_readfirstlane(tid >> 6), lane = tid & 63, wr = wid >> 2, wc = wid & 3, fr = lane & 15, fq = lane >> 4;
    const int K = g.K, nt = K / BK;
    unsigned voffA[2], voffB[2];
#pragma unroll
    for (int i = 0; i < 2; ++i) { int R, C; stage_rc(tid * 16 + i * 8192, R, C); const int Rb = Epi::PERM ? ((R & ~31) + perm32(R & 31)) : R;
        voffA[i] = (unsigned)(R * g.ld + C) * 2u; voffB[i] = (unsigned)(Rb * g.ld + C) * 2u; }
    const size_t kstep = (size_t)(BK * 2);
    const size_t hstep = (size_t)HALF * g.ld * 2;
    const size_t tstep = 2 * hstep;
    const unsigned ldsw = (unsigned)wid * 1024u;
    const int aoff = lds_byte(wr * 64 + fr, fq * 8), boff = lds_byte(wc * 32 + fr, fq * 8);
#define PG8_SA(b, h) (((b) * 2 + (h)) * HTB)
#define PG8_SB(b, h) ((4 + (b) * 2 + (h)) * HTB)
#define PG8_STAGE(bufoff, gbase, voff) do { unsigned long long gb_ = (unsigned long long)(gbase); asm volatile("" : "+s"(gb_)); _Pragma("unroll") for (int _i = 0; _i < 2; ++_i) { asm volatile("" : "+v"((voff)[_i])); \
        __builtin_amdgcn_global_load_lds((const unsigned*)((const char*)gb_ + (voff)[_i]), (PG8_LAS unsigned*)(lds + (bufoff) + ldsw + _i * 8192), 16, 0, 0); } } while (0)
#define PG8_LDA(dst, b, h) do { _Pragma("unroll") for (int m = 0; m < 4; ++m) _Pragma("unroll") for (int k = 0; k < 2; ++k) dst[m][k] = *(const PG8_LAS bf16x8*)(lds + PG8_SA(b, h) + aoff + m * 2048 + k * 1024); } while (0)
#define PG8_LDB(dst, b, h) do { _Pragma("unroll") for (int n = 0; n < 2; ++n) _Pragma("unroll") for (int k = 0; k < 2; ++k) dst[n][k] = *(const PG8_LAS bf16x8*)(lds + PG8_SB(b, h) + boff + n * 2048 + k * 1024); } while (0)
#define PG8_MMA(ai, bj, At, Bt) do { __builtin_amdgcn_s_setprio(1); _Pragma("unroll") for (int m = 0; m < 4; ++m) _Pragma("unroll") for (int n = 0; n < 2; ++n) _Pragma("unroll") for (int k = 0; k < 2; ++k) \
        acc[ai][bj][m][n] = __builtin_amdgcn_mfma_f32_16x16x32_bf16(Bt[n][k], At[m][k], acc[ai][bj][m][n], 0, 0, 0); __builtin_amdgcn_s_setprio(0); } while (0)
#define PG8_WAIT_V(n) asm volatile("s_waitcnt vmcnt(" #n ")" ::: "memory")
#define PG8_WAIT_L(n) asm volatile("s_waitcnt lgkmcnt(" #n ")" ::: "memory")
#define PG8_BAR __builtin_amdgcn_s_barrier()
#define PG8_SCHED __builtin_amdgcn_sched_barrier(0)
    Unit cur, nxt; int ui = 0;
    if (!S.next(0, cur)) return;
    f32x4 acc[2][2][4][2];
#pragma unroll
    for (int a = 0; a < 2; ++a)
#pragma unroll
        for (int b = 0; b < 2; ++b)
#pragma unroll
            for (int m = 0; m < 4; ++m)
#pragma unroll
                for (int n = 0; n < 2; ++n) acc[a][b][m][n] = (f32x4){0.f, 0.f, 0.f, 0.f};
    bf16x8 At[4][2], B0[2][2], B1[2][2];
    const char* cA = (const char*)g.A + (size_t)cur.pm * tstep + (size_t)(cur.pn * g.koff_pn) * 2; const char* cB = (const char*)g.Bt + (size_t)cur.pn * tstep + (size_t)(cur.pn * g.koff_pn) * 2;
    S.a_ready(cur);
    if constexpr (SP2) {
        PG8_STAGE(PG8_SB(0, 0), cB, voffB); PG8_STAGE(PG8_SB(0, 1), cB + hstep, voffB); PG8_STAGE(PG8_SA(0, 0), cA, voffA); PG8_STAGE(PG8_SA(0, 1), cA + hstep, voffA);
        if (wr == 1) PG8_BAR;
        PG8_WAIT_V(2); PG8_BAR;
        PG8_STAGE(PG8_SB(1, 0), cB + kstep, voffB); PG8_STAGE(PG8_SA(1, 0), cA + kstep, voffA); PG8_STAGE(PG8_SB(1, 1), cB + hstep + kstep, voffB);
        PG8_WAIT_V(6); PG8_BAR;
    } else {
        PG8_STAGE(PG8_SB(0, 0), cB, voffB); PG8_STAGE(PG8_SA(0, 0), cA, voffA); PG8_STAGE(PG8_SB(0, 1), cB + hstep, voffB); PG8_STAGE(PG8_SA(0, 1), cA + hstep, voffA);
        if (wr == 1) PG8_BAR;
        PG8_WAIT_V(4); PG8_BAR;
        PG8_STAGE(PG8_SB(1, 0), cB + kstep, voffB); PG8_STAGE(PG8_SA(1, 0), cA + kstep, voffA); PG8_STAGE(PG8_SB(1, 1), cB + hstep + kstep, voffB);
        PG8_WAIT_V(6); PG8_BAR;
    }
    for (;;) {
        const bool has_next = S.next(ui + 1, nxt);
        const char* nA = has_next ? (const char*)g.A + (size_t)nxt.pm * tstep + (size_t)(nxt.pn * g.koff_pn) * 2 : cA; const char* nB = has_next ? (const char*)g.Bt + (size_t)nxt.pn * tstep + (size_t)(nxt.pn * g.koff_pn) * 2 : cB;
        for (int t = 0; t < nt; t += 2) {
            const bool last = (t == nt - 2);
            const char* a1 = cA + (size_t)(t + 1) * kstep;
            const char* a2 = last ? nA : cA + (size_t)(t + 2) * kstep; const char* b2 = last ? nB : cB + (size_t)(t + 2) * kstep;
            const char* a3 = a2 + kstep; const char* b3 = b2 + kstep;
            if (last && has_next) S.a_ready(nxt);
            if constexpr (SP2) {
            PG8_LDB(B0, 0, 0); PG8_LDB(B1, 0, 1); PG8_SCHED; PG8_LDA(At, 0, 0); PG8_STAGE(PG8_SA(1, 1), a1 + hstep, voffA);
            PG8_WAIT_V(8); PG8_WAIT_L(0); PG8_BAR; PG8_MMA(0, 0, At, B0); PG8_MMA(0, 1, At, B1); PG8_BAR; PG8_SCHED;
            PG8_LDA(At, 0, 1); PG8_STAGE(PG8_SB(0, 0), b2, voffB); PG8_STAGE(PG8_SB(0, 1), b2 + hstep, voffB); PG8_STAGE(PG8_SA(0, 0), a2, voffA);
            PG8_WAIT_V(8); PG8_WAIT_L(0); PG8_BAR; PG8_MMA(1, 0, At, B0); PG8_MMA(1, 1, At, B1); PG8_BAR; PG8_SCHED;
            PG8_LDB(B0, 1, 0); PG8_LDB(B1, 1, 1); PG8_SCHED; PG8_LDA(At, 1, 0); PG8_STAGE(PG8_SA(0, 1), a2 + hstep, voffA);
            PG8_WAIT_V(8); PG8_WAIT_L(0); PG8_BAR; PG8_MMA(0, 0, At, B0); PG8_MMA(0, 1, At, B1); PG8_BAR; PG8_SCHED;
            PG8_LDA(At, 1, 1); PG8_STAGE(PG8_SB(1, 0), b3, voffB); PG8_STAGE(PG8_SB(1, 1), b3 + hstep, voffB); PG8_STAGE(PG8_SA(1, 0), a3, voffA);
            PG8_WAIT_V(8); PG8_WAIT_L(0); PG8_BAR; PG8_MMA(1, 0, At, B0); PG8_MMA(1, 1, At, B1); PG8_BAR; PG8_SCHED;
            } else {
            PG8_LDB(B0, 0, 0); PG8_SCHED; PG8_LDA(At, 0, 0); PG8_STAGE(PG8_SA(1, 1), a1 + hstep, voffA);
            PG8_WAIT_L(8); PG8_BAR; PG8_WAIT_L(0); PG8_MMA(0, 0, At, B0); PG8_BAR; PG8_SCHED;
            PG8_LDB(B1, 0, 1); PG8_STAGE(PG8_SB(0, 0), b2, voffB);
            PG8_BAR; PG8_WAIT_L(0); PG8_MMA(0, 1, At, B1); PG8_BAR;
            PG8_LDA(At, 0, 1); PG8_STAGE(PG8_SA(0, 0), a2, voffA);
            PG8_BAR; PG8_WAIT_L(0); PG8_MMA(1, 0, At, B0); PG8_BAR; PG8_SCHED;
            PG8_STAGE(PG8_SB(0, 1), b2 + hstep, voffB);
            PG8_WAIT_V(6); PG8_BAR; PG8_MMA(1, 1, At, B1); PG8_BAR;
            PG8_LDB(B0, 1, 0); PG8_SCHED; PG8_LDA(At, 1, 0); PG8_STAGE(PG8_SA(0, 1), a2 + hstep, voffA);
            PG8_WAIT_L(8); PG8_BAR; PG8_WAIT_L(0); PG8_MMA(0, 0, At, B0); PG8_BAR; PG8_SCHED;
            PG8_LDB(B1, 1, 1); PG8_STAGE(PG8_SB(1, 0), b3, voffB);
            PG8_BAR; PG8_WAIT_L(0); PG8_MMA(0, 1, At, B1); PG8_BAR;
            PG8_LDA(At, 1, 1); PG8_STAGE(PG8_SA(1, 0), a3, voffA);
            PG8_BAR; PG8_WAIT_L(0); PG8_MMA(1, 0, At, B0); PG8_BAR; PG8_SCHED;
            PG8_STAGE(PG8_SB(1, 1), b3 + hstep, voffB);
            PG8_WAIT_V(6); PG8_BAR; PG8_MMA(1, 1, At, B1); PG8_BAR;
            }
        }
        if constexpr (ALIGN_EPI) { if (wr == 0) PG8_BAR; }
        if constexpr (!Epi::AFTER_DRAIN) { const int l2_ = opq_tid(wave_) & 63; E(acc, cur, wr, wc, l2_ & 15, l2_ >> 4); S.done(cur); }
        if (!has_next) break;
#pragma unroll
        for (int a = 0; a < 2; ++a)
#pragma unroll
            for (int b = 0; b < 2; ++b)
#pragma unroll
                for (int m = 0; m < 4; ++m)
#pragma unroll
                    for (int n = 0; n < 2; ++n) acc[a][b][m][n] = (f32x4){0.f, 0.f, 0.f, 0.f};
        cur = nxt; cA = nA; cB = nB; ++ui;
        if constexpr (ALIGN_EPI) { if (wr == 1) PG8_BAR; }
    }
    PG8_WAIT_V(0);
    if constexpr (!ALIGN_EPI) { if (wr == 0) PG8_BAR; }
    PG8_BAR;
    if constexpr (Epi::AFTER_DRAIN) { E.fused(acc, cur, wr, wc, fr, fq, lds, wid, lane); S.done(cur); }
#undef PG8_SA
#undef PG8_SB
#undef PG8_STAGE
#undef PG8_LDA
#undef PG8_LDB
#undef PG8_MMA
#undef PG8_WAIT_V
#undef PG8_WAIT_L
#undef PG8_BAR
#undef PG8_SCHED
}
}
constexpr int NWAVES = 8;
constexpr int DM = 1024, NTOK = 49152, TPR = 32768, SEQP = 4096, SEQS = 8192, NBP = 8, NBS = 2, NIN = 3072, PLED = 256;
constexpr float LOG2E = 1.4426950408889634f;
constexpr float QSCALE = 0.125f * LOG2E;
constexpr size_t MiB = 1u << 20;
constexpr size_t WS_CTL = 0, CTL_ZERO_BYTES = 128 * 1024;
constexpr size_t WS_TAB = 1 * MiB;
constexpr size_t WS_GINV = 1 * MiB + 8192;
constexpr size_t WS_RINV = 1 * MiB + 16384;
constexpr size_t WS_WIN = 2 * MiB;
constexpr size_t WS_WOUT = 8 * MiB;
constexpr size_t WS_WG = 10 * MiB;
constexpr size_t WS_WP = 12 * MiB;
constexpr size_t WS_GT = 12 * MiB + 512 * 1024;
constexpr size_t WS_H1A = 13 * MiB + 512 * 1024;
constexpr size_t WS_H1B = WS_H1A + 64 * 1024;
constexpr size_t WS_M2A = 14 * MiB;
constexpr size_t WS_M2B = 15 * MiB + 256 * 1024;
constexpr size_t WS_SSQ1 = 18 * MiB, WS_SSQ2 = 21 * MiB;
constexpr size_t WS_XN = 24 * MiB;
constexpr size_t WS_QU = 120 * MiB;
constexpr size_t WS_K = 216 * MiB, WS_V = 264 * MiB;
constexpr size_t WS_GA = 312 * MiB, WS_GF = 360 * MiB;
constexpr size_t WS_PROJ = 408 * MiB;
constexpr size_t WS_QB = 504 * MiB, WS_UB = 552 * MiB;
constexpr size_t WS_END = 600 * MiB;
static_assert(WS_M2A + 33 * 32768 <= WS_M2B && WS_M2B + 65 * 32768 <= WS_SSQ1 && WS_SSQ2 + (size_t)NTOK * 64 <= WS_XN, "d_ws map");
constexpr int RING_BYTES = 131072, LDSCTL_OFF = RING_BYTES, MISC_OFF = LDSCTL_OFF + 320, LDS_BYTES = 147456;
#define GAS __attribute__((address_space(1)))
#define LAS __attribute__((address_space(3)))
typedef unsigned short bf16;
typedef unsigned v4u __attribute__((ext_vector_type(4)));
typedef unsigned v2u __attribute__((ext_vector_type(2)));
typedef float f32x4 __attribute__((ext_vector_type(4)));
typedef short bf16x8 __attribute__((ext_vector_type(8)));
#define LDS_WAIT() asm volatile("s_waitcnt lgkmcnt(0)" ::: "memory")
#define VM_WAIT() asm volatile("s_waitcnt vmcnt(0)" ::: "memory")
__device__ __forceinline__ unsigned f2bf(float f) { unsigned u = __builtin_bit_cast(unsigned, f); return (u + 0x7fffu + ((u >> 16) & 1u)) >> 16; }
__device__ __forceinline__ unsigned pk2(float lo, float hi) { return f2bf(lo) | (f2bf(hi) << 16); }
#define XB_TMO      128
#define XB_XCNT(j)  (256  + 64 * (j))
#define XB_XSUB(j)  (1280 + 64 * (j))
#define XB_XGEN(j)  (2304 + 64 * (j))
#define XB_TOP      3328
#define XB_TOPGEN   3392
#define XCD_BAR_WORDS 3456
#define XB_SPIN_CAP (1u << 18)

__device__ __forceinline__ unsigned xb_ld(unsigned* p)              { return __hip_atomic_load(p, __ATOMIC_RELAXED, __HIP_MEMORY_SCOPE_AGENT); }
__device__ __forceinline__ unsigned xb_add(unsigned* p, unsigned v) { return __hip_atomic_fetch_add(p, v, __ATOMIC_RELAXED, __HIP_MEMORY_SCOPE_AGENT); }
__device__ __forceinline__ unsigned xb_xcc_id() { return (unsigned)__builtin_amdgcn_s_getreg((3 << 11) | 20) & 0xFu; }
#define XB_SPIN(cond, bar) do { unsigned _sp = 0; while (cond) { __builtin_amdgcn_s_sleep(1); \
    if ((++_sp & 255u) == 0u) { if (xb_ld(&(bar)[XB_TMO])) break; if (_sp > XB_SPIN_CAP) { atomicAdd(&(bar)[XB_TMO], 1u); break; } } } } while (0)

struct XcdBarrier {
    unsigned* bar; unsigned x;
    volatile LAS unsigned* st;
};

__device__ __forceinline__ XcdBarrier xcd_barrier_post(unsigned* bar, volatile LAS unsigned* st) {
    XcdBarrier b; b.bar = bar; b.x = xb_xcc_id(); b.st = st;
    if (threadIdx.x == 0) (void)xb_add(&bar[XB_XCNT(b.x)], 1u);
    return b;
}
__device__ __forceinline__ void xcd_barrier_complete(unsigned* bar, unsigned x, unsigned& nloc, unsigned& nx) {
    const unsigned G = gridDim.x * gridDim.y * gridDim.z;
    unsigned sum, cnt, mine, sp = 0u;
    for (;;) {
        sum = 0u; cnt = 0u; mine = 0u;
#pragma unroll
        for (unsigned j = 0; j < 16; ++j) { const unsigned c = xb_ld(&bar[XB_XCNT(j)]); sum += c; cnt += (c > 0u) ? 1u : 0u; mine = (j == x) ? c : mine; }
        if (sum == G) break;
        __builtin_amdgcn_s_sleep(1);
        if ((++sp & 255u) == 0u) { if (xb_ld(&bar[XB_TMO])) break; if (sp > XB_SPIN_CAP) { atomicAdd(&bar[XB_TMO], 1u); break; } }
    }
    nloc = mine > 0u ? mine : 1u; nx = cnt > 0u ? cnt : 1u;
}

__device__ __forceinline__ void xcd_barrier(const XcdBarrier& b) {
    asm volatile("s_waitcnt vmcnt(0)" ::: "memory");
    __syncthreads();
    if (threadIdx.x == 0) {
        unsigned* bar = b.bar;
        __builtin_amdgcn_s_waitcnt(0);
        unsigned nloc = b.st[0], nx = b.st[1];
        if (nloc == 0u) { xcd_barrier_complete(bar, b.x, nloc, nx); b.st[0] = nloc; b.st[1] = nx; }
        const unsigned old = xb_add(&bar[XB_XSUB(b.x)], 1u);
        const unsigned gen = old / nloc;
        if (old + 1u == (gen + 1u) * nloc) {
            __builtin_amdgcn_fence(__ATOMIC_RELEASE, "agent");
            asm volatile("s_waitcnt vmcnt(0)" ::: "memory");
            const unsigned og = xb_add(&bar[XB_TOP], 1u);
            const unsigned tg = og / nx;
            if (og + 1u == (tg + 1u) * nx) xb_add(&bar[XB_TOPGEN], 1u);
            else XB_SPIN(xb_ld(&bar[XB_TOPGEN]) == tg, bar);
            __builtin_amdgcn_fence(__ATOMIC_ACQUIRE, "agent");
            xb_add(&bar[XB_XGEN(b.x)], 1u);
            asm volatile("s_waitcnt vmcnt(0)" ::: "memory");
        } else {
            XB_SPIN(xb_ld(&bar[XB_XGEN(b.x)]) == gen, bar);
            __builtin_amdgcn_fence(__ATOMIC_ACQUIRE, "agent");
            asm volatile("s_waitcnt vmcnt(0)" ::: "memory");
        }
    }
    __syncthreads();
}
namespace att3 {
#ifndef ATT_REGSTAGE
#define ATT_REGSTAGE 0
#endif
#ifndef DMA_IN_VSEG
#define DMA_IN_VSEG 0
#endif
#ifndef QK_IN_VSEG
#define QK_IN_VSEG 0
#endif
#ifndef ATT_ONEBAR
#define ATT_ONEBAR 1
#endif
#ifndef ATT_LOCKSTEP
#define ATT_LOCKSTEP 0
#endif
typedef unsigned short bf16_t;
typedef short bf16x8 __attribute__((ext_vector_type(8)));
typedef short s16x4 __attribute__((ext_vector_type(4)));
typedef float f32x16 __attribute__((ext_vector_type(16)));
typedef float f32x4 __attribute__((ext_vector_type(4)));
typedef unsigned u32x4 __attribute__((ext_vector_type(4)));
#define A2_LAS __attribute__((address_space(3)))
#ifndef PRIO_MODE
#define PRIO_MODE 0
#endif
#if PRIO_MODE == 1
#define A3_PRIO_M(x) __builtin_amdgcn_s_setprio(x)
#define A3_PRIO_V(x) do { } while (0)
#elif PRIO_MODE == 2
#define A3_PRIO_M(x) do { } while (0)
#define A3_PRIO_V(x) __builtin_amdgcn_s_setprio(x)
#else
#define A3_PRIO_M(x) do { } while (0)
#define A3_PRIO_V(x) do { } while (0)
#endif
constexpr int KVBLK = 64, TILEB = 16384, KRING = 4, VRING = 3;
constexpr int OFF_K = 0, OFF_V = KRING * TILEB, OFF_WS = (KRING + VRING) * TILEB, OFF_TAB = OFF_WS + 8 * 256, A2_LDS_END = OFF_TAB + 2048;
constexpr float THR2 = 11.5f;
#define KSWZ(row, colB) ((row) * 256 + ((colB) ^ (((row) & 15) << 4)))
__device__ __forceinline__ int crow(int r, int hi) { return (r & 3) + 8 * (r >> 2) + 4 * hi; }
__device__ __forceinline__ unsigned cvtpk(float lo, float hi) { unsigned r; asm volatile("v_cvt_pk_bf16_f32 %0, %1, %2" : "=v"(r) : "v"(lo), "v"(hi)); return r; }
__device__ __forceinline__ float bflo(unsigned w) { return __uint_as_float(w << 16); }
__device__ __forceinline__ float bfhi(unsigned w) { return __uint_as_float(w & 0xffff0000u); }
__device__ __forceinline__ float silu(float a) { return a * __builtin_amdgcn_rcpf(1.f + __expf(-a)); }
__device__ __forceinline__ float max3f(float a, float b, float c) { float r; asm("v_max3_f32 %0, %1, %2, %3" : "=v"(r) : "v"(a), "v"(b), "v"(c)); return r; }
__device__ __forceinline__ float max2f(float a, float b) { float r; asm("v_max_f32_e32 %0, %1, %2" : "=v"(r) : "v"(a), "v"(b)); return r; }
__device__ __forceinline__ float fadd_s(float a, float b) { float r; asm("v_add_f32_e32 %0, %1, %2" : "=v"(r) : "v"(a), "v"(b)); return r; }
__device__ __forceinline__ float exp2_s(float a) { float r; asm("v_exp_f32_e32 %0, %1" : "=v"(r) : "v"(a)); return r; }
typedef short v4i16_t __attribute__((ext_vector_type(4)));
__device__ __forceinline__ s16x4 vtr(const A2_LAS char* p) { return __builtin_bit_cast(s16x4, __builtin_amdgcn_ds_read_tr16_b64_v4i16((A2_LAS v4i16_t*)p)); }
__device__ __forceinline__ int v_rd_base(int lane) { return ((lane & 3) << 3) | (((lane >> 2) & 3) << 6) | (((lane >> 4) & 1) << 5) | (((lane >> 5) & 1) << 11); }
constexpr int v_rd_off(int d0, int ks, int half) { return d0 * 512 + ks * 4096 + half * 256; }

#ifndef MFMA_GAP
#define MFMA_GAP 0
#endif
#if MFMA_GAP > 0
#define MGAP_STR2(x) #x
#define MGAP_STR(x) MGAP_STR2(x)
#define MGAP() asm volatile("s_nop " MGAP_STR(MFMA_GAP))
#else
#define MGAP() do { } while (0)
#endif
__device__ __forceinline__ void kload(bf16x8* kf, const A2_LAS char* Ks, int r32, int hi, int comp) {
#pragma unroll
  for (int d0 = 0; d0 < 4; ++d0) { const int cb = ((comp * 4 + d0) * 16 + hi * 8) * 2;
    kf[2 * d0] = *reinterpret_cast<const A2_LAS bf16x8*>(Ks + KSWZ(r32, cb)); kf[2 * d0 + 1] = *reinterpret_cast<const A2_LAS bf16x8*>(Ks + KSWZ(32 + r32, cb)); }
}
__device__ __forceinline__ void qkt_a(f32x16& p0, f32x16& p1, const bf16x8* kf, const bf16x8* qr, const f32x16& negm) {
  p0 = __builtin_amdgcn_mfma_f32_32x32x16_bf16(kf[0], qr[0], negm, 0, 0, 0); MGAP(); p1 = __builtin_amdgcn_mfma_f32_32x32x16_bf16(kf[1], qr[0], negm, 0, 0, 0); MGAP();
  p0 = __builtin_amdgcn_mfma_f32_32x32x16_bf16(kf[2], qr[1], p0, 0, 0, 0); MGAP(); p1 = __builtin_amdgcn_mfma_f32_32x32x16_bf16(kf[3], qr[1], p1, 0, 0, 0); MGAP();
}
__device__ __forceinline__ void qkt_b(f32x16& p0, f32x16& p1, const bf16x8* kf, const bf16x8* qr) {
  p0 = __builtin_amdgcn_mfma_f32_32x32x16_bf16(kf[4], qr[2], p0, 0, 0, 0); MGAP(); p1 = __builtin_amdgcn_mfma_f32_32x32x16_bf16(kf[5], qr[2], p1, 0, 0, 0); MGAP();
  p0 = __builtin_amdgcn_mfma_f32_32x32x16_bf16(kf[6], qr[3], p0, 0, 0, 0); MGAP(); p1 = __builtin_amdgcn_mfma_f32_32x32x16_bf16(kf[7], qr[3], p1, 0, 0, 0); MGAP();
}
struct VFrag { s16x4 lo[4], hh[4]; };
template <int D0> __device__ __forceinline__ void vload(VFrag& f, const A2_LAS char* vp) {
#pragma unroll
  for (int ks = 0; ks < 4; ++ks) { f.lo[ks] = vtr(vp + v_rd_off(D0, ks, 0)); f.hh[ks] = vtr(vp + v_rd_off(D0, ks, 1)); }
}
template <int D0> __device__ __forceinline__ void vload_a(VFrag& f, unsigned va) {
#define VTR_A(dst, off) asm volatile("ds_read_b64_tr_b16 %0, %1 offset:%2" : "=v"(dst) : "v"(va), "n"(off))
  VTR_A(f.lo[0], v_rd_off(D0, 0, 0)); VTR_A(f.hh[0], v_rd_off(D0, 0, 1)); VTR_A(f.lo[1], v_rd_off(D0, 1, 0)); VTR_A(f.hh[1], v_rd_off(D0, 1, 1));
  VTR_A(f.lo[2], v_rd_off(D0, 2, 0)); VTR_A(f.hh[2], v_rd_off(D0, 2, 1)); VTR_A(f.lo[3], v_rd_off(D0, 3, 0)); VTR_A(f.hh[3], v_rd_off(D0, 3, 1));
#undef VTR_A
}
#define VWAIT(n, f) asm volatile("s_waitcnt lgkmcnt(" #n ")" : "+v"(f.lo[0]), "+v"(f.lo[1]), "+v"(f.lo[2]), "+v"(f.lo[3]), "+v"(f.hh[0]), "+v"(f.hh[1]), "+v"(f.hh[2]), "+v"(f.hh[3]))
__device__ __forceinline__ void pvmma(f32x16& od, const VFrag& f, bf16x8 pa0, bf16x8 pa1, bf16x8 pa2, bf16x8 pa3) {
#define PK(k) (bf16x8){f.lo[k][0], f.lo[k][1], f.lo[k][2], f.lo[k][3], f.hh[k][0], f.hh[k][1], f.hh[k][2], f.hh[k][3]}
  od = __builtin_amdgcn_mfma_f32_32x32x16_bf16(PK(0), pa0, od, 0, 0, 0); MGAP();
  od = __builtin_amdgcn_mfma_f32_32x32x16_bf16(PK(1), pa1, od, 0, 0, 0); MGAP();
  od = __builtin_amdgcn_mfma_f32_32x32x16_bf16(PK(2), pa2, od, 0, 0, 0); MGAP();
  od = __builtin_amdgcn_mfma_f32_32x32x16_bf16(PK(3), pa3, od, 0, 0, 0); MGAP();
#undef PK
}
__device__ __forceinline__ float vtail(const f32x16& p0, const f32x16& p1, bf16x8& pa0, bf16x8& pa1, bf16x8& pa2, bf16x8& pa3) {
  float sa, sb, e0, e1, e2, e3, e4, e5, e6, e7; u32x4 w0, w1, w2, w3;
#define VT_BODY(ADD0, ADD1) "v_exp_f32_e32 %6, %14\n\tv_exp_f32_e32 %7, %15\n\tv_exp_f32_e32 %8, %16\n\tv_exp_f32_e32 %9, %17\n\t" ADD0 "v_exp_f32_e32 %10, %18\n\t" ADD1 "v_exp_f32_e32 %11, %19\n\t" \
    "v_cvt_pk_bf16_f32 %2, %6, %7\n\tv_exp_f32_e32 %12, %20\n\tv_cvt_pk_bf16_f32 %3, %8, %9\n\tv_exp_f32_e32 %13, %21\n\tv_add_f32_e32 %0, %0, %10\n\tv_add_f32_e32 %1, %1, %11\n\t" \
    "v_cvt_pk_bf16_f32 %4, %10, %11\n\tv_add_f32_e32 %0, %0, %12\n\tv_add_f32_e32 %1, %1, %13\n\tv_cvt_pk_bf16_f32 %5, %12, %13"
#define VT_OUT(W) "=&v"(W.x), "=&v"(W.y), "=&v"(W.z), "=&v"(W.w), "=&v"(e0), "=&v"(e1), "=&v"(e2), "=&v"(e3), "=&v"(e4), "=&v"(e5), "=&v"(e6), "=&v"(e7)
#define VT_IN(P, B) "v"(P[B + 0]), "v"(P[B + 1]), "v"(P[B + 2]), "v"(P[B + 3]), "v"(P[B + 4]), "v"(P[B + 5]), "v"(P[B + 6]), "v"(P[B + 7])
  asm(VT_BODY("v_add_f32_e32 %0, %6, %7\n\t", "v_add_f32_e32 %1, %8, %9\n\t") : "=&v"(sa), "=&v"(sb), VT_OUT(w0) : VT_IN(p0, 0));
  asm(VT_BODY("v_add_f32_e32 %0, %0, %6\n\tv_add_f32_e32 %1, %1, %7\n\t", "v_add_f32_e32 %0, %0, %8\n\tv_add_f32_e32 %1, %1, %9\n\t") : "+v"(sa), "+v"(sb), VT_OUT(w1) : VT_IN(p0, 8));
  asm(VT_BODY("v_add_f32_e32 %0, %0, %6\n\tv_add_f32_e32 %1, %1, %7\n\t", "v_add_f32_e32 %0, %0, %8\n\tv_add_f32_e32 %1, %1, %9\n\t") : "+v"(sa), "+v"(sb), VT_OUT(w2) : VT_IN(p1, 0));
  asm(VT_BODY("v_add_f32_e32 %0, %0, %6\n\tv_add_f32_e32 %1, %1, %7\n\t", "v_add_f32_e32 %0, %0, %8\n\tv_add_f32_e32 %1, %1, %9\n\t") : "+v"(sa), "+v"(sb), VT_OUT(w3) : VT_IN(p1, 8));
#undef VT_BODY
#undef VT_OUT
#undef VT_IN
  pa0 = *reinterpret_cast<bf16x8*>(&w0); pa1 = *reinterpret_cast<bf16x8*>(&w1); pa2 = *reinterpret_cast<bf16x8*>(&w2); pa3 = *reinterpret_cast<bf16x8*>(&w3);
  return sa + sb;
}
__device__ __forceinline__ float rowmax64(const f32x16& p0, const f32x16& p1) {
  float a, b;
  asm("v_max3_f32 %0, %2, %3, %4\n\tv_max3_f32 %1, %5, %6, %7\n\tv_max3_f32 %0, %0, %8, %9" : "=&v"(a), "=&v"(b) : "v"(p0[0]), "v"(p0[1]), "v"(p1[0]), "v"(p0[2]), "v"(p0[3]), "v"(p1[1]), "v"(p1[2]), "v"(p1[3]));
#define MAX8(r) asm("v_max3_f32 %0, %0, %2, %3\n\tv_max3_f32 %1, %1, %4, %5\n\tv_max3_f32 %0, %0, %6, %7\n\tv_max3_f32 %1, %1, %8, %9" : "+v"(a), "+v"(b) : "v"(p0[r]), "v"(p0[r + 1]), "v"(p0[r + 2]), "v"(p0[r + 3]), "v"(p1[r]), "v"(p1[r + 1]), "v"(p1[r + 2]), "v"(p1[r + 3]))
  MAX8(4); MAX8(8);
  asm("v_max3_f32 %0, %0, %2, %3\n\tv_max3_f32 %1, %1, %4, %5\n\tv_max3_f32 %0, %0, %6, %7\n\tv_max3_f32 %1, %1, %8, %9\n\tv_max_f32_e32 %0, %0, %1" : "+v"(a), "+v"(b) : "v"(p0[12]), "v"(p0[13]), "v"(p0[14]), "v"(p0[15]), "v"(p1[12]), "v"(p1[13]), "v"(p1[14]), "v"(p1[15]));
#undef MAX8
  float rm = a;
  { auto rr = __builtin_amdgcn_permlane32_swap(__float_as_uint(rm), __float_as_uint(rm), false, false); rm = max2f(__uint_as_float(rr[0]), __uint_as_float(rr[1])); }
  return rm;
}
constexpr float REFOFF = THR2 - 1.f;
template <bool NEAR>
__device__ __forceinline__ bool vseg(f32x16& p0, f32x16& p1, float& mhat, float& l_reg, const bool first, const A2_LAS float* tabp, float& fsc, int r32, int hi,
                                     bf16x8& pa0, bf16x8& pa1, bf16x8& pa2, bf16x8& pa3) {
  if (NEAR) {
#pragma unroll
    for (int r = 0; r < 16; ++r) { const int o_ = (r & 3) + 8 * (r >> 2); p0[r] = fadd_s(p0[r], tabp[o_]); p1[r] = fadd_s(p1[r], tabp[o_ + 32]); }
  }
  if (first) { const float d = rowmax64(p0, p1) + REFOFF; mhat += d;
#pragma unroll
    for (int r = 0; r < 16; ++r) { p0[r] -= d; p1[r] -= d; }
    l_reg += vtail(p0, p1, pa0, pa1, pa2, pa3); return false;
  }
  const float ts = vtail(p0, p1, pa0, pa1, pa2, pa3);
  if (__builtin_expect(__any(!(ts < 2.f)), 0)) {
    const float dl = __builtin_fmaxf(rowmax64(p0, p1) + REFOFF, 0.f); mhat += dl;
#pragma unroll
    for (int r = 0; r < 16; ++r) { p0[r] -= dl; p1[r] -= dl; }
    const float f = __builtin_amdgcn_exp2f(-dl); l_reg *= f; fsc = f;
    l_reg += vtail(p0, p1, pa0, pa1, pa2, pa3); return true;
  }
  l_reg += ts; return false;
}

template <int VAR>
__device__ __forceinline__ void attn_unit(const bf16_t* QU, bf16_t* OQ, const bf16_t* __restrict__ KB, const bf16_t* __restrict__ VB, const bf16_t* __restrict__ GA,
                                          const float* __restrict__ tabg, const float* __restrict__ subg, float lam, int tok0, int seq, int h, int q0, A2_LAS unsigned char* lds, const int wave_, const int role_) {
  const int tid = opq_tid(wave_), lane = tid & 63, r32 = lane & 31, hi = lane >> 5; const int wid = wave_;
  const int comp = role_ >> 2, rb = role_ & 3;
  const A2_LAS char* Kr = (const A2_LAS char*)lds + OFF_K; const A2_LAS char* Vr = (const A2_LAS char*)lds + OFF_V;
  A2_LAS float* wsf = (A2_LAS float*)(lds + OFF_WS) + wid * 64; A2_LAS float* li_l = wsf; A2_LAS float* al_l = wsf + 32;
  A2_LAS float* tab = (A2_LAS float*)(lds + OFF_TAB);
  unsigned koff[2], voff[2];
#pragma unroll
  for (int i = 0; i < 2; ++i) { const int pc = 2 * wid + i;
    { const int row = 4 * pc + (lane >> 4), c = (lane & 15) ^ (row & 15); koff[i] = (unsigned)((row >> 4) * 16384 + (c >> 2) * 1024 + (row & 15) * 64 + (c & 3) * 16); }
    { const int st = 2 * pc + (lane >> 5), kk = (st >> 2) * 8 + ((lane & 31) >> 2), key = (kk & ~0xC) | ((kk & 4) << 1) | ((kk & 8) >> 1), col = (st & 3) * 32 + (lane & 3) * 8;
      voff[i] = (unsigned)((key >> 4) * 16384 + (col >> 5) * 1024 + (key & 15) * 64 + (col & 31) * 2); } }
  const char* Kh = (const char*)(KB + blk512(tok0, h * 128)); const char* Vh = (const char*)(VB + blk512(tok0, h * 128));
  const int NT = seq / KVBLK;
#define DMA_K(t, slot) do { const int t_ = (t) < NT ? (t) : NT - 1; const char* g_ = Kh + (size_t)t_ * (KVBLK * 1024); \
    __builtin_amdgcn_global_load_lds((const unsigned*)(g_ + koff[0]), (A2_LAS unsigned*)(lds + OFF_K + (slot) * TILEB + (2 * wid) * 1024), 16, 0, 0); \
    __builtin_amdgcn_global_load_lds((const unsigned*)(g_ + koff[1]), (A2_LAS unsigned*)(lds + OFF_K + (slot) * TILEB + (2 * wid + 1) * 1024), 16, 0, 0); } while (0)
#define DMA_V(t, slot) do { const int t_ = (t) < NT ? (t) : NT - 1; const char* g_ = Vh + (size_t)t_ * (KVBLK * 1024); \
    __builtin_amdgcn_global_load_lds((const unsigned*)(g_ + voff[0]), (A2_LAS unsigned*)(lds + OFF_V + (slot) * TILEB + (2 * wid) * 1024), 16, 0, 0); \
    __builtin_amdgcn_global_load_lds((const unsigned*)(g_ + voff[1]), (A2_LAS unsigned*)(lds + OFF_V + (slot) * TILEB + (2 * wid + 1) * 1024), 16, 0, 0); } while (0)
#define STG_GEOM() int tid_s = tid; asm volatile("" : "+v"(tid_s)); const int sr = tid_s >> 4, sc = (tid_s & 15) * 8
#define STG_KOFF() const int kst0 = KSWZ(sr, sc * 2), kst1 = KSWZ(32 + sr, sc * 2)
#define STG_VOFF() const int kk0 = (sr & ~0xC) | ((sr & 4) << 1) | ((sr & 8) >> 1), kk1 = kk0 + 32; \
    const int vst0 = ((kk0 >> 3) * 4 + (sc >> 5)) * 512 + ((kk0 & 7) * 32 + (sc & 31)) * 2, vst1 = ((kk1 >> 3) * 4 + (sc >> 5)) * 512 + ((kk1 & 7) * 32 + (sc & 31)) * 2
#define STG_SOFF() const unsigned soff0 = (unsigned)(sr * 1024 + sc * 2), soff1 = soff0 + 32 * 1024
  bf16x8 kq0, kq1, vq0, vq1;
#define LD16(base, off) (*reinterpret_cast<const bf16x8*>((base) + (off)))
#define LOADK(t) do { STG_GEOM(); STG_SOFF(); const int t_ = (t) < NT ? (t) : NT - 1; const char* g_ = Kh + (size_t)t_ * (KVBLK * 1024); kq0 = LD16(g_, soff0); kq1 = LD16(g_, soff1); } while (0)
#define LOADV(t) do { STG_GEOM(); STG_SOFF(); const int t_ = (t) < NT ? (t) : NT - 1; const char* g_ = Vh + (size_t)t_ * (KVBLK * 1024); vq0 = LD16(g_, soff0); vq1 = LD16(g_, soff1); } while (0)
#define WRITEK(slot) do { STG_GEOM(); STG_KOFF(); A2_LAS char* d_ = (A2_LAS char*)lds + OFF_K + (slot) * TILEB; *(A2_LAS bf16x8*)(d_ + kst0) = kq0; *(A2_LAS bf16x8*)(d_ + kst1) = kq1; } while (0)
#define WRITEV(slot) do { STG_GEOM(); STG_VOFF(); A2_LAS char* d_ = (A2_LAS char*)lds + OFF_V + (slot) * TILEB; *(A2_LAS bf16x8*)(d_ + vst0) = vq0; *(A2_LAS bf16x8*)(d_ + vst1) = vq1; } while (0)
#define BAR() __builtin_amdgcn_s_barrier()
#define WAITV(n) asm volatile("s_waitcnt vmcnt(" #n ")" ::: "memory")
#define WAITL() asm volatile("s_waitcnt lgkmcnt(0)" ::: "memory")
  bf16x8 qr[4];
  {
#pragma unroll
    for (int d0 = 0; d0 < 4; ++d0) qr[d0] = *reinterpret_cast<const bf16x8*>(QU + blk512(tok0 + q0 + rb * 32 + r32, h * 128 + comp * 64 + hi * 8 + d0 * 16)); }
  { const int i = tid; int rel = i - 256; rel = rel < -128 ? -128 : (rel > 127 ? 127 : rel); tab[i] = tabg[h * 256 + rel + 128]; }
#if ATT_REGSTAGE
  { LOADK(0); LOADV(0); const bf16x8 a0 = kq0, a1 = kq1; LOADK(1); const bf16x8 b0 = kq0, b1 = kq1; LOADK(2); STG_GEOM(); STG_KOFF();
    A2_LAS char* d_ = (A2_LAS char*)lds + OFF_K; *(A2_LAS bf16x8*)(d_ + kst0) = a0; *(A2_LAS bf16x8*)(d_ + kst1) = a1; *(A2_LAS bf16x8*)(d_ + TILEB + kst0) = b0; *(A2_LAS bf16x8*)(d_ + TILEB + kst1) = b1;
    WRITEK(2); WRITEV(0); }
#else
  DMA_K(0, 0); DMA_K(1, 1); DMA_V(0, 0); DMA_K(2, 2);
#endif
  const int qw0 = q0 + rb * 32, qpos = qw0 + r32;
  float mhat = 0.f, l_reg = 0.f; f32x16 o[4];
#pragma unroll
  for (int d = 0; d < 4; ++d) o[d] = f32x16{};
  f32x16 p0, p1, negm; bf16x8 pa0, pa1, pa2, pa3; bf16x8 kf[8]; VFrag vfa, vfb;
#define SBAR() __builtin_amdgcn_sched_barrier(0)
  const int vbase = v_rd_base(lane);
  if (!ATT_REGSTAGE) WAITV(4);
  WAITL(); BAR();
  const float tabL = tab[128], tabR = tab[383];
  if (!ATT_LOCKSTEP && !ATT_ONEBAR && comp == 1) BAR();
#define CLS(j) ((64 * (j) + 63 - qw0 <= -91) ? 0 : ((64 * (j) - qw0 - 31 >= 91) ? 1 : 2))
#define CCONST(c) ((c) == 0 ? tabL : ((c) == 1 ? tabR : 0.f))
#define SETNEGM(c) do { const float v_ = CCONST(c) - mhat; _Pragma("unroll") for (int r = 0; r < 16; ++r) negm[r] = v_; } while (0)
#define RESC() do { _Pragma("unroll") for (int d = 0; d < 4; ++d) _Pragma("unroll") for (int r = 0; r < 16; ++r) o[d][r] *= fsc_; } while (0)
#define VSEG(j, FIRST) do { const int c_ = cls; bool rs_; float fsc_ = 1.f; \
    if (c_ == 2) rs_ = vseg<true>(p0, p1, mhat, l_reg, FIRST, tab + (64 * (j) - qpos + 256 + 4 * hi), fsc_, r32, hi, pa0, pa1, pa2, pa3); \
    else rs_ = vseg<false>(p0, p1, mhat, l_reg, FIRST, tab, fsc_, r32, hi, pa0, pa1, pa2, pa3); \
    if (rs_) RESC(); \
    const int cn_ = CLS((j) + 1); if (__builtin_expect(rs_ || (FIRST) || cn_ != c_, 0)) { SETNEGM(cn_); asm volatile("" : "+v"(negm)); } cls = cn_; } while (0)
#define PKONLY() do { u32x4 w0 = {cvtpk(p0[0], p0[1]), cvtpk(p0[2], p0[3]), cvtpk(p0[4], p0[5]), cvtpk(p0[6], p0[7])}, w1 = {cvtpk(p0[8], p0[9]), cvtpk(p0[10], p0[11]), cvtpk(p0[12], p0[13]), cvtpk(p0[14], p0[15])}; \
    u32x4 w2 = {cvtpk(p1[0], p1[1]), cvtpk(p1[2], p1[3]), cvtpk(p1[4], p1[5]), cvtpk(p1[6], p1[7])}, w3 = {cvtpk(p1[8], p1[9]), cvtpk(p1[10], p1[11]), cvtpk(p1[12], p1[13]), cvtpk(p1[14], p1[15])}; \
    pa0 = *reinterpret_cast<bf16x8*>(&w0); pa1 = *reinterpret_cast<bf16x8*>(&w1); pa2 = *reinterpret_cast<bf16x8*>(&w2); pa3 = *reinterpret_cast<bf16x8*>(&w3); } while (0)
  int cls = CLS(0); SETNEGM(cls);
  kload(kf, Kr, r32, hi, comp);
  A3_PRIO_M(1);
  qkt_a(p0, p1, kf, qr, negm); qkt_b(p0, p1, kf, qr);
  A3_PRIO_M(0);
  if (ATT_REGSTAGE) { SBAR(); LOADK(3); LOADV(1); } else if (!DMA_IN_VSEG) { DMA_K(3, 3); DMA_V(1, 1); }
  if (!ATT_LOCKSTEP && (!ATT_ONEBAR || comp == 1)) { if (comp == 1 && !ATT_REGSTAGE) { if (DMA_IN_VSEG) WAITV(0); else WAITV(4); } WAITL(); BAR(); }
  if (DMA_IN_VSEG && !ATT_REGSTAGE) { DMA_K(3, 3); DMA_V(1, 1); }
  A3_PRIO_V(1); kload(kf, Kr + TILEB, r32, hi, comp); SBAR();
  VSEG(0, true); A3_PRIO_V(0);
  if (QK_IN_VSEG) { qkt_a(p0, p1, kf, qr, negm); qkt_b(p0, p1, kf, qr); }
  if (ATT_REGSTAGE) { WRITEK(3); WRITEV(1); WAITL(); } else if (ATT_LOCKSTEP || comp == 0) WAITV(4);
  if (!ATT_ONEBAR || ATT_LOCKSTEP || comp == 0) BAR();
  int sk = 2, sv = 0;
  for (int j = 1; j < NT; ++j) {
    asm volatile("" : "+v"(koff[0]), "+v"(koff[1]), "+v"(voff[0]), "+v"(voff[1]));
    const A2_LAS char* vp = Vr + sv * TILEB + vbase;
    A3_PRIO_M(1);
    if (VAR == 8) {
#define FILL() do { fx0 = __builtin_amdgcn_exp2f(fx0); fy0 += fx1; fy1 += fx0; fy2 += fy0; asm volatile("" : "+v"(fx0), "+v"(fy0), "+v"(fy1), "+v"(fy2)); } while (0)
#define MF(dst, a, b, c) do { dst = __builtin_amdgcn_mfma_f32_32x32x16_bf16(a, b, c, 0, 0, 0); FILL(); } while (0)
      float fx0 = (float)j, fx1 = 1.f, fy0 = 0.f, fy1 = 0.f, fy2 = 0.f;
      MF(p0, kf[0], qr[0], negm); MF(p1, kf[1], qr[0], negm); MF(p0, kf[2], qr[1], p0); MF(p1, kf[3], qr[1], p1); MF(p0, kf[4], qr[2], p0); MF(p1, kf[5], qr[2], p1); MF(p0, kf[6], qr[3], p0); MF(p1, kf[7], qr[3], p1);
      const bf16x8 vb_ = kf[0];
      _Pragma("unroll") for (int d = 0; d < 4; ++d) { MF(o[d], pa0, vb_, o[d]); MF(o[d], pa1, vb_, o[d]); MF(o[d], pa2, vb_, o[d]); MF(o[d], pa3, vb_, o[d]); }
      l_reg += fy1 + fy2;
#undef MF
#undef FILL
    } else if (VAR == 4 || VAR == 6 || VAR == 7) {
      asm volatile("" : "+v"(vfa.lo[0]), "+v"(vfa.hh[0]), "+v"(vfb.lo[0]), "+v"(vfb.hh[0]));
      qkt_a(p0, p1, kf, qr, negm); qkt_b(p0, p1, kf, qr);
      pvmma(o[0], vfa, pa0, pa1, pa2, pa3); pvmma(o[1], vfb, pa0, pa1, pa2, pa3); pvmma(o[2], vfa, pa0, pa1, pa2, pa3); pvmma(o[3], vfb, pa0, pa1, pa2, pa3);
    } else if (VAR == 5) {
      vload<0>(vfa, vp); vload<1>(vfb, vp); asm volatile("" : "+v"(vfa.lo[0]), "+v"(vfa.lo[1]), "+v"(vfa.lo[2]), "+v"(vfa.lo[3]), "+v"(vfa.hh[0]), "+v"(vfa.hh[1]), "+v"(vfa.hh[2]), "+v"(vfa.hh[3]), "+v"(vfb.lo[0]), "+v"(vfb.lo[1]), "+v"(vfb.lo[2]), "+v"(vfb.lo[3]), "+v"(vfb.hh[0]), "+v"(vfb.hh[1]), "+v"(vfb.hh[2]), "+v"(vfb.hh[3]));
      vload<2>(vfa, vp); vload<3>(vfb, vp); asm volatile("" : "+v"(vfa.lo[0]), "+v"(vfa.lo[1]), "+v"(vfa.lo[2]), "+v"(vfa.lo[3]), "+v"(vfa.hh[0]), "+v"(vfa.hh[1]), "+v"(vfa.hh[2]), "+v"(vfa.hh[3]), "+v"(vfb.lo[0]), "+v"(vfb.lo[1]), "+v"(vfb.lo[2]), "+v"(vfb.lo[3]), "+v"(vfb.hh[0]), "+v"(vfb.hh[1]), "+v"(vfb.hh[2]), "+v"(vfb.hh[3]));
      asm volatile("" : "+v"(kf[0]), "+v"(kf[1]), "+v"(kf[2]), "+v"(kf[3]), "+v"(kf[4]), "+v"(kf[5]), "+v"(kf[6]), "+v"(kf[7]));
      p0 = negm; p1 = negm;
    } else {
    const unsigned va = (unsigned)(size_t)vp;
    if (!QK_IN_VSEG) { qkt_a(p0, p1, kf, qr, negm); SBAR(); }
    vload_a<0>(vfa, va); SBAR();
    if (!QK_IN_VSEG) qkt_b(p0, p1, kf, qr);
    vload_a<1>(vfb, va); SBAR();
    VWAIT(8, vfa); pvmma(o[0], vfa, pa0, pa1, pa2, pa3);
    vload_a<2>(vfa, va); SBAR();
    VWAIT(8, vfb); pvmma(o[1], vfb, pa0, pa1, pa2, pa3);
    vload_a<3>(vfb, va); SBAR();
    VWAIT(8, vfa); pvmma(o[2], vfa, pa0, pa1, pa2, pa3);
    VWAIT(0, vfb); pvmma(o[3], vfb, pa0, pa1, pa2, pa3);
    }
    A3_PRIO_M(0);
    { const int s3 = (sk + 2) & 3  , s1 = sv == 0 ? 2 : sv - 1  ; if (VAR != 3 && VAR != 7 && VAR != 8) { if (ATT_REGSTAGE) { SBAR(); LOADK(j + 3); LOADV(j + 1); } else if (!DMA_IN_VSEG) { DMA_K(j + 3, s3); DMA_V(j + 1, s1); } } }
    if (!ATT_LOCKSTEP && (!ATT_ONEBAR || comp == 1)) { if (comp == 1 && VAR != 3 && VAR != 7 && VAR != 8 && !ATT_REGSTAGE) { if (DMA_IN_VSEG) WAITV(0); else WAITV(4); } WAITL(); BAR(); }
    if (DMA_IN_VSEG && !ATT_REGSTAGE && VAR != 3 && VAR != 7 && VAR != 8) { const int s3 = (sk + 2) & 3, s1 = sv == 0 ? 2 : sv - 1; DMA_K(j + 3, s3); DMA_V(j + 1, s1); }
    A3_PRIO_V(1); if (VAR != 4 && VAR != 6 && VAR != 7 && VAR != 8) { kload(kf, Kr + sk * TILEB, r32, hi, comp); } SBAR();
    if (VAR != 1 && VAR != 6 && VAR != 7 && VAR != 8) { VSEG(j, false); } else { PKONLY(); } A3_PRIO_V(0);
    if (QK_IN_VSEG && VAR == 0) { qkt_a(p0, p1, kf, qr, negm); qkt_b(p0, p1, kf, qr); }
    if (ATT_REGSTAGE) { if (VAR != 3 && VAR != 7 && VAR != 8) { WRITEK((sk + 2) & 3); WRITEV(sv == 0 ? 2 : sv - 1); WAITL(); } }
    else if ((ATT_LOCKSTEP || comp == 0) && VAR != 3 && VAR != 7 && VAR != 8) WAITV(4);
    if (!ATT_ONEBAR || ATT_LOCKSTEP || comp == 0) BAR();
    sk = (sk + 1) & 3; sv = sv == 2 ? 0 : sv + 1;
  }
  { const A2_LAS char* vp = Vr + sv * TILEB + vbase;
    A3_PRIO_M(1);
    const unsigned va = (unsigned)(size_t)vp;
    vload_a<0>(vfa, va); vload_a<1>(vfb, va); SBAR(); VWAIT(8, vfa); pvmma(o[0], vfa, pa0, pa1, pa2, pa3); vload_a<2>(vfa, va); SBAR(); VWAIT(8, vfb); pvmma(o[1], vfb, pa0, pa1, pa2, pa3); vload_a<3>(vfb, va); SBAR();
    VWAIT(8, vfa); pvmma(o[2], vfa, pa0, pa1, pa2, pa3); VWAIT(0, vfb); pvmma(o[3], vfb, pa0, pa1, pa2, pa3);
    A3_PRIO_M(0); }
  WAITV(0); WAITL();
  if (!ATT_LOCKSTEP && !ATT_ONEBAR && comp == 0) BAR();
  { auto rr = __builtin_amdgcn_permlane32_swap(__float_as_uint(l_reg), __float_as_uint(l_reg), false, false); l_reg = __uint_as_float(rr[0]) + __uint_as_float(rr[1]); }
  const float rl = __builtin_amdgcn_rcpf(l_reg);
  u32x4 gq[4]; f32x4 sq[8];
  { const int row = tid >> 2, qt = tid & 3; const bf16_t* gp = GA + blk512(tok0 + q0 + row, h * 128 + qt * 32); const float* sg = subg + qt * 32;
#pragma unroll
    for (int i = 0; i < 4; ++i) { gq[i] = *(const u32x4*)(gp + 8 * i); sq[2 * i] = *(const f32x4*)(sg + 8 * i); sq[2 * i + 1] = *(const f32x4*)(sg + 8 * i + 4); } }
  WAITL(); BAR(); asm volatile("" ::: "memory");
  A2_LAS float* OC = (A2_LAS float*)lds; constexpr int OST = 129;
  if (comp == 0) {
#pragma unroll
    for (int r = 0; r < 16; ++r) {
#pragma unroll
      for (int d0 = 0; d0 < 4; ++d0) OC[(32 * d0 + crow(r, hi)) * OST + rb * 32 + r32] = o[d0][r] * rl; }
  }
  WAITL(); BAR(); asm volatile("" ::: "memory");
  if (comp == 1) { const float sl = lam * rl;
#pragma unroll
    for (int r = 0; r < 16; ++r) {
#pragma unroll
      for (int d0 = 0; d0 < 4; ++d0) OC[(32 * d0 + crow(r, hi)) * OST + rb * 32 + r32] -= o[d0][r] * sl; }
  }
  WAITL(); BAR(); asm volatile("" ::: "memory");
  { const int row = tid >> 2, qt = tid & 3; const A2_LAS float* rp = OC + (qt * 32) * OST + row;
    f32x4 v[8]; float ss = 0.f;
#pragma unroll
    for (int i = 0; i < 8; ++i) { v[i] = (f32x4){rp[(4 * i) * OST], rp[(4 * i + 1) * OST], rp[(4 * i + 2) * OST], rp[(4 * i + 3) * OST]}; ss += (v[i][0] * v[i][0] + v[i][1] * v[i][1]) + (v[i][2] * v[i][2] + v[i][3] * v[i][3]); }
    ss += bperm_f(lane ^ 1, ss); ss += bperm_f(lane ^ 2, ss);
    const float rstd = __builtin_amdgcn_rsqf(ss * (1.f / 128.f) + 1e-5f) * 0.8f;
    const size_t t = (size_t)(tok0 + q0 + row); bf16_t* op = OQ + t * 1024 + h * 128 + qt * 32;
#pragma unroll
    for (int i = 0; i < 4; ++i) { const u32x4 g = gq[i]; const f32x4 s0 = sq[2 * i], s1 = sq[2 * i + 1];
      const f32x4 a = v[2 * i] * rstd * s0, b = v[2 * i + 1] * rstd * s1; u32x4 w;
      w.x = cvtpk(a[0] * silu(bflo(g.x)), a[1] * silu(bfhi(g.x))); w.y = cvtpk(a[2] * silu(bflo(g.y)), a[3] * silu(bfhi(g.y)));
      w.z = cvtpk(b[0] * silu(bflo(g.z)), b[1] * silu(bfhi(g.z))); w.w = cvtpk(b[2] * silu(bflo(g.w)), b[3] * silu(bfhi(g.w)));
      *(u32x4*)(op + 8 * i) = w; }
  }
  asm volatile("s_waitcnt vmcnt(0)" ::: "memory");
  __syncthreads();
#undef DMA_K
#undef LD16
#undef STG_GEOM
#undef STG_KOFF
#undef STG_VOFF
#undef STG_SOFF
#undef LOADK
#undef LOADV
#undef WRITEK
#undef WRITEV
#undef DMA_V
#undef BAR
#undef WAITV
#undef WAITL
#undef CLS
#undef CCONST
#undef SETNEGM
#undef RESC
#undef VSEG
#undef PKONLY
#undef SBAR
#undef VWAIT
}
#undef KSWZ
}
struct Frame {
    LAS unsigned char* lds;
    volatile LAS unsigned* MISC;
    unsigned* ctl;
    int wave;
    int role;
    int vcu, G;
};
__device__ __forceinline__ float wave_sum(float v, int lane) {
#pragma unroll
    for (int o = 1; o < 64; o <<= 1) v += bperm_f(lane ^ o, v);
    return v;
}
__device__ __forceinline__ void p0_transpose_item(const float* W, int K, int N, bf16* WT, const float* kscale, LAS float* scr, int item, int lane) {
    const int nblk = N / 32, kb = item / nblk, nb = item % nblk, k0 = 64 * kb, n0 = 32 * nb;
#pragma unroll 8
    for (int i = 0; i < 32; ++i) { const int kk = 2 * i + (lane >> 5); float w = W[(size_t)(k0 + kk) * N + n0 + (lane & 31)]; if (kscale) w *= kscale[k0 + kk]; scr[kk * 33 + (lane & 31)] = w; }
    LDS_WAIT(); asm volatile("" ::: "memory");
    const int c = lane & 7;
#pragma unroll
    for (int j = 0; j < 4; ++j) { const int n = (lane >> 3) + 8 * j; const LAS float* s = scr + (8 * c) * 33 + n;
        v4u o; o.x = pk2(s[0 * 33], s[1 * 33]); o.y = pk2(s[2 * 33], s[3 * 33]); o.z = pk2(s[4 * 33], s[5 * 33]); o.w = pk2(s[6 * 33], s[7 * 33]);
        *(GAS v4u*)(WT + (size_t)(n0 + n) * K + k0 + 8 * c) = o; }
    LDS_WAIT(); asm volatile("" ::: "memory");
}
__device__ __forceinline__ void rms_row2_to_bf16(const float* xrow0, const float* xrow1, const float* g, bf16* orow0, bf16* orow1, int lane) {
    const GAS f32x4* xr0 = (const GAS f32x4*)xrow0 + lane; const GAS f32x4* xr1 = (const GAS f32x4*)xrow1 + lane; const GAS f32x4* gr = (const GAS f32x4*)g + lane;
    f32x4 v[4], u[4]; float s = 0.f, t = 0.f;
#pragma unroll
    for (int j = 0; j < 4; ++j) { v[j] = xr0[64 * j]; u[j] = xr1[64 * j]; }
#pragma unroll
    for (int j = 0; j < 4; ++j) { s += (v[j].x * v[j].x + v[j].y * v[j].y) + (v[j].z * v[j].z + v[j].w * v[j].w); t += (u[j].x * u[j].x + u[j].y * u[j].y) + (u[j].z * u[j].z + u[j].w * u[j].w); }
#pragma unroll
    for (int o = 1; o < 64; o <<= 1) { s += bperm_f(lane ^ o, s); t += bperm_f(lane ^ o, t); }
    const float r0 = __builtin_amdgcn_rsqf(s * (1.f / 1024.f) + 1e-6f), r1 = __builtin_amdgcn_rsqf(t * (1.f / 1024.f) + 1e-6f);
    GAS unsigned long long* o0 = (GAS unsigned long long*)orow0 + lane; GAS unsigned long long* o1 = (GAS unsigned long long*)orow1 + lane;
#pragma unroll
    for (int j = 0; j < 4; ++j) { const f32x4 gg = gr[64 * j];
        o0[64 * j] = (unsigned long long)pk2(v[j].x * r0 * gg.x, v[j].y * r0 * gg.y) | ((unsigned long long)pk2(v[j].z * r0 * gg.z, v[j].w * r0 * gg.w) << 32);
        o1[64 * j] = (unsigned long long)pk2(u[j].x * r1 * gg.x, u[j].y * r1 * gg.y) | ((unsigned long long)pk2(u[j].z * r1 * gg.z, u[j].w * r1 * gg.w) << 32); }
}
__device__ __forceinline__ int t5_bucket(int rel) {
    const int n = rel < 0 ? -rel : rel; int b;
    if (n < 8) b = n; else b = 8 + (n >= 12) + (n >= 16) + (n >= 23) + (n >= 32) + (n >= 46) + (n >= 64) + (n >= 91);
    return b + (rel > 0 ? 16 : 0);
}
struct Args { const float* in[15]; float* out; unsigned char* ws; };
__device__ __forceinline__ void rms_row4_to_bf16(const float* xrow0, const float* g, bf16* orow0, int lane) {
    const GAS f32x4* gr = (const GAS f32x4*)g + lane;
    f32x4 v[4][4]; float s[4];
#pragma unroll
    for (int r = 0; r < 4; ++r) { const GAS f32x4* xr = (const GAS f32x4*)(xrow0 + (size_t)r * 1024) + lane;
#pragma unroll
        for (int j = 0; j < 4; ++j) v[r][j] = xr[64 * j]; }
#pragma unroll
    for (int r = 0; r < 4; ++r) { s[r] = 0.f;
#pragma unroll
        for (int j = 0; j < 4; ++j) s[r] += (v[r][j].x * v[r][j].x + v[r][j].y * v[r][j].y) + (v[r][j].z * v[r][j].z + v[r][j].w * v[r][j].w); }
#pragma unroll
    for (int o = 1; o < 64; o <<= 1) {
#pragma unroll
        for (int r = 0; r < 4; ++r) s[r] += bperm_f(lane ^ o, s[r]); }
    f32x4 gg[4];
#pragma unroll
    for (int j = 0; j < 4; ++j) gg[j] = gr[64 * j];
#pragma unroll
    for (int r = 0; r < 4; ++r) { const float rs = __builtin_amdgcn_rsqf(s[r] * (1.f / 1024.f) + 1e-6f); GAS unsigned long long* o8 = (GAS unsigned long long*)(orow0 + (size_t)r * 1024) + lane;
#pragma unroll
        for (int j = 0; j < 4; ++j) o8[64 * j] = (unsigned long long)pk2(v[r][j].x * rs * gg[j].x, v[r][j].y * rs * gg[j].y) | ((unsigned long long)pk2(v[r][j].z * rs * gg[j].z, v[r][j].w * rs * gg[j].w) << 32); }
}
__device__ __forceinline__ void p0_prologue(Frame& F, const Args& a, const int parts = 3) {
    const int tid_ = opq_tid(F.wave), lane_ = tid_ & 63;
    const float* xp = a.in[0]; const float* xs = a.in[1]; const float* pp = a.in[2]; const float* ps = a.in[3]; const float* g_mix = a.in[4]; const float* w_in = a.in[5];
    const float* lamp = a.in[6]; const float* relb = a.in[8]; const float* wf = a.in[9]; const float* w_out = a.in[10]; const float* g_ple = a.in[11];
    const float* w_gate = a.in[12]; const float* w_proj = a.in[13];
    unsigned char* ws = a.ws;
    if (parts & 2) {
        LAS float* scr = (LAS float*)(F.lds + F.wave * 16384);
        const int gw = F.vcu * NWAVES + F.wave, NGW = F.G * NWAVES;
        constexpr int I_IN = (DM / 64) * (NIN / 32), I_SQ = (DM / 64) * (DM / 32), I_P = (PLED / 64) * (DM / 32);
        for (int it = gw; it < I_IN + 2 * I_SQ + I_P; it += NGW) {
            int r = it;
            if (r < I_IN) { p0_transpose_item(w_in, DM, NIN, (bf16*)(ws + WS_WIN), nullptr, scr, r, lane_); continue; } r -= I_IN;
            if (r < I_SQ) { p0_transpose_item(w_out, DM, DM, (bf16*)(ws + WS_WOUT), nullptr, scr, r, lane_); continue; } r -= I_SQ;
            if (r < I_SQ) { p0_transpose_item(w_gate, DM, DM, (bf16*)(ws + WS_WG), g_ple, scr, r, lane_); continue; } r -= I_SQ;
            p0_transpose_item(w_proj, PLED, DM, (bf16*)(ws + WS_WP), nullptr, scr, r, lane_);
        }
        const int gt = F.vcu * (NWAVES * 64) + tid_, NGT = F.G * (NWAVES * 64);
        { constexpr int E_H1A = 64 * 64, E_H1B = 128 * 128, E_M2A = 33 * 16384, E_M2B = 65 * 16384;
          for (int i = gt; i < E_H1A + E_H1B + E_M2A + E_M2B; i += NGT) {
              int e = i; float val; bf16* dst;
              if (e < E_H1A + E_H1B) {
                  int N1, r, s1; if (e < E_H1A) { N1 = 64; r = e >> 6; s1 = e & 63; dst = (bf16*)(ws + WS_H1A) + e; } else { e -= E_H1A; N1 = 128; r = e >> 7; s1 = e & 127; dst = (bf16*)(ws + WS_H1B) + e; }
                  if (r == 0) val = 1.f; else if (r == 1) val = (s1 & 1) ? -1.f : 1.f;
                  else { const int k = r >> 1, j = (k * s1) & (N1 - 1); const float x = 2.f * (float)j / (float)N1; val = (r & 1) ? -sinpif(x) : cospif(x); }
              } else {
                  e -= E_H1A + E_H1B; int S, N1; float norm;
                  if (e < E_M2A) { S = 4096; N1 = 64; norm = 0.0013810679320049757f; dst = (bf16*)(ws + WS_M2A) + e; } else { e -= E_M2A; S = 8192; N1 = 128; norm = 0.0009765625f; dst = (bf16*)(ws + WS_M2B) + e; }
                  const int kt = e >> 14, m = (e >> 7) & 127, kp = e & 127, ro = m >> 6, k2 = m & 63, ri = kp >> 6, s2 = kp & 63;
                  const int sp = kt + N1 * k2, j = (s2 * sp) & (S - 1); const float x = 2.f * (float)j / (float)S; const float c = cospif(x), s = sinpif(x);
                  if (kt == 0) val = (ri == 0) ? (ro == 0 ? c : -s) : 0.f;
                  else if (kt == N1 / 2) val = (ri == 1) ? (ro == 0 ? c : -s) : 0.f;
                  else val = (ro == ri) ? c : (ro == 0 ? s : -s);
                  val *= norm;
              }
              *dst = (bf16)f2bf(val);
          } }
        { bf16* Gt = (bf16*)(ws + WS_GT); LAS float* ct = scr + 2304; LAS float* st = ct + 128;
          for (int i = lane_; i < 128; i += 64) { const float x = (float)i * (1.f / 64.f); ct[i] = cospif(x); st[i] = sinpif(x); }
          LDS_WAIT(); asm volatile("" ::: "memory");
          for (int i = gt; i < 512 * 1024 / 8; i += NGT) { const int n = i >> 7, k8 = (i & 127) * 8; if ((k8 >> 8) != (n >> 7)) *(v4u*)(Gt + (size_t)n * 1024 + k8) = (v4u){0u, 0u, 0u, 0u}; }
          for (int i = gt; i < 4 * 128 * 128; i += NGT) { const int g = i >> 14, c = (i >> 7) & 127, d = i & 127; float are = 0.f, aim = 0.f; const float* wp = wf + (size_t)g * 16384 + d;
#pragma unroll 8
              for (int cp = 0; cp < 128; ++cp) { const int j = (c * cp) & 127; const float w = wp[cp * 128]; are += ct[j] * w; aim += st[j] * w; }
              bf16* o = Gt + (size_t)(g * 128 + d) * 1024 + g * 256 + c; o[0] = (bf16)f2bf(are); o[128] = (bf16)f2bf(aim); } }
        if (F.vcu == 0) {
            float* tab = (float*)(ws + WS_TAB);
            for (int i = tid_; i < 1024; i += NWAVES * 64) { const int h = i >> 8, rel = (i & 255) - 128; tab[i] = relb[t5_bucket(rel) * 4 + h] * LOG2E; }
            if (tid_ == 0) { float s01 = 0.f, s23 = 0.f; for (int d = 0; d < 64; ++d) { s01 += lamp[d] * lamp[64 + d]; s23 += lamp[128 + d] * lamp[192 + d]; }
                tab[1024] = __expf(s01) - __expf(s23) + 0.2f; }
        }
    }
    if (parts & 1) {
        const int gw = F.vcu * NWAVES + F.wave, NGW = F.G * NWAVES;
        for (int m = 4 * gw; m < NTOK; m += 4 * NGW) { const float* xrow0 = m < TPR ? xp + (size_t)m * DM : xs + (size_t)(m - TPR) * DM;
            rms_row4_to_bf16(xrow0, g_mix, (bf16*)(ws + WS_XN) + (size_t)m * DM, lane_); }
        const int gt = F.vcu * (NWAVES * 64) + tid_, NGT = F.G * (NWAVES * 64); bf16* PB = (bf16*)a.out;
        for (int i0 = gt; i0 + 3 * NGT < NTOK * (PLED / 8); i0 += 4 * NGT) { f32x4 v0[4], v1[4];
#pragma unroll
            for (int k = 0; k < 4; ++k) { const int i = i0 + k * NGT, row = i >> 5, c8 = (i & 31) * 8; const float* src = (row < TPR ? pp + (size_t)row * PLED : ps + (size_t)(row - TPR) * PLED) + c8;
                v0[k] = *(const f32x4*)src; v1[k] = *(const f32x4*)(src + 4); }
#pragma unroll
            for (int k = 0; k < 4; ++k) { const int i = i0 + k * NGT, row = i >> 5, c8 = (i & 31) * 8; v4u o; o.x = pk2(v0[k].x, v0[k].y); o.y = pk2(v0[k].z, v0[k].w); o.z = pk2(v1[k].x, v1[k].y); o.w = pk2(v1[k].z, v1[k].w);
                *(v4u*)(PB + (size_t)row * PLED + c8) = o; } }
    }
}
typedef short s16x4_t __attribute__((ext_vector_type(4)));
__device__ __forceinline__ s16x4_t trd(const LAS bf16* p) { return __builtin_bit_cast(s16x4_t, __builtin_amdgcn_ds_read_tr16_b64_v4i16((LAS s16x4_t*)p)); }
template <int MK> struct NNRegs { v4u ra[MK * MK / 8 / (NWAVES * 64)], rb[MK * 16 / (NWAVES * 64)]; };
template <int MK, bool BLK = false>
__device__ __forceinline__ void nn_load(NNRegs<MK>& R, const bf16* A, const bf16* B, size_t ldb, int tid) {
    constexpr int NA = MK * MK / 8 / (NWAVES * 64), NB = MK * 16 / (NWAVES * 64);
    static_assert(NA * NWAVES * 64 * 8 == MK * MK && NB * NWAVES * 64 == MK * 16, "staging trip counts");
#pragma unroll
    for (int i = 0; i < NA; ++i) { const int idx = tid + i * (NWAVES * 64), r = idx / (MK / 8), c = idx % (MK / 8); R.ra[i] = *(const v4u*)(A + r * MK + c * 8); }
#pragma unroll
    for (int i = 0; i < NB; ++i) { const int idx = tid + i * (NWAVES * 64), r = idx >> 4, c = idx & 15; R.rb[i] = *(const v4u*)(B + (size_t)r * ldb + (BLK ? (c >> 2) * 512 + (c & 3) * 8 : c * 8)); }
}
template <int MK>
__device__ __forceinline__ void nn_stage(LAS unsigned char* lds, const NNRegs<MK>& R, int tid) {
    constexpr int AST = MK + 8, BST = 136, NA = MK * MK / 8 / (NWAVES * 64), NB = MK * 16 / (NWAVES * 64);
    LAS bf16* As = (LAS bf16*)lds; LAS bf16* Bs = (LAS bf16*)(lds + 40960);
    LDS_WAIT(); __builtin_amdgcn_s_barrier(); asm volatile("" ::: "memory");
#pragma unroll
    for (int i = 0; i < NA; ++i) { const int idx = tid + i * (NWAVES * 64), r = idx / (MK / 8), c = idx % (MK / 8); *(LAS v4u*)(As + r * AST + c * 8) = R.ra[i]; }
#pragma unroll
    for (int i = 0; i < NB; ++i) { const int idx = tid + i * (NWAVES * 64), r = idx >> 4, c = idx & 15; *(LAS v4u*)(Bs + r * BST + c * 8) = R.rb[i]; }
    LDS_WAIT(); __builtin_amdgcn_s_barrier(); asm volatile("" ::: "memory");
}
template <int MK>
__device__ __forceinline__ void nn_mfma(LAS unsigned char* lds, int tid, f32x4 (&acc)[MK / 16]) {
    constexpr int AST = MK + 8, BST = 136;
    const LAS bf16* As = (const LAS bf16*)lds; const LAS bf16* Bs = (const LAS bf16*)(lds + 40960);
    const int w = tid >> 6, l = tid & 63, lr = l & 15, lq = l >> 4;
#pragma unroll
    for (int mt = 0; mt < MK / 16; ++mt) acc[mt] = (f32x4){0.f, 0.f, 0.f, 0.f};
#pragma unroll
    for (int ks = 0; ks < MK / 32; ++ks) {
        const LAS bf16* bp = Bs + (ks * 32 + 8 * lq + (lr >> 2)) * BST + 16 * w + 4 * (lr & 3);
        const s16x4_t blo = trd(bp), bhi = trd(bp + 4 * BST);
        const bf16x8 bfr = {blo[0], blo[1], blo[2], blo[3], bhi[0], bhi[1], bhi[2], bhi[3]};
#pragma unroll
        for (int mt = 0; mt < MK / 16; ++mt) { const bf16x8 afr = *(const LAS bf16x8*)(As + (mt * 16 + lr) * AST + ks * 32 + 8 * lq);
            acc[mt] = __builtin_amdgcn_mfma_f32_16x16x32_bf16(bfr, afr, acc[mt], 0, 0, 0); }
    }
}
template <int MK>
__device__ __forceinline__ void nn_tile(LAS unsigned char* lds, const bf16* A, const bf16* B, size_t ldb, int tid, f32x4 (&acc)[MK / 16]) {
    NNRegs<MK> R; nn_load<MK>(R, A, B, ldb, tid); nn_stage<MK>(lds, R, tid); nn_mfma<MK>(lds, tid, acc);
}
template <int MK>
__device__ __forceinline__ void fft_stage1_run(LAS unsigned char* lds, const bf16* H1, const bf16* QU, bf16* Y, int tokbase, int seqlen, int first, int nitems, int G, int tid) {
    if (first >= nitems) return;
    NNRegs<MK> R;
#define S1_SRC(it) (QU + blk512(tokbase + ((it) >> 8) * seqlen + (((it) & 255) >> 2), (((it) & 255) & 3) * 128))
    nn_load<MK, true>(R, H1, S1_SRC(first), (size_t)32768, tid);
    for (int it = first; it < nitems; it += G) {
        nn_stage<MK>(lds, R, tid);
        if (it + G < nitems) nn_load<MK, true>(R, H1, S1_SRC(it + G), (size_t)32768, tid);
        f32x4 acc[MK / 16]; nn_mfma<MK>(lds, tid, acc);
        const int tok0 = tokbase + (it >> 8) * seqlen, nt = it & 255, s2 = nt >> 2, ch0 = (nt & 3) * 128;
        const int w = tid >> 6, l = tid & 63, lr = l & 15, lq = l >> 4;
        bf16* yb = Y + (size_t)tok0 * 512 + (size_t)s2 * 512 + ch0 + 16 * w + 4 * lq;
#pragma unroll
        for (int mt = 0; mt < MK / 16; ++mt) { const int r = mt * 16 + lr; v2u o; o.x = pk2(acc[mt][0], acc[mt][1]); o.y = pk2(acc[mt][2], acc[mt][3]); *(v2u*)(yb + (size_t)r * (64 * 512)) = o; }
    }
#undef S1_SRC
}
template <int MK>
__device__ __forceinline__ void fft_stage1_item(LAS unsigned char* lds, const bf16* H1, const bf16* QU, bf16* Y, int tok0, int nt, int tid) {
    const int s2 = nt >> 2, ch0 = (nt & 3) * 128;
    f32x4 acc[MK / 16];
    nn_tile<MK>(lds, H1, QU + (size_t)(tok0 + s2) * 1024 + 512 + ch0, (size_t)64 * 1024, tid, acc);
    const int w = tid >> 6, l = tid & 63, lr = l & 15, lq = l >> 4;
    bf16* yb = Y + (size_t)tok0 * 512 + (size_t)s2 * 512 + ch0 + 16 * w + 4 * lq;
#pragma unroll
    for (int mt = 0; mt < MK / 16; ++mt) { const int r = mt * 16 + lr; v2u o; o.x = pk2(acc[mt][0], acc[mt][1]); o.y = pk2(acc[mt][2], acc[mt][3]); *(v2u*)(yb + (size_t)r * (64 * 512)) = o; }
}
__device__ __forceinline__ void fft_stage2_item(LAS unsigned char* lds, const bf16* M2, const bf16* Y, bf16* XP, int tok0, int S, int N1, int kt, int g, int tid) {
    const int p = (kt == 0 || kt == N1 / 2) ? 0 : kt;
    f32x4 acc[8];
    nn_tile<128>(lds, M2 + (size_t)kt * 16384, Y + (size_t)tok0 * 512 + (size_t)(2 * p * 64) * 512 + g * 128, (size_t)512, tid, acc);
    const int w = tid >> 6, l = tid & 63, lr = l & 15, lq = l >> 4; const int c = 16 * w + 4 * lq; const bool mir = (kt != 0 && kt != N1 / 2);
#pragma unroll
    for (int mt = 0; mt < 8; ++mt) { const int m = mt * 16 + lr, ro = m >> 6, k2 = m & 63, sp = kt + N1 * k2;
        v2u o; o.x = pk2(acc[mt][0], acc[mt][1]); o.y = pk2(acc[mt][2], acc[mt][3]);
        *(v2u*)(XP + (size_t)(tok0 + sp) * 1024 + g * 256 + ro * 128 + c) = o;
        if (mir) { if (ro) { o.x ^= 0x80008000u; o.y ^= 0x80008000u; } *(v2u*)(XP + (size_t)(tok0 + S - sp) * 1024 + g * 256 + ro * 128 + c) = o; } }
}

__device__ __forceinline__ void fft_stage2c_item(LAS unsigned char* lds, const bf16* M2, const bf16* Y, const bf16* Gt, const bf16* GF, bf16* QU, int tok0, int S, int N1, int kt, int g, int tid) {
    const int p = (kt == 0 || kt == N1 / 2) ? 0 : kt;
    const int w = tid >> 6, l = tid & 63, lr = l & 15, lq = l >> 4; const bool mir = (kt != 0 && kt != N1 / 2);
    bf16x8 gre[4], gim[4];
    { const bf16* gp = Gt + (size_t)(g * 128 + 16 * w + lr) * 1024 + g * 256 + 8 * lq;
#pragma unroll
      for (int ks = 0; ks < 4; ++ks) { gre[ks] = *(const bf16x8*)(gp + ks * 32); gim[ks] = *(const bf16x8*)(gp + 128 + ks * 32); } }
    const int d0 = g * 128 + 16 * w + 4 * lq;
    v2u gwa[4], gwb[4];
#pragma unroll
    for (int tb = 0; tb < 4; ++tb) { const int sp = kt + N1 * (16 * tb + lr); gwa[tb] = *(const v2u*)(GF + (size_t)(tok0 + sp) * 512 + d0);
        if (mir) gwb[tb] = *(const v2u*)(GF + (size_t)(tok0 + S - sp) * 512 + d0); else gwb[tb] = (v2u){0u, 0u}; }
    f32x4 acc[8];
    nn_tile<128>(lds, M2 + (size_t)kt * 16384, Y + (size_t)tok0 * 512 + (size_t)(2 * p * 64) * 512 + g * 128, (size_t)512, tid, acc);
    constexpr int XST = 136; LAS bf16* XL = (LAS bf16*)(lds + 81920);
#pragma unroll
    for (int mt = 0; mt < 8; ++mt) { v2u o; o.x = pk2(acc[mt][0], acc[mt][1]); o.y = pk2(acc[mt][2], acc[mt][3]); *(LAS v2u*)(XL + (mt * 16 + lr) * XST + 16 * w + 4 * lq) = o; }
    __syncthreads();
    f32x4 P[4], Q[4];
#pragma unroll
    for (int tb = 0; tb < 4; ++tb) { P[tb] = (f32x4){0.f, 0.f, 0.f, 0.f}; Q[tb] = (f32x4){0.f, 0.f, 0.f, 0.f};
#pragma unroll
        for (int ks = 0; ks < 4; ++ks) { const bf16x8 xre = *(const LAS bf16x8*)(XL + (16 * tb + lr) * XST + ks * 32 + 8 * lq), xim = *(const LAS bf16x8*)(XL + (64 + 16 * tb + lr) * XST + ks * 32 + 8 * lq);
            P[tb] = __builtin_amdgcn_mfma_f32_16x16x32_bf16(gre[ks], xre, P[tb], 0, 0, 0); Q[tb] = __builtin_amdgcn_mfma_f32_16x16x32_bf16(gim[ks], xim, Q[tb], 0, 0, 0); } }
#pragma unroll
    for (int tb = 0; tb < 4; ++tb) { const int sp = kt + N1 * (16 * tb + lr);
        { const size_t t = (size_t)(tok0 + sp); const v2u gw = gwa[tb]; const f32x4 f = P[tb] + Q[tb]; v2u o;
          o.x = pk2(f[0] * pg8::silu(pg8::bflo(gw.x)), f[1] * pg8::silu(pg8::bfhi(gw.x))); o.y = pk2(f[2] * pg8::silu(pg8::bflo(gw.y)), f[3] * pg8::silu(pg8::bfhi(gw.y)));
          *(v2u*)(QU + t * 1024 + 512 + d0) = o; }
        if (mir) { const size_t t = (size_t)(tok0 + S - sp); const v2u gw = gwb[tb]; const f32x4 f = P[tb] - Q[tb]; v2u o;
          o.x = pk2(f[0] * pg8::silu(pg8::bflo(gw.x)), f[1] * pg8::silu(pg8::bfhi(gw.x))); o.y = pk2(f[2] * pg8::silu(pg8::bflo(gw.y)), f[3] * pg8::silu(pg8::bfhi(gw.y)));
          *(v2u*)(QU + t * 1024 + 512 + d0) = o; } }
}
struct S2Regs { NNRegs<128> T; bf16x8 gre[4], gim[4]; v2u gwa[4], gwb[4]; };
__device__ __forceinline__ void s2c_load(S2Regs& R, const bf16* M2, const bf16* Y, const bf16* Gt, const bf16* GF, int tok0, int S, int N1, int kt, int g, int tid) {
    const int p = (kt == 0 || kt == N1 / 2) ? 0 : kt;
    const int w = tid >> 6, l = tid & 63, lr = l & 15, lq = l >> 4; const bool mir = (kt != 0 && kt != N1 / 2);
    { const bf16* gp = Gt + (size_t)(g * 128 + 16 * w + lr) * 1024 + g * 256 + 8 * lq;
#pragma unroll
      for (int ks = 0; ks < 4; ++ks) { R.gre[ks] = *(const bf16x8*)(gp + ks * 32); R.gim[ks] = *(const bf16x8*)(gp + 128 + ks * 32); } }
    const int d0 = g * 128 + 16 * w + 4 * lq;
#pragma unroll
    for (int tb = 0; tb < 4; ++tb) { const int sp = kt + N1 * (16 * tb + lr); R.gwa[tb] = *(const v2u*)(GF + blk512(tok0 + sp, d0));
        if (mir) R.gwb[tb] = *(const v2u*)(GF + blk512(tok0 + S - sp, d0)); else R.gwb[tb] = (v2u){0u, 0u}; }
    nn_load<128>(R.T, M2 + (size_t)kt * 16384, Y + (size_t)tok0 * 512 + (size_t)(2 * p * 64) * 512 + g * 128, (size_t)512, tid);
}
__device__ __forceinline__ void fft_stage2c_run(LAS unsigned char* lds, const bf16* M2, const bf16* Y, const bf16* Gt, const bf16* GF, bf16* QU, int tokbase, int S, int N1, int perb, int first, int nitems, int G, int tid) {
    if (first >= nitems) return;
    S2Regs R;
#define S2_ARGS(it) tokbase + ((it) / perb) * S, S, N1, ((it) % perb) >> 2, ((it) % perb) & 3
    s2c_load(R, M2, Y, Gt, GF, S2_ARGS(first), tid);
    for (int it = first; it < nitems; it += G) {
        const int tok0 = tokbase + (it / perb) * S, kt = (it % perb) >> 2, g = (it % perb) & 3;
        const int w = tid >> 6, l = tid & 63, lr = l & 15, lq = l >> 4; const bool mir = (kt != 0 && kt != N1 / 2);
        nn_stage<128>(lds, R.T, tid);
        bf16x8 gre[4], gim[4]; v2u gwa[4], gwb[4];
#pragma unroll
        for (int k = 0; k < 4; ++k) { gre[k] = R.gre[k]; gim[k] = R.gim[k]; gwa[k] = R.gwa[k]; gwb[k] = R.gwb[k]; }
        if (it + G < nitems) s2c_load(R, M2, Y, Gt, GF, S2_ARGS(it + G), tid);
        f32x4 acc[8]; nn_mfma<128>(lds, tid, acc);
        constexpr int XST = 136; LAS bf16* XL = (LAS bf16*)(lds + 81920);
#pragma unroll
        for (int mt = 0; mt < 8; ++mt) { v2u o; o.x = pk2(acc[mt][0], acc[mt][1]); o.y = pk2(acc[mt][2], acc[mt][3]); *(LAS v2u*)(XL + (mt * 16 + lr) * XST + 16 * w + 4 * lq) = o; }
        LDS_WAIT(); __builtin_amdgcn_s_barrier(); asm volatile("" ::: "memory");
        f32x4 P[4], Q[4];
#pragma unroll
        for (int tb = 0; tb < 4; ++tb) { P[tb] = (f32x4){0.f, 0.f, 0.f, 0.f}; Q[tb] = (f32x4){0.f, 0.f, 0.f, 0.f};
#pragma unroll
            for (int ks = 0; ks < 4; ++ks) { const bf16x8 xre = *(const LAS bf16x8*)(XL + (16 * tb + lr) * XST + ks * 32 + 8 * lq), xim = *(const LAS bf16x8*)(XL + (64 + 16 * tb + lr) * XST + ks * 32 + 8 * lq);
                P[tb] = __builtin_amdgcn_mfma_f32_16x16x32_bf16(gre[ks], xre, P[tb], 0, 0, 0); Q[tb] = __builtin_amdgcn_mfma_f32_16x16x32_bf16(gim[ks], xim, Q[tb], 0, 0, 0); } }
        const int d0 = g * 128 + 16 * w + 4 * lq;
#pragma unroll
        for (int tb = 0; tb < 4; ++tb) { const int sp = kt + N1 * (16 * tb + lr);
            { const size_t t = (size_t)(tok0 + sp); const v2u gw = gwa[tb]; const f32x4 f = P[tb] + Q[tb]; v2u o;
              o.x = pk2(f[0] * pg8::silu(pg8::bflo(gw.x)), f[1] * pg8::silu(pg8::bfhi(gw.x))); o.y = pk2(f[2] * pg8::silu(pg8::bflo(gw.y)), f[3] * pg8::silu(pg8::bfhi(gw.y)));
              *(v2u*)(QU + t * 1024 + 512 + d0) = o; }
            if (mir) { const size_t t = (size_t)(tok0 + S - sp); const v2u gw = gwb[tb]; const f32x4 f = P[tb] - Q[tb]; v2u o;
              o.x = pk2(f[0] * pg8::silu(pg8::bflo(gw.x)), f[1] * pg8::silu(pg8::bfhi(gw.x))); o.y = pk2(f[2] * pg8::silu(pg8::bflo(gw.y)), f[3] * pg8::silu(pg8::bfhi(gw.y)));
              *(v2u*)(QU + t * 1024 + 512 + d0) = o; } }
    }
#undef S2_ARGS
}
__global__ void __launch_bounds__(NWAVES * 64, 2) mk_fwd(Args args) {
    extern __shared__ __attribute__((aligned(16))) unsigned char lds[];
    Frame F;
    F.lds = (LAS unsigned char*)lds;
    F.MISC = (volatile LAS unsigned*)(F.lds + MISC_OFF);
    F.wave = __builtin_amdgcn_readfirstlane((int)threadIdx.x >> 6);
    F.G = gridDim.x; { const int bx = blockIdx.x; F.vcu = (F.G % 8 == 0) ? (bx % 8) * (F.G / 8) + bx / 8 : bx; }
    unsigned char* ws = args.ws;
    F.ctl = (unsigned*)(ws + WS_CTL);
    for (int u = threadIdx.x; u < (LDS_BYTES - LDSCTL_OFF) / 4; u += NWAVES * 64) ((LAS unsigned*)(F.lds + LDSCTL_OFF))[u] = 0u;
    __syncthreads();
    XcdBarrier bar = xcd_barrier_post(F.ctl + 1024, F.MISC + 8);
    { const unsigned simd = (unsigned)__builtin_amdgcn_s_getreg((1 << 11) | (4 << 6) | 4) & 3u;
      if ((threadIdx.x & 63) == 0) F.MISC[48 + F.wave] = simd;
      __syncthreads();
      unsigned cnt0 = 0, cnt1 = 0, cnt2 = 0, cnt3 = 0, rank = 0;
#pragma unroll
      for (int w = 0; w < NWAVES; ++w) { const unsigned sw = F.MISC[48 + w]; cnt0 += sw == 0u; cnt1 += sw == 1u; cnt2 += sw == 2u; cnt3 += sw == 3u; rank += (w < F.wave && sw == simd) ? 1u : 0u; }
      const bool ok = cnt0 == 2u && cnt1 == 2u && cnt2 == 2u && cnt3 == 2u;
      F.role = __builtin_amdgcn_readfirstlane(ok ? (int)((rank << 2) | simd) : (((F.wave >> 2) << 2) | (F.wave & 3)));
#if defined(ROLE_PARITY)
      F.role = ((F.wave & 1) << 2) | (F.wave >> 1);
#endif
    }
#define GRID_BAR() xcd_barrier(bar)
#define STAGGER(ticks) do { if ((ticks) > 0) { const unsigned long long t0_ = __builtin_amdgcn_s_memrealtime(); const unsigned long long d_ = (unsigned long long)(F.vcu & 3) * (unsigned long long)(ticks); \
    while (__builtin_amdgcn_s_memrealtime() - t0_ < d_) __builtin_amdgcn_s_sleep(8); } } while (0)
#if defined(PROBE_A)
#define STAMP(k) do { if (blockIdx.x == 0 && threadIdx.x == 0) { const unsigned long long t_ = __builtin_amdgcn_s_memrealtime(); F.MISC[16 + 2 * (k)] = (unsigned)t_; F.MISC[17 + 2 * (k)] = (unsigned)(t_ >> 32); } } while (0)
#else
#define STAMP(k) do { } while (0)
#endif
    STAMP(0);
    bf16* const Win_t = (bf16*)(ws + WS_WIN); bf16* const Wout_t = (bf16*)(ws + WS_WOUT); bf16* const Wg_t = (bf16*)(ws + WS_WG); bf16* const Wp_t = (bf16*)(ws + WS_WP);
    bf16* const Gt = (bf16*)(ws + WS_GT); bf16* const XN = (bf16*)(ws + WS_XN); bf16* const XP = (bf16*)(ws + WS_XN); bf16* const QU = (bf16*)(ws + WS_QU);
    bf16* const KB = (bf16*)(ws + WS_K); bf16* const VB = (bf16*)(ws + WS_V); bf16* const H1B = (bf16*)(ws + WS_K); bf16* const GA = (bf16*)(ws + WS_GA); bf16* const GF = (bf16*)(ws + WS_GF);
    bf16* const QB = (bf16*)(ws + WS_QB); bf16* const UB = (bf16*)(ws + WS_UB);
    bf16* const PROJ = (bf16*)(ws + WS_PROJ); bf16* const PB = (bf16*)args.out; bf16* const Y = (bf16*)args.out;
    float* const SSQ1 = (float*)(ws + WS_SSQ1); float* const SSQ2 = (float*)(ws + WS_SSQ2); const float* const TAB = (const float*)(ws + WS_TAB);

    p0_prologue(F, args);
#if defined(DUP_P0)
    p0_prologue(F, args, (DUP_P0 + 0) ? (DUP_P0 + 0) : 3);
#endif
    GRID_BAR(); STAMP(1);
#if defined(DUP_BAR)
    GRID_BAR(); GRID_BAR(); GRID_BAR(); GRID_BAR(); GRID_BAR();
#endif
#if defined(DUP_P1)
    if ((DUP_P1 + 0) == 4) { const unsigned long long t0_ = __builtin_amdgcn_s_memrealtime(); const unsigned long long d_ = (unsigned long long)(F.vcu & 3) * 800ull;
        while (__builtin_amdgcn_s_memrealtime() - t0_ < d_) __builtin_amdgcn_s_sleep(8); }
    { pg8::Gemm g{XN, Win_t, NTOK, NIN, DM, DM, 0}; pg8::StaticOrder S; S.init(NTOK, NIN, F.G, (int)blockIdx.x);
      pg8::EpiInProj E{QB, KB, VB, GA, UB, GF, QSCALE, ((DUP_P1 + 0) >= 2) ? (DUP_P1 + 0) : 0};
      pg8::gemm_phase<pg8::EpiInProj, pg8::StaticOrder, true, true>(F.lds, g, S, E, F.wave); }
    { pg8::Gemm g{PB, Wp_t, NTOK, DM, PLED, PLED, 0}; pg8::StaticOrder S; S.init(NTOK, DM, F.G, (int)blockIdx.x);
      pg8::EpiPlainBf16 E{PROJ, DM};
      pg8::gemm_phase<pg8::EpiPlainBf16, pg8::StaticOrder, true, true>(F.lds, g, S, E, F.wave); }
#endif
    STAGGER(STG_P1);
#if defined(DUP_PROJ)
    { pg8::Gemm g{PB, Wp_t, NTOK, DM, PLED, PLED, 0}; pg8::StaticOrder S; S.init(NTOK, DM, F.G, (int)blockIdx.x);
      pg8::EpiPlainBf16 E{PROJ, DM};
      pg8::gemm_phase<pg8::EpiPlainBf16, pg8::StaticOrder, true, true>(F.lds, g, S, E, F.wave); }
#endif
    if (PROJ_FIRST_MASK && (F.vcu & PROJ_FIRST_MASK) == 0) {
    { pg8::Gemm g{PB, Wp_t, NTOK, DM, PLED, PLED, 0}; pg8::StaticOrder S; S.init(NTOK, DM, F.G, (int)blockIdx.x);
      pg8::EpiPlainBf16 E{PROJ, DM};
      pg8::gemm_phase<pg8::EpiPlainBf16, pg8::StaticOrder, true, true>(F.lds, g, S, E, F.wave); }
    { pg8::Gemm g{XN, Win_t, NTOK, NIN, DM, DM, 0}; pg8::StaticOrder S; S.init(NTOK, NIN, F.G, (int)blockIdx.x);
      pg8::EpiInProj E{QB, KB, VB, GA, UB, GF, QSCALE, 0};
      pg8::gemm_phase<pg8::EpiInProj, pg8::StaticOrder, true, true>(F.lds, g, S, E, F.wave); }
    } else {
    { pg8::Gemm g{XN, Win_t, NTOK, NIN, DM, DM, 0}; pg8::StaticOrder S; S.init(NTOK, NIN, F.G, (int)blockIdx.x);
      pg8::EpiInProj E{QB, KB, VB, GA, UB, GF, QSCALE, 0};
      pg8::gemm_phase<pg8::EpiInProj, pg8::StaticOrder, true, true>(F.lds, g, S, E, F.wave); }
    { pg8::Gemm g{PB, Wp_t, NTOK, DM, PLED, PLED, 0}; pg8::StaticOrder S; S.init(NTOK, DM, F.G, (int)blockIdx.x);
      pg8::EpiPlainBf16 E{PROJ, DM};
      pg8::gemm_phase<pg8::EpiPlainBf16, pg8::StaticOrder, true, true>(F.lds, g, S, E, F.wave); }
    }
    GRID_BAR(); STAMP(2);
#if defined(DUP_FFT)
    { constexpr int NIT_P = NBP * 256, NIT_S = NBS * 256;
      for (int it = F.vcu; it < NIT_P + NIT_S; it += F.G) {
          if (it < NIT_P) fft_stage1_item<64>(F.lds, (const bf16*)(ws + WS_H1A), QU, Y, (it >> 8) * SEQP, it & 255, opq_tid(F.wave));
          else { const int r = it - NIT_P; fft_stage1_item<128>(F.lds, (const bf16*)(ws + WS_H1B), QU, Y, TPR + (r >> 8) * SEQS, r & 255, opq_tid(F.wave)); } } }
    GRID_BAR(); STAMP(10);
    { constexpr int NIT_P = NBP * 33 * 4, NIT_S = NBS * 65 * 4;
      for (int it = F.vcu; it < NIT_P + NIT_S; it += F.G) {
          if (it < NIT_P) { const int b = it / 132, r = it % 132; fft_stage2_item(F.lds, (const bf16*)(ws + WS_M2A), Y, XP, b * SEQP, SEQP, 64, r >> 2, r & 3, opq_tid(F.wave)); }
          else { const int q = it - NIT_P, b = q / 260, r = q % 260; fft_stage2_item(F.lds, (const bf16*)(ws + WS_M2B), Y, XP, TPR + b * SEQS, SEQS, 128, r >> 2, r & 3, opq_tid(F.wave)); } } }
    GRID_BAR(); STAMP(11);
#endif
    { constexpr int NIT_P = NBP * 256, NIT_S = NBS * 256;
      const int nP = F.vcu < NIT_P ? (NIT_P - F.vcu + F.G - 1) / F.G : 0, firstS = F.vcu + nP * F.G - NIT_P;
      fft_stage1_run<64>(F.lds, (const bf16*)(ws + WS_H1A), UB, Y, 0, SEQP, F.vcu, NIT_P, F.G, opq_tid(F.wave));
      fft_stage1_run<128>(F.lds, (const bf16*)(ws + WS_H1B), UB, Y, TPR, SEQS, firstS, NIT_S, F.G, opq_tid(F.wave)); }
    GRID_BAR(); STAMP(3);
    { constexpr int NIT_P = NBP * 33 * 4, NIT_S = NBS * 65 * 4;
      const int nP = F.vcu < NIT_P ? (NIT_P - F.vcu + F.G - 1) / F.G : 0, firstS = F.vcu + nP * F.G - NIT_P;
      fft_stage2c_run(F.lds, (const bf16*)(ws + WS_M2A), Y, Gt, GF, QU, 0, SEQP, 64, 132, F.vcu, NIT_P, F.G, opq_tid(F.wave));
      fft_stage2c_run(F.lds, (const bf16*)(ws + WS_M2B), Y, Gt, GF, QU, TPR, SEQS, 128, 260, firstS, NIT_S, F.G, opq_tid(F.wave));
      __syncthreads(); }
    STAMP(4); STAMP(5);
#if defined(PROBE_CLK)
    unsigned long long ck_c0 = 0, ck_r0 = 0, ck_c1 = 0, ck_r1 = 0;
    if (PROBE_CLK == 2) { ck_c0 = __builtin_amdgcn_s_memtime(); ck_r0 = __builtin_amdgcn_s_memrealtime(); }
#endif
    { const float lam = TAB[1024]; const float* subg = args.in[7];
      const int xl = F.vcu >> 5, cu = F.vcu & 31;
#if defined(DUP_ATT)
      for (int rep = 0; rep < 2; ++rep)
#endif
      for (int i = 0; i < 6; ++i) {
          int tok0, seq, h, q0;
          if (i < 2) { const int pr = xl; tok0 = TPR + (pr >> 2) * SEQS; seq = SEQS; h = pr & 3; q0 = (cu + 32 * i) * 128; }
          else { const int pr = xl + 8 * (i - 2); tok0 = (pr >> 2) * SEQP; seq = SEQP; h = pr & 3; q0 = cu * 128; }
#if defined(DUP_ATT)
          if (rep == 0) ATTNS::attn_unit<DUP_ATT>(QB, XP, KB, VB, GA, TAB, subg, lam, tok0, seq, h, q0, F.lds, F.wave, F.role); else ATTNS::attn_unit<0>(QB, QU, KB, VB, GA, TAB, subg, lam, tok0, seq, h, q0, F.lds, F.wave, F.role);
#else
          ATTNS::attn_unit<0>(QB, QU, KB, VB, GA, TAB, subg, lam, tok0, seq, h, q0, F.lds, F.wave, F.role);
#endif
      } }
#if defined(PROBE_CLK)
    if (PROBE_CLK == 2) { ck_c1 = __builtin_amdgcn_s_memtime(); ck_r1 = __builtin_amdgcn_s_memrealtime(); }
#endif
    GRID_BAR(); STAMP(6);
#if defined(DUP_P3)
    { pg8::Gemm g{QU, Wout_t, NTOK, DM, DM, DM, 0}; pg8::StaticOrder S; S.init(NTOK, DM, F.G, (int)blockIdx.x);
      pg8::EpiOutProj E{args.in[0], args.in[1], args.out, H1B, SSQ1};
      pg8::gemm_phase<pg8::EpiOutProj, pg8::StaticOrder, P3_ALIGN, true>(F.lds, g, S, E, F.wave); }
#endif
    STAGGER(STG_P3);
    { pg8::Gemm g{QU, Wout_t, NTOK, DM, DM, DM, 0}; pg8::StaticOrder S; S.init(NTOK, DM, F.G, (int)blockIdx.x);
      pg8::EpiOutProj E{args.in[0], args.in[1], args.out, H1B, SSQ1};
      pg8::gemm_phase<pg8::EpiOutProj, pg8::StaticOrder, P3_ALIGN, true>(F.lds, g, S, E, F.wave); }
    GRID_BAR(); STAMP(7);
    STAGGER(STG_P4);
    { pg8::Gemm g{H1B, Wg_t, NTOK, DM, DM, DM, 0}; pg8::StaticOrder S; S.init(NTOK, DM, F.G, (int)blockIdx.x);
      pg8::EpiGateNorm E{args.out, H1B, PROJ, SSQ1, args.in[14], SSQ2, F.ctl + 16384, F.lds + RING_BYTES + 1024};
      pg8::gemm_phase<pg8::EpiGateNorm, pg8::StaticOrder, true, true>(F.lds, g, S, E, F.wave); }
    STAMP(8);
    STAMP(9);
#if defined(PROBE_CLK)
    GRID_BAR();
    if (blockIdx.x == 0 && threadIdx.x == 0) { const float ghz = 0.1f * (float)(ck_c1 - ck_c0) / (float)(ck_r1 - ck_r0); const float v = 20.f * rintf(ghz * 5.f); for (int i = 0; i < 8; ++i) args.out[i] = v; }
#endif
#if defined(PROBE_A)
    if (blockIdx.x == 0) { asm volatile("s_waitcnt vmcnt(0) lgkmcnt(0)" ::: "memory"); __syncthreads();
        const unsigned long long ta = ((unsigned long long)F.MISC[17 + 2 * PROBE_A] << 32) | F.MISC[16 + 2 * PROBE_A], tb = ((unsigned long long)F.MISC[17 + 2 * PROBE_B] << 32) | F.MISC[16 + 2 * PROBE_B];
        const float v = (float)(tb - ta) * 0.0001f; for (int i = 0; i < 8; ++i) args.out[threadIdx.x * 8 + i] = v; }
#endif
#undef GRID_BAR
}

extern "C" void kernel_launch(void* const* d_in, const int* in_sizes, int n_in, void* d_out, int out_size, void* d_ws, size_t ws_size, hipStream_t stream) {
    static int grid = 0;
    if (grid == 0) {
        if (n_in != 15 || in_sizes[0] != TPR * DM || out_size != NTOK * DM || ws_size < WS_END) {
            fprintf(stderr, "kernel_launch: shape mismatch: n_in %d in0 %d out %d ws %zu (need %zu)\n", n_in, n_in > 0 ? in_sizes[0] : -1, out_size, ws_size, (size_t)WS_END); grid = -1; return; }
        int dev = 0, cus = 0;
        if (hipGetDevice(&dev) != hipSuccess || hipDeviceGetAttribute(&cus, hipDeviceAttributeMultiprocessorCount, dev) != hipSuccess) { fprintf(stderr, "kernel_launch: device query failed\n"); grid = -1; return; }
        if (hipFuncSetAttribute((const void*)mk_fwd, hipFuncAttributeMaxDynamicSharedMemorySize, LDS_BYTES) != hipSuccess) { fprintf(stderr, "kernel_launch: hipFuncSetAttribute failed\n"); grid = -1; return; }
        (void)hipGetLastError();
        grid = cus;
        if (grid != 256) fprintf(stderr, "kernel_launch: %d CUs; this kernel's attention schedule assumes 256\n", grid);
    }
    if (grid < 0) return;
    if (hipMemsetAsync((char*)d_ws + WS_CTL, 0, CTL_ZERO_BYTES, stream) != hipSuccess) { fprintf(stderr, "kernel_launch: memset failed\n"); return; }
    Args a{};
    for (int i = 0; i < 15; ++i) a.in[i] = (const float*)d_in[i];
    a.out = (float*)d_out; a.ws = (unsigned char*)d_ws;
    hipLaunchKernelGGL(mk_fwd, dim3(grid), dim3(NWAVES * 64), LDS_BYTES, stream, a);
    const hipError_t le = hipPeekAtLastError();
    if (le != hipSuccess) fprintf(stderr, "kernel_launch: launch failed: %s\n", hipGetErrorName(le));
}
```

```cpp
#include <hip/hip_runtime.h>
#include <cstdio>
#include <cstdint>
#define PRIO_MODE 2
#define ATTNS att3
#define STG_P1 0
#define PROJ_FIRST_MASK 0
#define STG_P3 0
#define P3_ALIGN true
#define STG_P4 0
__device__ __forceinline__ int opq_tid(int wave) { int l; asm volatile("v_mbcnt_lo_u32_b32 %0, -1, 0\n\tv_mbcnt_hi_u32_b32 %0, -1, %0" : "=v"(l)); return wave * 64 + l; }
__device__ __forceinline__ float bperm_f(int srclane, float v) { return __int_as_float(__builtin_amdgcn_ds_bpermute(srclane << 2, __float_as_int(v))); }
__device__ __forceinline__ size_t blk512(int row, int col) { return ((size_t)(((row >> 4) << 4) + (col >> 5)) << 9) + (size_t)(((row & 15) << 5) + (col & 31)); }
__device__ __forceinline__ size_t blk1024(int row, int col) { return ((size_t)(((row >> 4) << 5) + (col >> 5)) << 9) + (size_t)(((row & 15) << 5) + (col & 31)); }
namespace pg8 {
#define PG8_LAS __attribute__((address_space(3)))
typedef unsigned short bf16_t;
typedef short bf16x8 __attribute__((ext_vector_type(8)));
typedef float f32x4 __attribute__((ext_vector_type(4)));
typedef unsigned u32x4 __attribute__((ext_vector_type(4)));
constexpr int BM = 256, BK = 64, HALF = 128, HTB = HALF * BK * 2  , STAGE_BYTES = 8 * HTB, NXCD = 8, WGM = 8;

__host__ __device__ __forceinline__ int lds_byte(int r, int c) { const int st = (r >> 4) * 2 + (c >> 5), rr = r & 15, cc = c & 31, ob = rr * 64 + cc * 2; return st * 1024 + (ob ^ (((ob >> 9) & 1) << 5)); }
__host__ __device__ __forceinline__ void stage_rc(int b, int& R, int& C) { const int st = b / 1024, sb = b % 1024, swz = sb ^ (((sb >> 9) & 1) << 5); R = (st >> 1) * 16 + swz / 64; C = (st & 1) * 32 + (swz % 64) / 2; }
__host__ __device__ __forceinline__ int perm32(int rho) { const int n = rho >> 4, i = rho & 15; return 8 * (i >> 2) + 4 * n + (i & 3); }

struct Unit { int pm, pn; };
struct Gemm { const bf16_t* A; const bf16_t* Bt; int M, N, K, ld, koff_pn; };

struct StaticOrder {
    int nM, nN, nwg, G, c;
    __host__ __device__ void init(int M, int N, int G_, int c_) { nM = M / BM; nN = N / BM; nwg = nM * nN; G = G_; c = c_; }
    __host__ __device__ bool next(int i, Unit& u) const {
        const long L = (long)i * G + c; if (L >= nwg) return false;
        int wgid = (int)L; { const int q = nwg / NXCD, r = nwg % NXCD, xcd = wgid % NXCD, off = wgid / NXCD; wgid = (xcd < r ? xcd * (q + 1) : r * (q + 1) + (xcd - r) * q) + off; }
        const int nig = WGM * nN, gid = wgid / nig, fm = gid * WGM, gsz = (nM - fm) < WGM ? (nM - fm) : WGM;
        u.pm = fm + ((wgid % nig) % gsz); u.pn = (wgid % nig) / gsz; return true;
    }
    __device__ __forceinline__ void a_ready(const Unit&) const {}
    __device__ __forceinline__ void done(const Unit&) const {}
};

__device__ __forceinline__ unsigned cvt_pk_bf16(float lo, float hi) { unsigned r; asm volatile("v_cvt_pk_bf16_f32 %0, %1, %2" : "=v"(r) : "v"(lo), "v"(hi)); return r; }
typedef float f32x2 __attribute__((ext_vector_type(2)));
typedef unsigned u32x2 __attribute__((ext_vector_type(2)));
__device__ __forceinline__ float bflo(unsigned w) { return __uint_as_float(w << 16); }
__device__ __forceinline__ float bfhi(unsigned w) { return __uint_as_float(w & 0xffff0000u); }
__device__ __forceinline__ float sigm(float a) { return __builtin_amdgcn_rcpf(1.f + __expf(-a)); }
__device__ __forceinline__ float silu(float a) { return a * sigm(a); }

struct EpiInProj {
    static constexpr bool PERM = true, AFTER_DRAIN = false;
    bf16_t* qb; bf16_t* kb; bf16_t* vb; bf16_t* ga; bf16_t* ub; bf16_t* gf; float qscale; int nostore;
    __device__ __forceinline__ void operator()(const f32x4 (&acc)[2][2][4][2], const Unit& u, int wr, int wc, int fr, int fq) const {
        const int seg = u.pn >> 1, colt = (u.pn & 1) * BM;
        bf16_t* base; float sc = 1.f;
        if (seg == 0) { base = qb; sc = qscale; } else if (seg == 1) base = kb; else if (seg == 2) base = vb; else if (seg == 3) base = ga; else if (seg == 4) base = ub; else base = gf;
        const int row0 = u.pm * BM + wr * 64 + fr, col0 = colt + wc * 32 + 8 * fq;
#pragma unroll
        for (int ai = 0; ai < 2; ++ai)
#pragma unroll
            for (int m = 0; m < 4; ++m) { const int row = row0 + ai * HALF + m * 16;
#pragma unroll
                for (int bj = 0; bj < 2; ++bj) { const f32x4 v0 = acc[ai][bj][m][0] * sc, v1 = acc[ai][bj][m][1] * sc;
                    u32x4 w; w.x = cvt_pk_bf16(v0[0], v0[1]); w.y = cvt_pk_bf16(v0[2], v0[3]); w.z = cvt_pk_bf16(v1[0], v1[1]); w.w = cvt_pk_bf16(v1[2], v1[3]);
                    if (nostore == 0) __builtin_nontemporal_store(w, (u32x4*)(base + blk512(row, col0 + bj * HALF))); else asm volatile("" :: "v"(w)); } }
    }
};
struct EpiPlainBf16 {
    static constexpr bool PERM = true, AFTER_DRAIN = false;
    bf16_t* O; int ldc;
    __device__ __forceinline__ void operator()(const f32x4 (&acc)[2][2][4][2], const Unit& u, int wr, int wc, int fr, int fq) const {
        const int row0 = u.pm * BM + wr * 64 + fr, col0 = u.pn * BM + wc * 32 + 8 * fq;
#pragma unroll
        for (int ai = 0; ai < 2; ++ai)
#pragma unroll
            for (int m = 0; m < 4; ++m) { const int row = row0 + ai * HALF + m * 16;
#pragma unroll
                for (int bj = 0; bj < 2; ++bj) { const f32x4 v0 = acc[ai][bj][m][0], v1 = acc[ai][bj][m][1];
                    u32x4 w; w.x = cvt_pk_bf16(v0[0], v0[1]); w.y = cvt_pk_bf16(v0[2], v0[3]); w.z = cvt_pk_bf16(v1[0], v1[1]); w.w = cvt_pk_bf16(v1[2], v1[3]);
                    __builtin_nontemporal_store(w, (u32x4*)(O + blk1024(row, col0 + bj * HALF))); } }
    }
};
struct EpiFno {
    static constexpr bool PERM = true, AFTER_DRAIN = false;
    const bf16_t* gf; bf16_t* qu;
    __device__ __forceinline__ void operator()(const f32x4 (&acc)[2][2][4][2], const Unit& u, int wr, int wc, int fr, int fq) const {
        const int row0 = u.pm * BM + wr * 64 + fr, col0 = u.pn * BM + wc * 32 + 8 * fq;
#pragma unroll
        for (int ai = 0; ai < 2; ++ai)
#pragma unroll
            for (int m = 0; m < 4; ++m) { const size_t r = (size_t)(row0 + ai * HALF + m * 16);
#pragma unroll
                for (int bj = 0; bj < 2; ++bj) { const int c = col0 + bj * HALF; const u32x4 g = *(const u32x4*)(gf + r * 512 + c);
                    const f32x4 v0 = acc[ai][bj][m][0], v1 = acc[ai][bj][m][1];
                    u32x4 w; w.x = cvt_pk_bf16(v0[0] * silu(bflo(g.x)), v0[1] * silu(bfhi(g.x))); w.y = cvt_pk_bf16(v0[2] * silu(bflo(g.y)), v0[3] * silu(bfhi(g.y)));
                    w.z = cvt_pk_bf16(v1[0] * silu(bflo(g.z)), v1[1] * silu(bfhi(g.z))); w.w = cvt_pk_bf16(v1[2] * silu(bflo(g.w)), v1[3] * silu(bfhi(g.w)));
                    *(u32x4*)(qu + r * 1024 + 512 + c) = w; } }
    }
};
struct EpiOutProj {
    static constexpr bool PERM = false, AFTER_DRAIN = false;
    const float* xp; const float* xs; float* out; bf16_t* h1b; float* ssq;
    __device__ __forceinline__ void operator()(const f32x4 (&acc)[2][2][4][2], const Unit& u, int wr, int wc, int fr, int fq) const {
        const int row0 = u.pm * BM + wr * 64 + fr, col0 = u.pn * BM + wc * 32 + 4 * fq;
        const float* xb = (u.pm < 128) ? xp : xs - (size_t)32768 * 1024;
        f32x4 xv[8][4]; float ssv[8];
#define EOP_LD(g) do { const float* xrow_ = xb + (size_t)(row0 + ((g) >> 2) * HALF + ((g) & 3) * 16) * 1024 + col0; \
            xv[g][0] = *(const f32x4*)(xrow_); xv[g][1] = *(const f32x4*)(xrow_ + 16); xv[g][2] = *(const f32x4*)(xrow_ + HALF); xv[g][3] = *(const f32x4*)(xrow_ + HALF + 16); } while (0)
        EOP_LD(0); EOP_LD(1); EOP_LD(2);
#pragma unroll
        for (int g = 0; g < 8; ++g) { const int ai = g >> 2, m = g & 3;
            if (g + 3 < 8) EOP_LD(g + 3);
            const size_t off = (size_t)(row0 + ai * HALF + m * 16) * 1024 + col0; float ss = 0.f;
#pragma unroll
            for (int bj = 0; bj < 2; ++bj)
#pragma unroll
                for (int n = 0; n < 2; ++n) { const f32x4 h = xv[g][bj * 2 + n] + acc[ai][bj][m][n];
                    ss += (h[0] * h[0] + h[1] * h[1]) + (h[2] * h[2] + h[3] * h[3]);
                    u32x2 w; w.x = cvt_pk_bf16(h[0], h[1]); w.y = cvt_pk_bf16(h[2], h[3]); *(u32x2*)(h1b + off + bj * HALF + n * 16) = w; }
            ss += bperm_f(((fq ^ 1) << 4) | fr, ss); ss += bperm_f(((fq ^ 2) << 4) | fr, ss); ssv[g] = ss; }
#undef EOP_LD
        if (fq == 0) {
#pragma unroll
            for (int g = 0; g < 8; ++g) ssq[(size_t)(row0 + (g >> 2) * HALF + (g & 3) * 16) * 16 + u.pn * 4 + wc] = ssv[g]; }
    }
};
struct EpiGate {
    static constexpr bool PERM = false, AFTER_DRAIN = false;
    float* out; const bf16_t* proj; const float* ssq1; float* ssq2;
    __device__ __forceinline__ void operator()(const f32x4 (&acc)[2][2][4][2], const Unit& u, int wr, int wc, int fr, int fq) const {
        const int row0 = u.pm * BM + wr * 64 + fr, col0 = u.pn * BM + wc * 32 + 4 * fq;
#pragma unroll
        for (int ai = 0; ai < 2; ++ai)
#pragma unroll
            for (int m = 0; m < 4; ++m) { const int r = row0 + ai * HALF + m * 16; const size_t off = (size_t)r * 1024 + col0;
                const f32x4* sp = (const f32x4*)(ssq1 + (size_t)r * 16); const f32x4 s0 = sp[0], s1 = sp[1], s2 = sp[2], s3 = sp[3];
                const float st = ((s0[0] + s0[1]) + (s0[2] + s0[3])) + ((s1[0] + s1[1]) + (s1[2] + s1[3])) + ((s2[0] + s2[1]) + (s2[2] + s2[3])) + ((s3[0] + s3[1]) + (s3[2] + s3[3]));
                const float rr = __builtin_amdgcn_rsqf(st * (1.f / 1024.f) + 1e-6f); float ss = 0.f;
#pragma unroll
                for (int bj = 0; bj < 2; ++bj)
#pragma unroll
                    for (int n = 0; n < 2; ++n) { const f32x4 a = acc[ai][bj][m][n] * rr; const u32x2 pw = *(const u32x2*)(proj + off + bj * HALF + n * 16);
                        const f32x4 h1 = *(const f32x4*)(out + off + bj * HALF + n * 16); f32x4 h;
                        h[0] = h1[0] + sigm(a[0]) * bflo(pw.x); h[1] = h1[1] + sigm(a[1]) * bfhi(pw.x); h[2] = h1[2] + sigm(a[2]) * bflo(pw.y); h[3] = h1[3] + sigm(a[3]) * bfhi(pw.y);
                        *(f32x4*)(out + off + bj * HALF + n * 16) = h; ss += (h[0] * h[0] + h[1] * h[1]) + (h[2] * h[2] + h[3] * h[3]); }
                ss += bperm_f(((fq ^ 1) << 4) | fr, ss); ss += bperm_f(((fq ^ 2) << 4) | fr, ss);
                if (fq == 0) ssq2[(size_t)r * 16 + u.pn * 4 + wc] = ss; }
    }
};

struct EpiGateNorm {
    static constexpr bool PERM = false, AFTER_DRAIN = false;
    float* out; const bf16_t* h1b; const bf16_t* proj; const float* ssq1; const float* gfin; float* slots; unsigned* cnt; PG8_LAS unsigned char* xl;
    __device__ __forceinline__ void operator()(f32x4 (&acc)[2][2][4][2], const Unit& u, int wr, int wc, int fr, int fq) const {
        const int row0 = u.pm * BM + wr * 64 + fr, col0 = u.pn * BM + wc * 32 + 4 * fq; const int wid = wr * 4 + wc, lane = fq * 16 + fr;
        PG8_LAS float* P = (PG8_LAS float*)xl; PG8_LAS float* S = (PG8_LAS float*)(xl + 4096); PG8_LAS float* R1 = (PG8_LAS float*)(xl + 5120);
        u32x2 pwv[8][4], hwv[8][4];
#define EGN_LD(g) do { const size_t off_ = (size_t)(row0 + ((g) >> 2) * HALF + ((g) & 3) * 16) * 1024 + col0; \
            { const int r_ = row0 + ((g) >> 2) * HALF + ((g) & 3) * 16; pwv[g][0] = *(const u32x2*)(proj + blk1024(r_, col0)); pwv[g][1] = *(const u32x2*)(proj + blk1024(r_, col0 + 16)); pwv[g][2] = *(const u32x2*)(proj + blk1024(r_, col0 + HALF)); pwv[g][3] = *(const u32x2*)(proj + blk1024(r_, col0 + HALF + 16)); } \
            hwv[g][0] = *(const u32x2*)(h1b + off_); hwv[g][1] = *(const u32x2*)(h1b + off_ + 16); hwv[g][2] = *(const u32x2*)(h1b + off_ + HALF); hwv[g][3] = *(const u32x2*)(h1b + off_ + HALF + 16); } while (0)
        EGN_LD(0); EGN_LD(1); EGN_LD(2); EGN_LD(3);
        { const int t_ = wid * 64 + lane; if (t_ < 256) { const f32x4* sp = (const f32x4*)(ssq1 + (size_t)(u.pm * BM + t_) * 16); const f32x4 s0 = sp[0], s1 = sp[1], s2 = sp[2], s3 = sp[3];
            const float st = ((s0[0] + s0[1]) + (s0[2] + s0[3])) + ((s1[0] + s1[1]) + (s1[2] + s1[3])) + ((s2[0] + s2[1]) + (s2[2] + s2[3])) + ((s3[0] + s3[1]) + (s3[2] + s3[3]));
            R1[t_] = __builtin_amdgcn_rsqf(st * (1.f / 1024.f) + 1e-6f); } }
        asm volatile("s_waitcnt vmcnt(0) lgkmcnt(0)" ::: "memory"); __builtin_amdgcn_s_barrier(); asm volatile("" ::: "memory");
#pragma unroll
        for (int g = 0; g < 8; ++g) { const int ai = g >> 2, m = g & 3;
            if (g + 4 < 8) EGN_LD(g + 4);
            const float rr = R1[ai * HALF + wr * 64 + m * 16 + fr]; float ss = 0.f;
#pragma unroll
            for (int bj = 0; bj < 2; ++bj)
#pragma unroll
                for (int n = 0; n < 2; ++n) { const f32x4 a = acc[ai][bj][m][n] * rr; const u32x2 pw = pwv[g][bj * 2 + n], hw = hwv[g][bj * 2 + n]; f32x4 h;
                    h[0] = bflo(hw.x) + sigm(a[0]) * bflo(pw.x); h[1] = bfhi(hw.x) + sigm(a[1]) * bfhi(pw.x); h[2] = bflo(hw.y) + sigm(a[2]) * bflo(pw.y); h[3] = bfhi(hw.y) + sigm(a[3]) * bfhi(pw.y);
                    acc[ai][bj][m][n] = h; ss += (h[0] * h[0] + h[1] * h[1]) + (h[2] * h[2] + h[3] * h[3]); }
            ss += bperm_f(((fq ^ 1) << 4) | fr, ss); ss += bperm_f(((fq ^ 2) << 4) | fr, ss);
            if (fq == 0) P[(ai * HALF + wr * 64 + m * 16 + fr) * 4 + wc] = ss; }
#undef EGN_LD
        asm volatile("s_waitcnt lgkmcnt(0)" ::: "memory"); __builtin_amdgcn_s_barrier(); asm volatile("" ::: "memory");
        const int row = wid * 32 + (lane & 31);
        if (lane < 32) { const float t = (P[row * 4 + 0] + P[row * 4 + 1]) + (P[row * 4 + 2] + P[row * 4 + 3]);
            __hip_atomic_store(slots + ((size_t)(u.pm * BM + row) * 4 + u.pn), t, __ATOMIC_RELAXED, __HIP_MEMORY_SCOPE_AGENT); }
        asm volatile("s_waitcnt vmcnt(0)" ::: "memory");
        if (lane == 0) __hip_atomic_fetch_add(cnt + 64 * u.pm, 1u, __ATOMIC_RELAXED, __HIP_MEMORY_SCOPE_AGENT);
        if (wid == 0) { unsigned spins = 0;
            while ((unsigned)__builtin_amdgcn_readfirstlane(__hip_atomic_load(cnt + 64 * u.pm, __ATOMIC_RELAXED, __HIP_MEMORY_SCOPE_AGENT)) < 32u) { __builtin_amdgcn_s_sleep(2); if (++spins > (1u << 22)) break; }
            __builtin_amdgcn_fence(__ATOMIC_ACQUIRE, "agent"); }
        asm volatile("s_waitcnt vmcnt(0) lgkmcnt(0)" ::: "memory"); __builtin_amdgcn_s_barrier(); asm volatile("" ::: "memory");
        if (lane < 32) { const float* sl = slots + (size_t)(u.pm * BM + row) * 4; float t = 0.f;
#pragma unroll
            for (int k = 0; k < 4; ++k) t += __hip_atomic_load(sl + k, __ATOMIC_RELAXED, __HIP_MEMORY_SCOPE_AGENT);
            S[row] = __builtin_amdgcn_rsqf(t * (1.f / 1024.f) + 1e-6f); }
        asm volatile("s_waitcnt vmcnt(0) lgkmcnt(0)" ::: "memory"); __builtin_amdgcn_s_barrier(); asm volatile("" ::: "memory");
        f32x4 gv[2][2];
#pragma unroll
        for (int bj = 0; bj < 2; ++bj)
#pragma unroll
            for (int n = 0; n < 2; ++n) gv[bj][n] = *(const f32x4*)(gfin + col0 + bj * HALF + n * 16);
#pragma unroll
        for (int ai = 0; ai < 2; ++ai)
#pragma unroll
            for (int m = 0; m < 4; ++m) { const int rl = ai * HALF + wr * 64 + m * 16 + fr; const float rs = S[rl]; const size_t off = (size_t)(u.pm * BM + rl) * 1024 + col0;
#pragma unroll
                for (int bj = 0; bj < 2; ++bj)
#pragma unroll
                    for (int n = 0; n < 2; ++n) __builtin_nontemporal_store(acc[ai][bj][m][n] * rs * gv[bj][n], (f32x4*)(out + off + bj * HALF + n * 16)); }
        asm volatile("s_waitcnt lgkmcnt(0)" ::: "memory"); __builtin_amdgcn_s_barrier(); asm volatile("" ::: "memory");
    }
};
template <class Epi, class Sched, bool ALIGN_EPI = false, bool SP2 = false>
__device__ __forceinline__ void gemm_phase(PG8_LAS unsigned char* lds, const Gemm g, const Sched& S, const Epi& E, const int wave_) {
    const int tid = opq_tid(wave_), wid = __builtin_amdgcn_readfirstlane(tid >> 6), lane = tid & 63, wr = wid >> 2, wc = wid & 3, fr = lane & 15, fq = lane >> 4;
    const int K = g.K, nt = K / BK;
    unsigned voffA[2], voffB[2];
#pragma unroll
    for (int i = 0; i < 2; ++i) { int R, C; stage_rc(tid * 16 + i * 8192, R, C); const int Rb = Epi::PERM ? ((R & ~31) + perm32(R & 31)) : R;
        voffA[i] = (unsigned)(R * g.ld + C) * 2u; voffB[i] = (unsigned)(Rb * g.ld + C) * 2u; }
    const size_t kstep = (size_t)(BK * 2);
    const size_t hstep = (size_t)HALF * g.ld * 2;
    const size_t tstep = 2 * hstep;
    const unsigned ldsw = (unsigned)wid * 1024u;
    const int aoff = lds_byte(wr * 64 + fr, fq * 8), boff = lds_byte(wc * 32 + fr, fq * 8);
#define PG8_SA(b, h) (((b) * 2 + (h)) * HTB)
#define PG8_SB(b, h) ((4 + (b) * 2 + (h)) * HTB)
#define PG8_STAGE(bufoff, gbase, voff) do { unsigned long long gb_ = (unsigned long long)(gbase); asm volatile("" : "+s"(gb_)); _Pragma("unroll") for (int _i = 0; _i < 2; ++_i) { asm volatile("" : "+v"((voff)[_i])); \
        __builtin_amdgcn_global_load_lds((const unsigned*)((const char*)gb_ + (voff)[_i]), (PG8_LAS unsigned*)(lds + (bufoff) + ldsw + _i * 8192), 16, 0, 0); } } while (0)
#define PG8_LDA(dst, b, h) do { _Pragma("unroll") for (int m = 0; m < 4; ++m) _Pragma("unroll") for (int k = 0; k < 2; ++k) dst[m][k] = *(const PG8_LAS bf16x8*)(lds + PG8_SA(b, h) + aoff + m * 2048 + k * 1024); } while (0)
#define PG8_LDB(dst, b, h) do { _Pragma("unroll") for (int n = 0; n < 2; ++n) _Pragma("unroll") for (int k = 0; k < 2; ++k) dst[n][k] = *(const PG8_LAS bf16x8*)(lds + PG8_SB(b, h) + boff + n * 2048 + k * 1024); } while (0)
#define PG8_MMA(ai, bj, At, Bt) do { __builtin_amdgcn_s_setprio(1); _Pragma("unroll") for (int m = 0; m < 4; ++m) _Pragma("unroll") for (int n = 0; n < 2; ++n) _Pragma("unroll") for (int k = 0; k < 2; ++k) \
        acc[ai][bj][m][n] = __builtin_amdgcn_mfma_f32_16x16x32_bf16(Bt[n][k], At[m][k], acc[ai][bj][m][n], 0, 0, 0); __builtin_amdgcn_s_setprio(0); } while (0)
#define PG8_WAIT_V(n) asm volatile("s_waitcnt vmcnt(" #n ")" ::: "memory")
#define PG8_WAIT_L(n) asm volatile("s_waitcnt lgkmcnt(" #n ")" ::: "memory")
#define PG8_BAR __builtin_amdgcn_s_barrier()
#define PG8_SCHED __builtin_amdgcn_sched_barrier(0)
    Unit cur, nxt; int ui = 0;
    if (!S.next(0, cur)) return;
    f32x4 acc[2][2][4][2];
#pragma unroll
    for (int a = 0; a < 2; ++a)
#pragma unroll
        for (int b = 0; b < 2; ++b)
#pragma unroll
            for (int m = 0; m < 4; ++m)
#pragma unroll
                for (int n = 0; n < 2; ++n) acc[a][b][m][n] = (f32x4){0.f, 0.f, 0.f, 0.f};
    bf16x8 At[4][2], B0[2][2], B1[2][2];
    const char* cA = (const char*)g.A + (size_t)cur.pm * tstep + (size_t)(cur.pn * g.koff_pn) * 2; const char* cB = (const char*)g.Bt + (size_t)cur.pn * tstep + (size_t)(cur.pn * g.koff_pn) * 2;
    S.a_ready(cur);
    if constexpr (SP2) {
        PG8_STAGE(PG8_SB(0, 0), cB, voffB); PG8_STAGE(PG8_SB(0, 1), cB + hstep, voffB); PG8_STAGE(PG8_SA(0, 0), cA, voffA); PG8_STAGE(PG8_SA(0, 1), cA + hstep, voffA);
        if (wr == 1) PG8_BAR;
        PG8_WAIT_V(2); PG8_BAR;
        PG8_STAGE(PG8_SB(1, 0), cB + kstep, voffB); PG8_STAGE(PG8_SA(1, 0), cA + kstep, voffA); PG8_STAGE(PG8_SB(1, 1), cB + hstep + kstep, voffB);
        PG8_WAIT_V(6); PG8_BAR;
    } else {
        PG8_STAGE(PG8_SB(0, 0), cB, voffB); PG8_STAGE(PG8_SA(0, 0), cA, voffA); PG8_STAGE(PG8_SB(0, 1), cB + hstep, voffB); PG8_STAGE(PG8_SA(0, 1), cA + hstep, voffA);
        if (wr == 1) PG8_BAR;
        PG8_WAIT_V(4); PG8_BAR;
        PG8_STAGE(PG8_SB(1, 0), cB + kstep, voffB); PG8_STAGE(PG8_SA(1, 0), cA + kstep, voffA); PG8_STAGE(PG8_SB(1, 1), cB + hstep + kstep, voffB);
        PG8_WAIT_V(6); PG8_BAR;
    }
    for (;;) {
        const bool has_next = S.next(ui + 1, nxt);
        const char* nA = has_next ? (const char*)g.A + (size_t)nxt.pm * tstep + (size_t)(nxt.pn * g.koff_pn) * 2 : cA; const char* nB = has_next ? (const char*)g.Bt + (size_t)nxt.pn * tstep + (size_t)(nxt.pn * g.koff_pn) * 2 : cB;
        for (int t = 0; t < nt; t += 2) {
            const bool last = (t == nt - 2);
            const char* a1 = cA + (size_t)(t + 1) * kstep;
            const char* a2 = last ? nA : cA + (size_t)(t + 2) * kstep; const char* b2 = last ? nB : cB + (size_t)(t + 2) * kstep;
            const char* a3 = a2 + kstep; const char* b3 = b2 + kstep;
            if (last && has_next) S.a_ready(nxt);
            if constexpr (SP2) {
            PG8_LDB(B0, 0, 0); PG8_LDB(B1, 0, 1); PG8_SCHED; PG8_LDA(At, 0, 0); PG8_STAGE(PG8_SA(1, 1), a1 + hstep, voffA);
            PG8_WAIT_V(8); PG8_WAIT_L(0); PG8_BAR; PG8_MMA(0, 0, At, B0); PG8_MMA(0, 1, At, B1); PG8_BAR; PG8_SCHED;
            PG8_LDA(At, 0, 1); PG8_STAGE(PG8_SB(0, 0), b2, voffB); PG8_STAGE(PG8_SB(0, 1), b2 + hstep, voffB); PG8_STAGE(PG8_SA(0, 0), a2, voffA);
            PG8_WAIT_V(8); PG8_WAIT_L(0); PG8_BAR; PG8_MMA(1, 0, At, B0); PG8_MMA(1, 1, At, B1); PG8_BAR; PG8_SCHED;
            PG8_LDB(B0, 1, 0); PG8_LDB(B1, 1, 1); PG8_SCHED; PG8_LDA(At, 1, 0); PG8_STAGE(PG8_SA(0, 1), a2 + hstep, voffA);
            PG8_WAIT_V(8); PG8_WAIT_L(0); PG8_BAR; PG8_MMA(0, 0, At, B0); PG8_MMA(0, 1, At, B1); PG8_BAR; PG8_SCHED;
            PG8_LDA(At, 1, 1); PG8_STAGE(PG8_SB(1, 0), b3, voffB); PG8_STAGE(PG8_SB(1, 1), b3 + hstep, voffB); PG8_STAGE(PG8_SA(1, 0), a3, voffA);
            PG8_WAIT_V(8); PG8_WAIT_L(0); PG8_BAR; PG8_MMA(1, 0, At, B0); PG8_MMA(1, 1, At, B1); PG8_BAR; PG8_SCHED;
            } else {
            PG8_LDB(B0, 0, 0); PG8_SCHED; PG8_LDA(At, 0, 0); PG8_STAGE(PG8_SA(1, 1), a1 + hstep, voffA);
            PG8_WAIT_L(8); PG8_BAR; PG8_WAIT_L(0); PG8_MMA(0, 0, At, B0); PG8_BAR; PG8_SCHED;
            PG8_LDB(B1, 0, 1); PG8_STAGE(PG8_SB(0, 0), b2, voffB);
            PG8_BAR; PG8_WAIT_L(0); PG8_MMA(0, 1, At, B1); PG8_BAR;
            PG8_LDA(At, 0, 1); PG8_STAGE(PG8_SA(0, 0), a2, voffA);
            PG8_BAR; PG8_WAIT_L(0); PG8_MMA(1, 0, At, B0); PG8_BAR; PG8_SCHED;
            PG8_STAGE(PG8_SB(0, 1), b2 + hstep, voffB);
            PG8_WAIT_V(6); PG8_BAR; PG8_MMA(1, 1, At, B1); PG8_BAR;
            PG8_LDB(B0, 1, 0); PG8_SCHED; PG8_LDA(At, 1, 0); PG8_STAGE(PG8_SA(0, 1), a2 + hstep, voffA);
            PG8_WAIT_L(8); PG8_BAR; PG8_WAIT_L(0); PG8_MMA(0, 0, At, B0); PG8_BAR; PG8_SCHED;
            PG8_LDB(B1, 1, 1); PG8_STAGE(PG8_SB(1, 0), b3, voffB);
            PG8_BAR; PG8_WAIT_L(0); PG8_MMA(0, 1, At, B1); PG8_BAR;
            PG8_LDA(At, 1, 1); PG8_STAGE(PG8_SA(1, 0), a3, voffA);
            PG8_BAR; PG8_WAIT_L(0); PG8_MMA(1, 0, At, B0); PG8_BAR; PG8_SCHED;
            PG8_STAGE(PG8_SB(1, 1), b3 + hstep, voffB);
            PG8_WAIT_V(6); PG8_BAR; PG8_MMA(1, 1, At, B1); PG8_BAR;
            }
        }
        if constexpr (ALIGN_EPI) { if (wr == 0) PG8_BAR; }
        if constexpr (!Epi::AFTER_DRAIN) { const int l2_ = opq_tid(wave_) & 63; E(acc, cur, wr, wc, l2_ & 15, l2_ >> 4); S.done(cur); }
        if (!has_next) break;
#pragma unroll
        for (int a = 0; a < 2; ++a)
#pragma unroll
            for (int b = 0; b < 2; ++b)
#pragma unroll
                for (int m = 0; m < 4; ++m)
#pragma unroll
                    for (int n = 0; n < 2; ++n) acc[a][b][m][n] = (f32x4){0.f, 0.f, 0.f, 0.f};
        cur = nxt; cA = nA; cB = nB; ++ui;
        if constexpr (ALIGN_EPI) { if (wr == 1) PG8_BAR; }
    }
    PG8_WAIT_V(0);
    if constexpr (!ALIGN_EPI) { if (wr == 0) PG8_BAR; }
    PG8_BAR;
    if constexpr (Epi::AFTER_DRAIN) { E.fused(acc, cur, wr, wc, fr, fq, lds, wid, lane); S.done(cur); }
#undef PG8_SA
#undef PG8_SB
#undef PG8_STAGE
#undef PG8_LDA
#undef PG8_LDB
#undef PG8_MMA
#undef PG8_WAIT_V
#undef PG8_WAIT_L
#undef PG8_BAR
#undef PG8_SCHED
}
}
constexpr int NWAVES = 8;
constexpr int DM = 1024, NTOK = 49152, TPR = 32768, SEQP = 4096, SEQS = 8192, NBP = 8, NBS = 2, NIN = 3072, PLED = 256;
constexpr float LOG2E = 1.4426950408889634f;
constexpr float QSCALE = 0.125f * LOG2E;
constexpr size_t MiB = 1u << 20;
constexpr size_t WS_CTL = 0, CTL_ZERO_BYTES = 128 * 1024;
constexpr size_t WS_TAB = 1 * MiB;
constexpr size_t WS_GINV = 1 * MiB + 8192;
constexpr size_t WS_RINV = 1 * MiB + 16384;
constexpr size_t WS_WIN = 2 * MiB;
constexpr size_t WS_WOUT = 8 * MiB;
constexpr size_t WS_WG = 10 * MiB;
constexpr size_t WS_WP = 12 * MiB;
constexpr size_t WS_GT = 12 * MiB + 512 * 1024;
constexpr size_t WS_H1A = 13 * MiB + 512 * 1024;
constexpr size_t WS_H1B = WS_H1A + 64 * 1024;
constexpr size_t WS_M2A = 14 * MiB;
constexpr size_t WS_M2B = 15 * MiB + 256 * 1024;
constexpr size_t WS_SSQ1 = 18 * MiB, WS_SSQ2 = 21 * MiB;
constexpr size_t WS_XN = 24 * MiB;
constexpr size_t WS_QU = 120 * MiB;
constexpr size_t WS_K = 216 * MiB, WS_V = 264 * MiB;
constexpr size_t WS_GA = 312 * MiB, WS_GF = 360 * MiB;
constexpr size_t WS_PROJ = 408 * MiB;
constexpr size_t WS_QB = 504 * MiB, WS_UB = 552 * MiB;
constexpr size_t WS_END = 600 * MiB;
static_assert(WS_M2A + 33 * 32768 <= WS_M2B && WS_M2B + 65 * 32768 <= WS_SSQ1 && WS_SSQ2 + (size_t)NTOK * 64 <= WS_XN, "d_ws map");
constexpr int RING_BYTES = 131072, LDSCTL_OFF = RING_BYTES, MISC_OFF = LDSCTL_OFF + 320, LDS_BYTES = 147456;
#define GAS __attribute__((address_space(1)))
#define LAS __attribute__((address_space(3)))
typedef unsigned short bf16;
typedef unsigned v4u __attribute__((ext_vector_type(4)));
typedef unsigned v2u __attribute__((ext_vector_type(2)));
typedef float f32x4 __attribute__((ext_vector_type(4)));
typedef short bf16x8 __attribute__((ext_vector_type(8)));
#define LDS_WAIT() asm volatile("s_waitcnt lgkmcnt(0)" ::: "memory")
#define VM_WAIT() asm volatile("s_waitcnt vmcnt(0)" ::: "memory")
__device__ __forceinline__ unsigned f2bf(float f) { unsigned u = __builtin_bit_cast(unsigned, f); return (u + 0x7fffu + ((u >> 16) & 1u)) >> 16; }
__device__ __forceinline__ unsigned pk2(float lo, float hi) { return f2bf(lo) | (f2bf(hi) << 16); }
#define XB_TMO      128
#define XB_XCNT(j)  (256  + 64 * (j))
#define XB_XSUB(j)  (1280 + 64 * (j))
#define XB_XGEN(j)  (2304 + 64 * (j))
#define XB_TOP      3328
#define XB_TOPGEN   3392
#define XCD_BAR_WORDS 3456
#define XB_SPIN_CAP (1u << 18)

__device__ __forceinline__ unsigned xb_ld(unsigned* p)              { return __hip_atomic_load(p, __ATOMIC_RELAXED, __HIP_MEMORY_SCOPE_AGENT); }
__device__ __forceinline__ unsigned xb_add(unsigned* p, unsigned v) { return __hip_atomic_fetch_add(p, v, __ATOMIC_RELAXED, __HIP_MEMORY_SCOPE_AGENT); }
__device__ __forceinline__ unsigned xb_xcc_id() { return (unsigned)__builtin_amdgcn_s_getreg((3 << 11) | 20) & 0xFu; }
#define XB_SPIN(cond, bar) do { unsigned _sp = 0; while (cond) { __builtin_amdgcn_s_sleep(1); \
    if ((++_sp & 255u) == 0u) { if (xb_ld(&(bar)[XB_TMO])) break; if (_sp > XB_SPIN_CAP) { atomicAdd(&(bar)[XB_TMO], 1u); break; } } } } while (0)

struct XcdBarrier {
    unsigned* bar; unsigned x;
    volatile LAS unsigned* st;
};

__device__ __forceinline__ XcdBarrier xcd_barrier_post(unsigned* bar, volatile LAS unsigned* st) {
    XcdBarrier b; b.bar = bar; b.x = xb_xcc_id(); b.st = st;
    if (threadIdx.x == 0) (void)xb_add(&bar[XB_XCNT(b.x)], 1u);
    return b;
}
__device__ __forceinline__ void xcd_barrier_complete(unsigned* bar, unsigned x, unsigned& nloc, unsigned& nx) {
    const unsigned G = gridDim.x * gridDim.y * gridDim.z;
    unsigned sum, cnt, mine, sp = 0u;
    for (;;) {
        sum = 0u; cnt = 0u; mine = 0u;
#pragma unroll
        for (unsigned j = 0; j < 16; ++j) { const unsigned c = xb_ld(&bar[XB_XCNT(j)]); sum += c; cnt += (c > 0u) ? 1u : 0u; mine = (j == x) ? c : mine; }
        if (sum == G) break;
        __builtin_amdgcn_s_sleep(1);
        if ((++sp & 255u) == 0u) { if (xb_ld(&bar[XB_TMO])) break; if (sp > XB_SPIN_CAP) { atomicAdd(&bar[XB_TMO], 1u); break; } }
    }
    nloc = mine > 0u ? mine : 1u; nx = cnt > 0u ? cnt : 1u;
}

__device__ __forceinline__ void xcd_barrier(const XcdBarrier& b) {
    asm volatile("s_waitcnt vmcnt(0)" ::: "memory");
    __syncthreads();
    if (threadIdx.x == 0) {
        unsigned* bar = b.bar;
        __builtin_amdgcn_s_waitcnt(0);
        unsigned nloc = b.st[0], nx = b.st[1];
        if (nloc == 0u) { xcd_barrier_complete(bar, b.x, nloc, nx); b.st[0] = nloc; b.st[1] = nx; }
        const unsigned old = xb_add(&bar[XB_XSUB(b.x)], 1u);
        const unsigned gen = old / nloc;
        if (old + 1u == (gen + 1u) * nloc) {
            __builtin_amdgcn_fence(__ATOMIC_RELEASE, "agent");
            asm volatile("s_waitcnt vmcnt(0)" ::: "memory");
            const unsigned og = xb_add(&bar[XB_TOP], 1u);
            const unsigned tg = og / nx;
            if (og + 1u == (tg + 1u) * nx) xb_add(&bar[XB_TOPGEN], 1u);
            else XB_SPIN(xb_ld(&bar[XB_TOPGEN]) == tg, bar);
            __builtin_amdgcn_fence(__ATOMIC_ACQUIRE, "agent");
            xb_add(&bar[XB_XGEN(b.x)], 1u);
            asm volatile("s_waitcnt vmcnt(0)" ::: "memory");
        } else {
            XB_SPIN(xb_ld(&bar[XB_XGEN(b.x)]) == gen, bar);
            __builtin_amdgcn_fence(__ATOMIC_ACQUIRE, "agent");
            asm volatile("s_waitcnt vmcnt(0)" ::: "memory");
        }
    }
    __syncthreads();
}
namespace att3 {
#ifndef ATT_REGSTAGE
#define ATT_REGSTAGE 0
#endif
#ifndef DMA_IN_VSEG
#define DMA_IN_VSEG 0
#endif
#ifndef QK_IN_VSEG
#define QK_IN_VSEG 0
#endif
#ifndef ATT_ONEBAR
#define ATT_ONEBAR 1
#endif
#ifndef ATT_LOCKSTEP
#define ATT_LOCKSTEP 0
#endif
typedef unsigned short bf16_t;
typedef short bf16x8 __attribute__((ext_vector_type(8)));
typedef short s16x4 __attribute__((ext_vector_type(4)));
typedef float f32x16 __attribute__((ext_vector_type(16)));
typedef float f32x4 __attribute__((ext_vector_type(4)));
typedef unsigned u32x4 __attribute__((ext_vector_type(4)));
#define A2_LAS __attribute__((address_space(3)))
#ifndef PRIO_MODE
#define PRIO_MODE 0
#endif
#if PRIO_MODE == 1
#define A3_PRIO_M(x) __builtin_amdgcn_s_setprio(x)
#define A3_PRIO_V(x) do { } while (0)
#elif PRIO_MODE == 2
#define A3_PRIO_M(x) do { } while (0)
#define A3_PRIO_V(x) __builtin_amdgcn_s_setprio(x)
#else
#define A3_PRIO_M(x) do { } while (0)
#define A3_PRIO_V(x) do { } while (0)
#endif
constexpr int KVBLK = 64, TILEB = 16384, KRING = 4, VRING = 3;
constexpr int OFF_K = 0, OFF_V = KRING * TILEB, OFF_WS = (KRING + VRING) * TILEB, OFF_TAB = OFF_WS + 8 * 256, A2_LDS_END = OFF_TAB + 2048;
constexpr float THR2 = 11.5f;
#define KSWZ(row, colB) ((row) * 256 + ((colB) ^ (((row) & 15) << 4)))
__device__ __forceinline__ int crow(int r, int hi) { return (r & 3) + 8 * (r >> 2) + 4 * hi; }
__device__ __forceinline__ unsigned cvtpk(float lo, float hi) { unsigned r; asm volatile("v_cvt_pk_bf16_f32 %0, %1, %2" : "=v"(r) : "v"(lo), "v"(hi)); return r; }
__device__ __forceinline__ float bflo(unsigned w) { return __uint_as_float(w << 16); }
__device__ __forceinline__ float bfhi(unsigned w) { return __uint_as_float(w & 0xffff0000u); }
__device__ __forceinline__ float silu(float a) { return a * __builtin_amdgcn_rcpf(1.f + __expf(-a)); }
__device__ __forceinline__ float max3f(float a, float b, float c) { float r; asm("v_max3_f32 %0, %1, %2, %3" : "=v"(r) : "v"(a), "v"(b), "v"(c)); return r; }
__device__ __forceinline__ float max2f(float a, float b) { float r; asm("v_max_f32_e32 %0, %1, %2" : "=v"(r) : "v"(a), "v"(b)); return r; }
__device__ __forceinline__ float fadd_s(float a, float b) { float r; asm("v_add_f32_e32 %0, %1, %2" : "=v"(r) : "v"(a), "v"(b)); return r; }
__device__ __forceinline__ float exp2_s(float a) { float r; asm("v_exp_f32_e32 %0, %1" : "=v"(r) : "v"(a)); return r; }
typedef short v4i16_t __attribute__((ext_vector_type(4)));
__device__ __forceinline__ s16x4 vtr(const A2_LAS char* p) { return __builtin_bit_cast(s16x4, __builtin_amdgcn_ds_read_tr16_b64_v4i16((A2_LAS v4i16_t*)p)); }
__device__ __forceinline__ int v_rd_base(int lane) { return ((lane & 3) << 3) | (((lane >> 2) & 3) << 6) | (((lane >> 4) & 1) << 5) | (((lane >> 5) & 1) << 11); }
constexpr int v_rd_off(int d0, int ks, int half) { return d0 * 512 + ks * 4096 + half * 256; }

#ifndef MFMA_GAP
#define MFMA_GAP 0
#endif
#if MFMA_GAP > 0
#define MGAP_STR2(x) #x
#define MGAP_STR(x) MGAP_STR2(x)
#define MGAP() asm volatile("s_nop " MGAP_STR(MFMA_GAP))
#else
#define MGAP() do { } while (0)
#endif
__device__ __forceinline__ void kload(bf16x8* kf, const A2_LAS char* Ks, int r32, int hi, int comp) {
#pragma unroll
  for (int d0 = 0; d0 < 4; ++d0) { const int cb = ((comp * 4 + d0) * 16 + hi * 8) * 2;
    kf[2 * d0] = *reinterpret_cast<const A2_LAS bf16x8*>(Ks + KSWZ(r32, cb)); kf[2 * d0 + 1] = *reinterpret_cast<const A2_LAS bf16x8*>(Ks + KSWZ(32 + r32, cb)); }
}
__device__ __forceinline__ void qkt_a(f32x16& p0, f32x16& p1, const bf16x8* kf, const bf16x8* qr, const f32x16& negm) {
  p0 = __builtin_amdgcn_mfma_f32_32x32x16_bf16(kf[0], qr[0], negm, 0, 0, 0); MGAP(); p1 = __builtin_amdgcn_mfma_f32_32x32x16_bf16(kf[1], qr[0], negm, 0, 0, 0); MGAP();
  p0 = __builtin_amdgcn_mfma_f32_32x32x16_bf16(kf[2], qr[1], p0, 0, 0, 0); MGAP(); p1 = __builtin_amdgcn_mfma_f32_32x32x16_bf16(kf[3], qr[1], p1, 0, 0, 0); MGAP();
}
__device__ __forceinline__ void qkt_b(f32x16& p0, f32x16& p1, const bf16x8* kf, const bf16x8* qr) {
  p0 = __builtin_amdgcn_mfma_f32_32x32x16_bf16(kf[4], qr[2], p0, 0, 0, 0); MGAP(); p1 = __builtin_amdgcn_mfma_f32_32x32x16_bf16(kf[5], qr[2], p1, 0, 0, 0); MGAP();
  p0 = __builtin_amdgcn_mfma_f32_32x32x16_bf16(kf[6], qr[3], p0, 0, 0, 0); MGAP(); p1 = __builtin_amdgcn_mfma_f32_32x32x16_bf16(kf[7], qr[3], p1, 0, 0, 0); MGAP();
}
struct VFrag { s16x4 lo[4], hh[4]; };
template <int D0> __device__ __forceinline__ void vload(VFrag& f, const A2_LAS char* vp) {
#pragma unroll
  for (int ks = 0; ks < 4; ++ks) { f.lo[ks] = vtr(vp + v_rd_off(D0, ks, 0)); f.hh[ks] = vtr(vp + v_rd_off(D0, ks, 1)); }
}
template <int D0> __device__ __forceinline__ void vload_a(VFrag& f, unsigned va) {
#define VTR_A(dst, off) asm volatile("ds_read_b64_tr_b16 %0, %1 offset:%2" : "=v"(dst) : "v"(va), "n"(off))
  VTR_A(f.lo[0], v_rd_off(D0, 0, 0)); VTR_A(f.hh[0], v_rd_off(D0, 0, 1)); VTR_A(f.lo[1], v_rd_off(D0, 1, 0)); VTR_A(f.hh[1], v_rd_off(D0, 1, 1));
  VTR_A(f.lo[2], v_rd_off(D0, 2, 0)); VTR_A(f.hh[2], v_rd_off(D0, 2, 1)); VTR_A(f.lo[3], v_rd_off(D0, 3, 0)); VTR_A(f.hh[3], v_rd_off(D0, 3, 1));
#undef VTR_A
}
#define VWAIT(n, f) asm volatile("s_waitcnt lgkmcnt(" #n ")" : "+v"(f.lo[0]), "+v"(f.lo[1]), "+v"(f.lo[2]), "+v"(f.lo[3]), "+v"(f.hh[0]), "+v"(f.hh[1]), "+v"(f.hh[2]), "+v"(f.hh[3]))
__device__ __forceinline__ void pvmma(f32x16& od, const VFrag& f, bf16x8 pa0, bf16x8 pa1, bf16x8 pa2, bf16x8 pa3) {
#define PK(k) (bf16x8){f.lo[k][0], f.lo[k][1], f.lo[k][2], f.lo[k][3], f.hh[k][0], f.hh[k][1], f.hh[k][2], f.hh[k][3]}
  od = __builtin_amdgcn_mfma_f32_32x32x16_bf16(PK(0), pa0, od, 0, 0, 0); MGAP();
  od = __builtin_amdgcn_mfma_f32_32x32x16_bf16(PK(1), pa1, od, 0, 0, 0); MGAP();
  od = __builtin_amdgcn_mfma_f32_32x32x16_bf16(PK(2), pa2, od, 0, 0, 0); MGAP();
  od = __builtin_amdgcn_mfma_f32_32x32x16_bf16(PK(3), pa3, od, 0, 0, 0); MGAP();
#undef PK
}
__device__ __forceinline__ float vtail(const f32x16& p0, const f32x16& p1, bf16x8& pa0, bf16x8& pa1, bf16x8& pa2, bf16x8& pa3) {
  float sa, sb, e0, e1, e2, e3, e4, e5, e6, e7; u32x4 w0, w1, w2, w3;
#define VT_BODY(ADD0, ADD1) "v_exp_f32_e32 %6, %14\n\tv_exp_f32_e32 %7, %15\n\tv_exp_f32_e32 %8, %16\n\tv_exp_f32_e32 %9, %17\n\t" ADD0 "v_exp_f32_e32 %10, %18\n\t" ADD1 "v_exp_f32_e32 %11, %19\n\t" \
    "v_cvt_pk_bf16_f32 %2, %6, %7\n\tv_exp_f32_e32 %12, %20\n\tv_cvt_pk_bf16_f32 %3, %8, %9\n\tv_exp_f32_e32 %13, %21\n\tv_add_f32_e32 %0, %0, %10\n\tv_add_f32_e32 %1, %1, %11\n\t" \
    "v_cvt_pk_bf16_f32 %4, %10, %11\n\tv_add_f32_e32 %0, %0, %12\n\tv_add_f32_e32 %1, %1, %13\n\tv_cvt_pk_bf16_f32 %5, %12, %13"
#define VT_OUT(W) "=&v"(W.x), "=&v"(W.y), "=&v"(W.z), "=&v"(W.w), "=&v"(e0), "=&v"(e1), "=&v"(e2), "=&v"(e3), "=&v"(e4), "=&v"(e5), "=&v"(e6), "=&v"(e7)
#define VT_IN(P, B) "v"(P[B + 0]), "v"(P[B + 1]), "v"(P[B + 2]), "v"(P[B + 3]), "v"(P[B + 4]), "v"(P[B + 5]), "v"(P[B + 6]), "v"(P[B + 7])
  asm(VT_BODY("v_add_f32_e32 %0, %6, %7\n\t", "v_add_f32_e32 %1, %8, %9\n\t") : "=&v"(sa), "=&v"(sb), VT_OUT(w0) : VT_IN(p0, 0));
  asm(VT_BODY("v_add_f32_e32 %0, %0, %6\n\tv_add_f32_e32 %1, %1, %7\n\t", "v_add_f32_e32 %0, %0, %8\n\tv_add_f32_e32 %1, %1, %9\n\t") : "+v"(sa), "+v"(sb), VT_OUT(w1) : VT_IN(p0, 8));
  asm(VT_BODY("v_add_f32_e32 %0, %0, %6\n\tv_add_f32_e32 %1, %1, %7\n\t", "v_add_f32_e32 %0, %0, %8\n\tv_add_f32_e32 %1, %1, %9\n\t") : "+v"(sa), "+v"(sb), VT_OUT(w2) : VT_IN(p1, 0));
  asm(VT_BODY("v_add_f32_e32 %0, %0, %6\n\tv_add_f32_e32 %1, %1, %7\n\t", "v_add_f32_e32 %0, %0, %8\n\tv_add_f32_e32 %1, %1, %9\n\t") : "+v"(sa), "+v"(sb), VT_OUT(w3) : VT_IN(p1, 8));
#undef VT_BODY
#undef VT_OUT
#undef VT_IN
  pa0 = *reinterpret_cast<bf16x8*>(&w0); pa1 = *reinterpret_cast<bf16x8*>(&w1); pa2 = *reinterpret_cast<bf16x8*>(&w2); pa3 = *reinterpret_cast<bf16x8*>(&w3);
  return sa + sb;
}
__device__ __forceinline__ float rowmax64(const f32x16& p0, const f32x16& p1) {
  float a, b;
  asm("v_max3_f32 %0, %2, %3, %4\n\tv_max3_f32 %1, %5, %6, %7\n\tv_max3_f32 %0, %0, %8, %9" : "=&v"(a), "=&v"(b) : "v"(p0[0]), "v"(p0[1]), "v"(p1[0]), "v"(p0[2]), "v"(p0[3]), "v"(p1[1]), "v"(p1[2]), "v"(p1[3]));
#define MAX8(r) asm("v_max3_f32 %0, %0, %2, %3\n\tv_max3_f32 %1, %1, %4, %5\n\tv_max3_f32 %0, %0, %6, %7\n\tv_max3_f32 %1, %1, %8, %9" : "+v"(a), "+v"(b) : "v"(p0[r]), "v"(p0[r + 1]), "v"(p0[r + 2]), "v"(p0[r + 3]), "v"(p1[r]), "v"(p1[r + 1]), "v"(p1[r + 2]), "v"(p1[r + 3]))
  MAX8(4); MAX8(8);
  asm("v_max3_f32 %0, %0, %2, %3\n\tv_max3_f32 %1, %1, %4, %5\n\tv_max3_f32 %0, %0, %6, %7\n\tv_max3_f32 %1, %1, %8, %9\n\tv_max_f32_e32 %0, %0, %1" : "+v"(a), "+v"(b) : "v"(p0[12]), "v"(p0[13]), "v"(p0[14]), "v"(p0[15]), "v"(p1[12]), "v"(p1[13]), "v"(p1[14]), "v"(p1[15]));
#undef MAX8
  float rm = a;
  { auto rr = __builtin_amdgcn_permlane32_swap(__float_as_uint(rm), __float_as_uint(rm), false, false); rm = max2f(__uint_as_float(rr[0]), __uint_as_float(rr[1])); }
  return rm;
}
constexpr float REFOFF = THR2 - 1.f;
template <bool NEAR>
__device__ __forceinline__ bool vseg(f32x16& p0, f32x16& p1, float& mhat, float& l_reg, const bool first, const A2_LAS float* tabp, float& fsc, int r32, int hi,
                                     bf16x8& pa0, bf16x8& pa1, bf16x8& pa2, bf16x8& pa3) {
  if (NEAR) {
#pragma unroll
    for (int r = 0; r < 16; ++r) { const int o_ = (r & 3) + 8 * (r >> 2); p0[r] = fadd_s(p0[r], tabp[o_]); p1[r] = fadd_s(p1[r], tabp[o_ + 32]); }
  }
  if (first) { const float d = rowmax64(p0, p1) + REFOFF; mhat += d;
#pragma unroll
    for (int r = 0; r < 16; ++r) { p0[r] -= d; p1[r] -= d; }
    l_reg += vtail(p0, p1, pa0, pa1, pa2, pa3); return false;
  }
  const float ts = vtail(p0, p1, pa0, pa1, pa2, pa3);
  if (__builtin_expect(__any(!(ts < 2.f)), 0)) {
    const float dl = __builtin_fmaxf(rowmax64(p0, p1) + REFOFF, 0.f); mhat += dl;
#pragma unroll
    for (int r = 0; r < 16; ++r) { p0[r] -= dl; p1[r] -= dl; }
    const float f = __builtin_amdgcn_exp2f(-dl); l_reg *= f; fsc = f;
    l_reg += vtail(p0, p1, pa0, pa1, pa2, pa3); return true;
  }
  l_reg += ts; return false;
}

template <int VAR>
__device__ __forceinline__ void attn_unit(const bf16_t* QU, bf16_t* OQ, const bf16_t* __restrict__ KB, const bf16_t* __restrict__ VB, const bf16_t* __restrict__ GA,
                                          const float* __restrict__ tabg, const float* __restrict__ subg, float lam, int tok0, int seq, int h, int q0, A2_LAS unsigned char* lds, const int wave_, const int role_) {
  const int tid = opq_tid(wave_), lane = tid & 63, r32 = lane & 31, hi = lane >> 5; const int wid = wave_;
  const int comp = role_ >> 2, rb = role_ & 3;
  const A2_LAS char* Kr = (const A2_LAS char*)lds + OFF_K; const A2_LAS char* Vr = (const A2_LAS char*)lds + OFF_V;
  A2_LAS float* wsf = (A2_LAS float*)(lds + OFF_WS) + wid * 64; A2_LAS float* li_l = wsf; A2_LAS float* al_l = wsf + 32;
  A2_LAS float* tab = (A2_LAS float*)(lds + OFF_TAB);
  unsigned koff[2], voff[2];
#pragma unroll
  for (int i = 0; i < 2; ++i) { const int pc = 2 * wid + i;
    { const int row = 4 * pc + (lane >> 4), c = (lane & 15) ^ (row & 15); koff[i] = (unsigned)((row >> 4) * 16384 + (c >> 2) * 1024 + (row & 15) * 64 + (c & 3) * 16); }
    { const int st = 2 * pc + (lane >> 5), kk = (st >> 2) * 8 + ((lane & 31) >> 2), key = (kk & ~0xC) | ((kk & 4) << 1) | ((kk & 8) >> 1), col = (st & 3) * 32 + (lane & 3) * 8;
      voff[i] = (unsigned)((key >> 4) * 16384 + (col >> 5) * 1024 + (key & 15) * 64 + (col & 31) * 2); } }
  const char* Kh = (const char*)(KB + blk512(tok0, h * 128)); const char* Vh = (const char*)(VB + blk512(tok0, h * 128));
  const int NT = seq / KVBLK;
#define DMA_K(t, slot) do { const int t_ = (t) < NT ? (t) : NT - 1; const char* g_ = Kh + (size_t)t_ * (KVBLK * 1024); \
    __builtin_amdgcn_global_load_lds((const unsigned*)(g_ + koff[0]), (A2_LAS unsigned*)(lds + OFF_K + (slot) * TILEB + (2 * wid) * 1024), 16, 0, 0); \
    __builtin_amdgcn_global_load_lds((const unsigned*)(g_ + koff[1]), (A2_LAS unsigned*)(lds + OFF_K + (slot) * TILEB + (2 * wid + 1) * 1024), 16, 0, 0); } while (0)
#define DMA_V(t, slot) do { const int t_ = (t) < NT ? (t) : NT - 1; const char* g_ = Vh + (size_t)t_ * (KVBLK * 1024); \
    __builtin_amdgcn_global_load_lds((const unsigned*)(g_ + voff[0]), (A2_LAS unsigned*)(lds + OFF_V + (slot) * TILEB + (2 * wid) * 1024), 16, 0, 0); \
    __builtin_amdgcn_global_load_lds((const unsigned*)(g_ + voff[1]), (A2_LAS unsigned*)(lds + OFF_V + (slot) * TILEB + (2 * wid + 1) * 1024), 16, 0, 0); } while (0)
#define STG_GEOM() int tid_s = tid; asm volatile("" : "+v"(tid_s)); const int sr = tid_s >> 4, sc = (tid_s & 15) * 8
#define STG_KOFF() const int kst0 = KSWZ(sr, sc * 2), kst1 = KSWZ(32 + sr, sc * 2)
#define STG_VOFF() const int kk0 = (sr & ~0xC) | ((sr & 4) << 1) | ((sr & 8) >> 1), kk1 = kk0 + 32; \
    const int vst0 = ((kk0 >> 3) * 4 + (sc >> 5)) * 512 + ((kk0 & 7) * 32 + (sc & 31)) * 2, vst1 = ((kk1 >> 3) * 4 + (sc >> 5)) * 512 + ((kk1 & 7) * 32 + (sc & 31)) * 2
#define STG_SOFF() const unsigned soff0 = (unsigned)(sr * 1024 + sc * 2), soff1 = soff0 + 32 * 1024
  bf16x8 kq0, kq1, vq0, vq1;
#define LD16(base, off) (*reinterpret_cast<const bf16x8*>((base) + (off)))
#define LOADK(t) do { STG_GEOM(); STG_SOFF(); const int t_ = (t) < NT ? (t) : NT - 1; const char* g_ = Kh + (size_t)t_ * (KVBLK * 1024); kq0 = LD16(g_, soff0); kq1 = LD16(g_, soff1); } while (0)
#define LOADV(t) do { STG_GEOM(); STG_SOFF(); const int t_ = (t) < NT ? (t) : NT - 1; const char* g_ = Vh + (size_t)t_ * (KVBLK * 1024); vq0 = LD16(g_, soff0); vq1 = LD16(g_, soff1); } while (0)
#define WRITEK(slot) do { STG_GEOM(); STG_KOFF(); A2_LAS char* d_ = (A2_LAS char*)lds + OFF_K + (slot) * TILEB; *(A2_LAS bf16x8*)(d_ + kst0) = kq0; *(A2_LAS bf16x8*)(d_ + kst1) = kq1; } while (0)
#define WRITEV(slot) do { STG_GEOM(); STG_VOFF(); A2_LAS char* d_ = (A2_LAS char*)lds + OFF_V + (slot) * TILEB; *(A2_LAS bf16x8*)(d_ + vst0) = vq0; *(A2_LAS bf16x8*)(d_ + vst1) = vq1; } while (0)
#define BAR() __builtin_amdgcn_s_barrier()
#define WAITV(n) asm volatile("s_waitcnt vmcnt(" #n ")" ::: "memory")
#define WAITL() asm volatile("s_waitcnt lgkmcnt(0)" ::: "memory")
  bf16x8 qr[4];
  {
#pragma unroll
    for (int d0 = 0; d0 < 4; ++d0) qr[d0] = *reinterpret_cast<const bf16x8*>(QU + blk512(tok0 + q0 + rb * 32 + r32, h * 128 + comp * 64 + hi * 8 + d0 * 16)); }
  { const int i = tid; int rel = i - 256; rel = rel < -128 ? -128 : (rel > 127 ? 127 : rel); tab[i] = tabg[h * 256 + rel + 128]; }
#if ATT_REGSTAGE
  { LOADK(0); LOADV(0); const bf16x8 a0 = kq0, a1 = kq1; LOADK(1); const bf16x8 b0 = kq0, b1 = kq1; LOADK(2); STG_GEOM(); STG_KOFF();
    A2_LAS char* d_ = (A2_LAS char*)lds + OFF_K; *(A2_LAS bf16x8*)(d_ + kst0) = a0; *(A2_LAS bf16x8*)(d_ + kst1) = a1; *(A2_LAS bf16x8*)(d_ + TILEB + kst0) = b0; *(A2_LAS bf16x8*)(d_ + TILEB + kst1) = b1;
    WRITEK(2); WRITEV(0); }
#else
  DMA_K(0, 0); DMA_K(1, 1); DMA_V(0, 0); DMA_K(2, 2);
#endif
  const int qw0 = q0 + rb * 32, qpos = qw0 + r32;
  float mhat = 0.f, l_reg = 0.f; f32x16 o[4];
#pragma unroll
  for (int d = 0; d < 4; ++d) o[d] = f32x16{};
  f32x16 p0, p1, negm; bf16x8 pa0, pa1, pa2, pa3; bf16x8 kf[8]; VFrag vfa, vfb;
#define SBAR() __builtin_amdgcn_sched_barrier(0)
  const int vbase = v_rd_base(lane);
  if (!ATT_REGSTAGE) WAITV(4);
  WAITL(); BAR();
  const float tabL = tab[128], tabR = tab[383];
  if (!ATT_LOCKSTEP && !ATT_ONEBAR && comp == 1) BAR();
#define CLS(j) ((64 * (j) + 63 - qw0 <= -91) ? 0 : ((64 * (j) - qw0 - 31 >= 91) ? 1 : 2))
#define CCONST(c) ((c) == 0 ? tabL : ((c) == 1 ? tabR : 0.f))
#define SETNEGM(c) do { const float v_ = CCONST(c) - mhat; _Pragma("unroll") for (int r = 0; r < 16; ++r) negm[r] = v_; } while (0)
#define RESC() do { _Pragma("unroll") for (int d = 0; d < 4; ++d) _Pragma("unroll") for (int r = 0; r < 16; ++r) o[d][r] *= fsc_; } while (0)
#define VSEG(j, FIRST) do { const int c_ = cls; bool rs_; float fsc_ = 1.f; \
    if (c_ == 2) rs_ = vseg<true>(p0, p1, mhat, l_reg, FIRST, tab + (64 * (j) - qpos + 256 + 4 * hi), fsc_, r32, hi, pa0, pa1, pa2, pa3); \
    else rs_ = vseg<false>(p0, p1, mhat, l_reg, FIRST, tab, fsc_, r32, hi, pa0, pa1, pa2, pa3); \
    if (rs_) RESC(); \
    const int cn_ = CLS((j) + 1); if (__builtin_expect(rs_ || (FIRST) || cn_ != c_, 0)) { SETNEGM(cn_); asm volatile("" : "+v"(negm)); } cls = cn_; } while (0)
#define PKONLY() do { u32x4 w0 = {cvtpk(p0[0], p0[1]), cvtpk(p0[2], p0[3]), cvtpk(p0[4], p0[5]), cvtpk(p0[6], p0[7])}, w1 = {cvtpk(p0[8], p0[9]), cvtpk(p0[10], p0[11]), cvtpk(p0[12], p0[13]), cvtpk(p0[14], p0[15])}; \
    u32x4 w2 = {cvtpk(p1[0], p1[1]), cvtpk(p1[2], p1[3]), cvtpk(p1[4], p1[5]), cvtpk(p1[6], p1[7])}, w3 = {cvtpk(p1[8], p1[9]), cvtpk(p1[10], p1[11]), cvtpk(p1[12], p1[13]), cvtpk(p1[14], p1[15])}; \
    pa0 = *reinterpret_cast<bf16x8*>(&w0); pa1 = *reinterpret_cast<bf16x8*>(&w1); pa2 = *reinterpret_cast<bf16x8*>(&w2); pa3 = *reinterpret_cast<bf16x8*>(&w3); } while (0)
  int cls = CLS(0); SETNEGM(cls);
  kload(kf, Kr, r32, hi, comp);
  A3_PRIO_M(1);
  qkt_a(p0, p1, kf, qr, negm); qkt_b(p0, p1, kf, qr);
  A3_PRIO_M(0);
  if (ATT_REGSTAGE) { SBAR(); LOADK(3); LOADV(1); } else if (!DMA_IN_VSEG) { DMA_K(3, 3); DMA_V(1, 1); }
  if (!ATT_LOCKSTEP && (!ATT_ONEBAR || comp == 1)) { if (comp == 1 && !ATT_REGSTAGE) { if (DMA_IN_VSEG) WAITV(0); else WAITV(4); } WAITL(); BAR(); }
  if (DMA_IN_VSEG && !ATT_REGSTAGE) { DMA_K(3, 3); DMA_V(1, 1); }
  A3_PRIO_V(1); kload(kf, Kr + TILEB, r32, hi, comp); SBAR();
  VSEG(0, true); A3_PRIO_V(0);
  if (QK_IN_VSEG) { qkt_a(p0, p1, kf, qr, negm); qkt_b(p0, p1, kf, qr); }
  if (ATT_REGSTAGE) { WRITEK(3); WRITEV(1); WAITL(); } else if (ATT_LOCKSTEP || comp == 0) WAITV(4);
  if (!ATT_ONEBAR || ATT_LOCKSTEP || comp == 0) BAR();
  int sk = 2, sv = 0;
  for (int j = 1; j < NT; ++j) {
    asm volatile("" : "+v"(koff[0]), "+v"(koff[1]), "+v"(voff[0]), "+v"(voff[1]));
    const A2_LAS char* vp = Vr + sv * TILEB + vbase;
    A3_PRIO_M(1);
    if (VAR == 8) {
#define FILL() do { fx0 = __builtin_amdgcn_exp2f(fx0); fy0 += fx1; fy1 += fx0; fy2 += fy0; asm volatile("" : "+v"(fx0), "+v"(fy0), "+v"(fy1), "+v"(fy2)); } while (0)
#define MF(dst, a, b, c) do { dst = __builtin_amdgcn_mfma_f32_32x32x16_bf16(a, b, c, 0, 0, 0); FILL(); } while (0)
      float fx0 = (float)j, fx1 = 1.f, fy0 = 0.f, fy1 = 0.f, fy2 = 0.f;
      MF(p0, kf[0], qr[0], negm); MF(p1, kf[1], qr[0], negm); MF(p0, kf[2], qr[1], p0); MF(p1, kf[3], qr[1], p1); MF(p0, kf[4], qr[2], p0); MF(p1, kf[5], qr[2], p1); MF(p0, kf[6], qr[3], p0); MF(p1, kf[7], qr[3], p1);
      const bf16x8 vb_ = kf[0];
      _Pragma("unroll") for (int d = 0; d < 4; ++d) { MF(o[d], pa0, vb_, o[d]); MF(o[d], pa1, vb_, o[d]); MF(o[d], pa2, vb_, o[d]); MF(o[d], pa3, vb_, o[d]); }
      l_reg += fy1 + fy2;
#undef MF
#undef FILL
    } else if (VAR == 4 || VAR == 6 || VAR == 7) {
      asm volatile("" : "+v"(vfa.lo[0]), "+v"(vfa.hh[0]), "+v"(vfb.lo[0]), "+v"(vfb.hh[0]));
      qkt_a(p0, p1, kf, qr, negm); qkt_b(p0, p1, kf, qr);
      pvmma(o[0], vfa, pa0, pa1, pa2, pa3); pvmma(o[1], vfb, pa0, pa1, pa2, pa3); pvmma(o[2], vfa, pa0, pa1, pa2, pa3); pvmma(o[3], vfb, pa0, pa1, pa2, pa3);
    } else if (VAR == 5) {
      vload<0>(vfa, vp); vload<1>(vfb, vp); asm volatile("" : "+v"(vfa.lo[0]), "+v"(vfa.lo[1]), "+v"(vfa.lo[2]), "+v"(vfa.lo[3]), "+v"(vfa.hh[0]), "+v"(vfa.hh[1]), "+v"(vfa.hh[2]), "+v"(vfa.hh[3]), "+v"(vfb.lo[0]), "+v"(vfb.lo[1]), "+v"(vfb.lo[2]), "+v"(vfb.lo[3]), "+v"(vfb.hh[0]), "+v"(vfb.hh[1]), "+v"(vfb.hh[2]), "+v"(vfb.hh[3]));
      vload<2>(vfa, vp); vload<3>(vfb, vp); asm volatile("" : "+v"(vfa.lo[0]), "+v"(vfa.lo[1]), "+v"(vfa.lo[2]), "+v"(vfa.lo[3]), "+v"(vfa.hh[0]), "+v"(vfa.hh[1]), "+v"(vfa.hh[2]), "+v"(vfa.hh[3]), "+v"(vfb.lo[0]), "+v"(vfb.lo[1]), "+v"(vfb.lo[2]), "+v"(vfb.lo[3]), "+v"(vfb.hh[0]), "+v"(vfb.hh[1]), "+v"(vfb.hh[2]), "+v"(vfb.hh[3]));
      asm volatile("" : "+v"(kf[0]), "+v"(kf[1]), "+v"(kf[2]), "+v"(kf[3]), "+v"(kf[4]), "+v"(kf[5]), "+v"(kf[6]), "+v"(kf[7]));
      p0 = negm; p1 = negm;
    } else {
    const unsigned va = (unsigned)(size_t)vp;
    if (!QK_IN_VSEG) { qkt_a(p0, p1, kf, qr, negm); SBAR(); }
    vload_a<0>(vfa, va); SBAR();
    if (!QK_IN_VSEG) qkt_b(p0, p1, kf, qr);
    vload_a<1>(vfb, va); SBAR();
    VWAIT(8, vfa); pvmma(o[0], vfa, pa0, pa1, pa2, pa3);
    vload_a<2>(vfa, va); SBAR();
    VWAIT(8, vfb); pvmma(o[1], vfb, pa0, pa1, pa2, pa3);
    vload_a<3>(vfb, va); SBAR();
    VWAIT(8, vfa); pvmma(o[2], vfa, pa0, pa1, pa2, pa3);
    VWAIT(0, vfb); pvmma(o[3], vfb, pa0, pa1, pa2, pa3);
    }
    A3_PRIO_M(0);
    { const int s3 = (sk + 2) & 3  , s1 = sv == 0 ? 2 : sv - 1  ; if (VAR != 3 && VAR != 7 && VAR != 8) { if (ATT_REGSTAGE) { SBAR(); LOADK(j + 3); LOADV(j + 1); } else if (!DMA_IN_VSEG) { DMA_K(j + 3, s3); DMA_V(j + 1, s1); } } }
    if (!ATT_LOCKSTEP && (!ATT_ONEBAR || comp == 1)) { if (comp == 1 && VAR != 3 && VAR != 7 && VAR != 8 && !ATT_REGSTAGE) { if (DMA_IN_VSEG) WAITV(0); else WAITV(4); } WAITL(); BAR(); }
    if (DMA_IN_VSEG && !ATT_REGSTAGE && VAR != 3 && VAR != 7 && VAR != 8) { const int s3 = (sk + 2) & 3, s1 = sv == 0 ? 2 : sv - 1; DMA_K(j + 3, s3); DMA_V(j + 1, s1); }
    A3_PRIO_V(1); if (VAR != 4 && VAR != 6 && VAR != 7 && VAR != 8) { kload(kf, Kr + sk * TILEB, r32, hi, comp); } SBAR();
    if (VAR != 1 && VAR != 6 && VAR != 7 && VAR != 8) { VSEG(j, false); } else { PKONLY(); } A3_PRIO_V(0);
    if (QK_IN_VSEG && VAR == 0) { qkt_a(p0, p1, kf, qr, negm); qkt_b(p0, p1, kf, qr); }
    if (ATT_REGSTAGE) { if (VAR != 3 && VAR != 7 && VAR != 8) { WRITEK((sk + 2) & 3); WRITEV(sv == 0 ? 2 : sv - 1); WAITL(); } }
    else if ((ATT_LOCKSTEP || comp == 0) && VAR != 3 && VAR != 7 && VAR != 8) WAITV(4);
    if (!ATT_ONEBAR || ATT_LOCKSTEP || comp == 0) BAR();
    sk = (sk + 1) & 3; sv = sv == 2 ? 0 : sv + 1;
  }
  { const A2_LAS char* vp = Vr + sv * TILEB + vbase;
    A3_PRIO_M(1);
    const unsigned va = (unsigned)(size_t)vp;
    vload_a<0>(vfa, va); vload_a<1>(vfb, va); SBAR(); VWAIT(8, vfa); pvmma(o[0], vfa, pa0, pa1, pa2, pa3); vload_a<2>(vfa, va); SBAR(); VWAIT(8, vfb); pvmma(o[1], vfb, pa0, pa1, pa2, pa3); vload_a<3>(vfb, va); SBAR();
    VWAIT(8, vfa); pvmma(o[2], vfa, pa0, pa1, pa2, pa3); VWAIT(0, vfb); pvmma(o[3], vfb, pa0, pa1, pa2, pa3);
    A3_PRIO_M(0); }
  WAITV(0); WAITL();
  if (!ATT_LOCKSTEP && !ATT_ONEBAR && comp == 0) BAR();
  { auto rr = __builtin_amdgcn_permlane32_swap(__float_as_uint(l_reg), __float_as_uint(l_reg), false, false); l_reg = __uint_as_float(rr[0]) + __uint_as_float(rr[1]); }
  const float rl = __builtin_amdgcn_rcpf(l_reg);
  u32x4 gq[4]; f32x4 sq[8];
  { const int row = tid >> 2, qt = tid & 3; const bf16_t* gp = GA + blk512(tok0 + q0 + row, h * 128 + qt * 32); const float* sg = subg + qt * 32;
#pragma unroll
    for (int i = 0; i < 4; ++i) { gq[i] = *(const u32x4*)(gp + 8 * i); sq[2 * i] = *(const f32x4*)(sg + 8 * i); sq[2 * i + 1] = *(const f32x4*)(sg + 8 * i + 4); } }
  WAITL(); BAR(); asm volatile("" ::: "memory");
  A2_LAS float* OC = (A2_LAS float*)lds; constexpr int OST = 129;
  if (comp == 0) {
#pragma unroll
    for (int r = 0; r < 16; ++r) {
#pragma unroll
      for (int d0 = 0; d0 < 4; ++d0) OC[(32 * d0 + crow(r, hi)) * OST + rb * 32 + r32] = o[d0][r] * rl; }
  }
  WAITL(); BAR(); asm volatile("" ::: "memory");
  if (comp == 1) { const float sl = lam * rl;
#pragma unroll
    for (int r = 0; r < 16; ++r) {
#pragma unroll
      for (int d0 = 0; d0 < 4; ++d0) OC[(32 * d0 + crow(r, hi)) * OST + rb * 32 + r32] -= o[d0][r] * sl; }
  }
  WAITL(); BAR(); asm volatile("" ::: "memory");
  { const int row = tid >> 2, qt = tid & 3; const A2_LAS float* rp = OC + (qt * 32) * OST + row;
    f32x4 v[8]; float ss = 0.f;
#pragma unroll
    for (int i = 0; i < 8; ++i) { v[i] = (f32x4){rp[(4 * i) * OST], rp[(4 * i + 1) * OST], rp[(4 * i + 2) * OST], rp[(4 * i + 3) * OST]}; ss += (v[i][0] * v[i][0] + v[i][1] * v[i][1]) + (v[i][2] * v[i][2] + v[i][3] * v[i][3]); }
    ss += bperm_f(lane ^ 1, ss); ss += bperm_f(lane ^ 2, ss);
    const float rstd = __builtin_amdgcn_rsqf(ss * (1.f / 128.f) + 1e-5f) * 0.8f;
    const size_t t = (size_t)(tok0 + q0 + row); bf16_t* op = OQ + t * 1024 + h * 128 + qt * 32;
#pragma unroll
    for (int i = 0; i < 4; ++i) { const u32x4 g = gq[i]; const f32x4 s0 = sq[2 * i], s1 = sq[2 * i + 1];
      const f32x4 a = v[2 * i] * rstd * s0, b = v[2 * i + 1] * rstd * s1; u32x4 w;
      w.x = cvtpk(a[0] * silu(bflo(g.x)), a[1] * silu(bfhi(g.x))); w.y = cvtpk(a[2] * silu(bflo(g.y)), a[3] * silu(bfhi(g.y)));
      w.z = cvtpk(b[0] * silu(bflo(g.z)), b[1] * silu(bfhi(g.z))); w.w = cvtpk(b[2] * silu(bflo(g.w)), b[3] * silu(bfhi(g.w)));
      *(u32x4*)(op + 8 * i) = w; }
  }
  asm volatile("s_waitcnt vmcnt(0)" ::: "memory");
  __syncthreads();
#undef DMA_K
#undef LD16
#undef STG_GEOM
#undef STG_KOFF
#undef STG_VOFF
#undef STG_SOFF
#undef LOADK
#undef LOADV
#undef WRITEK
#undef WRITEV
#undef DMA_V
#undef BAR
#undef WAITV
#undef WAITL
#undef CLS
#undef CCONST
#undef SETNEGM
#undef RESC
#undef VSEG
#undef PKONLY
#undef SBAR
#undef VWAIT
}
#undef KSWZ
}
struct Frame {
    LAS unsigned char* lds;
    volatile LAS unsigned* MISC;
    unsigned* ctl;
    int wave;
    int role;
    int vcu, G;
};
__device__ __forceinline__ float wave_sum(float v, int lane) {
#pragma unroll
    for (int o = 1; o < 64; o <<= 1) v += bperm_f(lane ^ o, v);
    return v;
}
__device__ __forceinline__ void p0_transpose_item(const float* W, int K, int N, bf16* WT, const float* kscale, LAS float* scr, int item, int lane) {
    const int nblk = N / 32, kb = item / nblk, nb = item % nblk, k0 = 64 * kb, n0 = 32 * nb;
#pragma unroll 8
    for (int i = 0; i < 32; ++i) { const int kk = 2 * i + (lane >> 5); float w = W[(size_t)(k0 + kk) * N + n0 + (lane & 31)]; if (kscale) w *= kscale[k0 + kk]; scr[kk * 33 + (lane & 31)] = w; }
    LDS_WAIT(); asm volatile("" ::: "memory");
    const int c = lane & 7;
#pragma unroll
    for (int j = 0; j < 4; ++j) { const int n = (lane >> 3) + 8 * j; const LAS float* s = scr + (8 * c) * 33 + n;
        v4u o; o.x = pk2(s[0 * 33], s[1 * 33]); o.y = pk2(s[2 * 33], s[3 * 33]); o.z = pk2(s[4 * 33], s[5 * 33]); o.w = pk2(s[6 * 33], s[7 * 33]);
        *(GAS v4u*)(WT + (size_t)(n0 + n) * K + k0 + 8 * c) = o; }
    LDS_WAIT(); asm volatile("" ::: "memory");
}
__device__ __forceinline__ void rms_row2_to_bf16(const float* xrow0, const float* xrow1, const float* g, bf16* orow0, bf16* orow1, int lane) {
    const GAS f32x4* xr0 = (const GAS f32x4*)xrow0 + lane; const GAS f32x4* xr1 = (const GAS f32x4*)xrow1 + lane; const GAS f32x4* gr = (const GAS f32x4*)g + lane;
    f32x4 v[4], u[4]; float s = 0.f, t = 0.f;
#pragma unroll
    for (int j = 0; j < 4; ++j) { v[j] = xr0[64 * j]; u[j] = xr1[64 * j]; }
#pragma unroll
    for (int j = 0; j < 4; ++j) { s += (v[j].x * v[j].x + v[j].y * v[j].y) + (v[j].z * v[j].z + v[j].w * v[j].w); t += (u[j].x * u[j].x + u[j].y * u[j].y) + (u[j].z * u[j].z + u[j].w * u[j].w); }
#pragma unroll
    for (int o = 1; o < 64; o <<= 1) { s += bperm_f(lane ^ o, s); t += bperm_f(lane ^ o, t); }
    const float r0 = __builtin_amdgcn_rsqf(s * (1.f / 1024.f) + 1e-6f), r1 = __builtin_amdgcn_rsqf(t * (1.f / 1024.f) + 1e-6f);
    GAS unsigned long long* o0 = (GAS unsigned long long*)orow0 + lane; GAS unsigned long long* o1 = (GAS unsigned long long*)orow1 + lane;
#pragma unroll
    for (int j = 0; j < 4; ++j) { const f32x4 gg = gr[64 * j];
        o0[64 * j] = (unsigned long long)pk2(v[j].x * r0 * gg.x, v[j].y * r0 * gg.y) | ((unsigned long long)pk2(v[j].z * r0 * gg.z, v[j].w * r0 * gg.w) << 32);
        o1[64 * j] = (unsigned long long)pk2(u[j].x * r1 * gg.x, u[j].y * r1 * gg.y) | ((unsigned long long)pk2(u[j].z * r1 * gg.z, u[j].w * r1 * gg.w) << 32); }
}
__device__ __forceinline__ int t5_bucket(int rel) {
    const int n = rel < 0 ? -rel : rel; int b;
    if (n < 8) b = n; else b = 8 + (n >= 12) + (n >= 16) + (n >= 23) + (n >= 32) + (n >= 46) + (n >= 64) + (n >= 91);
    return b + (rel > 0 ? 16 : 0);
}
struct Args { const float* in[15]; float* out; unsigned char* ws; };
__device__ __forceinline__ void rms_row4_to_bf16(const float* xrow0, const float* g, bf16* orow0, int lane) {
    const GAS f32x4* gr = (const GAS f32x4*)g + lane;
    f32x4 v[4][4]; float s[4];
#pragma unroll
    for (int r = 0; r < 4; ++r) { const GAS f32x4* xr = (const GAS f32x4*)(xrow0 + (size_t)r * 1024) + lane;
#pragma unroll
        for (int j = 0; j < 4; ++j) v[r][j] = xr[64 * j]; }
#pragma unroll
    for (int r = 0; r < 4; ++r) { s[r] = 0.f;
#pragma unroll
        for (int j = 0; j < 4; ++j) s[r] += (v[r][j].x * v[r][j].x + v[r][j].y * v[r][j].y) + (v[r][j].z * v[r][j].z + v[r][j].w * v[r][j].w); }
#pragma unroll
    for (int o = 1; o < 64; o <<= 1) {
#pragma unroll
        for (int r = 0; r < 4; ++r) s[r] += bperm_f(lane ^ o, s[r]); }
    f32x4 gg[4];
#pragma unroll
    for (int j = 0; j < 4; ++j) gg[j] = gr[64 * j];
#pragma unroll
    for (int r = 0; r < 4; ++r) { const float rs = __builtin_amdgcn_rsqf(s[r] * (1.f / 1024.f) + 1e-6f); GAS unsigned long long* o8 = (GAS unsigned long long*)(orow0 + (size_t)r * 1024) + lane;
#pragma unroll
        for (int j = 0; j < 4; ++j) o8[64 * j] = (unsigned long long)pk2(v[r][j].x * rs * gg[j].x, v[r][j].y * rs * gg[j].y) | ((unsigned long long)pk2(v[r][j].z * rs * gg[j].z, v[r][j].w * rs * gg[j].w) << 32); }
}
__device__ __forceinline__ void p0_prologue(Frame& F, const Args& a, const int parts = 3) {
    const int tid_ = opq_tid(F.wave), lane_ = tid_ & 63;
    const float* xp = a.in[0]; const float* xs = a.in[1]; const float* pp = a.in[2]; const float* ps = a.in[3]; const float* g_mix = a.in[4]; const float* w_in = a.in[5];
    const float* lamp = a.in[6]; const float* relb = a.in[8]; const float* wf = a.in[9]; const float* w_out = a.in[10]; const float* g_ple = a.in[11];
    const float* w_gate = a.in[12]; const float* w_proj = a.in[13];
    unsigned char* ws = a.ws;
    if (parts & 2) {
        LAS float* scr = (LAS float*)(F.lds + F.wave * 16384);
        const int gw = F.vcu * NWAVES + F.wave, NGW = F.G * NWAVES;
        constexpr int I_IN = (DM / 64) * (NIN / 32), I_SQ = (DM / 64) * (DM / 32), I_P = (PLED / 64) * (DM / 32);
        for (int it = gw; it < I_IN + 2 * I_SQ + I_P; it += NGW) {
            int r = it;
            if (r < I_IN) { p0_transpose_item(w_in, DM, NIN, (bf16*)(ws + WS_WIN), nullptr, scr, r, lane_); continue; } r -= I_IN;
            if (r < I_SQ) { p0_transpose_item(w_out, DM, DM, (bf16*)(ws + WS_WOUT), nullptr, scr, r, lane_); continue; } r -= I_SQ;
            if (r < I_SQ) { p0_transpose_item(w_gate, DM, DM, (bf16*)(ws + WS_WG), g_ple, scr, r, lane_); continue; } r -= I_SQ;
            p0_transpose_item(w_proj, PLED, DM, (bf16*)(ws + WS_WP), nullptr, scr, r, lane_);
        }
        const int gt = F.vcu * (NWAVES * 64) + tid_, NGT = F.G * (NWAVES * 64);
        { constexpr int E_H1A = 64 * 64, E_H1B = 128 * 128, E_M2A = 33 * 16384, E_M2B = 65 * 16384;
          for (int i = gt; i < E_H1A + E_H1B + E_M2A + E_M2B; i += NGT) {
              int e = i; float val; bf16* dst;
              if (e < E_H1A + E_H1B) {
                  int N1, r, s1; if (e < E_H1A) { N1 = 64; r = e >> 6; s1 = e & 63; dst = (bf16*)(ws + WS_H1A) + e; } else { e -= E_H1A; N1 = 128; r = e >> 7; s1 = e & 127; dst = (bf16*)(ws + WS_H1B) + e; }
                  if (r == 0) val = 1.f; else if (r == 1) val = (s1 & 1) ? -1.f : 1.f;
                  else { const int k = r >> 1, j = (k * s1) & (N1 - 1); const float x = 2.f * (float)j / (float)N1; val = (r & 1) ? -sinpif(x) : cospif(x); }
              } else {
                  e -= E_H1A + E_H1B; int S, N1; float norm;
                  if (e < E_M2A) { S = 4096; N1 = 64; norm = 0.0013810679320049757f; dst = (bf16*)(ws + WS_M2A) + e; } else { e -= E_M2A; S = 8192; N1 = 128; norm = 0.0009765625f; dst = (bf16*)(ws + WS_M2B) + e; }
                  const int kt = e >> 14, m = (e >> 7) & 127, kp = e & 127, ro = m >> 6, k2 = m & 63, ri = kp >> 6, s2 = kp & 63;
                  const int sp = kt + N1 * k2, j = (s2 * sp) & (S - 1); const float x = 2.f * (float)j / (float)S; const float c = cospif(x), s = sinpif(x);
                  if (kt == 0) val = (ri == 0) ? (ro == 0 ? c : -s) : 0.f;
                  else if (kt == N1 / 2) val = (ri == 1) ? (ro == 0 ? c : -s) : 0.f;
                  else val = (ro == ri) ? c : (ro == 0 ? s : -s);
                  val *= norm;
              }
              *dst = (bf16)f2bf(val);
          } }
        { bf16* Gt = (bf16*)(ws + WS_GT); LAS float* ct = scr + 2304; LAS float* st = ct + 128;
          for (int i = lane_; i < 128; i += 64) { const float x = (float)i * (1.f / 64.f); ct[i] = cospif(x); st[i] = sinpif(x); }
          LDS_WAIT(); asm volatile("" ::: "memory");
          for (int i = gt; i < 512 * 1024 / 8; i += NGT) { const int n = i >> 7, k8 = (i & 127) * 8; if ((k8 >> 8) != (n >> 7)) *(v4u*)(Gt + (size_t)n * 1024 + k8) = (v4u){0u, 0u, 0u, 0u}; }
          for (int i = gt; i < 4 * 128 * 128; i += NGT) { const int g = i >> 14, c = (i >> 7) & 127, d = i & 127; float are = 0.f, aim = 0.f; const float* wp = wf + (size_t)g * 16384 + d;
#pragma unroll 8
              for (int cp = 0; cp < 128; ++cp) { const int j = (c * cp) & 127; const float w = wp[cp * 128]; are += ct[j] * w; aim += st[j] * w; }
              bf16* o = Gt + (size_t)(g * 128 + d) * 1024 + g * 256 + c; o[0] = (bf16)f2bf(are); o[128] = (bf16)f2bf(aim); } }
        if (F.vcu == 0) {
            float* tab = (float*)(ws + WS_TAB);
            for (int i = tid_; i < 1024; i += NWAVES * 64) { const int h = i >> 8, rel = (i & 255) - 128; tab[i] = relb[t5_bucket(rel) * 4 + h] * LOG2E; }
            if (tid_ == 0) { float s01 = 0.f, s23 = 0.f; for (int d = 0; d < 64; ++d) { s01 += lamp[d] * lamp[64 + d]; s23 += lamp[128 + d] * lamp[192 + d]; }
                tab[1024] = __expf(s01) - __expf(s23) + 0.2f; }
        }
    }
    if (parts & 1) {
        const int gw = F.vcu * NWAVES + F.wave, NGW = F.G * NWAVES;
        for (int m = 4 * gw; m < NTOK; m += 4 * NGW) { const float* xrow0 = m < TPR ? xp + (size_t)m * DM : xs + (size_t)(m - TPR) * DM;
            rms_row4_to_bf16(xrow0, g_mix, (bf16*)(ws + WS_XN) + (size_t)m * DM, lane_); }
        const int gt = F.vcu * (NWAVES * 64) + tid_, NGT = F.G * (NWAVES * 64); bf16* PB = (bf16*)a.out;
        for (int i0 = gt; i0 + 3 * NGT < NTOK * (PLED / 8); i0 += 4 * NGT) { f32x4 v0[4], v1[4];
#pragma unroll
            for (int k = 0; k < 4; ++k) { const int i = i0 + k * NGT, row = i >> 5, c8 = (i & 31) * 8; const float* src = (row < TPR ? pp + (size_t)row * PLED : ps + (size_t)(row - TPR) * PLED) + c8;
                v0[k] = *(const f32x4*)src; v1[k] = *(const f32x4*)(src + 4); }
#pragma unroll
            for (int k = 0; k < 4; ++k) { const int i = i0 + k * NGT, row = i >> 5, c8 = (i & 31) * 8; v4u o; o.x = pk2(v0[k].x, v0[k].y); o.y = pk2(v0[k].z, v0[k].w); o.z = pk2(v1[k].x, v1[k].y); o.w = pk2(v1[k].z, v1[k].w);
                *(v4u*)(PB + (size_t)row * PLED + c8) = o; } }
    }
}
typedef short s16x4_t __attribute__((ext_vector_type(4)));
__device__ __forceinline__ s16x4_t trd(const LAS bf16* p) { return __builtin_bit_cast(s16x4_t, __builtin_amdgcn_ds_read_tr16_b64_v4i16((LAS s16x4_t*)p)); }
template <int MK> struct NNRegs { v4u ra[MK * MK / 8 / (NWAVES * 64)], rb[MK * 16 / (NWAVES * 64)]; };
template <int MK, bool BLK = false>
__device__ __forceinline__ void nn_load(NNRegs<MK>& R, const bf16* A, const bf16* B, size_t ldb, int tid) {
    constexpr int NA = MK * MK / 8 / (NWAVES * 64), NB = MK * 16 / (NWAVES * 64);
    static_assert(NA * NWAVES * 64 * 8 == MK * MK && NB * NWAVES * 64 == MK * 16, "staging trip counts");
#pragma unroll
    for (int i = 0; i < NA; ++i) { const int idx = tid + i * (NWAVES * 64), r = idx / (MK / 8), c = idx % (MK / 8); R.ra[i] = *(const v4u*)(A + r * MK + c * 8); }
#pragma unroll
    for (int i = 0; i < NB; ++i) { const int idx = tid + i * (NWAVES * 64), r = idx >> 4, c = idx & 15; R.rb[i] = *(const v4u*)(B + (size_t)r * ldb + (BLK ? (c >> 2) * 512 + (c & 3) * 8 : c * 8)); }
}
template <int MK>
__device__ __forceinline__ void nn_stage(LAS unsigned char* lds, const NNRegs<MK>& R, int tid) {
    constexpr int AST = MK + 8, BST = 136, NA = MK * MK / 8 / (NWAVES * 64), NB = MK * 16 / (NWAVES * 64);
    LAS bf16* As = (LAS bf16*)lds; LAS bf16* Bs = (LAS bf16*)(lds + 40960);
    LDS_WAIT(); __builtin_amdgcn_s_barrier(); asm volatile("" ::: "memory");
#pragma unroll
    for (int i = 0; i < NA; ++i) { const int idx = tid + i * (NWAVES * 64), r = idx / (MK / 8), c = idx % (MK / 8); *(LAS v4u*)(As + r * AST + c * 8) = R.ra[i]; }
#pragma unroll
    for (int i = 0; i < NB; ++i) { const int idx = tid + i * (NWAVES * 64), r = idx >> 4, c = idx & 15; *(LAS v4u*)(Bs + r * BST + c * 8) = R.rb[i]; }
    LDS_WAIT(); __builtin_amdgcn_s_barrier(); asm volatile("" ::: "memory");
}
template <int MK>
__device__ __forceinline__ void nn_mfma(LAS unsigned char* lds, int tid, f32x4 (&acc)[MK / 16]) {
    constexpr int AST = MK + 8, BST = 136;
    const LAS bf16* As = (const LAS bf16*)lds; const LAS bf16* Bs = (const LAS bf16*)(lds + 40960);
    const int w = tid >> 6, l = tid & 63, lr = l & 15, lq = l >> 4;
#pragma unroll
    for (int mt = 0; mt < MK / 16; ++mt) acc[mt] = (f32x4){0.f, 0.f, 0.f, 0.f};
#pragma unroll
    for (int ks = 0; ks < MK / 32; ++ks) {
        const LAS bf16* bp = Bs + (ks * 32 + 8 * lq + (lr >> 2)) * BST + 16 * w + 4 * (lr & 3);
        const s16x4_t blo = trd(bp), bhi = trd(bp + 4 * BST);
        const bf16x8 bfr = {blo[0], blo[1], blo[2], blo[3], bhi[0], bhi[1], bhi[2], bhi[3]};
#pragma unroll
        for (int mt = 0; mt < MK / 16; ++mt) { const bf16x8 afr = *(const LAS bf16x8*)(As + (mt * 16 + lr) * AST + ks * 32 + 8 * lq);
            acc[mt] = __builtin_amdgcn_mfma_f32_16x16x32_bf16(bfr, afr, acc[mt], 0, 0, 0); }
    }
}
template <int MK>
__device__ __forceinline__ void nn_tile(LAS unsigned char* lds, const bf16* A, const bf16* B, size_t ldb, int tid, f32x4 (&acc)[MK / 16]) {
    NNRegs<MK> R; nn_load<MK>(R, A, B, ldb, tid); nn_stage<MK>(lds, R, tid); nn_mfma<MK>(lds, tid, acc);
}
template <int MK>
__device__ __forceinline__ void fft_stage1_run(LAS unsigned char* lds, const bf16* H1, const bf16* QU, bf16* Y, int tokbase, int seqlen, int first, int nitems, int G, int tid) {
    if (first >= nitems) return;
    NNRegs<MK> R;
#define S1_SRC(it) (QU + blk512(tokbase + ((it) >> 8) * seqlen + (((it) & 255) >> 2), (((it) & 255) & 3) * 128))
    nn_load<MK, true>(R, H1, S1_SRC(first), (size_t)32768, tid);
    for (int it = first; it < nitems; it += G) {
        nn_stage<MK>(lds, R, tid);
        if (it + G < nitems) nn_load<MK, true>(R, H1, S1_SRC(it + G), (size_t)32768, tid);
        f32x4 acc[MK / 16]; nn_mfma<MK>(lds, tid, acc);
        const int tok0 = tokbase + (it >> 8) * seqlen, nt = it & 255, s2 = nt >> 2, ch0 = (nt & 3) * 128;
        const int w = tid >> 6, l = tid & 63, lr = l & 15, lq = l >> 4;
        bf16* yb = Y + (size_t)tok0 * 512 + (size_t)s2 * 512 + ch0 + 16 * w + 4 * lq;
#pragma unroll
        for (int mt = 0; mt < MK / 16; ++mt) { const int r = mt * 16 + lr; v2u o; o.x = pk2(acc[mt][0], acc[mt][1]); o.y = pk2(acc[mt][2], acc[mt][3]); *(v2u*)(yb + (size_t)r * (64 * 512)) = o; }
    }
#undef S1_SRC
}
template <int MK>
__device__ __forceinline__ void fft_stage1_item(LAS unsigned char* lds, const bf16* H1, const bf16* QU, bf16* Y, int tok0, int nt, int tid) {
    const int s2 = nt >> 2, ch0 = (nt & 3) * 128;
    f32x4 acc[MK / 16];
    nn_tile<MK>(lds, H1, QU + (size_t)(tok0 + s2) * 1024 + 512 + ch0, (size_t)64 * 1024, tid, acc);
    const int w = tid >> 6, l = tid & 63, lr = l & 15, lq = l >> 4;
    bf16* yb = Y + (size_t)tok0 * 512 + (size_t)s2 * 512 + ch0 + 16 * w + 4 * lq;
#pragma unroll
    for (int mt = 0; mt < MK / 16; ++mt) { const int r = mt * 16 + lr; v2u o; o.x = pk2(acc[mt][0], acc[mt][1]); o.y = pk2(acc[mt][2], acc[mt][3]); *(v2u*)(yb + (size_t)r * (64 * 512)) = o; }
}
__device__ __forceinline__ void fft_stage2_item(LAS unsigned char* lds, const bf16* M2, const bf16* Y, bf16* XP, int tok0, int S, int N1, int kt, int g, int tid) {
    const int p = (kt == 0 || kt == N1 / 2) ? 0 : kt;
    f32x4 acc[8];
    nn_tile<128>(lds, M2 + (size_t)kt * 16384, Y + (size_t)tok0 * 512 + (size_t)(2 * p * 64) * 512 + g * 128, (size_t)512, tid, acc);
    const int w = tid >> 6, l = tid & 63, lr = l & 15, lq = l >> 4; const int c = 16 * w + 4 * lq; const bool mir = (kt != 0 && kt != N1 / 2);
#pragma unroll
    for (int mt = 0; mt < 8; ++mt) { const int m = mt * 16 + lr, ro = m >> 6, k2 = m & 63, sp = kt + N1 * k2;
        v2u o; o.x = pk2(acc[mt][0], acc[mt][1]); o.y = pk2(acc[mt][2], acc[mt][3]);
        *(v2u*)(XP + (size_t)(tok0 + sp) * 1024 + g * 256 + ro * 128 + c) = o;
        if (mir) { if (ro) { o.x ^= 0x80008000u; o.y ^= 0x80008000u; } *(v2u*)(XP + (size_t)(tok0 + S - sp) * 1024 + g * 256 + ro * 128 + c) = o; } }
}

__device__ __forceinline__ void fft_stage2c_item(LAS unsigned char* lds, const bf16* M2, const bf16* Y, const bf16* Gt, const bf16* GF, bf16* QU, int tok0, int S, int N1, int kt, int g, int tid) {
    const int p = (kt == 0 || kt == N1 / 2) ? 0 : kt;
    const int w = tid >> 6, l = tid & 63, lr = l & 15, lq = l >> 4; const bool mir = (kt != 0 && kt != N1 / 2);
    bf16x8 gre[4], gim[4];
    { const bf16* gp = Gt + (size_t)(g * 128 + 16 * w + lr) * 1024 + g * 256 + 8 * lq;
#pragma unroll
      for (int ks = 0; ks < 4; ++ks) { gre[ks] = *(const bf16x8*)(gp + ks * 32); gim[ks] = *(const bf16x8*)(gp + 128 + ks * 32); } }
    const int d0 = g * 128 + 16 * w + 4 * lq;
    v2u gwa[4], gwb[4];
#pragma unroll
    for (int tb = 0; tb < 4; ++tb) { const int sp = kt + N1 * (16 * tb + lr); gwa[tb] = *(const v2u*)(GF + (size_t)(tok0 + sp) * 512 + d0);
        if (mir) gwb[tb] = *(const v2u*)(GF + (size_t)(tok0 + S - sp) * 512 + d0); else gwb[tb] = (v2u){0u, 0u}; }
    f32x4 acc[8];
    nn_tile<128>(lds, M2 + (size_t)kt * 16384, Y + (size_t)tok0 * 512 + (size_t)(2 * p * 64) * 512 + g * 128, (size_t)512, tid, acc);
    constexpr int XST = 136; LAS bf16* XL = (LAS bf16*)(lds + 81920);
#pragma unroll
    for (int mt = 0; mt < 8; ++mt) { v2u o; o.x = pk2(acc[mt][0], acc[mt][1]); o.y = pk2(acc[mt][2], acc[mt][3]); *(LAS v2u*)(XL + (mt * 16 + lr) * XST + 16 * w + 4 * lq) = o; }
    __syncthreads();
    f32x4 P[4], Q[4];
#pragma unroll
    for (int tb = 0; tb < 4; ++tb) { P[tb] = (f32x4){0.f, 0.f, 0.f, 0.f}; Q[tb] = (f32x4){0.f, 0.f, 0.f, 0.f};
#pragma unroll
        for (int ks = 0; ks < 4; ++ks) { const bf16x8 xre = *(const LAS bf16x8*)(XL + (16 * tb + lr) * XST + ks * 32 + 8 * lq), xim = *(const LAS bf16x8*)(XL + (64 + 16 * tb + lr) * XST + ks * 32 + 8 * lq);
            P[tb] = __builtin_amdgcn_mfma_f32_16x16x32_bf16(gre[ks], xre, P[tb], 0, 0, 0); Q[tb] = __builtin_amdgcn_mfma_f32_16x16x32_bf16(gim[ks], xim, Q[tb], 0, 0, 0); } }
#pragma unroll
    for (int tb = 0; tb < 4; ++tb) { const int sp = kt + N1 * (16 * tb + lr);
        { const size_t t = (size_t)(tok0 + sp); const v2u gw = gwa[tb]; const f32x4 f = P[tb] + Q[tb]; v2u o;
          o.x = pk2(f[0] * pg8::silu(pg8::bflo(gw.x)), f[1] * pg8::silu(pg8::bfhi(gw.x))); o.y = pk2(f[2] * pg8::silu(pg8::bflo(gw.y)), f[3] * pg8::silu(pg8::bfhi(gw.y)));
          *(v2u*)(QU + t * 1024 + 512 + d0) = o; }
        if (mir) { const size_t t = (size_t)(tok0 + S - sp); const v2u gw = gwb[tb]; const f32x4 f = P[tb] - Q[tb]; v2u o;
          o.x = pk2(f[0] * pg8::silu(pg8::bflo(gw.x)), f[1] * pg8::silu(pg8::bfhi(gw.x))); o.y = pk2(f[2] * pg8::silu(pg8::bflo(gw.y)), f[3] * pg8::silu(pg8::bfhi(gw.y)));
          *(v2u*)(QU + t * 1024 + 512 + d0) = o; } }
}
struct S2Regs { NNRegs<128> T; bf16x8 gre[4], gim[4]; v2u gwa[4], gwb[4]; };
__device__ __forceinline__ void s2c_load(S2Regs& R, const bf16* M2, const bf16* Y, const bf16* Gt, const bf16* GF, int tok0, int S, int N1, int kt, int g, int tid) {
    const int p = (kt == 0 || kt == N1 / 2) ? 0 : kt;
    const int w = tid >> 6, l = tid & 63, lr = l & 15, lq = l >> 4; const bool mir = (kt != 0 && kt != N1 / 2);
    { const bf16* gp = Gt + (size_t)(g * 128 + 16 * w + lr) * 1024 + g * 256 + 8 * lq;
#pragma unroll
      for (int ks = 0; ks < 4; ++ks) { R.gre[ks] = *(const bf16x8*)(gp + ks * 32); R.gim[ks] = *(const bf16x8*)(gp + 128 + ks * 32); } }
    const int d0 = g * 128 + 16 * w + 4 * lq;
#pragma unroll
    for (int tb = 0; tb < 4; ++tb) { const int sp = kt + N1 * (16 * tb + lr); R.gwa[tb] = *(const v2u*)(GF + blk512(tok0 + sp, d0));
        if (mir) R.gwb[tb] = *(const v2u*)(GF + blk512(tok0 + S - sp, d0)); else R.gwb[tb] = (v2u){0u, 0u}; }
    nn_load<128>(R.T, M2 + (size_t)kt * 16384, Y + (size_t)tok0 * 512 + (size_t)(2 * p * 64) * 512 + g * 128, (size_t)512, tid);
}
__device__ __forceinline__ void fft_stage2c_run(LAS unsigned char* lds, const bf16* M2, const bf16* Y, const bf16* Gt, const bf16* GF, bf16* QU, int tokbase, int S, int N1, int perb, int first, int nitems, int G, int tid) {
    if (first >= nitems) return;
    S2Regs R;
#define S2_ARGS(it) tokbase + ((it) / perb) * S, S, N1, ((it) % perb) >> 2, ((it) % perb) & 3
    s2c_load(R, M2, Y, Gt, GF, S2_ARGS(first), tid);
    for (int it = first; it < nitems; it += G) {
        const int tok0 = tokbase + (it / perb) * S, kt = (it % perb) >> 2, g = (it % perb) & 3;
        const int w = tid >> 6, l = tid & 63, lr = l & 15, lq = l >> 4; const bool mir = (kt != 0 && kt != N1 / 2);
        nn_stage<128>(lds, R.T, tid);
        bf16x8 gre[4], gim[4]; v2u gwa[4], gwb[4];
#pragma unroll
        for (int k = 0; k < 4; ++k) { gre[k] = R.gre[k]; gim[k] = R.gim[k]; gwa[k] = R.gwa[k]; gwb[k] = R.gwb[k]; }
        if (it + G < nitems) s2c_load(R, M2, Y, Gt, GF, S2_ARGS(it + G), tid);
        f32x4 acc[8]; nn_mfma<128>(lds, tid, acc);
        constexpr int XST = 136; LAS bf16* XL = (LAS bf16*)(lds + 81920);
#pragma unroll
        for (int mt = 0; mt < 8; ++mt) { v2u o; o.x = pk2(acc[mt][0], acc[mt][1]); o.y = pk2(acc[mt][2], acc[mt][3]); *(LAS v2u*)(XL + (mt * 16 + lr) * XST + 16 * w + 4 * lq) = o; }
        LDS_WAIT(); __builtin_amdgcn_s_barrier(); asm volatile("" ::: "memory");
        f32x4 P[4], Q[4];
#pragma unroll
        for (int tb = 0; tb < 4; ++tb) { P[tb] = (f32x4){0.f, 0.f, 0.f, 0.f}; Q[tb] = (f32x4){0.f, 0.f, 0.f, 0.f};
#pragma unroll
            for (int ks = 0; ks < 4; ++ks) { const bf16x8 xre = *(const LAS bf16x8*)(XL + (16 * tb + lr) * XST + ks * 32 + 8 * lq), xim = *(const LAS bf16x8*)(XL + (64 + 16 * tb + lr) * XST + ks * 32 + 8 * lq);
                P[tb] = __builtin_amdgcn_mfma_f32_16x16x32_bf16(gre[ks], xre, P[tb], 0, 0, 0); Q[tb] = __builtin_amdgcn_mfma_f32_16x16x32_bf16(gim[ks], xim, Q[tb], 0, 0, 0); } }
        const int d0 = g * 128 + 16 * w + 4 * lq;
#pragma unroll
        for (int tb = 0; tb < 4; ++tb) { const int sp = kt + N1 * (16 * tb + lr);
            { const size_t t = (size_t)(tok0 + sp); const v2u gw = gwa[tb]; const f32x4 f = P[tb] + Q[tb]; v2u o;
              o.x = pk2(f[0] * pg8::silu(pg8::bflo(gw.x)), f[1] * pg8::silu(pg8::bfhi(gw.x))); o.y = pk2(f[2] * pg8::silu(pg8::bflo(gw.y)), f[3] * pg8::silu(pg8::bfhi(gw.y)));
              *(v2u*)(QU + t * 1024 + 512 + d0) = o; }
            if (mir) { const size_t t = (size_t)(tok0 + S - sp); const v2u gw = gwb[tb]; const f32x4 f = P[tb] - Q[tb]; v2u o;
              o.x = pk2(f[0] * pg8::silu(pg8::bflo(gw.x)), f[1] * pg8::silu(pg8::bfhi(gw.x))); o.y = pk2(f[2] * pg8::silu(pg8::bflo(gw.y)), f[3] * pg8::silu(pg8::bfhi(gw.y)));
              *(v2u*)(QU + t * 1024 + 512 + d0) = o; } }
    }
#undef S2_ARGS
}
__global__ void __launch_bounds__(NWAVES * 64, 2) mk_fwd(Args args) {
    extern __shared__ __attribute__((aligned(16))) unsigned char lds[];
    Frame F;
    F.lds = (LAS unsigned char*)lds;
    F.MISC = (volatile LAS unsigned*)(F.lds + MISC_OFF);
    F.wave = __builtin_amdgcn_readfirstlane((int)threadIdx.x >> 6);
    F.G = gridDim.x; { const int bx = blockIdx.x; F.vcu = (F.G % 8 == 0) ? (bx % 8) * (F.G / 8) + bx / 8 : bx; }
    unsigned char* ws = args.ws;
    F.ctl = (unsigned*)(ws + WS_CTL);
    for (int u = threadIdx.x; u < (LDS_BYTES - LDSCTL_OFF) / 4; u += NWAVES * 64) ((LAS unsigned*)(F.lds + LDSCTL_OFF))[u] = 0u;
    __syncthreads();
    XcdBarrier bar = xcd_barrier_post(F.ctl + 1024, F.MISC + 8);
    { const unsigned simd = (unsigned)__builtin_amdgcn_s_getreg((1 << 11) | (4 << 6) | 4) & 3u;
      if ((threadIdx.x & 63) == 0) F.MISC[48 + F.wave] = simd;
      __syncthreads();
      unsigned cnt0 = 0, cnt1 = 0, cnt2 = 0, cnt3 = 0, rank = 0;
#pragma unroll
      for (int w = 0; w < NWAVES; ++w) { const unsigned sw = F.MISC[48 + w]; cnt0 += sw == 0u; cnt1 += sw == 1u; cnt2 += sw == 2u; cnt3 += sw == 3u; rank += (w < F.wave && sw == simd) ? 1u : 0u; }
      const bool ok = cnt0 == 2u && cnt1 == 2u && cnt2 == 2u && cnt3 == 2u;
      F.role = __builtin_amdgcn_readfirstlane(ok ? (int)((rank << 2) | simd) : (((F.wave >> 2) << 2) | (F.wave & 3)));
#if defined(ROLE_PARITY)
      F.role = ((F.wave & 1) << 2) | (F.wave >> 1);
#endif
    }
#define GRID_BAR() xcd_barrier(bar)
#define STAGGER(ticks) do { if ((ticks) > 0) { const unsigned long long t0_ = __builtin_amdgcn_s_memrealtime(); const unsigned long long d_ = (unsigned long long)(F.vcu & 3) * (unsigned long long)(ticks); \
    while (__builtin_amdgcn_s_memrealtime() - t0_ < d_) __builtin_amdgcn_s_sleep(8); } } while (0)
#if defined(PROBE_A)
#define STAMP(k) do { if (blockIdx.x == 0 && threadIdx.x == 0) { const unsigned long long t_ = __builtin_amdgcn_s_memrealtime(); F.MISC[16 + 2 * (k)] = (unsigned)t_; F.MISC[17 + 2 * (k)] = (unsigned)(t_ >> 32); } } while (0)
#else
#define STAMP(k) do { } while (0)
#endif
    STAMP(0);
    bf16* const Win_t = (bf16*)(ws + WS_WIN); bf16* const Wout_t = (bf16*)(ws + WS_WOUT); bf16* const Wg_t = (bf16*)(ws + WS_WG); bf16* const Wp_t = (bf16*)(ws + WS_WP);
    bf16* const Gt = (bf16*)(ws + WS_GT); bf16* const XN = (bf16*)(ws + WS_XN); bf16* const XP = (bf16*)(ws + WS_XN); bf16* const QU = (bf16*)(ws + WS_QU);
    bf16* const KB = (bf16*)(ws + WS_K); bf16* const VB = (bf16*)(ws + WS_V); bf16* const H1B = (bf16*)(ws + WS_K); bf16* const GA = (bf16*)(ws + WS_GA); bf16* const GF = (bf16*)(ws + WS_GF);
    bf16* const QB = (bf16*)(ws + WS_QB); bf16* const UB = (bf16*)(ws + WS_UB);
    bf16* const PROJ = (bf16*)(ws + WS_PROJ); bf16* const PB = (bf16*)args.out; bf16* const Y = (bf16*)args.out;
    float* const SSQ1 = (float*)(ws + WS_SSQ1); float* const SSQ2 = (float*)(ws + WS_SSQ2); const float* const TAB = (const float*)(ws + WS_TAB);

    p0_prologue(F, args);
#if defined(DUP_P0)
    p0_prologue(F, args, (DUP_P0 + 0) ? (DUP_P0 + 0) : 3);
#endif
    GRID_BAR(); STAMP(1);
#if defined(DUP_BAR)
    GRID_BAR(); GRID_BAR(); GRID_BAR(); GRID_BAR(); GRID_BAR();
#endif
#if defined(DUP_P1)
    if ((DUP_P1 + 0) == 4) { const unsigned long long t0_ = __builtin_amdgcn_s_memrealtime(); const unsigned long long d_ = (unsigned long long)(F.vcu & 3) * 800ull;
        while (__builtin_amdgcn_s_memrealtime() - t0_ < d_) __builtin_amdgcn_s_sleep(8); }
    { pg8::Gemm g{XN, Win_t, NTOK, NIN, DM, DM, 0}; pg8::StaticOrder S; S.init(NTOK, NIN, F.G, (int)blockIdx.x);
      pg8::EpiInProj E{QB, KB, VB, GA, UB, GF, QSCALE, ((DUP_P1 + 0) >= 2) ? (DUP_P1 + 0) : 0};
      pg8::gemm_phase<pg8::EpiInProj, pg8::StaticOrder, true, true>(F.lds, g, S, E, F.wave); }
    { pg8::Gemm g{PB, Wp_t, NTOK, DM, PLED, PLED, 0}; pg8::StaticOrder S; S.init(NTOK, DM, F.G, (int)blockIdx.x);
      pg8::EpiPlainBf16 E{PROJ, DM};
      pg8::gemm_phase<pg8::EpiPlainBf16, pg8::StaticOrder, true, true>(F.lds, g, S, E, F.wave); }
#endif
    STAGGER(STG_P1);
#if defined(DUP_PROJ)
    { pg8::Gemm g{PB, Wp_t, NTOK, DM, PLED, PLED, 0}; pg8::StaticOrder S; S.init(NTOK, DM, F.G, (int)blockIdx.x);
      pg8::EpiPlainBf16 E{PROJ, DM};
      pg8::gemm_phase<pg8::EpiPlainBf16, pg8::StaticOrder, true, true>(F.lds, g, S, E, F.wave); }
#endif
    if (PROJ_FIRST_MASK && (F.vcu & PROJ_FIRST_MASK) == 0) {
    { pg8::Gemm g{PB, Wp_t, NTOK, DM, PLED, PLED, 0}; pg8::StaticOrder S; S.init(NTOK, DM, F.G, (int)blockIdx.x);
      pg8::EpiPlainBf16 E{PROJ, DM};
      pg8::gemm_phase<pg8::EpiPlainBf16, pg8::StaticOrder, true, true>(F.lds, g, S, E, F.wave); }
    { pg8::Gemm g{XN, Win_t, NTOK, NIN, DM, DM, 0}; pg8::StaticOrder S; S.init(NTOK, NIN, F.G, (int)blockIdx.x);
      pg8::EpiInProj E{QB, KB, VB, GA, UB, GF, QSCALE, 0};
      pg8::gemm_phase<pg8::EpiInProj, pg8::StaticOrder, true, true>(F.lds, g, S, E, F.wave); }
    } else {
    { pg8::Gemm g{XN, Win_t, NTOK, NIN, DM, DM, 0}; pg8::StaticOrder S; S.init(NTOK, NIN, F.G, (int)blockIdx.x);
      pg8::EpiInProj E{QB, KB, VB, GA, UB, GF, QSCALE, 0};
      pg8::gemm_phase<pg8::EpiInProj, pg8::StaticOrder, true, true>(F.lds, g, S, E, F.wave); }
    { pg8::Gemm g{PB, Wp_t, NTOK, DM, PLED, PLED, 0}; pg8::StaticOrder S; S.init(NTOK, DM, F.G, (int)blockIdx.x);
      pg8::EpiPlainBf16 E{PROJ, DM};
      pg8::gemm_phase<pg8::EpiPlainBf16, pg8::StaticOrder, true, true>(F.lds, g, S, E, F.wave); }
    }
    GRID_BAR(); STAMP(2);
#if defined(DUP_FFT)
    { constexpr int NIT_P = NBP * 256, NIT_S = NBS * 256;
      for (int it = F.vcu; it < NIT_P + NIT_S; it += F.G) {
          if (it < NIT_P) fft_stage1_item<64>(F.lds, (const bf16*)(ws + WS_H1A), QU, Y, (it >> 8) * SEQP, it & 255, opq_tid(F.wave));
          else { const int r = it - NIT_P; fft_stage1_item<128>(F.lds, (const bf16*)(ws + WS_H1B), QU, Y, TPR + (r >> 8) * SEQS, r & 255, opq_tid(F.wave)); } } }
    GRID_BAR(); STAMP(10);
    { constexpr int NIT_P = NBP * 33 * 4, NIT_S = NBS * 65 * 4;
      for (int it = F.vcu; it < NIT_P + NIT_S; it += F.G) {
          if (it < NIT_P) { const int b = it / 132, r = it % 132; fft_stage2_item(F.lds, (const bf16*)(ws + WS_M2A), Y, XP, b * SEQP, SEQP, 64, r >> 2, r & 3, opq_tid(F.wave)); }
          else { const int q = it - NIT_P, b = q / 260, r = q % 260; fft_stage2_item(F.lds, (const bf16*)(ws + WS_M2B), Y, XP, TPR + b * SEQS, SEQS, 128, r >> 2, r & 3, opq_tid(F.wave)); } } }
    GRID_BAR(); STAMP(11);
#endif
    { constexpr int NIT_P = NBP * 256, NIT_S = NBS * 256;
      const int nP = F.vcu < NIT_P ? (NIT_P - F.vcu + F.G - 1) / F.G : 0, firstS = F.vcu + nP * F.G - NIT_P;
      fft_stage1_run<64>(F.lds, (const bf16*)(ws + WS_H1A), UB, Y, 0, SEQP, F.vcu, NIT_P, F.G, opq_tid(F.wave));
      fft_stage1_run<128>(F.lds, (const bf16*)(ws + WS_H1B), UB, Y, TPR, SEQS, firstS, NIT_S, F.G, opq_tid(F.wave)); }
    GRID_BAR(); STAMP(3);
    { constexpr int NIT_P = NBP * 33 * 4, NIT_S = NBS * 65 * 4;
      const int nP = F.vcu < NIT_P ? (NIT_P - F.vcu + F.G - 1) / F.G : 0, firstS = F.vcu + nP * F.G - NIT_P;
      fft_stage2c_run(F.lds, (const bf16*)(ws + WS_M2A), Y, Gt, GF, QU, 0, SEQP, 64, 132, F.vcu, NIT_P, F.G, opq_tid(F.wave));
      fft_stage2c_run(F.lds, (const bf16*)(ws + WS_M2B), Y, Gt, GF, QU, TPR, SEQS, 128, 260, firstS, NIT_S, F.G, opq_tid(F.wave));
      __syncthreads(); }
    STAMP(4); STAMP(5);
#if defined(PROBE_CLK)
    unsigned long long ck_c0 = 0, ck_r0 = 0, ck_c1 = 0, ck_r1 = 0;
    if (PROBE_CLK == 2) { ck_c0 = __builtin_amdgcn_s_memtime(); ck_r0 = __builtin_amdgcn_s_memrealtime(); }
#endif
    { const float lam = TAB[1024]; const float* subg = args.in[7];
      const int xl = F.vcu >> 5, cu = F.vcu & 31;
#if defined(DUP_ATT)
      for (int rep = 0; rep < 2; ++rep)
#endif
      for (int i = 0; i < 6; ++i) {
          int tok0, seq, h, q0;
          if (i < 2) { const int pr = xl; tok0 = TPR + (pr >> 2) * SEQS; seq = SEQS; h = pr & 3; q0 = (cu + 32 * i) * 128; }
          else { const int pr = xl + 8 * (i - 2); tok0 = (pr >> 2) * SEQP; seq = SEQP; h = pr & 3; q0 = cu * 128; }
#if defined(DUP_ATT)
          if (rep == 0) ATTNS::attn_unit<DUP_ATT>(QB, XP, KB, VB, GA, TAB, subg, lam, tok0, seq, h, q0, F.lds, F.wave, F.role); else ATTNS::attn_unit<0>(QB, QU, KB, VB, GA, TAB, subg, lam, tok0, seq, h, q0, F.lds, F.wave, F.role);
#else
          ATTNS::attn_unit<0>(QB, QU, KB, VB, GA, TAB, subg, lam, tok0, seq, h, q0, F.lds, F.wave, F.role);
#endif
      } }
#if defined(PROBE_CLK)
    if (PROBE_CLK == 2) { ck_c1 = __builtin_amdgcn_s_memtime(); ck_r1 = __builtin_amdgcn_s_memrealtime(); }
#endif
    GRID_BAR(); STAMP(6);
#if defined(DUP_P3)
    { pg8::Gemm g{QU, Wout_t, NTOK, DM, DM, DM, 0}; pg8::StaticOrder S; S.init(NTOK, DM, F.G, (int)blockIdx.x);
      pg8::EpiOutProj E{args.in[0], args.in[1], args.out, H1B, SSQ1};
      pg8::gemm_phase<pg8::EpiOutProj, pg8::StaticOrder, P3_ALIGN, true>(F.lds, g, S, E, F.wave); }
#endif
    STAGGER(STG_P3);
    { pg8::Gemm g{QU, Wout_t, NTOK, DM, DM, DM, 0}; pg8::StaticOrder S; S.init(NTOK, DM, F.G, (int)blockIdx.x);
      pg8::EpiOutProj E{args.in[0], args.in[1], args.out, H1B, SSQ1};
      pg8::gemm_phase<pg8::EpiOutProj, pg8::StaticOrder, P3_ALIGN, true>(F.lds, g, S, E, F.wave); }
    GRID_BAR(); STAMP(7);
    STAGGER(STG_P4);
    { pg8::Gemm g{H1B, Wg_t, NTOK, DM, DM, DM, 0}; pg8::StaticOrder S; S.init(NTOK, DM, F.G, (int)blockIdx.x);
      pg8::EpiGateNorm E{args.out, H1B, PROJ, SSQ1, args.in[14], SSQ2, F.ctl + 16384, F.lds + RING_BYTES + 1024};
      pg8::gemm_phase<pg8::EpiGateNorm, pg8::StaticOrder, true, true>(F.lds, g, S, E, F.wave); }
    STAMP(8);
    STAMP(9);
#if defined(PROBE_CLK)
    GRID_BAR();
    if (blockIdx.x == 0 && threadIdx.x == 0) { const float ghz = 0.1f * (float)(ck_c1 - ck_c0) / (float)(ck_r1 - ck_r0); const float v = 20.f * rintf(ghz * 5.f); for (int i = 0; i < 8; ++i) args.out[i] = v; }
#endif
#if defined(PROBE_A)
    if (blockIdx.x == 0) { asm volatile("s_waitcnt vmcnt(0) lgkmcnt(0)" ::: "memory"); __syncthreads();
        const unsigned long long ta = ((unsigned long long)F.MISC[17 + 2 * PROBE_A] << 32) | F.MISC[16 + 2 * PROBE_A], tb = ((unsigned long long)F.MISC[17 + 2 * PROBE_B] << 32) | F.MISC[16 + 2 * PROBE_B];
        const float v = (float)(tb - ta) * 0.0001f; for (int i = 0; i < 8; ++i) args.out[threadIdx.x * 8 + i] = v; }
#endif
#undef GRID_BAR
}

extern "C" void kernel_launch(void* const* d_in, const int* in_sizes, int n_in, void* d_out, int out_size, void* d_ws, size_t ws_size, hipStream_t stream) {
    static int grid = 0;
    if (grid == 0) {
        if (n_in != 15 || in_sizes[0] != TPR * DM || out_size != NTOK * DM || ws_size < WS_END) {
            fprintf(stderr, "kernel_launch: shape mismatch: n_in %d in0 %d out %d ws %zu (need %zu)\n", n_in, n_in > 0 ? in_sizes[0] : -1, out_size, ws_size, (size_t)WS_END); grid = -1; return; }
        int dev = 0, cus = 0;
        if (hipGetDevice(&dev) != hipSuccess || hipDeviceGetAttribute(&cus, hipDeviceAttributeMultiprocessorCount, dev) != hipSuccess) { fprintf(stderr, "kernel_launch: device query failed\n"); grid = -1; return; }
        if (hipFuncSetAttribute((const void*)mk_fwd, hipFuncAttributeMaxDynamicSharedMemorySize, LDS_BYTES) != hipSuccess) { fprintf(stderr, "kernel_launch: hipFuncSetAttribute failed\n"); grid = -1; return; }
        (void)hipGetLastError();
        grid = cus;
        if (grid != 256) fprintf(stderr, "kernel_launch: %d CUs; this kernel's attention schedule assumes 256\n", grid);
    }
    if (grid < 0) return;
    if (hipMemsetAsync((char*)d_ws + WS_CTL, 0, CTL_ZERO_BYTES, stream) != hipSuccess) { fprintf(stderr, "kernel_launch: memset failed\n"); return; }
    Args a{};
    for (int i = 0; i < 15; ++i) a.in[i] = (const float*)d_in[i];
    a.out = (float*)d_out; a.ws = (unsigned char*)d_ws;
    hipLaunchKernelGGL(mk_fwd, dim3(grid), dim3(NWAVES * 64), LDS_BYTES, stream, a);
    const hipError_t le = hipPeekAtLastError();
    if (le != hipSuccess) fprintf(stderr, "kernel_launch: launch failed: %s\n", hipGetErrorName(le));
}
```

```cpp
#include <hip/hip_runtime.h>
#include <cstdio>
#include <cstdint>
#define PRIO_MODE 2
#define ATTNS att3
#define STG_P1 0
#define PROJ_FIRST_MASK 0
#define STG_P3 0
#define P3_ALIGN true
#define STG_P4 0
__device__ __forceinline__ int opq_tid(int wave) { int l; asm volatile("v_mbcnt_lo_u32_b32 %0, -1, 0\n\tv_mbcnt_hi_u32_b32 %0, -1, %0" : "=v"(l)); return wave * 64 + l; }
__device__ __forceinline__ float bperm_f(int srclane, float v) { return __int_as_float(__builtin_amdgcn_ds_bpermute(srclane << 2, __float_as_int(v))); }
__device__ __forceinline__ size_t blk512(int row, int col) { return ((size_t)(((row >> 4) << 4) + (col >> 5)) << 9) + (size_t)(((row & 15) << 5) + (col & 31)); }
__device__ __forceinline__ size_t blk1024(int row, int col) { return ((size_t)(((row >> 4) << 5) + (col >> 5)) << 9) + (size_t)(((row & 15) << 5) + (col & 31)); }
namespace pg8 {
#define PG8_LAS __attribute__((address_space(3)))
typedef unsigned short bf16_t;
typedef short bf16x8 __attribute__((ext_vector_type(8)));
typedef float f32x4 __attribute__((ext_vector_type(4)));
typedef unsigned u32x4 __attribute__((ext_vector_type(4)));
constexpr int BM = 256, BK = 64, HALF = 128, HTB = HALF * BK * 2  , STAGE_BYTES = 8 * HTB, NXCD = 8, WGM = 8;

__host__ __device__ __forceinline__ int lds_byte(int r, int c) { const int st = (r >> 4) * 2 + (c >> 5), rr = r & 15, cc = c & 31, ob = rr * 64 + cc * 2; return st * 1024 + (ob ^ (((ob >> 9) & 1) << 5)); }
__host__ __device__ __forceinline__ void stage_rc(int b, int& R, int& C) { const int st = b / 1024, sb = b % 1024, swz = sb ^ (((sb >> 9) & 1) << 5); R = (st >> 1) * 16 + swz / 64; C = (st & 1) * 32 + (swz % 64) / 2; }
__host__ __device__ __forceinline__ int perm32(int rho) { const int n = rho >> 4, i = rho & 15; return 8 * (i >> 2) + 4 * n + (i & 3); }

struct Unit { int pm, pn; };
struct Gemm { const bf16_t* A; const bf16_t* Bt; int M, N, K, ld, koff_pn, ablk; };

struct StaticOrder {
    int nM, nN, nwg, G, c;
    __host__ __device__ void init(int M, int N, int G_, int c_) { nM = M / BM; nN = N / BM; nwg = nM * nN; G = G_; c = c_; }
    __host__ __device__ bool next(int i, Unit& u) const {
        const long L = (long)i * G + c; if (L >= nwg) return false;
        int wgid = (int)L; { const int q = nwg / NXCD, r = nwg % NXCD, xcd = wgid % NXCD, off = wgid / NXCD; wgid = (xcd < r ? xcd * (q + 1) : r * (q + 1) + (xcd - r) * q) + off; }
        const int nig = WGM * nN, gid = wgid / nig, fm = gid * WGM, gsz = (nM - fm) < WGM ? (nM - fm) : WGM;
        u.pm = fm + ((wgid % nig) % gsz); u.pn = (wgid % nig) / gsz; return true;
    }
    __device__ __forceinline__ void a_ready(const Unit&) const {}
    __device__ __forceinline__ void done(const Unit&) const {}
};

__device__ __forceinline__ unsigned cvt_pk_bf16(float lo, float hi) { unsigned r; asm volatile("v_cvt_pk_bf16_f32 %0, %1, %2" : "=v"(r) : "v"(lo), "v"(hi)); return r; }
typedef float f32x2 __attribute__((ext_vector_type(2)));
typedef unsigned u32x2 __attribute__((ext_vector_type(2)));
__device__ __forceinline__ float bflo(unsigned w) { return __uint_as_float(w << 16); }
__device__ __forceinline__ float bfhi(unsigned w) { return __uint_as_float(w & 0xffff0000u); }
__device__ __forceinline__ float sigm(float a) { return __builtin_amdgcn_rcpf(1.f + __expf(-a)); }
__device__ __forceinline__ float silu(float a) { return a * sigm(a); }

struct EpiInProj {
    static constexpr bool PERM = true, AFTER_DRAIN = false;
    bf16_t* qb; bf16_t* kb; bf16_t* vb; bf16_t* ga; bf16_t* ub; bf16_t* gf; float qscale; int nostore;
    __device__ __forceinline__ void operator()(const f32x4 (&acc)[2][2][4][2], const Unit& u, int wr, int wc, int fr, int fq) const {
        const int seg = u.pn >> 1, colt = (u.pn & 1) * BM;
        bf16_t* base; float sc = 1.f;
        if (seg == 0) { base = qb; sc = qscale; } else if (seg == 1) base = kb; else if (seg == 2) base = vb; else if (seg == 3) base = ga; else if (seg == 4) base = ub; else base = gf;
        const int row0 = u.pm * BM + wr * 64 + fr, col0 = colt + wc * 32 + 8 * fq;
#pragma unroll
        for (int ai = 0; ai < 2; ++ai)
#pragma unroll
            for (int m = 0; m < 4; ++m) { const int row = row0 + ai * HALF + m * 16;
#pragma unroll
                for (int bj = 0; bj < 2; ++bj) { const f32x4 v0 = acc[ai][bj][m][0] * sc, v1 = acc[ai][bj][m][1] * sc;
                    u32x4 w; w.x = cvt_pk_bf16(v0[0], v0[1]); w.y = cvt_pk_bf16(v0[2], v0[3]); w.z = cvt_pk_bf16(v1[0], v1[1]); w.w = cvt_pk_bf16(v1[2], v1[3]);
                    if (nostore == 0) __builtin_nontemporal_store(w, (u32x4*)(base + blk512(row, col0 + bj * HALF))); else asm volatile("" :: "v"(w)); } }
    }
};
struct EpiPlainBf16 {
    static constexpr bool PERM = true, AFTER_DRAIN = false;
    bf16_t* O; int ldc;
    __device__ __forceinline__ void operator()(const f32x4 (&acc)[2][2][4][2], const Unit& u, int wr, int wc, int fr, int fq) const {
        const int row0 = u.pm * BM + wr * 64 + fr, col0 = u.pn * BM + wc * 32 + 8 * fq;
#pragma unroll
        for (int ai = 0; ai < 2; ++ai)
#pragma unroll
            for (int m = 0; m < 4; ++m) { const int row = row0 + ai * HALF + m * 16;
#pragma unroll
                for (int bj = 0; bj < 2; ++bj) { const f32x4 v0 = acc[ai][bj][m][0], v1 = acc[ai][bj][m][1];
                    u32x4 w; w.x = cvt_pk_bf16(v0[0], v0[1]); w.y = cvt_pk_bf16(v0[2], v0[3]); w.z = cvt_pk_bf16(v1[0], v1[1]); w.w = cvt_pk_bf16(v1[2], v1[3]);
                    __builtin_nontemporal_store(w, (u32x4*)(O + blk1024(row, col0 + bj * HALF))); } }
    }
};
struct EpiFno {
    static constexpr bool PERM = true, AFTER_DRAIN = false;
    const bf16_t* gf; bf16_t* qu;
    __device__ __forceinline__ void operator()(const f32x4 (&acc)[2][2][4][2], const Unit& u, int wr, int wc, int fr, int fq) const {
        const int row0 = u.pm * BM + wr * 64 + fr, col0 = u.pn * BM + wc * 32 + 8 * fq;
#pragma unroll
        for (int ai = 0; ai < 2; ++ai)
#pragma unroll
            for (int m = 0; m < 4; ++m) { const size_t r = (size_t)(row0 + ai * HALF + m * 16);
#pragma unroll
                for (int bj = 0; bj < 2; ++bj) { const int c = col0 + bj * HALF; const u32x4 g = *(const u32x4*)(gf + r * 512 + c);
                    const f32x4 v0 = acc[ai][bj][m][0], v1 = acc[ai][bj][m][1];
                    u32x4 w; w.x = cvt_pk_bf16(v0[0] * silu(bflo(g.x)), v0[1] * silu(bfhi(g.x))); w.y = cvt_pk_bf16(v0[2] * silu(bflo(g.y)), v0[3] * silu(bfhi(g.y)));
                    w.z = cvt_pk_bf16(v1[0] * silu(bflo(g.z)), v1[1] * silu(bfhi(g.z))); w.w = cvt_pk_bf16(v1[2] * silu(bflo(g.w)), v1[3] * silu(bfhi(g.w)));
                    *(u32x4*)(qu + r * 1024 + 512 + c) = w; } }
    }
};
struct EpiOutProj {
    static constexpr bool PERM = false, AFTER_DRAIN = false;
    const float* xp; const float* xs; float* out; bf16_t* h1b; float* ssq;
    __device__ __forceinline__ void operator()(const f32x4 (&acc)[2][2][4][2], const Unit& u, int wr, int wc, int fr, int fq) const {
        const int row0 = u.pm * BM + wr * 64 + fr, col0 = u.pn * BM + wc * 32 + 4 * fq;
        const float* xb = (u.pm < 128) ? xp : xs - (size_t)32768 * 1024;
        f32x4 xv[8][4]; float ssv[8];
#define EOP_LD(g) do { const float* xrow_ = xb + (size_t)(row0 + ((g) >> 2) * HALF + ((g) & 3) * 16) * 1024 + col0; \
            xv[g][0] = *(const f32x4*)(xrow_); xv[g][1] = *(const f32x4*)(xrow_ + 16); xv[g][2] = *(const f32x4*)(xrow_ + HALF); xv[g][3] = *(const f32x4*)(xrow_ + HALF + 16); } while (0)
        EOP_LD(0); EOP_LD(1); EOP_LD(2);
#pragma unroll
        for (int g = 0; g < 8; ++g) { const int ai = g >> 2, m = g & 3;
            if (g + 3 < 8) EOP_LD(g + 3);
            const int row = row0 + ai * HALF + m * 16; float ss = 0.f;
#pragma unroll
            for (int bj = 0; bj < 2; ++bj)
#pragma unroll
                for (int n = 0; n < 2; ++n) { const f32x4 h = xv[g][bj * 2 + n] + acc[ai][bj][m][n];
                    ss += (h[0] * h[0] + h[1] * h[1]) + (h[2] * h[2] + h[3] * h[3]);
                    u32x2 w; w.x = cvt_pk_bf16(h[0], h[1]); w.y = cvt_pk_bf16(h[2], h[3]); *(u32x2*)(h1b + blk1024(row, col0 + bj * HALF + n * 16)) = w; }
            ss += bperm_f(((fq ^ 1) << 4) | fr, ss); ss += bperm_f(((fq ^ 2) << 4) | fr, ss); ssv[g] = ss; }
#undef EOP_LD
        if (fq == 0) {
#pragma unroll
            for (int g = 0; g < 8; ++g) ssq[(size_t)(row0 + (g >> 2) * HALF + (g & 3) * 16) * 16 + u.pn * 4 + wc] = ssv[g]; }
    }
};
struct EpiGate {
    static constexpr bool PERM = false, AFTER_DRAIN = false;
    float* out; const bf16_t* proj; const float* ssq1; float* ssq2;
    __device__ __forceinline__ void operator()(const f32x4 (&acc)[2][2][4][2], const Unit& u, int wr, int wc, int fr, int fq) const {
        const int row0 = u.pm * BM + wr * 64 + fr, col0 = u.pn * BM + wc * 32 + 4 * fq;
#pragma unroll
        for (int ai = 0; ai < 2; ++ai)
#pragma unroll
            for (int m = 0; m < 4; ++m) { const int r = row0 + ai * HALF + m * 16; const size_t off = (size_t)r * 1024 + col0;
                const f32x4* sp = (const f32x4*)(ssq1 + (size_t)r * 16); const f32x4 s0 = sp[0], s1 = sp[1], s2 = sp[2], s3 = sp[3];
                const float st = ((s0[0] + s0[1]) + (s0[2] + s0[3])) + ((s1[0] + s1[1]) + (s1[2] + s1[3])) + ((s2[0] + s2[1]) + (s2[2] + s2[3])) + ((s3[0] + s3[1]) + (s3[2] + s3[3]));
                const float rr = __builtin_amdgcn_rsqf(st * (1.f / 1024.f) + 1e-6f); float ss = 0.f;
#pragma unroll
                for (int bj = 0; bj < 2; ++bj)
#pragma unroll
                    for (int n = 0; n < 2; ++n) { const f32x4 a = acc[ai][bj][m][n] * rr; const u32x2 pw = *(const u32x2*)(proj + off + bj * HALF + n * 16);
                        const f32x4 h1 = *(const f32x4*)(out + off + bj * HALF + n * 16); f32x4 h;
                        h[0] = h1[0] + sigm(a[0]) * bflo(pw.x); h[1] = h1[1] + sigm(a[1]) * bfhi(pw.x); h[2] = h1[2] + sigm(a[2]) * bflo(pw.y); h[3] = h1[3] + sigm(a[3]) * bfhi(pw.y);
                        *(f32x4*)(out + off + bj * HALF + n * 16) = h; ss += (h[0] * h[0] + h[1] * h[1]) + (h[2] * h[2] + h[3] * h[3]); }
                ss += bperm_f(((fq ^ 1) << 4) | fr, ss); ss += bperm_f(((fq ^ 2) << 4) | fr, ss);
                if (fq == 0) ssq2[(size_t)r * 16 + u.pn * 4 + wc] = ss; }
    }
};

struct EpiGateNorm {
    static constexpr bool PERM = false, AFTER_DRAIN = false;
    float* out; const bf16_t* h1b; const bf16_t* proj; const float* ssq1; const float* gfin; float* slots; unsigned* cnt; PG8_LAS unsigned char* xl;
    __device__ __forceinline__ void operator()(f32x4 (&acc)[2][2][4][2], const Unit& u, int wr, int wc, int fr, int fq) const {
        const int row0 = u.pm * BM + wr * 64 + fr, col0 = u.pn * BM + wc * 32 + 4 * fq; const int wid = wr * 4 + wc, lane = fq * 16 + fr;
        PG8_LAS float* P = (PG8_LAS float*)xl; PG8_LAS float* S = (PG8_LAS float*)(xl + 4096); PG8_LAS float* R1 = (PG8_LAS float*)(xl + 5120);
        u32x2 pwv[8][4], hwv[8][4];
#define EGN_LD(g) do { const size_t off_ = (size_t)(row0 + ((g) >> 2) * HALF + ((g) & 3) * 16) * 1024 + col0; \
            { const int r_ = row0 + ((g) >> 2) * HALF + ((g) & 3) * 16; pwv[g][0] = *(const u32x2*)(proj + blk1024(r_, col0)); pwv[g][1] = *(const u32x2*)(proj + blk1024(r_, col0 + 16)); pwv[g][2] = *(const u32x2*)(proj + blk1024(r_, col0 + HALF)); pwv[g][3] = *(const u32x2*)(proj + blk1024(r_, col0 + HALF + 16)); } \
            { const int r_ = row0 + ((g) >> 2) * HALF + ((g) & 3) * 16; hwv[g][0] = *(const u32x2*)(h1b + blk1024(r_, col0)); hwv[g][1] = *(const u32x2*)(h1b + blk1024(r_, col0 + 16)); hwv[g][2] = *(const u32x2*)(h1b + blk1024(r_, col0 + HALF)); hwv[g][3] = *(const u32x2*)(h1b + blk1024(r_, col0 + HALF + 16)); } } while (0)
        EGN_LD(0); EGN_LD(1); EGN_LD(2); EGN_LD(3);
        { const int t_ = wid * 64 + lane; if (t_ < 256) { const f32x4* sp = (const f32x4*)(ssq1 + (size_t)(u.pm * BM + t_) * 16); const f32x4 s0 = sp[0], s1 = sp[1], s2 = sp[2], s3 = sp[3];
            const float st = ((s0[0] + s0[1]) + (s0[2] + s0[3])) + ((s1[0] + s1[1]) + (s1[2] + s1[3])) + ((s2[0] + s2[1]) + (s2[2] + s2[3])) + ((s3[0] + s3[1]) + (s3[2] + s3[3]));
            R1[t_] = __builtin_amdgcn_rsqf(st * (1.f / 1024.f) + 1e-6f); } }
        asm volatile("s_waitcnt vmcnt(0) lgkmcnt(0)" ::: "memory"); __builtin_amdgcn_s_barrier(); asm volatile("" ::: "memory");
#pragma unroll
        for (int g = 0; g < 8; ++g) { const int ai = g >> 2, m = g & 3;
            if (g + 4 < 8) EGN_LD(g + 4);
            const float rr = R1[ai * HALF + wr * 64 + m * 16 + fr]; float ss = 0.f;
#pragma unroll
            for (int bj = 0; bj < 2; ++bj)
#pragma unroll
                for (int n = 0; n < 2; ++n) { const f32x4 a = acc[ai][bj][m][n] * rr; const u32x2 pw = pwv[g][bj * 2 + n], hw = hwv[g][bj * 2 + n]; f32x4 h;
                    h[0] = bflo(hw.x) + sigm(a[0]) * bflo(pw.x); h[1] = bfhi(hw.x) + sigm(a[1]) * bfhi(pw.x); h[2] = bflo(hw.y) + sigm(a[2]) * bflo(pw.y); h[3] = bfhi(hw.y) + sigm(a[3]) * bfhi(pw.y);
                    acc[ai][bj][m][n] = h; ss += (h[0] * h[0] + h[1] * h[1]) + (h[2] * h[2] + h[3] * h[3]); }
            ss += bperm_f(((fq ^ 1) << 4) | fr, ss); ss += bperm_f(((fq ^ 2) << 4) | fr, ss);
            if (fq == 0) P[(ai * HALF + wr * 64 + m * 16 + fr) * 4 + wc] = ss; }
#undef EGN_LD
        asm volatile("s_waitcnt lgkmcnt(0)" ::: "memory"); __builtin_amdgcn_s_barrier(); asm volatile("" ::: "memory");
        const int row = wid * 32 + (lane & 31);
        if (lane < 32) { const float t = (P[row * 4 + 0] + P[row * 4 + 1]) + (P[row * 4 + 2] + P[row * 4 + 3]);
            __hip_atomic_store(slots + ((size_t)(u.pm * BM + row) * 4 + u.pn), t, __ATOMIC_RELAXED, __HIP_MEMORY_SCOPE_AGENT); }
        asm volatile("s_waitcnt vmcnt(0)" ::: "memory");
        if (lane == 0) __hip_atomic_fetch_add(cnt + 64 * u.pm, 1u, __ATOMIC_RELAXED, __HIP_MEMORY_SCOPE_AGENT);
        if (wid == 0) { unsigned spins = 0;
            while ((unsigned)__builtin_amdgcn_readfirstlane(__hip_atomic_load(cnt + 64 * u.pm, __ATOMIC_RELAXED, __HIP_MEMORY_SCOPE_AGENT)) < 32u) { __builtin_amdgcn_s_sleep(2); if (++spins > (1u << 22)) break; }
            __builtin_amdgcn_fence(__ATOMIC_ACQUIRE, "agent"); }
        asm volatile("s_waitcnt vmcnt(0) lgkmcnt(0)" ::: "memory"); __builtin_amdgcn_s_barrier(); asm volatile("" ::: "memory");
        if (lane < 32) { const float* sl = slots + (size_t)(u.pm * BM + row) * 4; float t = 0.f;
#pragma unroll
            for (int k = 0; k < 4; ++k) t += __hip_atomic_load(sl + k, __ATOMIC_RELAXED, __HIP_MEMORY_SCOPE_AGENT);
            S[row] = __builtin_amdgcn_rsqf(t * (1.f / 1024.f) + 1e-6f); }
        asm volatile("s_waitcnt vmcnt(0) lgkmcnt(0)" ::: "memory"); __builtin_amdgcn_s_barrier(); asm volatile("" ::: "memory");
        f32x4 gv[2][2];
#pragma unroll
        for (int bj = 0; bj < 2; ++bj)
#pragma unroll
            for (int n = 0; n < 2; ++n) gv[bj][n] = *(const f32x4*)(gfin + col0 + bj * HALF + n * 16);
#pragma unroll
        for (int ai = 0; ai < 2; ++ai)
#pragma unroll
            for (int m = 0; m < 4; ++m) { const int rl = ai * HALF + wr * 64 + m * 16 + fr; const float rs = S[rl]; const size_t off = (size_t)(u.pm * BM + rl) * 1024 + col0;
#pragma unroll
                for (int bj = 0; bj < 2; ++bj)
#pragma unroll
                    for (int n = 0; n < 2; ++n) __builtin_nontemporal_store(acc[ai][bj][m][n] * rs * gv[bj][n], (f32x4*)(out + off + bj * HALF + n * 16)); }
        asm volatile("s_waitcnt lgkmcnt(0)" ::: "memory"); __builtin_amdgcn_s_barrier(); asm volatile("" ::: "memory");
    }
};
template <class Epi, class Sched, bool ALIGN_EPI = false, bool SP2 = false>
__device__ __forceinline__ void gemm_phase(PG8_LAS unsigned char* lds, const Gemm g, const Sched& S, const Epi& E, const int wave_) {
    const int tid = opq_tid(wave_), wid = __builtin_amdgcn_readfirstlane(tid >> 6), lane = tid & 63, wr = wid >> 2, wc = wid & 3, fr = lane & 15, fq = lane >> 4;
    const int K = g.K, nt = K / BK;
    unsigned voffA[2], voffB[2];
#pragma unroll
    for (int i = 0; i < 2; ++i) { int R, C; stage_rc(tid * 16 + i * 8192, R, C); const int Rb = Epi::PERM ? ((R & ~31) + perm32(R & 31)) : R;
        voffA[i] = g.ablk ? (unsigned)(((R >> 4) * 32 + (C >> 5)) * 1024 + (R & 15) * 64 + (C & 31) * 2) : (unsigned)(R * g.ld + C) * 2u; voffB[i] = (unsigned)(Rb * g.ld + C) * 2u; }
    const size_t kstep = (size_t)(BK * 2);
    const size_t kstepA = g.ablk ? (size_t)2048 : kstep;
    const size_t hstep = (size_t)HALF * g.ld * 2;
    const size_t tstep = 2 * hstep;
    const unsigned ldsw = (unsigned)wid * 1024u;
    const int aoff = lds_byte(wr * 64 + fr, fq * 8), boff = lds_byte(wc * 32 + fr, fq * 8);
#define PG8_SA(b, h) (((b) * 2 + (h)) * HTB)
#define PG8_SB(b, h) ((4 + (b) * 2 + (h)) * HTB)
#define PG8_STAGE(bufoff, gbase, voff) do { unsigned long long gb_ = (unsigned long long)(gbase); asm volatile("" : "+s"(gb_)); _Pragma("unroll") for (int _i = 0; _i < 2; ++_i) { asm volatile("" : "+v"((voff)[_i])); \
        __builtin_amdgcn_global_load_lds((const unsigned*)((const char*)gb_ + (voff)[_i]), (PG8_LAS unsigned*)(lds + (bufoff) + ldsw + _i * 8192), 16, 0, 0); } } while (0)
#define PG8_LDA(dst, b, h) do { _Pragma("unroll") for (int m = 0; m < 4; ++m) _Pragma("unroll") for (int k = 0; k < 2; ++k) dst[m][k] = *(const PG8_LAS bf16x8*)(lds + PG8_SA(b, h) + aoff + m * 2048 + k * 1024); } while (0)
#define PG8_LDB(dst, b, h) do { _Pragma("unroll") for (int n = 0; n < 2; ++n) _Pragma("unroll") for (int k = 0; k < 2; ++k) dst[n][k] = *(const PG8_LAS bf16x8*)(lds + PG8_SB(b, h) + boff + n * 2048 + k * 1024); } while (0)
#define PG8_MMA(ai, bj, At, Bt) do { __builtin_amdgcn_s_setprio(1); _Pragma("unroll") for (int m = 0; m < 4; ++m) _Pragma("unroll") for (int n = 0; n < 2; ++n) _Pragma("unroll") for (int k = 0; k < 2; ++k) \
        acc[ai][bj][m][n] = __builtin_amdgcn_mfma_f32_16x16x32_bf16(Bt[n][k], At[m][k], acc[ai][bj][m][n], 0, 0, 0); __builtin_amdgcn_s_setprio(0); } while (0)
#define PG8_WAIT_V(n) asm volatile("s_waitcnt vmcnt(" #n ")" ::: "memory")
#define PG8_WAIT_L(n) asm volatile("s_waitcnt lgkmcnt(" #n ")" ::: "memory")
#define PG8_BAR __builtin_amdgcn_s_barrier()
#define PG8_SCHED __builtin_amdgcn_sched_barrier(0)
    Unit cur, nxt; int ui = 0;
    if (!S.next(0, cur)) return;
    f32x4 acc[2][2][4][2];
#pragma unroll
    for (int a = 0; a < 2; ++a)
#pragma unroll
        for (int b = 0; b < 2; ++b)
#pragma unroll
            for (int m = 0; m < 4; ++m)
#pragma unroll
                for (int n = 0; n < 2; ++n) acc[a][b][m][n] = (f32x4){0.f, 0.f, 0.f, 0.f};
    bf16x8 At[4][2], B0[2][2], B1[2][2];
    const char* cA = (const char*)g.A + (size_t)cur.pm * tstep + (size_t)(cur.pn * g.koff_pn) * 2; const char* cB = (const char*)g.Bt + (size_t)cur.pn * tstep + (size_t)(cur.pn * g.koff_pn) * 2;
    S.a_ready(cur);
    if constexpr (SP2) {
        PG8_STAGE(PG8_SB(0, 0), cB, voffB); PG8_STAGE(PG8_SB(0, 1), cB + hstep, voffB); PG8_STAGE(PG8_SA(0, 0), cA, voffA); PG8_STAGE(PG8_SA(0, 1), cA + hstep, voffA);
        if (wr == 1) PG8_BAR;
        PG8_WAIT_V(2); PG8_BAR;
        PG8_STAGE(PG8_SB(1, 0), cB + kstep, voffB); PG8_STAGE(PG8_SA(1, 0), cA + kstepA, voffA); PG8_STAGE(PG8_SB(1, 1), cB + hstep + kstep, voffB);
        PG8_WAIT_V(6); PG8_BAR;
    } else {
        PG8_STAGE(PG8_SB(0, 0), cB, voffB); PG8_STAGE(PG8_SA(0, 0), cA, voffA); PG8_STAGE(PG8_SB(0, 1), cB + hstep, voffB); PG8_STAGE(PG8_SA(0, 1), cA + hstep, voffA);
        if (wr == 1) PG8_BAR;
        PG8_WAIT_V(4); PG8_BAR;
        PG8_STAGE(PG8_SB(1, 0), cB + kstep, voffB); PG8_STAGE(PG8_SA(1, 0), cA + kstepA, voffA); PG8_STAGE(PG8_SB(1, 1), cB + hstep + kstep, voffB);
        PG8_WAIT_V(6); PG8_BAR;
    }
    for (;;) {
        const bool has_next = S.next(ui + 1, nxt);
        const char* nA = has_next ? (const char*)g.A + (size_t)nxt.pm * tstep + (size_t)(nxt.pn * g.koff_pn) * 2 : cA; const char* nB = has_next ? (const char*)g.Bt + (size_t)nxt.pn * tstep + (size_t)(nxt.pn * g.koff_pn) * 2 : cB;
        for (int t = 0; t < nt; t += 2) {
            const bool last = (t == nt - 2);
            const char* a1 = cA + (size_t)(t + 1) * kstepA;
            const char* a2 = last ? nA : cA + (size_t)(t + 2) * kstepA; const char* b2 = last ? nB : cB + (size_t)(t + 2) * kstep;
            const char* a3 = a2 + kstepA; const char* b3 = b2 + kstep;
            if (last && has_next) S.a_ready(nxt);
            if constexpr (SP2) {
            PG8_LDB(B0, 0, 0); PG8_LDB(B1, 0, 1); PG8_SCHED; PG8_LDA(At, 0, 0); PG8_STAGE(PG8_SA(1, 1), a1 + hstep, voffA);
            PG8_WAIT_V(8); PG8_WAIT_L(0); PG8_BAR; PG8_MMA(0, 0, At, B0); PG8_MMA(0, 1, At, B1); PG8_BAR; PG8_SCHED;
            PG8_LDA(At, 0, 1); PG8_STAGE(PG8_SB(0, 0), b2, voffB); PG8_STAGE(PG8_SB(0, 1), b2 + hstep, voffB); PG8_STAGE(PG8_SA(0, 0), a2, voffA);
            PG8_WAIT_V(8); PG8_WAIT_L(0); PG8_BAR; PG8_MMA(1, 0, At, B0); PG8_MMA(1, 1, At, B1); PG8_BAR; PG8_SCHED;
            PG8_LDB(B0, 1, 0); PG8_LDB(B1, 1, 1); PG8_SCHED; PG8_LDA(At, 1, 0); PG8_STAGE(PG8_SA(0, 1), a2 + hstep, voffA);
            PG8_WAIT_V(8); PG8_WAIT_L(0); PG8_BAR; PG8_MMA(0, 0, At, B0); PG8_MMA(0, 1, At, B1); PG8_BAR; PG8_SCHED;
            PG8_LDA(At, 1, 1); PG8_STAGE(PG8_SB(1, 0), b3, voffB); PG8_STAGE(PG8_SB(1, 1), b3 + hstep, voffB); PG8_STAGE(PG8_SA(1, 0), a3, voffA);
            PG8_WAIT_V(8); PG8_WAIT_L(0); PG8_BAR; PG8_MMA(1, 0, At, B0); PG8_MMA(1, 1, At, B1); PG8_BAR; PG8_SCHED;
            } else {
            PG8_LDB(B0, 0, 0); PG8_SCHED; PG8_LDA(At, 0, 0); PG8_STAGE(PG8_SA(1, 1), a1 + hstep, voffA);
            PG8_WAIT_L(8); PG8_BAR; PG8_WAIT_L(0); PG8_MMA(0, 0, At, B0); PG8_BAR; PG8_SCHED;
            PG8_LDB(B1, 0, 1); PG8_STAGE(PG8_SB(0, 0), b2, voffB);
            PG8_BAR; PG8_WAIT_L(0); PG8_MMA(0, 1, At, B1); PG8_BAR;
            PG8_LDA(At, 0, 1); PG8_STAGE(PG8_SA(0, 0), a2, voffA);
            PG8_BAR; PG8_WAIT_L(0); PG8_MMA(1, 0, At, B0); PG8_BAR; PG8_SCHED;
            PG8_STAGE(PG8_SB(0, 1), b2 + hstep, voffB);
            PG8_WAIT_V(6); PG8_BAR; PG8_MMA(1, 1, At, B1); PG8_BAR;
            PG8_LDB(B0, 1, 0); PG8_SCHED; PG8_LDA(At, 1, 0); PG8_STAGE(PG8_SA(0, 1), a2 + hstep, voffA);
            PG8_WAIT_L(8); PG8_BAR; PG8_WAIT_L(0); PG8_MMA(0, 0, At, B0); PG8_BAR; PG8_SCHED;
            PG8_LDB(B1, 1, 1); PG8_STAGE(PG8_SB(1, 0), b3, voffB);
            PG8_BAR; PG8_WAIT_L(0); PG8_MMA(0, 1, At, B1); PG8_BAR;
            PG8_LDA(At, 1, 1); PG8_STAGE(PG8_SA(1, 0), a3, voffA);
            PG8_BAR; PG8_WAIT_L(0); PG8_MMA(1, 0, At, B0); PG8_BAR; PG8_SCHED;
            PG8_STAGE(PG8_SB(1, 1), b3 + hstep, voffB);
            PG8_WAIT_V(6); PG8_BAR; PG8_MMA(1, 1, At, B1); PG8_BAR;
            }
        }
        if constexpr (ALIGN_EPI) { if (wr == 0) PG8_BAR; }
        if constexpr (!Epi::AFTER_DRAIN) { const int l2_ = opq_tid(wave_) & 63; E(acc, cur, wr, wc, l2_ & 15, l2_ >> 4); S.done(cur); }
        if (!has_next) break;
#pragma unroll
        for (int a = 0; a < 2; ++a)
#pragma unroll
            for (int b = 0; b < 2; ++b)
#pragma unroll
                for (int m = 0; m < 4; ++m)
#pragma unroll
                    for (int n = 0; n < 2; ++n) acc[a][b][m][n] = (f32x4){0.f, 0.f, 0.f, 0.f};
        cur = nxt; cA = nA; cB = nB; ++ui;
        if constexpr (ALIGN_EPI) { if (wr == 1) PG8_BAR; }
    }
    PG8_WAIT_V(0);
    if constexpr (!ALIGN_EPI) { if (wr == 0) PG8_BAR; }
    PG8_BAR;
    if constexpr (Epi::AFTER_DRAIN) { E.fused(acc, cur, wr, wc, fr, fq, lds, wid, lane); S.done(cur); }
#undef PG8_SA
#undef PG8_SB
#undef PG8_STAGE
#undef PG8_LDA
#undef PG8_LDB
#undef PG8_MMA
#undef PG8_WAIT_V
#undef PG8_WAIT_L
#undef PG8_BAR
#undef PG8_SCHED
}
}
constexpr int NWAVES = 8;
constexpr int DM = 1024, NTOK = 49152, TPR = 32768, SEQP = 4096, SEQS = 8192, NBP = 8, NBS = 2, NIN = 3072, PLED = 256;
constexpr float LOG2E = 1.4426950408889634f;
constexpr float QSCALE = 0.125f * LOG2E;
constexpr size_t MiB = 1u << 20;
constexpr size_t WS_CTL = 0, CTL_ZERO_BYTES = 128 * 1024;
constexpr size_t WS_TAB = 1 * MiB;
constexpr size_t WS_GINV = 1 * MiB + 8192;
constexpr size_t WS_RINV = 1 * MiB + 16384;
constexpr size_t WS_WIN = 2 * MiB;
constexpr size_t WS_WOUT = 8 * MiB;
constexpr size_t WS_WG = 10 * MiB;
constexpr size_t WS_WP = 12 * MiB;
constexpr size_t WS_GT = 12 * MiB + 512 * 1024;
constexpr size_t WS_H1A = 13 * MiB + 512 * 1024;
constexpr size_t WS_H1B = WS_H1A + 64 * 1024;
constexpr size_t WS_M2A = 14 * MiB;
constexpr size_t WS_M2B = 15 * MiB + 256 * 1024;
constexpr size_t WS_SSQ1 = 18 * MiB, WS_SSQ2 = 21 * MiB;
constexpr size_t WS_XN = 24 * MiB;
constexpr size_t WS_QU = 120 * MiB;
constexpr size_t WS_K = 216 * MiB, WS_V = 264 * MiB;
constexpr size_t WS_GA = 312 * MiB, WS_GF = 360 * MiB;
constexpr size_t WS_PROJ = 408 * MiB;
constexpr size_t WS_QB = 504 * MiB, WS_UB = 552 * MiB;
constexpr size_t WS_END = 600 * MiB;
static_assert(WS_M2A + 33 * 32768 <= WS_M2B && WS_M2B + 65 * 32768 <= WS_SSQ1 && WS_SSQ2 + (size_t)NTOK * 64 <= WS_XN, "d_ws map");
constexpr int RING_BYTES = 131072, LDSCTL_OFF = RING_BYTES, MISC_OFF = LDSCTL_OFF + 320, LDS_BYTES = 147456;
#define GAS __attribute__((address_space(1)))
#define LAS __attribute__((address_space(3)))
typedef unsigned short bf16;
typedef unsigned v4u __attribute__((ext_vector_type(4)));
typedef unsigned v2u __attribute__((ext_vector_type(2)));
typedef float f32x4 __attribute__((ext_vector_type(4)));
typedef short bf16x8 __attribute__((ext_vector_type(8)));
#define LDS_WAIT() asm volatile("s_waitcnt lgkmcnt(0)" ::: "memory")
#define VM_WAIT() asm volatile("s_waitcnt vmcnt(0)" ::: "memory")
__device__ __forceinline__ unsigned f2bf(float f) { unsigned u = __builtin_bit_cast(unsigned, f); return (u + 0x7fffu + ((u >> 16) & 1u)) >> 16; }
__device__ __forceinline__ unsigned pk2(float lo, float hi) { return f2bf(lo) | (f2bf(hi) << 16); }
#define XB_TMO      128
#define XB_XCNT(j)  (256  + 64 * (j))
#define XB_XSUB(j)  (1280 + 64 * (j))
#define XB_XGEN(j)  (2304 + 64 * (j))
#define XB_TOP      3328
#define XB_TOPGEN   3392
#define XCD_BAR_WORDS 3456
#define XB_SPIN_CAP (1u << 18)

__device__ __forceinline__ unsigned xb_ld(unsigned* p)              { return __hip_atomic_load(p, __ATOMIC_RELAXED, __HIP_MEMORY_SCOPE_AGENT); }
__device__ __forceinline__ unsigned xb_add(unsigned* p, unsigned v) { return __hip_atomic_fetch_add(p, v, __ATOMIC_RELAXED, __HIP_MEMORY_SCOPE_AGENT); }
__device__ __forceinline__ unsigned xb_xcc_id() { return (unsigned)__builtin_amdgcn_s_getreg((3 << 11) | 20) & 0xFu; }
#define XB_SPIN(cond, bar) do { unsigned _sp = 0; while (cond) { __builtin_amdgcn_s_sleep(1); \
    if ((++_sp & 255u) == 0u) { if (xb_ld(&(bar)[XB_TMO])) break; if (_sp > XB_SPIN_CAP) { atomicAdd(&(bar)[XB_TMO], 1u); break; } } } } while (0)

struct XcdBarrier {
    unsigned* bar; unsigned x;
    volatile LAS unsigned* st;
};

__device__ __forceinline__ XcdBarrier xcd_barrier_post(unsigned* bar, volatile LAS unsigned* st) {
    XcdBarrier b; b.bar = bar; b.x = xb_xcc_id(); b.st = st;
    if (threadIdx.x == 0) (void)xb_add(&bar[XB_XCNT(b.x)], 1u);
    return b;
}
__device__ __forceinline__ void xcd_barrier_complete(unsigned* bar, unsigned x, unsigned& nloc, unsigned& nx) {
    const unsigned G = gridDim.x * gridDim.y * gridDim.z;
    unsigned sum, cnt, mine, sp = 0u;
    for (;;) {
        sum = 0u; cnt = 0u; mine = 0u;
#pragma unroll
        for (unsigned j = 0; j < 16; ++j) { const unsigned c = xb_ld(&bar[XB_XCNT(j)]); sum += c; cnt += (c > 0u) ? 1u : 0u; mine = (j == x) ? c : mine; }
        if (sum == G) break;
        __builtin_amdgcn_s_sleep(1);
        if ((++sp & 255u) == 0u) { if (xb_ld(&bar[XB_TMO])) break; if (sp > XB_SPIN_CAP) { atomicAdd(&bar[XB_TMO], 1u); break; } }
    }
    nloc = mine > 0u ? mine : 1u; nx = cnt > 0u ? cnt : 1u;
}

__device__ __forceinline__ void xcd_barrier(const XcdBarrier& b) {
    asm volatile("s_waitcnt vmcnt(0)" ::: "memory");
    __syncthreads();
    if (threadIdx.x == 0) {
        unsigned* bar = b.bar;
        __builtin_amdgcn_s_waitcnt(0);
        unsigned nloc = b.st[0], nx = b.st[1];
        if (nloc == 0u) { xcd_barrier_complete(bar, b.x, nloc, nx); b.st[0] = nloc; b.st[1] = nx; }
        const unsigned old = xb_add(&bar[XB_XSUB(b.x)], 1u);
        const unsigned gen = old / nloc;
        if (old + 1u == (gen + 1u) * nloc) {
            __builtin_amdgcn_fence(__ATOMIC_RELEASE, "agent");
            asm volatile("s_waitcnt vmcnt(0)" ::: "memory");
            const unsigned og = xb_add(&bar[XB_TOP], 1u);
            const unsigned tg = og / nx;
            if (og + 1u == (tg + 1u) * nx) xb_add(&bar[XB_TOPGEN], 1u);
            else XB_SPIN(xb_ld(&bar[XB_TOPGEN]) == tg, bar);
            __builtin_amdgcn_fence(__ATOMIC_ACQUIRE, "agent");
            xb_add(&bar[XB_XGEN(b.x)], 1u);
            asm volatile("s_waitcnt vmcnt(0)" ::: "memory");
        } else {
            XB_SPIN(xb_ld(&bar[XB_XGEN(b.x)]) == gen, bar);
            __builtin_amdgcn_fence(__ATOMIC_ACQUIRE, "agent");
            asm volatile("s_waitcnt vmcnt(0)" ::: "memory");
        }
    }
    __syncthreads();
}
namespace att3 {
#ifndef ATT_REGSTAGE
#define ATT_REGSTAGE 0
#endif
#ifndef DMA_IN_VSEG
#define DMA_IN_VSEG 0
#endif
#ifndef QK_IN_VSEG
#define QK_IN_VSEG 0
#endif
#ifndef ATT_ONEBAR
#define ATT_ONEBAR 1
#endif
#ifndef ATT_LOCKSTEP
#define ATT_LOCKSTEP 0
#endif
typedef unsigned short bf16_t;
typedef short bf16x8 __attribute__((ext_vector_type(8)));
typedef short s16x4 __attribute__((ext_vector_type(4)));
typedef float f32x16 __attribute__((ext_vector_type(16)));
typedef float f32x4 __attribute__((ext_vector_type(4)));
typedef unsigned u32x4 __attribute__((ext_vector_type(4)));
#define A2_LAS __attribute__((address_space(3)))
#ifndef PRIO_MODE
#define PRIO_MODE 0
#endif
#if PRIO_MODE == 1
#define A3_PRIO_M(x) __builtin_amdgcn_s_setprio(x)
#define A3_PRIO_V(x) do { } while (0)
#elif PRIO_MODE == 2
#define A3_PRIO_M(x) do { } while (0)
#define A3_PRIO_V(x) __builtin_amdgcn_s_setprio(x)
#else
#define A3_PRIO_M(x) do { } while (0)
#define A3_PRIO_V(x) do { } while (0)
#endif
constexpr int KVBLK = 64, TILEB = 16384, KRING = 4, VRING = 3;
constexpr int OFF_K = 0, OFF_V = KRING * TILEB, OFF_WS = (KRING + VRING) * TILEB, OFF_TAB = OFF_WS + 8 * 256, A2_LDS_END = OFF_TAB + 2048;
constexpr float THR2 = 11.5f;
#define KSWZ(row, colB) ((row) * 256 + ((colB) ^ (((row) & 15) << 4)))
__device__ __forceinline__ int crow(int r, int hi) { return (r & 3) + 8 * (r >> 2) + 4 * hi; }
__device__ __forceinline__ unsigned cvtpk(float lo, float hi) { unsigned r; asm volatile("v_cvt_pk_bf16_f32 %0, %1, %2" : "=v"(r) : "v"(lo), "v"(hi)); return r; }
__device__ __forceinline__ float bflo(unsigned w) { return __uint_as_float(w << 16); }
__device__ __forceinline__ float bfhi(unsigned w) { return __uint_as_float(w & 0xffff0000u); }
__device__ __forceinline__ float silu(float a) { return a * __builtin_amdgcn_rcpf(1.f + __expf(-a)); }
__device__ __forceinline__ float max3f(float a, float b, float c) { float r; asm("v_max3_f32 %0, %1, %2, %3" : "=v"(r) : "v"(a), "v"(b), "v"(c)); return r; }
__device__ __forceinline__ float max2f(float a, float b) { float r; asm("v_max_f32_e32 %0, %1, %2" : "=v"(r) : "v"(a), "v"(b)); return r; }
__device__ __forceinline__ float fadd_s(float a, float b) { float r; asm("v_add_f32_e32 %0, %1, %2" : "=v"(r) : "v"(a), "v"(b)); return r; }
__device__ __forceinline__ float exp2_s(float a) { float r; asm("v_exp_f32_e32 %0, %1" : "=v"(r) : "v"(a)); return r; }
typedef short v4i16_t __attribute__((ext_vector_type(4)));
__device__ __forceinline__ s16x4 vtr(const A2_LAS char* p) { return __builtin_bit_cast(s16x4, __builtin_amdgcn_ds_read_tr16_b64_v4i16((A2_LAS v4i16_t*)p)); }
__device__ __forceinline__ int v_rd_base(int lane) { return ((lane & 3) << 3) | (((lane >> 2) & 3) << 6) | (((lane >> 4) & 1) << 5) | (((lane >> 5) & 1) << 11); }
constexpr int v_rd_off(int d0, int ks, int half) { return d0 * 512 + ks * 4096 + half * 256; }

#ifndef MFMA_GAP
#define MFMA_GAP 0
#endif
#if MFMA_GAP > 0
#define MGAP_STR2(x) #x
#define MGAP_STR(x) MGAP_STR2(x)
#define MGAP() asm volatile("s_nop " MGAP_STR(MFMA_GAP))
#else
#define MGAP() do { } while (0)
#endif
__device__ __forceinline__ void kload(bf16x8* kf, const A2_LAS char* Ks, int r32, int hi, int comp) {
#pragma unroll
  for (int d0 = 0; d0 < 4; ++d0) { const int cb = ((comp * 4 + d0) * 16 + hi * 8) * 2;
    kf[2 * d0] = *reinterpret_cast<const A2_LAS bf16x8*>(Ks + KSWZ(r32, cb)); kf[2 * d0 + 1] = *reinterpret_cast<const A2_LAS bf16x8*>(Ks + KSWZ(32 + r32, cb)); }
}
__device__ __forceinline__ void qkt_a(f32x16& p0, f32x16& p1, const bf16x8* kf, const bf16x8* qr, const f32x16& negm) {
  p0 = __builtin_amdgcn_mfma_f32_32x32x16_bf16(kf[0], qr[0], negm, 0, 0, 0); MGAP(); p1 = __builtin_amdgcn_mfma_f32_32x32x16_bf16(kf[1], qr[0], negm, 0, 0, 0); MGAP();
  p0 = __builtin_amdgcn_mfma_f32_32x32x16_bf16(kf[2], qr[1], p0, 0, 0, 0); MGAP(); p1 = __builtin_amdgcn_mfma_f32_32x32x16_bf16(kf[3], qr[1], p1, 0, 0, 0); MGAP();
}
__device__ __forceinline__ void qkt_b(f32x16& p0, f32x16& p1, const bf16x8* kf, const bf16x8* qr) {
  p0 = __builtin_amdgcn_mfma_f32_32x32x16_bf16(kf[4], qr[2], p0, 0, 0, 0); MGAP(); p1 = __builtin_amdgcn_mfma_f32_32x32x16_bf16(kf[5], qr[2], p1, 0, 0, 0); MGAP();
  p0 = __builtin_amdgcn_mfma_f32_32x32x16_bf16(kf[6], qr[3], p0, 0, 0, 0); MGAP(); p1 = __builtin_amdgcn_mfma_f32_32x32x16_bf16(kf[7], qr[3], p1, 0, 0, 0); MGAP();
}
struct VFrag { s16x4 lo[4], hh[4]; };
template <int D0> __device__ __forceinline__ void vload(VFrag& f, const A2_LAS char* vp) {
#pragma unroll
  for (int ks = 0; ks < 4; ++ks) { f.lo[ks] = vtr(vp + v_rd_off(D0, ks, 0)); f.hh[ks] = vtr(vp + v_rd_off(D0, ks, 1)); }
}
template <int D0> __device__ __forceinline__ void vload_a(VFrag& f, unsigned va) {
#define VTR_A(dst, off) asm volatile("ds_read_b64_tr_b16 %0, %1 offset:%2" : "=v"(dst) : "v"(va), "n"(off))
  VTR_A(f.lo[0], v_rd_off(D0, 0, 0)); VTR_A(f.hh[0], v_rd_off(D0, 0, 1)); VTR_A(f.lo[1], v_rd_off(D0, 1, 0)); VTR_A(f.hh[1], v_rd_off(D0, 1, 1));
  VTR_A(f.lo[2], v_rd_off(D0, 2, 0)); VTR_A(f.hh[2], v_rd_off(D0, 2, 1)); VTR_A(f.lo[3], v_rd_off(D0, 3, 0)); VTR_A(f.hh[3], v_rd_off(D0, 3, 1));
#undef VTR_A
}
#define VWAIT(n, f) asm volatile("s_waitcnt lgkmcnt(" #n ")" : "+v"(f.lo[0]), "+v"(f.lo[1]), "+v"(f.lo[2]), "+v"(f.lo[3]), "+v"(f.hh[0]), "+v"(f.hh[1]), "+v"(f.hh[2]), "+v"(f.hh[3]))
__device__ __forceinline__ void pvmma(f32x16& od, const VFrag& f, bf16x8 pa0, bf16x8 pa1, bf16x8 pa2, bf16x8 pa3) {
#define PK(k) (bf16x8){f.lo[k][0], f.lo[k][1], f.lo[k][2], f.lo[k][3], f.hh[k][0], f.hh[k][1], f.hh[k][2], f.hh[k][3]}
  od = __builtin_amdgcn_mfma_f32_32x32x16_bf16(PK(0), pa0, od, 0, 0, 0); MGAP();
  od = __builtin_amdgcn_mfma_f32_32x32x16_bf16(PK(1), pa1, od, 0, 0, 0); MGAP();
  od = __builtin_amdgcn_mfma_f32_32x32x16_bf16(PK(2), pa2, od, 0, 0, 0); MGAP();
  od = __builtin_amdgcn_mfma_f32_32x32x16_bf16(PK(3), pa3, od, 0, 0, 0); MGAP();
#undef PK
}
__device__ __forceinline__ float vtail(const f32x16& p0, const f32x16& p1, bf16x8& pa0, bf16x8& pa1, bf16x8& pa2, bf16x8& pa3) {
  float sa, sb, e0, e1, e2, e3, e4, e5, e6, e7; u32x4 w0, w1, w2, w3;
#define VT_BODY(ADD0, ADD1) "v_exp_f32_e32 %6, %14\n\tv_exp_f32_e32 %7, %15\n\tv_exp_f32_e32 %8, %16\n\tv_exp_f32_e32 %9, %17\n\t" ADD0 "v_exp_f32_e32 %10, %18\n\t" ADD1 "v_exp_f32_e32 %11, %19\n\t" \
    "v_cvt_pk_bf16_f32 %2, %6, %7\n\tv_exp_f32_e32 %12, %20\n\tv_cvt_pk_bf16_f32 %3, %8, %9\n\tv_exp_f32_e32 %13, %21\n\tv_add_f32_e32 %0, %0, %10\n\tv_add_f32_e32 %1, %1, %11\n\t" \
    "v_cvt_pk_bf16_f32 %4, %10, %11\n\tv_add_f32_e32 %0, %0, %12\n\tv_add_f32_e32 %1, %1, %13\n\tv_cvt_pk_bf16_f32 %5, %12, %13"
#define VT_OUT(W) "=&v"(W.x), "=&v"(W.y), "=&v"(W.z), "=&v"(W.w), "=&v"(e0), "=&v"(e1), "=&v"(e2), "=&v"(e3), "=&v"(e4), "=&v"(e5), "=&v"(e6), "=&v"(e7)
#define VT_IN(P, B) "v"(P[B + 0]), "v"(P[B + 1]), "v"(P[B + 2]), "v"(P[B + 3]), "v"(P[B + 4]), "v"(P[B + 5]), "v"(P[B + 6]), "v"(P[B + 7])
  asm(VT_BODY("v_add_f32_e32 %0, %6, %7\n\t", "v_add_f32_e32 %1, %8, %9\n\t") : "=&v"(sa), "=&v"(sb), VT_OUT(w0) : VT_IN(p0, 0));
  asm(VT_BODY("v_add_f32_e32 %0, %0, %6\n\tv_add_f32_e32 %1, %1, %7\n\t", "v_add_f32_e32 %0, %0, %8\n\tv_add_f32_e32 %1, %1, %9\n\t") : "+v"(sa), "+v"(sb), VT_OUT(w1) : VT_IN(p0, 8));
  asm(VT_BODY("v_add_f32_e32 %0, %0, %6\n\tv_add_f32_e32 %1, %1, %7\n\t", "v_add_f32_e32 %0, %0, %8\n\tv_add_f32_e32 %1, %1, %9\n\t") : "+v"(sa), "+v"(sb), VT_OUT(w2) : VT_IN(p1, 0));
  asm(VT_BODY("v_add_f32_e32 %0, %0, %6\n\tv_add_f32_e32 %1, %1, %7\n\t", "v_add_f32_e32 %0, %0, %8\n\tv_add_f32_e32 %1, %1, %9\n\t") : "+v"(sa), "+v"(sb), VT_OUT(w3) : VT_IN(p1, 8));
#undef VT_BODY
#undef VT_OUT
#undef VT_IN
  pa0 = *reinterpret_cast<bf16x8*>(&w0); pa1 = *reinterpret_cast<bf16x8*>(&w1); pa2 = *reinterpret_cast<bf16x8*>(&w2); pa3 = *reinterpret_cast<bf16x8*>(&w3);
  return sa + sb;
}
__device__ __forceinline__ float rowmax64(const f32x16& p0, const f32x16& p1) {
  float a, b;
  asm("v_max3_f32 %0, %2, %3, %4\n\tv_max3_f32 %1, %5, %6, %7\n\tv_max3_f32 %0, %0, %8, %9" : "=&v"(a), "=&v"(b) : "v"(p0[0]), "v"(p0[1]), "v"(p1[0]), "v"(p0[2]), "v"(p0[3]), "v"(p1[1]), "v"(p1[2]), "v"(p1[3]));
#define MAX8(r) asm("v_max3_f32 %0, %0, %2, %3\n\tv_max3_f32 %1, %1, %4, %5\n\tv_max3_f32 %0, %0, %6, %7\n\tv_max3_f32 %1, %1, %8, %9" : "+v"(a), "+v"(b) : "v"(p0[r]), "v"(p0[r + 1]), "v"(p0[r + 2]), "v"(p0[r + 3]), "v"(p1[r]), "v"(p1[r + 1]), "v"(p1[r + 2]), "v"(p1[r + 3]))
  MAX8(4); MAX8(8);
  asm("v_max3_f32 %0, %0, %2, %3\n\tv_max3_f32 %1, %1, %4, %5\n\tv_max3_f32 %0, %0, %6, %7\n\tv_max3_f32 %1, %1, %8, %9\n\tv_max_f32_e32 %0, %0, %1" : "+v"(a), "+v"(b) : "v"(p0[12]), "v"(p0[13]), "v"(p0[14]), "v"(p0[15]), "v"(p1[12]), "v"(p1[13]), "v"(p1[14]), "v"(p1[15]));
#undef MAX8
  float rm = a;
  { auto rr = __builtin_amdgcn_permlane32_swap(__float_as_uint(rm), __float_as_uint(rm), false, false); rm = max2f(__uint_as_float(rr[0]), __uint_as_float(rr[1])); }
  return rm;
}
constexpr float REFOFF = THR2 - 1.f;
template <bool NEAR>
__device__ __forceinline__ bool vseg(f32x16& p0, f32x16& p1, float& mhat, float& l_reg, const bool first, const A2_LAS float* tabp, float& fsc, int r32, int hi,
                                     bf16x8& pa0, bf16x8& pa1, bf16x8& pa2, bf16x8& pa3) {
  if (NEAR) {
#pragma unroll
    for (int r = 0; r < 16; ++r) { const int o_ = (r & 3) + 8 * (r >> 2); p0[r] = fadd_s(p0[r], tabp[o_]); p1[r] = fadd_s(p1[r], tabp[o_ + 32]); }
  }
  if (first) { const float d = rowmax64(p0, p1) + REFOFF; mhat += d;
#pragma unroll
    for (int r = 0; r < 16; ++r) { p0[r] -= d; p1[r] -= d; }
    l_reg += vtail(p0, p1, pa0, pa1, pa2, pa3); return false;
  }
  const float ts = vtail(p0, p1, pa0, pa1, pa2, pa3);
  if (__builtin_expect(__any(!(ts < 2.f)), 0)) {
    const float dl = __builtin_fmaxf(rowmax64(p0, p1) + REFOFF, 0.f); mhat += dl;
#pragma unroll
    for (int r = 0; r < 16; ++r) { p0[r] -= dl; p1[r] -= dl; }
    const float f = __builtin_amdgcn_exp2f(-dl); l_reg *= f; fsc = f;
    l_reg += vtail(p0, p1, pa0, pa1, pa2, pa3); return true;
  }
  l_reg += ts; return false;
}

template <int VAR>
__device__ __forceinline__ void attn_unit(const bf16_t* QU, bf16_t* OQ, const bf16_t* __restrict__ KB, const bf16_t* __restrict__ VB, const bf16_t* __restrict__ GA,
                                          const float* __restrict__ tabg, const float* __restrict__ subg, float lam, int tok0, int seq, int h, int q0, A2_LAS unsigned char* lds, const int wave_, const int role_) {
  const int tid = opq_tid(wave_), lane = tid & 63, r32 = lane & 31, hi = lane >> 5; const int wid = wave_;
  const int comp = role_ >> 2, rb = role_ & 3;
  const A2_LAS char* Kr = (const A2_LAS char*)lds + OFF_K; const A2_LAS char* Vr = (const A2_LAS char*)lds + OFF_V;
  A2_LAS float* wsf = (A2_LAS float*)(lds + OFF_WS) + wid * 64; A2_LAS float* li_l = wsf; A2_LAS float* al_l = wsf + 32;
  A2_LAS float* tab = (A2_LAS float*)(lds + OFF_TAB);
  unsigned koff[2], voff[2];
#pragma unroll
  for (int i = 0; i < 2; ++i) { const int pc = 2 * wid + i;
    { const int row = 4 * pc + (lane >> 4), c = (lane & 15) ^ (row & 15); koff[i] = (unsigned)((row >> 4) * 16384 + (c >> 2) * 1024 + (row & 15) * 64 + (c & 3) * 16); }
    { const int st = 2 * pc + (lane >> 5), kk = (st >> 2) * 8 + ((lane & 31) >> 2), key = (kk & ~0xC) | ((kk & 4) << 1) | ((kk & 8) >> 1), col = (st & 3) * 32 + (lane & 3) * 8;
      voff[i] = (unsigned)((key >> 4) * 16384 + (col >> 5) * 1024 + (key & 15) * 64 + (col & 31) * 2); } }
  const char* Kh = (const char*)(KB + blk512(tok0, h * 128)); const char* Vh = (const char*)(VB + blk512(tok0, h * 128));
  const int NT = seq / KVBLK;
#define DMA_K(t, slot) do { const int t_ = (t) < NT ? (t) : NT - 1; const char* g_ = Kh + (size_t)t_ * (KVBLK * 1024); \
    __builtin_amdgcn_global_load_lds((const unsigned*)(g_ + koff[0]), (A2_LAS unsigned*)(lds + OFF_K + (slot) * TILEB + (2 * wid) * 1024), 16, 0, 0); \
    __builtin_amdgcn_global_load_lds((const unsigned*)(g_ + koff[1]), (A2_LAS unsigned*)(lds + OFF_K + (slot) * TILEB + (2 * wid + 1) * 1024), 16, 0, 0); } while (0)
#define DMA_V(t, slot) do { const int t_ = (t) < NT ? (t) : NT - 1; const char* g_ = Vh + (size_t)t_ * (KVBLK * 1024); \
    __builtin_amdgcn_global_load_lds((const unsigned*)(g_ + voff[0]), (A2_LAS unsigned*)(lds + OFF_V + (slot) * TILEB + (2 * wid) * 1024), 16, 0, 0); \
    __builtin_amdgcn_global_load_lds((const unsigned*)(g_ + voff[1]), (A2_LAS unsigned*)(lds + OFF_V + (slot) * TILEB + (2 * wid + 1) * 1024), 16, 0, 0); } while (0)
#define STG_GEOM() int tid_s = tid; asm volatile("" : "+v"(tid_s)); const int sr = tid_s >> 4, sc = (tid_s & 15) * 8
#define STG_KOFF() const int kst0 = KSWZ(sr, sc * 2), kst1 = KSWZ(32 + sr, sc * 2)
#define STG_VOFF() const int kk0 = (sr & ~0xC) | ((sr & 4) << 1) | ((sr & 8) >> 1), kk1 = kk0 + 32; \
    const int vst0 = ((kk0 >> 3) * 4 + (sc >> 5)) * 512 + ((kk0 & 7) * 32 + (sc & 31)) * 2, vst1 = ((kk1 >> 3) * 4 + (sc >> 5)) * 512 + ((kk1 & 7) * 32 + (sc & 31)) * 2
#define STG_SOFF() const unsigned soff0 = (unsigned)(sr * 1024 + sc * 2), soff1 = soff0 + 32 * 1024
  bf16x8 kq0, kq1, vq0, vq1;
#define LD16(base, off) (*reinterpret_cast<const bf16x8*>((base) + (off)))
#define LOADK(t) do { STG_GEOM(); STG_SOFF(); const int t_ = (t) < NT ? (t) : NT - 1; const char* g_ = Kh + (size_t)t_ * (KVBLK * 1024); kq0 = LD16(g_, soff0); kq1 = LD16(g_, soff1); } while (0)
#define LOADV(t) do { STG_GEOM(); STG_SOFF(); const int t_ = (t) < NT ? (t) : NT - 1; const char* g_ = Vh + (size_t)t_ * (KVBLK * 1024); vq0 = LD16(g_, soff0); vq1 = LD16(g_, soff1); } while (0)
#define WRITEK(slot) do { STG_GEOM(); STG_KOFF(); A2_LAS char* d_ = (A2_LAS char*)lds + OFF_K + (slot) * TILEB; *(A2_LAS bf16x8*)(d_ + kst0) = kq0; *(A2_LAS bf16x8*)(d_ + kst1) = kq1; } while (0)
#define WRITEV(slot) do { STG_GEOM(); STG_VOFF(); A2_LAS char* d_ = (A2_LAS char*)lds + OFF_V + (slot) * TILEB; *(A2_LAS bf16x8*)(d_ + vst0) = vq0; *(A2_LAS bf16x8*)(d_ + vst1) = vq1; } while (0)
#define BAR() __builtin_amdgcn_s_barrier()
#define WAITV(n) asm volatile("s_waitcnt vmcnt(" #n ")" ::: "memory")
#define WAITL() asm volatile("s_waitcnt lgkmcnt(0)" ::: "memory")
  bf16x8 qr[4];
  {
#pragma unroll
    for (int d0 = 0; d0 < 4; ++d0) qr[d0] = *reinterpret_cast<const bf16x8*>(QU + blk512(tok0 + q0 + rb * 32 + r32, h * 128 + comp * 64 + hi * 8 + d0 * 16)); }
  { const int i = tid; int rel = i - 256; rel = rel < -128 ? -128 : (rel > 127 ? 127 : rel); tab[i] = tabg[h * 256 + rel + 128]; }
#if ATT_REGSTAGE
  { LOADK(0); LOADV(0); const bf16x8 a0 = kq0, a1 = kq1; LOADK(1); const bf16x8 b0 = kq0, b1 = kq1; LOADK(2); STG_GEOM(); STG_KOFF();
    A2_LAS char* d_ = (A2_LAS char*)lds + OFF_K; *(A2_LAS bf16x8*)(d_ + kst0) = a0; *(A2_LAS bf16x8*)(d_ + kst1) = a1; *(A2_LAS bf16x8*)(d_ + TILEB + kst0) = b0; *(A2_LAS bf16x8*)(d_ + TILEB + kst1) = b1;
    WRITEK(2); WRITEV(0); }
#else
  DMA_K(0, 0); DMA_K(1, 1); DMA_V(0, 0); DMA_K(2, 2);
#endif
  const int qw0 = q0 + rb * 32, qpos = qw0 + r32;
  float mhat = 0.f, l_reg = 0.f; f32x16 o[4];
#pragma unroll
  for (int d = 0; d < 4; ++d) o[d] = f32x16{};
  f32x16 p0, p1, negm; bf16x8 pa0, pa1, pa2, pa3; bf16x8 kf[8]; VFrag vfa, vfb;
#define SBAR() __builtin_amdgcn_sched_barrier(0)
  const int vbase = v_rd_base(lane);
  if (!ATT_REGSTAGE) WAITV(4);
  WAITL(); BAR();
  const float tabL = tab[128], tabR = tab[383];
  if (!ATT_LOCKSTEP && !ATT_ONEBAR && comp == 1) BAR();
#define CLS(j) ((64 * (j) + 63 - qw0 <= -91) ? 0 : ((64 * (j) - qw0 - 31 >= 91) ? 1 : 2))
#define CCONST(c) ((c) == 0 ? tabL : ((c) == 1 ? tabR : 0.f))
#define SETNEGM(c) do { const float v_ = CCONST(c) - mhat; _Pragma("unroll") for (int r = 0; r < 16; ++r) negm[r] = v_; } while (0)
#define RESC() do { _Pragma("unroll") for (int d = 0; d < 4; ++d) _Pragma("unroll") for (int r = 0; r < 16; ++r) o[d][r] *= fsc_; } while (0)
#define VSEG(j, FIRST) do { const int c_ = cls; bool rs_; float fsc_ = 1.f; \
    if (c_ == 2) rs_ = vseg<true>(p0, p1, mhat, l_reg, FIRST, tab + (64 * (j) - qpos + 256 + 4 * hi), fsc_, r32, hi, pa0, pa1, pa2, pa3); \
    else rs_ = vseg<false>(p0, p1, mhat, l_reg, FIRST, tab, fsc_, r32, hi, pa0, pa1, pa2, pa3); \
    if (rs_) RESC(); \
    const int cn_ = CLS((j) + 1); if (__builtin_expect(rs_ || (FIRST) || cn_ != c_, 0)) { SETNEGM(cn_); asm volatile("" : "+v"(negm)); } cls = cn_; } while (0)
#define PKONLY() do { u32x4 w0 = {cvtpk(p0[0], p0[1]), cvtpk(p0[2], p0[3]), cvtpk(p0[4], p0[5]), cvtpk(p0[6], p0[7])}, w1 = {cvtpk(p0[8], p0[9]), cvtpk(p0[10], p0[11]), cvtpk(p0[12], p0[13]), cvtpk(p0[14], p0[15])}; \
    u32x4 w2 = {cvtpk(p1[0], p1[1]), cvtpk(p1[2], p1[3]), cvtpk(p1[4], p1[5]), cvtpk(p1[6], p1[7])}, w3 = {cvtpk(p1[8], p1[9]), cvtpk(p1[10], p1[11]), cvtpk(p1[12], p1[13]), cvtpk(p1[14], p1[15])}; \
    pa0 = *reinterpret_cast<bf16x8*>(&w0); pa1 = *reinterpret_cast<bf16x8*>(&w1); pa2 = *reinterpret_cast<bf16x8*>(&w2); pa3 = *reinterpret_cast<bf16x8*>(&w3); } while (0)
  int cls = CLS(0); SETNEGM(cls);
  kload(kf, Kr, r32, hi, comp);
  A3_PRIO_M(1);
  qkt_a(p0, p1, kf, qr, negm); qkt_b(p0, p1, kf, qr);
  A3_PRIO_M(0);
  if (ATT_REGSTAGE) { SBAR(); LOADK(3); LOADV(1); } else if (!DMA_IN_VSEG) { DMA_K(3, 3); DMA_V(1, 1); }
  if (!ATT_LOCKSTEP && (!ATT_ONEBAR || comp == 1)) { if (comp == 1 && !ATT_REGSTAGE) { if (DMA_IN_VSEG) WAITV(0); else WAITV(4); } WAITL(); BAR(); }
  if (DMA_IN_VSEG && !ATT_REGSTAGE) { DMA_K(3, 3); DMA_V(1, 1); }
  A3_PRIO_V(1); kload(kf, Kr + TILEB, r32, hi, comp); SBAR();
  VSEG(0, true); A3_PRIO_V(0);
  if (QK_IN_VSEG) { qkt_a(p0, p1, kf, qr, negm); qkt_b(p0, p1, kf, qr); }
  if (ATT_REGSTAGE) { WRITEK(3); WRITEV(1); WAITL(); } else if (ATT_LOCKSTEP || comp == 0) WAITV(4);
  if (!ATT_ONEBAR || ATT_LOCKSTEP || comp == 0) BAR();
  int sk = 2, sv = 0;
  for (int j = 1; j < NT; ++j) {
    asm volatile("" : "+v"(koff[0]), "+v"(koff[1]), "+v"(voff[0]), "+v"(voff[1]));
    const A2_LAS char* vp = Vr + sv * TILEB + vbase;
    A3_PRIO_M(1);
    if (VAR == 8) {
#define FILL() do { fx0 = __builtin_amdgcn_exp2f(fx0); fy0 += fx1; fy1 += fx0; fy2 += fy0; asm volatile("" : "+v"(fx0), "+v"(fy0), "+v"(fy1), "+v"(fy2)); } while (0)
#define MF(dst, a, b, c) do { dst = __builtin_amdgcn_mfma_f32_32x32x16_bf16(a, b, c, 0, 0, 0); FILL(); } while (0)
      float fx0 = (float)j, fx1 = 1.f, fy0 = 0.f, fy1 = 0.f, fy2 = 0.f;
      MF(p0, kf[0], qr[0], negm); MF(p1, kf[1], qr[0], negm); MF(p0, kf[2], qr[1], p0); MF(p1, kf[3], qr[1], p1); MF(p0, kf[4], qr[2], p0); MF(p1, kf[5], qr[2], p1); MF(p0, kf[6], qr[3], p0); MF(p1, kf[7], qr[3], p1);
      const bf16x8 vb_ = kf[0];
      _Pragma("unroll") for (int d = 0; d < 4; ++d) { MF(o[d], pa0, vb_, o[d]); MF(o[d], pa1, vb_, o[d]); MF(o[d], pa2, vb_, o[d]); MF(o[d], pa3, vb_, o[d]); }
      l_reg += fy1 + fy2;
#undef MF
#undef FILL
    } else if (VAR == 4 || VAR == 6 || VAR == 7) {
      asm volatile("" : "+v"(vfa.lo[0]), "+v"(vfa.hh[0]), "+v"(vfb.lo[0]), "+v"(vfb.hh[0]));
      qkt_a(p0, p1, kf, qr, negm); qkt_b(p0, p1, kf, qr);
      pvmma(o[0], vfa, pa0, pa1, pa2, pa3); pvmma(o[1], vfb, pa0, pa1, pa2, pa3); pvmma(o[2], vfa, pa0, pa1, pa2, pa3); pvmma(o[3], vfb, pa0, pa1, pa2, pa3);
    } else if (VAR == 5) {
      vload<0>(vfa, vp); vload<1>(vfb, vp); asm volatile("" : "+v"(vfa.lo[0]), "+v"(vfa.lo[1]), "+v"(vfa.lo[2]), "+v"(vfa.lo[3]), "+v"(vfa.hh[0]), "+v"(vfa.hh[1]), "+v"(vfa.hh[2]), "+v"(vfa.hh[3]), "+v"(vfb.lo[0]), "+v"(vfb.lo[1]), "+v"(vfb.lo[2]), "+v"(vfb.lo[3]), "+v"(vfb.hh[0]), "+v"(vfb.hh[1]), "+v"(vfb.hh[2]), "+v"(vfb.hh[3]));
      vload<2>(vfa, vp); vload<3>(vfb, vp); asm volatile("" : "+v"(vfa.lo[0]), "+v"(vfa.lo[1]), "+v"(vfa.lo[2]), "+v"(vfa.lo[3]), "+v"(vfa.hh[0]), "+v"(vfa.hh[1]), "+v"(vfa.hh[2]), "+v"(vfa.hh[3]), "+v"(vfb.lo[0]), "+v"(vfb.lo[1]), "+v"(vfb.lo[2]), "+v"(vfb.lo[3]), "+v"(vfb.hh[0]), "+v"(vfb.hh[1]), "+v"(vfb.hh[2]), "+v"(vfb.hh[3]));
      asm volatile("" : "+v"(kf[0]), "+v"(kf[1]), "+v"(kf[2]), "+v"(kf[3]), "+v"(kf[4]), "+v"(kf[5]), "+v"(kf[6]), "+v"(kf[7]));
      p0 = negm; p1 = negm;
    } else {
    const unsigned va = (unsigned)(size_t)vp;
    if (!QK_IN_VSEG) { qkt_a(p0, p1, kf, qr, negm); SBAR(); }
    vload_a<0>(vfa, va); SBAR();
    if (!QK_IN_VSEG) qkt_b(p0, p1, kf, qr);
    vload_a<1>(vfb, va); SBAR();
    VWAIT(8, vfa); pvmma(o[0], vfa, pa0, pa1, pa2, pa3);
    vload_a<2>(vfa, va); SBAR();
    VWAIT(8, vfb); pvmma(o[1], vfb, pa0, pa1, pa2, pa3);
    vload_a<3>(vfb, va); SBAR();
    VWAIT(8, vfa); pvmma(o[2], vfa, pa0, pa1, pa2, pa3);
    VWAIT(0, vfb); pvmma(o[3], vfb, pa0, pa1, pa2, pa3);
    }
    A3_PRIO_M(0);
    { const int s3 = (sk + 2) & 3  , s1 = sv == 0 ? 2 : sv - 1  ; if (VAR != 3 && VAR != 7 && VAR != 8) { if (ATT_REGSTAGE) { SBAR(); LOADK(j + 3); LOADV(j + 1); } else if (!DMA_IN_VSEG) { DMA_K(j + 3, s3); DMA_V(j + 1, s1); } } }
    if (!ATT_LOCKSTEP && (!ATT_ONEBAR || comp == 1)) { if (comp == 1 && VAR != 3 && VAR != 7 && VAR != 8 && !ATT_REGSTAGE) { if (DMA_IN_VSEG) WAITV(0); else WAITV(4); } WAITL(); BAR(); }
    if (DMA_IN_VSEG && !ATT_REGSTAGE && VAR != 3 && VAR != 7 && VAR != 8) { const int s3 = (sk + 2) & 3, s1 = sv == 0 ? 2 : sv - 1; DMA_K(j + 3, s3); DMA_V(j + 1, s1); }
    A3_PRIO_V(1); if (VAR != 4 && VAR != 6 && VAR != 7 && VAR != 8) { kload(kf, Kr + sk * TILEB, r32, hi, comp); } SBAR();
    if (VAR != 1 && VAR != 6 && VAR != 7 && VAR != 8) { VSEG(j, false); } else { PKONLY(); } A3_PRIO_V(0);
    if (QK_IN_VSEG && VAR == 0) { qkt_a(p0, p1, kf, qr, negm); qkt_b(p0, p1, kf, qr); }
    if (ATT_REGSTAGE) { if (VAR != 3 && VAR != 7 && VAR != 8) { WRITEK((sk + 2) & 3); WRITEV(sv == 0 ? 2 : sv - 1); WAITL(); } }
    else if ((ATT_LOCKSTEP || comp == 0) && VAR != 3 && VAR != 7 && VAR != 8) WAITV(4);
    if (!ATT_ONEBAR || ATT_LOCKSTEP || comp == 0) BAR();
    sk = (sk + 1) & 3; sv = sv == 2 ? 0 : sv + 1;
  }
  { const A2_LAS char* vp = Vr + sv * TILEB + vbase;
    A3_PRIO_M(1);
    const unsigned va = (unsigned)(size_t)vp;
    vload_a<0>(vfa, va); vload_a<1>(vfb, va); SBAR(); VWAIT(8, vfa); pvmma(o[0], vfa, pa0, pa1, pa2, pa3); vload_a<2>(vfa, va); SBAR(); VWAIT(8, vfb); pvmma(o[1], vfb, pa0, pa1, pa2, pa3); vload_a<3>(vfb, va); SBAR();
    VWAIT(8, vfa); pvmma(o[2], vfa, pa0, pa1, pa2, pa3); VWAIT(0, vfb); pvmma(o[3], vfb, pa0, pa1, pa2, pa3);
    A3_PRIO_M(0); }
  WAITV(0); WAITL();
  if (!ATT_LOCKSTEP && !ATT_ONEBAR && comp == 0) BAR();
  { auto rr = __builtin_amdgcn_permlane32_swap(__float_as_uint(l_reg), __float_as_uint(l_reg), false, false); l_reg = __uint_as_float(rr[0]) + __uint_as_float(rr[1]); }
  const float rl = __builtin_amdgcn_rcpf(l_reg);
  u32x4 gq[4]; f32x4 sq[8];
  { const int row = tid >> 2, qt = tid & 3; const bf16_t* gp = GA + blk512(tok0 + q0 + row, h * 128 + qt * 32); const float* sg = subg + qt * 32;
#pragma unroll
    for (int i = 0; i < 4; ++i) { gq[i] = *(const u32x4*)(gp + 8 * i); sq[2 * i] = *(const f32x4*)(sg + 8 * i); sq[2 * i + 1] = *(const f32x4*)(sg + 8 * i + 4); } }
  WAITL(); BAR(); asm volatile("" ::: "memory");
  A2_LAS float* OC = (A2_LAS float*)lds; constexpr int OST = 129;
  if (comp == 0) {
#pragma unroll
    for (int r = 0; r < 16; ++r) {
#pragma unroll
      for (int d0 = 0; d0 < 4; ++d0) OC[(32 * d0 + crow(r, hi)) * OST + rb * 32 + r32] = o[d0][r] * rl; }
  }
  WAITL(); BAR(); asm volatile("" ::: "memory");
  if (comp == 1) { const float sl = lam * rl;
#pragma unroll
    for (int r = 0; r < 16; ++r) {
#pragma unroll
      for (int d0 = 0; d0 < 4; ++d0) OC[(32 * d0 + crow(r, hi)) * OST + rb * 32 + r32] -= o[d0][r] * sl; }
  }
  WAITL(); BAR(); asm volatile("" ::: "memory");
  { const int row = tid >> 2, qt = tid & 3; const A2_LAS float* rp = OC + (qt * 32) * OST + row;
    f32x4 v[8]; float ss = 0.f;
#pragma unroll
    for (int i = 0; i < 8; ++i) { v[i] = (f32x4){rp[(4 * i) * OST], rp[(4 * i + 1) * OST], rp[(4 * i + 2) * OST], rp[(4 * i + 3) * OST]}; ss += (v[i][0] * v[i][0] + v[i][1] * v[i][1]) + (v[i][2] * v[i][2] + v[i][3] * v[i][3]); }
    ss += bperm_f(lane ^ 1, ss); ss += bperm_f(lane ^ 2, ss);
    const float rstd = __builtin_amdgcn_rsqf(ss * (1.f / 128.f) + 1e-5f) * 0.8f;
    const size_t t = (size_t)(tok0 + q0 + row); bf16_t* op = OQ + t * 1024 + h * 128 + qt * 32;
#pragma unroll
    for (int i = 0; i < 4; ++i) { const u32x4 g = gq[i]; const f32x4 s0 = sq[2 * i], s1 = sq[2 * i + 1];
      const f32x4 a = v[2 * i] * rstd * s0, b = v[2 * i + 1] * rstd * s1; u32x4 w;
      w.x = cvtpk(a[0] * silu(bflo(g.x)), a[1] * silu(bfhi(g.x))); w.y = cvtpk(a[2] * silu(bflo(g.y)), a[3] * silu(bfhi(g.y)));
      w.z = cvtpk(b[0] * silu(bflo(g.z)), b[1] * silu(bfhi(g.z))); w.w = cvtpk(b[2] * silu(bflo(g.w)), b[3] * silu(bfhi(g.w)));
      *(u32x4*)(op + 8 * i) = w; }
  }
  asm volatile("s_waitcnt vmcnt(0)" ::: "memory");
  __syncthreads();
#undef DMA_K
#undef LD16
#undef STG_GEOM
#undef STG_KOFF
#undef STG_VOFF
#undef STG_SOFF
#undef LOADK
#undef LOADV
#undef WRITEK
#undef WRITEV
#undef DMA_V
#undef BAR
#undef WAITV
#undef WAITL
#undef CLS
#undef CCONST
#undef SETNEGM
#undef RESC
#undef VSEG
#undef PKONLY
#undef SBAR
#undef VWAIT
}
#undef KSWZ
}
struct Frame {
    LAS unsigned char* lds;
    volatile LAS unsigned* MISC;
    unsigned* ctl;
    int wave;
    int role;
    int vcu, G;
};
__device__ __forceinline__ float wave_sum(float v, int lane) {
#pragma unroll
    for (int o = 1; o < 64; o <<= 1) v += bperm_f(lane ^ o, v);
    return v;
}
__device__ __forceinline__ void p0_transpose_item(const float* W, int K, int N, bf16* WT, const float* kscale, LAS float* scr, int item, int lane) {
    const int nblk = N / 32, kb = item / nblk, nb = item % nblk, k0 = 64 * kb, n0 = 32 * nb;
#pragma unroll 8
    for (int i = 0; i < 32; ++i) { const int kk = 2 * i + (lane >> 5); float w = W[(size_t)(k0 + kk) * N + n0 + (lane & 31)]; if (kscale) w *= kscale[k0 + kk]; scr[kk * 33 + (lane & 31)] = w; }
    LDS_WAIT(); asm volatile("" ::: "memory");
    const int c = lane & 7;
#pragma unroll
    for (int j = 0; j < 4; ++j) { const int n = (lane >> 3) + 8 * j; const LAS float* s = scr + (8 * c) * 33 + n;
        v4u o; o.x = pk2(s[0 * 33], s[1 * 33]); o.y = pk2(s[2 * 33], s[3 * 33]); o.z = pk2(s[4 * 33], s[5 * 33]); o.w = pk2(s[6 * 33], s[7 * 33]);
        *(GAS v4u*)(WT + (size_t)(n0 + n) * K + k0 + 8 * c) = o; }
    LDS_WAIT(); asm volatile("" ::: "memory");
}
__device__ __forceinline__ void rms_row2_to_bf16(const float* xrow0, const float* xrow1, const float* g, bf16* orow0, bf16* orow1, int lane) {
    const GAS f32x4* xr0 = (const GAS f32x4*)xrow0 + lane; const GAS f32x4* xr1 = (const GAS f32x4*)xrow1 + lane; const GAS f32x4* gr = (const GAS f32x4*)g + lane;
    f32x4 v[4], u[4]; float s = 0.f, t = 0.f;
#pragma unroll
    for (int j = 0; j < 4; ++j) { v[j] = xr0[64 * j]; u[j] = xr1[64 * j]; }
#pragma unroll
    for (int j = 0; j < 4; ++j) { s += (v[j].x * v[j].x + v[j].y * v[j].y) + (v[j].z * v[j].z + v[j].w * v[j].w); t += (u[j].x * u[j].x + u[j].y * u[j].y) + (u[j].z * u[j].z + u[j].w * u[j].w); }
#pragma unroll
    for (int o = 1; o < 64; o <<= 1) { s += bperm_f(lane ^ o, s); t += bperm_f(lane ^ o, t); }
    const float r0 = __builtin_amdgcn_rsqf(s * (1.f / 1024.f) + 1e-6f), r1 = __builtin_amdgcn_rsqf(t * (1.f / 1024.f) + 1e-6f);
    GAS unsigned long long* o0 = (GAS unsigned long long*)orow0 + lane; GAS unsigned long long* o1 = (GAS unsigned long long*)orow1 + lane;
#pragma unroll
    for (int j = 0; j < 4; ++j) { const f32x4 gg = gr[64 * j];
        o0[64 * j] = (unsigned long long)pk2(v[j].x * r0 * gg.x, v[j].y * r0 * gg.y) | ((unsigned long long)pk2(v[j].z * r0 * gg.z, v[j].w * r0 * gg.w) << 32);
        o1[64 * j] = (unsigned long long)pk2(u[j].x * r1 * gg.x, u[j].y * r1 * gg.y) | ((unsigned long long)pk2(u[j].z * r1 * gg.z, u[j].w * r1 * gg.w) << 32); }
}
__device__ __forceinline__ int t5_bucket(int rel) {
    const int n = rel < 0 ? -rel : rel; int b;
    if (n < 8) b = n; else b = 8 + (n >= 12) + (n >= 16) + (n >= 23) + (n >= 32) + (n >= 46) + (n >= 64) + (n >= 91);
    return b + (rel > 0 ? 16 : 0);
}
struct Args { const float* in[15]; float* out; unsigned char* ws; };
__device__ __forceinline__ void rms_row4_to_bf16(const float* xrow0, const float* g, bf16* orow0, int lane) {
    const GAS f32x4* gr = (const GAS f32x4*)g + lane;
    f32x4 v[4][4]; float s[4];
#pragma unroll
    for (int r = 0; r < 4; ++r) { const GAS f32x4* xr = (const GAS f32x4*)(xrow0 + (size_t)r * 1024) + lane;
#pragma unroll
        for (int j = 0; j < 4; ++j) v[r][j] = xr[64 * j]; }
#pragma unroll
    for (int r = 0; r < 4; ++r) { s[r] = 0.f;
#pragma unroll
        for (int j = 0; j < 4; ++j) s[r] += (v[r][j].x * v[r][j].x + v[r][j].y * v[r][j].y) + (v[r][j].z * v[r][j].z + v[r][j].w * v[r][j].w); }
#pragma unroll
    for (int o = 1; o < 64; o <<= 1) {
#pragma unroll
        for (int r = 0; r < 4; ++r) s[r] += bperm_f(lane ^ o, s[r]); }
    f32x4 gg[4];
#pragma unroll
    for (int j = 0; j < 4; ++j) gg[j] = gr[64 * j];
#pragma unroll
    for (int r = 0; r < 4; ++r) { const float rs = __builtin_amdgcn_rsqf(s[r] * (1.f / 1024.f) + 1e-6f); GAS unsigned long long* o8 = (GAS unsigned long long*)(orow0 + (size_t)r * 1024) + lane;
#pragma unroll
        for (int j = 0; j < 4; ++j) o8[64 * j] = (unsigned long long)pk2(v[r][j].x * rs * gg[j].x, v[r][j].y * rs * gg[j].y) | ((unsigned long long)pk2(v[r][j].z * rs * gg[j].z, v[r][j].w * rs * gg[j].w) << 32); }
}
__device__ __forceinline__ void p0_prologue(Frame& F, const Args& a, const int parts = 3) {
    const int tid_ = opq_tid(F.wave), lane_ = tid_ & 63;
    const float* xp = a.in[0]; const float* xs = a.in[1]; const float* pp = a.in[2]; const float* ps = a.in[3]; const float* g_mix = a.in[4]; const float* w_in = a.in[5];
    const float* lamp = a.in[6]; const float* relb = a.in[8]; const float* wf = a.in[9]; const float* w_out = a.in[10]; const float* g_ple = a.in[11];
    const float* w_gate = a.in[12]; const float* w_proj = a.in[13];
    unsigned char* ws = a.ws;
    if (parts & 2) {
        LAS float* scr = (LAS float*)(F.lds + F.wave * 16384);
        const int gw = F.vcu * NWAVES + F.wave, NGW = F.G * NWAVES;
        constexpr int I_IN = (DM / 64) * (NIN / 32), I_SQ = (DM / 64) * (DM / 32), I_P = (PLED / 64) * (DM / 32);
        for (int it = gw; it < I_IN + 2 * I_SQ + I_P; it += NGW) {
            int r = it;
            if (r < I_IN) { p0_transpose_item(w_in, DM, NIN, (bf16*)(ws + WS_WIN), nullptr, scr, r, lane_); continue; } r -= I_IN;
            if (r < I_SQ) { p0_transpose_item(w_out, DM, DM, (bf16*)(ws + WS_WOUT), nullptr, scr, r, lane_); continue; } r -= I_SQ;
            if (r < I_SQ) { p0_transpose_item(w_gate, DM, DM, (bf16*)(ws + WS_WG), g_ple, scr, r, lane_); continue; } r -= I_SQ;
            p0_transpose_item(w_proj, PLED, DM, (bf16*)(ws + WS_WP), nullptr, scr, r, lane_);
        }
        const int gt = F.vcu * (NWAVES * 64) + tid_, NGT = F.G * (NWAVES * 64);
        { constexpr int E_H1A = 64 * 64, E_H1B = 128 * 128, E_M2A = 33 * 16384, E_M2B = 65 * 16384;
          for (int i = gt; i < E_H1A + E_H1B + E_M2A + E_M2B; i += NGT) {
              int e = i; float val; bf16* dst;
              if (e < E_H1A + E_H1B) {
                  int N1, r, s1; if (e < E_H1A) { N1 = 64; r = e >> 6; s1 = e & 63; dst = (bf16*)(ws + WS_H1A) + e; } else { e -= E_H1A; N1 = 128; r = e >> 7; s1 = e & 127; dst = (bf16*)(ws + WS_H1B) + e; }
                  if (r == 0) val = 1.f; else if (r == 1) val = (s1 & 1) ? -1.f : 1.f;
                  else { const int k = r >> 1, j = (k * s1) & (N1 - 1); const float x = 2.f * (float)j / (float)N1; val = (r & 1) ? -sinpif(x) : cospif(x); }
              } else {
                  e -= E_H1A + E_H1B; int S, N1; float norm;
                  if (e < E_M2A) { S = 4096; N1 = 64; norm = 0.0013810679320049757f; dst = (bf16*)(ws + WS_M2A) + e; } else { e -= E_M2A; S = 8192; N1 = 128; norm = 0.0009765625f; dst = (bf16*)(ws + WS_M2B) + e; }
                  const int kt = e >> 14, m = (e >> 7) & 127, kp = e & 127, ro = m >> 6, k2 = m & 63, ri = kp >> 6, s2 = kp & 63;
                  const int sp = kt + N1 * k2, j = (s2 * sp) & (S - 1); const float x = 2.f * (float)j / (float)S; const float c = cospif(x), s = sinpif(x);
                  if (kt == 0) val = (ri == 0) ? (ro == 0 ? c : -s) : 0.f;
                  else if (kt == N1 / 2) val = (ri == 1) ? (ro == 0 ? c : -s) : 0.f;
                  else val = (ro == ri) ? c : (ro == 0 ? s : -s);
                  val *= norm;
              }
              *dst = (bf16)f2bf(val);
          } }
        { bf16* Gt = (bf16*)(ws + WS_GT); LAS float* ct = scr + 2304; LAS float* st = ct + 128;
          for (int i = lane_; i < 128; i += 64) { const float x = (float)i * (1.f / 64.f); ct[i] = cospif(x); st[i] = sinpif(x); }
          LDS_WAIT(); asm volatile("" ::: "memory");
          for (int i = gt; i < 512 * 1024 / 8; i += NGT) { const int n = i >> 7, k8 = (i & 127) * 8; if ((k8 >> 8) != (n >> 7)) *(v4u*)(Gt + (size_t)n * 1024 + k8) = (v4u){0u, 0u, 0u, 0u}; }
          for (int i = gt; i < 4 * 128 * 128; i += NGT) { const int g = i >> 14, c = (i >> 7) & 127, d = i & 127; float are = 0.f, aim = 0.f; const float* wp = wf + (size_t)g * 16384 + d;
#pragma unroll 8
              for (int cp = 0; cp < 128; ++cp) { const int j = (c * cp) & 127; const float w = wp[cp * 128]; are += ct[j] * w; aim += st[j] * w; }
              bf16* o = Gt + (size_t)(g * 128 + d) * 1024 + g * 256 + c; o[0] = (bf16)f2bf(are); o[128] = (bf16)f2bf(aim); } }
        if (F.vcu == 0) {
            float* tab = (float*)(ws + WS_TAB);
            for (int i = tid_; i < 1024; i += NWAVES * 64) { const int h = i >> 8, rel = (i & 255) - 128; tab[i] = relb[t5_bucket(rel) * 4 + h] * LOG2E; }
            if (tid_ == 0) { float s01 = 0.f, s23 = 0.f; for (int d = 0; d < 64; ++d) { s01 += lamp[d] * lamp[64 + d]; s23 += lamp[128 + d] * lamp[192 + d]; }
                tab[1024] = __expf(s01) - __expf(s23) + 0.2f; }
        }
    }
    if (parts & 1) {
        const int gw = F.vcu * NWAVES + F.wave, NGW = F.G * NWAVES;
        for (int m = 4 * gw; m < NTOK; m += 4 * NGW) { const float* xrow0 = m < TPR ? xp + (size_t)m * DM : xs + (size_t)(m - TPR) * DM;
            rms_row4_to_bf16(xrow0, g_mix, (bf16*)(ws + WS_XN) + (size_t)m * DM, lane_); }
        const int gt = F.vcu * (NWAVES * 64) + tid_, NGT = F.G * (NWAVES * 64); bf16* PB = (bf16*)a.out;
        for (int i0 = gt; i0 + 3 * NGT < NTOK * (PLED / 8); i0 += 4 * NGT) { f32x4 v0[4], v1[4];
#pragma unroll
            for (int k = 0; k < 4; ++k) { const int i = i0 + k * NGT, row = i >> 5, c8 = (i & 31) * 8; const float* src = (row < TPR ? pp + (size_t)row * PLED : ps + (size_t)(row - TPR) * PLED) + c8;
                v0[k] = *(const f32x4*)src; v1[k] = *(const f32x4*)(src + 4); }
#pragma unroll
            for (int k = 0; k < 4; ++k) { const int i = i0 + k * NGT, row = i >> 5, c8 = (i & 31) * 8; v4u o; o.x = pk2(v0[k].x, v0[k].y); o.y = pk2(v0[k].z, v0[k].w); o.z = pk2(v1[k].x, v1[k].y); o.w = pk2(v1[k].z, v1[k].w);
                *(v4u*)(PB + (size_t)row * PLED + c8) = o; } }
    }
}
typedef short s16x4_t __attribute__((ext_vector_type(4)));
__device__ __forceinline__ s16x4_t trd(const LAS bf16* p) { return __builtin_bit_cast(s16x4_t, __builtin_amdgcn_ds_read_tr16_b64_v4i16((LAS s16x4_t*)p)); }
template <int MK> struct NNRegs { v4u ra[MK * MK / 8 / (NWAVES * 64)], rb[MK * 16 / (NWAVES * 64)]; };
template <int MK, bool BLK = false>
__device__ __forceinline__ void nn_load(NNRegs<MK>& R, const bf16* A, const bf16* B, size_t ldb, int tid) {
    constexpr int NA = MK * MK / 8 / (NWAVES * 64), NB = MK * 16 / (NWAVES * 64);
    static_assert(NA * NWAVES * 64 * 8 == MK * MK && NB * NWAVES * 64 == MK * 16, "staging trip counts");
#pragma unroll
    for (int i = 0; i < NA; ++i) { const int idx = tid + i * (NWAVES * 64), r = idx / (MK / 8), c = idx % (MK / 8); R.ra[i] = *(const v4u*)(A + r * MK + c * 8); }
#pragma unroll
    for (int i = 0; i < NB; ++i) { const int idx = tid + i * (NWAVES * 64), r = idx >> 4, c = idx & 15; R.rb[i] = *(const v4u*)(B + (size_t)r * ldb + (BLK ? (c >> 2) * 512 + (c & 3) * 8 : c * 8)); }
}
template <int MK>
__device__ __forceinline__ void nn_stage(LAS unsigned char* lds, const NNRegs<MK>& R, int tid) {
    constexpr int AST = MK + 8, BST = 136, NA = MK * MK / 8 / (NWAVES * 64), NB = MK * 16 / (NWAVES * 64);
    LAS bf16* As = (LAS bf16*)lds; LAS bf16* Bs = (LAS bf16*)(lds + 40960);
    LDS_WAIT(); __builtin_amdgcn_s_barrier(); asm volatile("" ::: "memory");
#pragma unroll
    for (int i = 0; i < NA; ++i) { const int idx = tid + i * (NWAVES * 64), r = idx / (MK / 8), c = idx % (MK / 8); *(LAS v4u*)(As + r * AST + c * 8) = R.ra[i]; }
#pragma unroll
    for (int i = 0; i < NB; ++i) { const int idx = tid + i * (NWAVES * 64), r = idx >> 4, c = idx & 15; *(LAS v4u*)(Bs + r * BST + c * 8) = R.rb[i]; }
    LDS_WAIT(); __builtin_amdgcn_s_barrier(); asm volatile("" ::: "memory");
}
template <int MK>
__device__ __forceinline__ void nn_mfma(LAS unsigned char* lds, int tid, f32x4 (&acc)[MK / 16]) {
    constexpr int AST = MK + 8, BST = 136;
    const LAS bf16* As = (const LAS bf16*)lds; const LAS bf16* Bs = (const LAS bf16*)(lds + 40960);
    const int w = tid >> 6, l = tid & 63, lr = l & 15, lq = l >> 4;
#pragma unroll
    for (int mt = 0; mt < MK / 16; ++mt) acc[mt] = (f32x4){0.f, 0.f, 0.f, 0.f};
#pragma unroll
    for (int ks = 0; ks < MK / 32; ++ks) {
        const LAS bf16* bp = Bs + (ks * 32 + 8 * lq + (lr >> 2)) * BST + 16 * w + 4 * (lr & 3);
        const s16x4_t blo = trd(bp), bhi = trd(bp + 4 * BST);
        const bf16x8 bfr = {blo[0], blo[1], blo[2], blo[3], bhi[0], bhi[1], bhi[2], bhi[3]};
#pragma unroll
        for (int mt = 0; mt < MK / 16; ++mt) { const bf16x8 afr = *(const LAS bf16x8*)(As + (mt * 16 + lr) * AST + ks * 32 + 8 * lq);
            acc[mt] = __builtin_amdgcn_mfma_f32_16x16x32_bf16(bfr, afr, acc[mt], 0, 0, 0); }
    }
}
template <int MK>
__device__ __forceinline__ void nn_tile(LAS unsigned char* lds, const bf16* A, const bf16* B, size_t ldb, int tid, f32x4 (&acc)[MK / 16]) {
    NNRegs<MK> R; nn_load<MK>(R, A, B, ldb, tid); nn_stage<MK>(lds, R, tid); nn_mfma<MK>(lds, tid, acc);
}
template <int MK>
__device__ __forceinline__ void fft_stage1_run(LAS unsigned char* lds, const bf16* H1, const bf16* QU, bf16* Y, int tokbase, int seqlen, int first, int nitems, int G, int tid) {
    if (first >= nitems) return;
    NNRegs<MK> R;
#define S1_SRC(it) (QU + blk512(tokbase + ((it) >> 8) * seqlen + (((it) & 255) >> 2), (((it) & 255) & 3) * 128))
    nn_load<MK, true>(R, H1, S1_SRC(first), (size_t)32768, tid);
    for (int it = first; it < nitems; it += G) {
        nn_stage<MK>(lds, R, tid);
        if (it + G < nitems) nn_load<MK, true>(R, H1, S1_SRC(it + G), (size_t)32768, tid);
        f32x4 acc[MK / 16]; nn_mfma<MK>(lds, tid, acc);
        const int tok0 = tokbase + (it >> 8) * seqlen, nt = it & 255, s2 = nt >> 2, ch0 = (nt & 3) * 128;
        const int w = tid >> 6, l = tid & 63, lr = l & 15, lq = l >> 4;
        bf16* yb = Y + (size_t)tok0 * 512 + (size_t)s2 * 512 + ch0 + 16 * w + 4 * lq;
#pragma unroll
        for (int mt = 0; mt < MK / 16; ++mt) { const int r = mt * 16 + lr; v2u o; o.x = pk2(acc[mt][0], acc[mt][1]); o.y = pk2(acc[mt][2], acc[mt][3]); *(v2u*)(yb + (size_t)r * (64 * 512)) = o; }
    }
#undef S1_SRC
}
template <int MK>
__device__ __forceinline__ void fft_stage1_item(LAS unsigned char* lds, const bf16* H1, const bf16* QU, bf16* Y, int tok0, int nt, int tid) {
    const int s2 = nt >> 2, ch0 = (nt & 3) * 128;
    f32x4 acc[MK / 16];
    nn_tile<MK>(lds, H1, QU + (size_t)(tok0 + s2) * 1024 + 512 + ch0, (size_t)64 * 1024, tid, acc);
    const int w = tid >> 6, l = tid & 63, lr = l & 15, lq = l >> 4;
    bf16* yb = Y + (size_t)tok0 * 512 + (size_t)s2 * 512 + ch0 + 16 * w + 4 * lq;
#pragma unroll
    for (int mt = 0; mt < MK / 16; ++mt) { const int r = mt * 16 + lr; v2u o; o.x = pk2(acc[mt][0], acc[mt][1]); o.y = pk2(acc[mt][2], acc[mt][3]); *(v2u*)(yb + (size_t)r * (64 * 512)) = o; }
}
__device__ __forceinline__ void fft_stage2_item(LAS unsigned char* lds, const bf16* M2, const bf16* Y, bf16* XP, int tok0, int S, int N1, int kt, int g, int tid) {
    const int p = (kt == 0 || kt == N1 / 2) ? 0 : kt;
    f32x4 acc[8];
    nn_tile<128>(lds, M2 + (size_t)kt * 16384, Y + (size_t)tok0 * 512 + (size_t)(2 * p * 64) * 512 + g * 128, (size_t)512, tid, acc);
    const int w = tid >> 6, l = tid & 63, lr = l & 15, lq = l >> 4; const int c = 16 * w + 4 * lq; const bool mir = (kt != 0 && kt != N1 / 2);
#pragma unroll
    for (int mt = 0; mt < 8; ++mt) { const int m = mt * 16 + lr, ro = m >> 6, k2 = m & 63, sp = kt + N1 * k2;
        v2u o; o.x = pk2(acc[mt][0], acc[mt][1]); o.y = pk2(acc[mt][2], acc[mt][3]);
        *(v2u*)(XP + (size_t)(tok0 + sp) * 1024 + g * 256 + ro * 128 + c) = o;
        if (mir) { if (ro) { o.x ^= 0x80008000u; o.y ^= 0x80008000u; } *(v2u*)(XP + (size_t)(tok0 + S - sp) * 1024 + g * 256 + ro * 128 + c) = o; } }
}

__device__ __forceinline__ void fft_stage2c_item(LAS unsigned char* lds, const bf16* M2, const bf16* Y, const bf16* Gt, const bf16* GF, bf16* QU, int tok0, int S, int N1, int kt, int g, int tid) {
    const int p = (kt == 0 || kt == N1 / 2) ? 0 : kt;
    const int w = tid >> 6, l = tid & 63, lr = l & 15, lq = l >> 4; const bool mir = (kt != 0 && kt != N1 / 2);
    bf16x8 gre[4], gim[4];
    { const bf16* gp = Gt + (size_t)(g * 128 + 16 * w + lr) * 1024 + g * 256 + 8 * lq;
#pragma unroll
      for (int ks = 0; ks < 4; ++ks) { gre[ks] = *(const bf16x8*)(gp + ks * 32); gim[ks] = *(const bf16x8*)(gp + 128 + ks * 32); } }
    const int d0 = g * 128 + 16 * w + 4 * lq;
    v2u gwa[4], gwb[4];
#pragma unroll
    for (int tb = 0; tb < 4; ++tb) { const int sp = kt + N1 * (16 * tb + lr); gwa[tb] = *(const v2u*)(GF + (size_t)(tok0 + sp) * 512 + d0);
        if (mir) gwb[tb] = *(const v2u*)(GF + (size_t)(tok0 + S - sp) * 512 + d0); else gwb[tb] = (v2u){0u, 0u}; }
    f32x4 acc[8];
    nn_tile<128>(lds, M2 + (size_t)kt * 16384, Y + (size_t)tok0 * 512 + (size_t)(2 * p * 64) * 512 + g * 128, (size_t)512, tid, acc);
    constexpr int XST = 136; LAS bf16* XL = (LAS bf16*)(lds + 81920);
#pragma unroll
    for (int mt = 0; mt < 8; ++mt) { v2u o; o.x = pk2(acc[mt][0], acc[mt][1]); o.y = pk2(acc[mt][2], acc[mt][3]); *(LAS v2u*)(XL + (mt * 16 + lr) * XST + 16 * w + 4 * lq) = o; }
    __syncthreads();
    f32x4 P[4], Q[4];
#pragma unroll
    for (int tb = 0; tb < 4; ++tb) { P[tb] = (f32x4){0.f, 0.f, 0.f, 0.f}; Q[tb] = (f32x4){0.f, 0.f, 0.f, 0.f};
#pragma unroll
        for (int ks = 0; ks < 4; ++ks) { const bf16x8 xre = *(const LAS bf16x8*)(XL + (16 * tb + lr) * XST + ks * 32 + 8 * lq), xim = *(const LAS bf16x8*)(XL + (64 + 16 * tb + lr) * XST + ks * 32 + 8 * lq);
            P[tb] = __builtin_amdgcn_mfma_f32_16x16x32_bf16(gre[ks], xre, P[tb], 0, 0, 0); Q[tb] = __builtin_amdgcn_mfma_f32_16x16x32_bf16(gim[ks], xim, Q[tb], 0, 0, 0); } }
#pragma unroll
    for (int tb = 0; tb < 4; ++tb) { const int sp = kt + N1 * (16 * tb + lr);
        { const size_t t = (size_t)(tok0 + sp); const v2u gw = gwa[tb]; const f32x4 f = P[tb] + Q[tb]; v2u o;
          o.x = pk2(f[0] * pg8::silu(pg8::bflo(gw.x)), f[1] * pg8::silu(pg8::bfhi(gw.x))); o.y = pk2(f[2] * pg8::silu(pg8::bflo(gw.y)), f[3] * pg8::silu(pg8::bfhi(gw.y)));
          *(v2u*)(QU + t * 1024 + 512 + d0) = o; }
        if (mir) { const size_t t = (size_t)(tok0 + S - sp); const v2u gw = gwb[tb]; const f32x4 f = P[tb] - Q[tb]; v2u o;
          o.x = pk2(f[0] * pg8::silu(pg8::bflo(gw.x)), f[1] * pg8::silu(pg8::bfhi(gw.x))); o.y = pk2(f[2] * pg8::silu(pg8::bflo(gw.y)), f[3] * pg8::silu(pg8::bfhi(gw.y)));
          *(v2u*)(QU + t * 1024 + 512 + d0) = o; } }
}
struct S2Regs { NNRegs<128> T; bf16x8 gre[4], gim[4]; v2u gwa[4], gwb[4]; };
__device__ __forceinline__ void s2c_load(S2Regs& R, const bf16* M2, const bf16* Y, const bf16* Gt, const bf16* GF, int tok0, int S, int N1, int kt, int g, int tid) {
    const int p = (kt == 0 || kt == N1 / 2) ? 0 : kt;
    const int w = tid >> 6, l = tid & 63, lr = l & 15, lq = l >> 4; const bool mir = (kt != 0 && kt != N1 / 2);
    { const bf16* gp = Gt + (size_t)(g * 128 + 16 * w + lr) * 1024 + g * 256 + 8 * lq;
#pragma unroll
      for (int ks = 0; ks < 4; ++ks) { R.gre[ks] = *(const bf16x8*)(gp + ks * 32); R.gim[ks] = *(const bf16x8*)(gp + 128 + ks * 32); } }
    const int d0 = g * 128 + 16 * w + 4 * lq;
#pragma unroll
    for (int tb = 0; tb < 4; ++tb) { const int sp = kt + N1 * (16 * tb + lr); R.gwa[tb] = *(const v2u*)(GF + blk512(tok0 + sp, d0));
        if (mir) R.gwb[tb] = *(const v2u*)(GF + blk512(tok0 + S - sp, d0)); else R.gwb[tb] = (v2u){0u, 0u}; }
    nn_load<128>(R.T, M2 + (size_t)kt * 16384, Y + (size_t)tok0 * 512 + (size_t)(2 * p * 64) * 512 + g * 128, (size_t)512, tid);
}
__device__ __forceinline__ void fft_stage2c_run(LAS unsigned char* lds, const bf16* M2, const bf16* Y, const bf16* Gt, const bf16* GF, bf16* QU, int tokbase, int S, int N1, int perb, int first, int nitems, int G, int tid) {
    if (first >= nitems) return;
    S2Regs R;
#define S2_ARGS(it) tokbase + ((it) / perb) * S, S, N1, ((it) % perb) >> 2, ((it) % perb) & 3
    s2c_load(R, M2, Y, Gt, GF, S2_ARGS(first), tid);
    for (int it = first; it < nitems; it += G) {
        const int tok0 = tokbase + (it / perb) * S, kt = (it % perb) >> 2, g = (it % perb) & 3;
        const int w = tid >> 6, l = tid & 63, lr = l & 15, lq = l >> 4; const bool mir = (kt != 0 && kt != N1 / 2);
        nn_stage<128>(lds, R.T, tid);
        bf16x8 gre[4], gim[4]; v2u gwa[4], gwb[4];
#pragma unroll
        for (int k = 0; k < 4; ++k) { gre[k] = R.gre[k]; gim[k] = R.gim[k]; gwa[k] = R.gwa[k]; gwb[k] = R.gwb[k]; }
        if (it + G < nitems) s2c_load(R, M2, Y, Gt, GF, S2_ARGS(it + G), tid);
        f32x4 acc[8]; nn_mfma<128>(lds, tid, acc);
        constexpr int XST = 136; LAS bf16* XL = (LAS bf16*)(lds + 81920);
#pragma unroll
        for (int mt = 0; mt < 8; ++mt) { v2u o; o.x = pk2(acc[mt][0], acc[mt][1]); o.y = pk2(acc[mt][2], acc[mt][3]); *(LAS v2u*)(XL + (mt * 16 + lr) * XST + 16 * w + 4 * lq) = o; }
        LDS_WAIT(); __builtin_amdgcn_s_barrier(); asm volatile("" ::: "memory");
        f32x4 P[4], Q[4];
#pragma unroll
        for (int tb = 0; tb < 4; ++tb) { P[tb] = (f32x4){0.f, 0.f, 0.f, 0.f}; Q[tb] = (f32x4){0.f, 0.f, 0.f, 0.f};
#pragma unroll
            for (int ks = 0; ks < 4; ++ks) { const bf16x8 xre = *(const LAS bf16x8*)(XL + (16 * tb + lr) * XST + ks * 32 + 8 * lq), xim = *(const LAS bf16x8*)(XL + (64 + 16 * tb + lr) * XST + ks * 32 + 8 * lq);
                P[tb] = __builtin_amdgcn_mfma_f32_16x16x32_bf16(gre[ks], xre, P[tb], 0, 0, 0); Q[tb] = __builtin_amdgcn_mfma_f32_16x16x32_bf16(gim[ks], xim, Q[tb], 0, 0, 0); } }
        const int d0 = g * 128 + 16 * w + 4 * lq;
#pragma unroll
        for (int tb = 0; tb < 4; ++tb) { const int sp = kt + N1 * (16 * tb + lr);
            { const size_t t = (size_t)(tok0 + sp); const v2u gw = gwa[tb]; const f32x4 f = P[tb] + Q[tb]; v2u o;
              o.x = pk2(f[0] * pg8::silu(pg8::bflo(gw.x)), f[1] * pg8::silu(pg8::bfhi(gw.x))); o.y = pk2(f[2] * pg8::silu(pg8::bflo(gw.y)), f[3] * pg8::silu(pg8::bfhi(gw.y)));
              *(v2u*)(QU + t * 1024 + 512 + d0) = o; }
            if (mir) { const size_t t = (size_t)(tok0 + S - sp); const v2u gw = gwb[tb]; const f32x4 f = P[tb] - Q[tb]; v2u o;
              o.x = pk2(f[0] * pg8::silu(pg8::bflo(gw.x)), f[1] * pg8::silu(pg8::bfhi(gw.x))); o.y = pk2(f[2] * pg8::silu(pg8::bflo(gw.y)), f[3] * pg8::silu(pg8::bfhi(gw.y)));
              *(v2u*)(QU + t * 1024 + 512 + d0) = o; } }
    }
#undef S2_ARGS
}
__global__ void __launch_bounds__(NWAVES * 64, 2) mk_fwd(Args args) {
    extern __shared__ __attribute__((aligned(16))) unsigned char lds[];
    Frame F;
    F.lds = (LAS unsigned char*)lds;
    F.MISC = (volatile LAS unsigned*)(F.lds + MISC_OFF);
    F.wave = __builtin_amdgcn_readfirstlane((int)threadIdx.x >> 6);
    F.G = gridDim.x; { const int bx = blockIdx.x; F.vcu = (F.G % 8 == 0) ? (bx % 8) * (F.G / 8) + bx / 8 : bx; }
    unsigned char* ws = args.ws;
    F.ctl = (unsigned*)(ws + WS_CTL);
    for (int u = threadIdx.x; u < (LDS_BYTES - LDSCTL_OFF) / 4; u += NWAVES * 64) ((LAS unsigned*)(F.lds + LDSCTL_OFF))[u] = 0u;
    __syncthreads();
    XcdBarrier bar = xcd_barrier_post(F.ctl + 1024, F.MISC + 8);
    { const unsigned simd = (unsigned)__builtin_amdgcn_s_getreg((1 << 11) | (4 << 6) | 4) & 3u;
      if ((threadIdx.x & 63) == 0) F.MISC[48 + F.wave] = simd;
      __syncthreads();
      unsigned cnt0 = 0, cnt1 = 0, cnt2 = 0, cnt3 = 0, rank = 0;
#pragma unroll
      for (int w = 0; w < NWAVES; ++w) { const unsigned sw = F.MISC[48 + w]; cnt0 += sw == 0u; cnt1 += sw == 1u; cnt2 += sw == 2u; cnt3 += sw == 3u; rank += (w < F.wave && sw == simd) ? 1u : 0u; }
      const bool ok = cnt0 == 2u && cnt1 == 2u && cnt2 == 2u && cnt3 == 2u;
      F.role = __builtin_amdgcn_readfirstlane(ok ? (int)((rank << 2) | simd) : (((F.wave >> 2) << 2) | (F.wave & 3)));
#if defined(ROLE_PARITY)
      F.role = ((F.wave & 1) << 2) | (F.wave >> 1);
#endif
    }
#define GRID_BAR() xcd_barrier(bar)
#define STAGGER(ticks) do { if ((ticks) > 0) { const unsigned long long t0_ = __builtin_amdgcn_s_memrealtime(); const unsigned long long d_ = (unsigned long long)(F.vcu & 3) * (unsigned long long)(ticks); \
    while (__builtin_amdgcn_s_memrealtime() - t0_ < d_) __builtin_amdgcn_s_sleep(8); } } while (0)
#if defined(PROBE_A)
#define STAMP(k) do { if (blockIdx.x == 0 && threadIdx.x == 0) { const unsigned long long t_ = __builtin_amdgcn_s_memrealtime(); F.MISC[16 + 2 * (k)] = (unsigned)t_; F.MISC[17 + 2 * (k)] = (unsigned)(t_ >> 32); } } while (0)
#else
#define STAMP(k) do { } while (0)
#endif
    STAMP(0);
    bf16* const Win_t = (bf16*)(ws + WS_WIN); bf16* const Wout_t = (bf16*)(ws + WS_WOUT); bf16* const Wg_t = (bf16*)(ws + WS_WG); bf16* const Wp_t = (bf16*)(ws + WS_WP);
    bf16* const Gt = (bf16*)(ws + WS_GT); bf16* const XN = (bf16*)(ws + WS_XN); bf16* const XP = (bf16*)(ws + WS_XN); bf16* const QU = (bf16*)(ws + WS_QU);
    bf16* const KB = (bf16*)(ws + WS_K); bf16* const VB = (bf16*)(ws + WS_V); bf16* const H1B = (bf16*)(ws + WS_K); bf16* const GA = (bf16*)(ws + WS_GA); bf16* const GF = (bf16*)(ws + WS_GF);
    bf16* const QB = (bf16*)(ws + WS_QB); bf16* const UB = (bf16*)(ws + WS_UB);
    bf16* const PROJ = (bf16*)(ws + WS_PROJ); bf16* const PB = (bf16*)args.out; bf16* const Y = (bf16*)args.out;
    float* const SSQ1 = (float*)(ws + WS_SSQ1); float* const SSQ2 = (float*)(ws + WS_SSQ2); const float* const TAB = (const float*)(ws + WS_TAB);

    p0_prologue(F, args);
#if defined(DUP_P0)
    p0_prologue(F, args, (DUP_P0 + 0) ? (DUP_P0 + 0) : 3);
#endif
    GRID_BAR(); STAMP(1);
#if defined(DUP_BAR)
    GRID_BAR(); GRID_BAR(); GRID_BAR(); GRID_BAR(); GRID_BAR();
#endif
#if defined(DUP_P1)
    if ((DUP_P1 + 0) == 4) { const unsigned long long t0_ = __builtin_amdgcn_s_memrealtime(); const unsigned long long d_ = (unsigned long long)(F.vcu & 3) * 800ull;
        while (__builtin_amdgcn_s_memrealtime() - t0_ < d_) __builtin_amdgcn_s_sleep(8); }
    { pg8::Gemm g{XN, Win_t, NTOK, NIN, DM, DM, 0}; pg8::StaticOrder S; S.init(NTOK, NIN, F.G, (int)blockIdx.x);
      pg8::EpiInProj E{QB, KB, VB, GA, UB, GF, QSCALE, ((DUP_P1 + 0) >= 2) ? (DUP_P1 + 0) : 0};
      pg8::gemm_phase<pg8::EpiInProj, pg8::StaticOrder, true, true>(F.lds, g, S, E, F.wave); }
    { pg8::Gemm g{PB, Wp_t, NTOK, DM, PLED, PLED, 0}; pg8::StaticOrder S; S.init(NTOK, DM, F.G, (int)blockIdx.x);
      pg8::EpiPlainBf16 E{PROJ, DM};
      pg8::gemm_phase<pg8::EpiPlainBf16, pg8::StaticOrder, true, true>(F.lds, g, S, E, F.wave); }
#endif
    STAGGER(STG_P1);
#if defined(DUP_PROJ)
    { pg8::Gemm g{PB, Wp_t, NTOK, DM, PLED, PLED, 0}; pg8::StaticOrder S; S.init(NTOK, DM, F.G, (int)blockIdx.x);
      pg8::EpiPlainBf16 E{PROJ, DM};
      pg8::gemm_phase<pg8::EpiPlainBf16, pg8::StaticOrder, true, true>(F.lds, g, S, E, F.wave); }
#endif
    if (PROJ_FIRST_MASK && (F.vcu & PROJ_FIRST_MASK) == 0) {
    { pg8::Gemm g{PB, Wp_t, NTOK, DM, PLED, PLED, 0}; pg8::StaticOrder S; S.init(NTOK, DM, F.G, (int)blockIdx.x);
      pg8::EpiPlainBf16 E{PROJ, DM};
      pg8::gemm_phase<pg8::EpiPlainBf16, pg8::StaticOrder, true, true>(F.lds, g, S, E, F.wave); }
    { pg8::Gemm g{XN, Win_t, NTOK, NIN, DM, DM, 0}; pg8::StaticOrder S; S.init(NTOK, NIN, F.G, (int)blockIdx.x);
      pg8::EpiInProj E{QB, KB, VB, GA, UB, GF, QSCALE, 0};
      pg8::gemm_phase<pg8::EpiInProj, pg8::StaticOrder, true, true>(F.lds, g, S, E, F.wave); }
    } else {
    { pg8::Gemm g{XN, Win_t, NTOK, NIN, DM, DM, 0}; pg8::StaticOrder S; S.init(NTOK, NIN, F.G, (int)blockIdx.x);
      pg8::EpiInProj E{QB, KB, VB, GA, UB, GF, QSCALE, 0};
      pg8::gemm_phase<pg8::EpiInProj, pg8::StaticOrder, true, true>(F.lds, g, S, E, F.wave); }
    { pg8::Gemm g{PB, Wp_t, NTOK, DM, PLED, PLED, 0}; pg8::StaticOrder S; S.init(NTOK, DM, F.G, (int)blockIdx.x);
      pg8::EpiPlainBf16 E{PROJ, DM};
      pg8::gemm_phase<pg8::EpiPlainBf16, pg8::StaticOrder, true, true>(F.lds, g, S, E, F.wave); }
    }
    GRID_BAR(); STAMP(2);
#if defined(DUP_FFT)
    { constexpr int NIT_P = NBP * 256, NIT_S = NBS * 256;
      for (int it = F.vcu; it < NIT_P + NIT_S; it += F.G) {
          if (it < NIT_P) fft_stage1_item<64>(F.lds, (const bf16*)(ws + WS_H1A), QU, Y, (it >> 8) * SEQP, it & 255, opq_tid(F.wave));
          else { const int r = it - NIT_P; fft_stage1_item<128>(F.lds, (const bf16*)(ws + WS_H1B), QU, Y, TPR + (r >> 8) * SEQS, r & 255, opq_tid(F.wave)); } } }
    GRID_BAR(); STAMP(10);
    { constexpr int NIT_P = NBP * 33 * 4, NIT_S = NBS * 65 * 4;
      for (int it = F.vcu; it < NIT_P + NIT_S; it += F.G) {
          if (it < NIT_P) { const int b = it / 132, r = it % 132; fft_stage2_item(F.lds, (const bf16*)(ws + WS_M2A), Y, XP, b * SEQP, SEQP, 64, r >> 2, r & 3, opq_tid(F.wave)); }
          else { const int q = it - NIT_P, b = q / 260, r = q % 260; fft_stage2_item(F.lds, (const bf16*)(ws + WS_M2B), Y, XP, TPR + b * SEQS, SEQS, 128, r >> 2, r & 3, opq_tid(F.wave)); } } }
    GRID_BAR(); STAMP(11);
#endif
    { constexpr int NIT_P = NBP * 256, NIT_S = NBS * 256;
      const int nP = F.vcu < NIT_P ? (NIT_P - F.vcu + F.G - 1) / F.G : 0, firstS = F.vcu + nP * F.G - NIT_P;
      fft_stage1_run<64>(F.lds, (const bf16*)(ws + WS_H1A), UB, Y, 0, SEQP, F.vcu, NIT_P, F.G, opq_tid(F.wave));
      fft_stage1_run<128>(F.lds, (const bf16*)(ws + WS_H1B), UB, Y, TPR, SEQS, firstS, NIT_S, F.G, opq_tid(F.wave)); }
    GRID_BAR(); STAMP(3);
    { constexpr int NIT_P = NBP * 33 * 4, NIT_S = NBS * 65 * 4;
      const int nP = F.vcu < NIT_P ? (NIT_P - F.vcu + F.G - 1) / F.G : 0, firstS = F.vcu + nP * F.G - NIT_P;
      fft_stage2c_run(F.lds, (const bf16*)(ws + WS_M2A), Y, Gt, GF, QU, 0, SEQP, 64, 132, F.vcu, NIT_P, F.G, opq_tid(F.wave));
      fft_stage2c_run(F.lds, (const bf16*)(ws + WS_M2B), Y, Gt, GF, QU, TPR, SEQS, 128, 260, firstS, NIT_S, F.G, opq_tid(F.wave));
      __syncthreads(); }
    STAMP(4); STAMP(5);
#if defined(PROBE_CLK)
    unsigned long long ck_c0 = 0, ck_r0 = 0, ck_c1 = 0, ck_r1 = 0;
    if (PROBE_CLK == 2) { ck_c0 = __builtin_amdgcn_s_memtime(); ck_r0 = __builtin_amdgcn_s_memrealtime(); }
#endif
    { const float lam = TAB[1024]; const float* subg = args.in[7];
      const int xl = F.vcu >> 5, cu = F.vcu & 31;
#if defined(DUP_ATT)
      for (int rep = 0; rep < 2; ++rep)
#endif
      for (int i = 0; i < 6; ++i) {
          int tok0, seq, h, q0;
          if (i < 2) { const int pr = xl; tok0 = TPR + (pr >> 2) * SEQS; seq = SEQS; h = pr & 3; q0 = (cu + 32 * i) * 128; }
          else { const int pr = xl + 8 * (i - 2); tok0 = (pr >> 2) * SEQP; seq = SEQP; h = pr & 3; q0 = cu * 128; }
#if defined(DUP_ATT)
          if (rep == 0) ATTNS::attn_unit<DUP_ATT>(QB, XP, KB, VB, GA, TAB, subg, lam, tok0, seq, h, q0, F.lds, F.wave, F.role); else ATTNS::attn_unit<0>(QB, QU, KB, VB, GA, TAB, subg, lam, tok0, seq, h, q0, F.lds, F.wave, F.role);
#else
          ATTNS::attn_unit<0>(QB, QU, KB, VB, GA, TAB, subg, lam, tok0, seq, h, q0, F.lds, F.wave, F.role);
#endif
      } }
#if defined(PROBE_CLK)
    if (PROBE_CLK == 2) { ck_c1 = __builtin_amdgcn_s_memtime(); ck_r1 = __builtin_amdgcn_s_memrealtime(); }
#endif
    GRID_BAR(); STAMP(6);
#if defined(DUP_P3)
    { pg8::Gemm g{QU, Wout_t, NTOK, DM, DM, DM, 0}; pg8::StaticOrder S; S.init(NTOK, DM, F.G, (int)blockIdx.x);
      pg8::EpiOutProj E{args.in[0], args.in[1], args.out, H1B, SSQ1};
      pg8::gemm_phase<pg8::EpiOutProj, pg8::StaticOrder, P3_ALIGN, true>(F.lds, g, S, E, F.wave); }
#endif
    STAGGER(STG_P3);
    { pg8::Gemm g{QU, Wout_t, NTOK, DM, DM, DM, 0}; pg8::StaticOrder S; S.init(NTOK, DM, F.G, (int)blockIdx.x);
      pg8::EpiOutProj E{args.in[0], args.in[1], args.out, H1B, SSQ1};
      pg8::gemm_phase<pg8::EpiOutProj, pg8::StaticOrder, P3_ALIGN, true>(F.lds, g, S, E, F.wave); }
    GRID_BAR(); STAMP(7);
    STAGGER(STG_P4);
    { pg8::Gemm g{H1B, Wg_t, NTOK, DM, DM, DM, 0, 1}; pg8::StaticOrder S; S.init(NTOK, DM, F.G, (int)blockIdx.x);
      pg8::EpiGateNorm E{args.out, H1B, PROJ, SSQ1, args.in[14], SSQ2, F.ctl + 16384, F.lds + RING_BYTES + 1024};
      pg8::gemm_phase<pg8::EpiGateNorm, pg8::StaticOrder, true, true>(F.lds, g, S, E, F.wave); }
    STAMP(8);
    STAMP(9);
#if defined(PROBE_CLK)
    GRID_BAR();
    if (blockIdx.x == 0 && threadIdx.x == 0) { const float ghz = 0.1f * (float)(ck_c1 - ck_c0) / (float)(ck_r1 - ck_r0); const float v = 20.f * rintf(ghz * 5.f); for (int i = 0; i < 8; ++i) args.out[i] = v; }
#endif
#if defined(PROBE_A)
    if (blockIdx.x == 0) { asm volatile("s_waitcnt vmcnt(0) lgkmcnt(0)" ::: "memory"); __syncthreads();
        const unsigned long long ta = ((unsigned long long)F.MISC[17 + 2 * PROBE_A] << 32) | F.MISC[16 + 2 * PROBE_A], tb = ((unsigned long long)F.MISC[17 + 2 * PROBE_B] << 32) | F.MISC[16 + 2 * PROBE_B];
        const float v = (float)(tb - ta) * 0.0001f; for (int i = 0; i < 8; ++i) args.out[threadIdx.x * 8 + i] = v; }
#endif
#undef GRID_BAR
}

extern "C" void kernel_launch(void* const* d_in, const int* in_sizes, int n_in, void* d_out, int out_size, void* d_ws, size_t ws_size, hipStream_t stream) {
    static int grid = 0;
    if (grid == 0) {
        if (n_in != 15 || in_sizes[0] != TPR * DM || out_size != NTOK * DM || ws_size < WS_END) {
            fprintf(stderr, "kernel_launch: shape mismatch: n_in %d in0 %d out %d ws %zu (need %zu)\n", n_in, n_in > 0 ? in_sizes[0] : -1, out_size, ws_size, (size_t)WS_END); grid = -1; return; }
        int dev = 0, cus = 0;
        if (hipGetDevice(&dev) != hipSuccess || hipDeviceGetAttribute(&cus, hipDeviceAttributeMultiprocessorCount, dev) != hipSuccess) { fprintf(stderr, "kernel_launch: device query failed\n"); grid = -1; return; }
        if (hipFuncSetAttribute((const void*)mk_fwd, hipFuncAttributeMaxDynamicSharedMemorySize, LDS_BYTES) != hipSuccess) { fprintf(stderr, "kernel_launch: hipFuncSetAttribute failed\n"); grid = -1; return; }
        (void)hipGetLastError();
        grid = cus;
        if (grid != 256) fprintf(stderr, "kernel_launch: %d CUs; this kernel's attention schedule assumes 256\n", grid);
    }
    if (grid < 0) return;
    if (hipMemsetAsync((char*)d_ws + WS_CTL, 0, CTL_ZERO_BYTES, stream) != hipSuccess) { fprintf(stderr, "kernel_launch: memset failed\n"); return; }
    Args a{};
    for (int i = 0; i < 15; ++i) a.in[i] = (const float*)d_in[i];
    a.out = (float*)d_out; a.ws = (unsigned char*)d_ws;
    hipLaunchKernelGGL(mk_fwd, dim3(grid), dim3(NWAVES * 64), LDS_BYTES, stream, a);
    const hipError_t le = hipPeekAtLastError();
    if (le != hipSuccess) fprintf(stderr, "kernel_launch: launch failed: %s\n", hipGetErrorName(le));
}
```

```cpp
#include <hip/hip_runtime.h>
#include <cstdio>
#include <cstdint>
#define PRIO_MODE 2
#define ATTNS att3
#define STG_P1 0
#define PROJ_FIRST_MASK 0
#define STG_P3 0
#define P3_ALIGN true
#define STG_P4 0
__device__ __forceinline__ int opq_tid(int wave) { int l; asm volatile("v_mbcnt_lo_u32_b32 %0, -1, 0\n\tv_mbcnt_hi_u32_b32 %0, -1, %0" : "=v"(l)); return wave * 64 + l; }
__device__ __forceinline__ float bperm_f(int srclane, float v) { return __int_as_float(__builtin_amdgcn_ds_bpermute(srclane << 2, __float_as_int(v))); }
__device__ __forceinline__ size_t blk512(int row, int col) { return ((size_t)(((row >> 4) << 4) + (col >> 5)) << 9) + (size_t)(((row & 15) << 5) + (col & 31)); }
__device__ __forceinline__ size_t blk1024(int row, int col) { return ((size_t)(((row >> 4) << 5) + (col >> 5)) << 9) + (size_t)(((row & 15) << 5) + (col & 31)); }
namespace pg8 {
#define PG8_LAS __attribute__((address_space(3)))
typedef unsigned short bf16_t;
typedef short bf16x8 __attribute__((ext_vector_type(8)));
typedef float f32x4 __attribute__((ext_vector_type(4)));
typedef unsigned u32x4 __attribute__((ext_vector_type(4)));
constexpr int BM = 256, BK = 64, HALF = 128, HTB = HALF * BK * 2  , STAGE_BYTES = 8 * HTB, NXCD = 8, WGM = 8;

__host__ __device__ __forceinline__ int lds_byte(int r, int c) { const int st = (r >> 4) * 2 + (c >> 5), rr = r & 15, cc = c & 31, ob = rr * 64 + cc * 2; return st * 1024 + (ob ^ (((ob >> 9) & 1) << 5)); }
__host__ __device__ __forceinline__ void stage_rc(int b, int& R, int& C) { const int st = b / 1024, sb = b % 1024, swz = sb ^ (((sb >> 9) & 1) << 5); R = (st >> 1) * 16 + swz / 64; C = (st & 1) * 32 + (swz % 64) / 2; }
__host__ __device__ __forceinline__ int perm32(int rho) { const int n = rho >> 4, i = rho & 15; return 8 * (i >> 2) + 4 * n + (i & 3); }

struct Unit { int pm, pn; };
struct Gemm { const bf16_t* A; const bf16_t* Bt; int M, N, K, ld, koff_pn, ablk; };

struct StaticOrder {
    int nM, nN, nwg, G, c;
    __host__ __device__ void init(int M, int N, int G_, int c_) { nM = M / BM; nN = N / BM; nwg = nM * nN; G = G_; c = c_; }
    __host__ __device__ bool next(int i, Unit& u) const {
        const long L = (long)i * G + c; if (L >= nwg) return false;
        int wgid = (int)L; { const int q = nwg / NXCD, r = nwg % NXCD, xcd = wgid % NXCD, off = wgid / NXCD; wgid = (xcd < r ? xcd * (q + 1) : r * (q + 1) + (xcd - r) * q) + off; }
        const int nig = WGM * nN, gid = wgid / nig, fm = gid * WGM, gsz = (nM - fm) < WGM ? (nM - fm) : WGM;
        u.pm = fm + ((wgid % nig) % gsz); u.pn = (wgid % nig) / gsz; return true;
    }
    __device__ __forceinline__ void a_ready(const Unit&) const {}
    __device__ __forceinline__ void done(const Unit&) const {}
};

__device__ __forceinline__ unsigned cvt_pk_bf16(float lo, float hi) { unsigned r; asm volatile("v_cvt_pk_bf16_f32 %0, %1, %2" : "=v"(r) : "v"(lo), "v"(hi)); return r; }
typedef float f32x2 __attribute__((ext_vector_type(2)));
typedef unsigned u32x2 __attribute__((ext_vector_type(2)));
__device__ __forceinline__ float bflo(unsigned w) { return __uint_as_float(w << 16); }
__device__ __forceinline__ float bfhi(unsigned w) { return __uint_as_float(w & 0xffff0000u); }
__device__ __forceinline__ float sigm(float a) { return __builtin_amdgcn_rcpf(1.f + __expf(-a)); }
__device__ __forceinline__ float silu(float a) { return a * sigm(a); }

struct EpiInProj {
    static constexpr bool PERM = true, AFTER_DRAIN = false;
    bf16_t* qb; bf16_t* kb; bf16_t* vb; bf16_t* ga; bf16_t* ub; bf16_t* gf; float qscale; int nostore;
    __device__ __forceinline__ void operator()(const f32x4 (&acc)[2][2][4][2], const Unit& u, int wr, int wc, int fr, int fq) const {
        const int seg = u.pn >> 1, colt = (u.pn & 1) * BM;
        bf16_t* base; float sc = 1.f;
        if (seg == 0) { base = qb; sc = qscale; } else if (seg == 1) base = kb; else if (seg == 2) base = vb; else if (seg == 3) base = ga; else if (seg == 4) base = ub; else base = gf;
        const int row0 = u.pm * BM + wr * 64 + fr, col0 = colt + wc * 32 + 8 * fq;
#pragma unroll
        for (int ai = 0; ai < 2; ++ai)
#pragma unroll
            for (int m = 0; m < 4; ++m) { const int row = row0 + ai * HALF + m * 16;
#pragma unroll
                for (int bj = 0; bj < 2; ++bj) { const f32x4 v0 = acc[ai][bj][m][0] * sc, v1 = acc[ai][bj][m][1] * sc;
                    u32x4 w; w.x = cvt_pk_bf16(v0[0], v0[1]); w.y = cvt_pk_bf16(v0[2], v0[3]); w.z = cvt_pk_bf16(v1[0], v1[1]); w.w = cvt_pk_bf16(v1[2], v1[3]);
                    if (nostore == 0) __builtin_nontemporal_store(w, (u32x4*)(base + blk512(row, col0 + bj * HALF))); else asm volatile("" :: "v"(w)); } }
    }
};
struct EpiPlainBf16 {
    static constexpr bool PERM = true, AFTER_DRAIN = false;
    bf16_t* O; int ldc;
    __device__ __forceinline__ void operator()(const f32x4 (&acc)[2][2][4][2], const Unit& u, int wr, int wc, int fr, int fq) const {
        const int row0 = u.pm * BM + wr * 64 + fr, col0 = u.pn * BM + wc * 32 + 8 * fq;
#pragma unroll
        for (int ai = 0; ai < 2; ++ai)
#pragma unroll
            for (int m = 0; m < 4; ++m) { const int row = row0 + ai * HALF + m * 16;
#pragma unroll
                for (int bj = 0; bj < 2; ++bj) { const f32x4 v0 = acc[ai][bj][m][0], v1 = acc[ai][bj][m][1];
                    u32x4 w; w.x = cvt_pk_bf16(v0[0], v0[1]); w.y = cvt_pk_bf16(v0[2], v0[3]); w.z = cvt_pk_bf16(v1[0], v1[1]); w.w = cvt_pk_bf16(v1[2], v1[3]);
                    __builtin_nontemporal_store(w, (u32x4*)(O + blk1024(row, col0 + bj * HALF))); } }
    }
};
struct EpiFno {
    static constexpr bool PERM = true, AFTER_DRAIN = false;
    const bf16_t* gf; bf16_t* qu;
    __device__ __forceinline__ void operator()(const f32x4 (&acc)[2][2][4][2], const Unit& u, int wr, int wc, int fr, int fq) const {
        const int row0 = u.pm * BM + wr * 64 + fr, col0 = u.pn * BM + wc * 32 + 8 * fq;
#pragma unroll
        for (int ai = 0; ai < 2; ++ai)
#pragma unroll
            for (int m = 0; m < 4; ++m) { const size_t r = (size_t)(row0 + ai * HALF + m * 16);
#pragma unroll
                for (int bj = 0; bj < 2; ++bj) { const int c = col0 + bj * HALF; const u32x4 g = *(const u32x4*)(gf + r * 512 + c);
                    const f32x4 v0 = acc[ai][bj][m][0], v1 = acc[ai][bj][m][1];
                    u32x4 w; w.x = cvt_pk_bf16(v0[0] * silu(bflo(g.x)), v0[1] * silu(bfhi(g.x))); w.y = cvt_pk_bf16(v0[2] * silu(bflo(g.y)), v0[3] * silu(bfhi(g.y)));
                    w.z = cvt_pk_bf16(v1[0] * silu(bflo(g.z)), v1[1] * silu(bfhi(g.z))); w.w = cvt_pk_bf16(v1[2] * silu(bflo(g.w)), v1[3] * silu(bfhi(g.w)));
                    *(u32x4*)(qu + r * 1024 + 512 + c) = w; } }
    }
};
struct EpiOutProj {
    static constexpr bool PERM = false, AFTER_DRAIN = false;
    const float* xp; const float* xs; float* out; bf16_t* h1b; float* ssq;
    __device__ __forceinline__ void operator()(const f32x4 (&acc)[2][2][4][2], const Unit& u, int wr, int wc, int fr, int fq) const {
        const int row0 = u.pm * BM + wr * 64 + fr, col0 = u.pn * BM + wc * 32 + 4 * fq;
        const float* xb = (u.pm < 128) ? xp : xs - (size_t)32768 * 1024;
        f32x4 xv[8][4]; float ssv[8];
#define EOP_LD(g) do { const float* xrow_ = xb + (size_t)(row0 + ((g) >> 2) * HALF + ((g) & 3) * 16) * 1024 + col0; \
            xv[g][0] = *(const f32x4*)(xrow_); xv[g][1] = *(const f32x4*)(xrow_ + 16); xv[g][2] = *(const f32x4*)(xrow_ + HALF); xv[g][3] = *(const f32x4*)(xrow_ + HALF + 16); } while (0)
        EOP_LD(0); EOP_LD(1); EOP_LD(2);
#pragma unroll
        for (int g = 0; g < 8; ++g) { const int ai = g >> 2, m = g & 3;
            if (g + 3 < 8) EOP_LD(g + 3);
            const int row = row0 + ai * HALF + m * 16; float ss = 0.f;
#pragma unroll
            for (int bj = 0; bj < 2; ++bj)
#pragma unroll
                for (int n = 0; n < 2; ++n) { const f32x4 h = xv[g][bj * 2 + n] + acc[ai][bj][m][n];
                    ss += (h[0] * h[0] + h[1] * h[1]) + (h[2] * h[2] + h[3] * h[3]);
                    u32x2 w; w.x = cvt_pk_bf16(h[0], h[1]); w.y = cvt_pk_bf16(h[2], h[3]); *(u32x2*)(h1b + blk1024(row, col0 + bj * HALF + n * 16)) = w; }
            ss += bperm_f(((fq ^ 1) << 4) | fr, ss); ss += bperm_f(((fq ^ 2) << 4) | fr, ss); ssv[g] = ss; }
#undef EOP_LD
        if (fq == 0) {
#pragma unroll
            for (int g = 0; g < 8; ++g) ssq[(size_t)(row0 + (g >> 2) * HALF + (g & 3) * 16) * 16 + u.pn * 4 + wc] = ssv[g]; }
    }
};
struct EpiGate {
    static constexpr bool PERM = false, AFTER_DRAIN = false;
    float* out; const bf16_t* proj; const float* ssq1; float* ssq2;
    __device__ __forceinline__ void operator()(const f32x4 (&acc)[2][2][4][2], const Unit& u, int wr, int wc, int fr, int fq) const {
        const int row0 = u.pm * BM + wr * 64 + fr, col0 = u.pn * BM + wc * 32 + 4 * fq;
#pragma unroll
        for (int ai = 0; ai < 2; ++ai)
#pragma unroll
            for (int m = 0; m < 4; ++m) { const int r = row0 + ai * HALF + m * 16; const size_t off = (size_t)r * 1024 + col0;
                const f32x4* sp = (const f32x4*)(ssq1 + (size_t)r * 16); const f32x4 s0 = sp[0], s1 = sp[1], s2 = sp[2], s3 = sp[3];
                const float st = ((s0[0] + s0[1]) + (s0[2] + s0[3])) + ((s1[0] + s1[1]) + (s1[2] + s1[3])) + ((s2[0] + s2[1]) + (s2[2] + s2[3])) + ((s3[0] + s3[1]) + (s3[2] + s3[3]));
                const float rr = __builtin_amdgcn_rsqf(st * (1.f / 1024.f) + 1e-6f); float ss = 0.f;
#pragma unroll
                for (int bj = 0; bj < 2; ++bj)
#pragma unroll
                    for (int n = 0; n < 2; ++n) { const f32x4 a = acc[ai][bj][m][n] * rr; const u32x2 pw = *(const u32x2*)(proj + off + bj * HALF + n * 16);
                        const f32x4 h1 = *(const f32x4*)(out + off + bj * HALF + n * 16); f32x4 h;
                        h[0] = h1[0] + sigm(a[0]) * bflo(pw.x); h[1] = h1[1] + sigm(a[1]) * bfhi(pw.x); h[2] = h1[2] + sigm(a[2]) * bflo(pw.y); h[3] = h1[3] + sigm(a[3]) * bfhi(pw.y);
                        *(f32x4*)(out + off + bj * HALF + n * 16) = h; ss += (h[0] * h[0] + h[1] * h[1]) + (h[2] * h[2] + h[3] * h[3]); }
                ss += bperm_f(((fq ^ 1) << 4) | fr, ss); ss += bperm_f(((fq ^ 2) << 4) | fr, ss);
                if (fq == 0) ssq2[(size_t)r * 16 + u.pn * 4 + wc] = ss; }
    }
};

struct EpiGateNorm {
    static constexpr bool PERM = false, AFTER_DRAIN = false;
    float* out; const bf16_t* h1b; const bf16_t* proj; const float* ssq1; const float* gfin; float* slots; unsigned* cnt; PG8_LAS unsigned char* xl;
    __device__ __forceinline__ void operator()(f32x4 (&acc)[2][2][4][2], const Unit& u, int wr, int wc, int fr, int fq) const {
        const int row0 = u.pm * BM + wr * 64 + fr, col0 = u.pn * BM + wc * 32 + 4 * fq; const int wid = wr * 4 + wc, lane = fq * 16 + fr;
        PG8_LAS float* P = (PG8_LAS float*)xl; PG8_LAS float* S = (PG8_LAS float*)(xl + 4096); PG8_LAS float* R1 = (PG8_LAS float*)(xl + 5120);
        u32x2 pwv[8][4], hwv[8][4];
#define EGN_LD(g) do { \
            { const int r_ = row0 + ((g) >> 2) * HALF + ((g) & 3) * 16; pwv[g][0] = *(const u32x2*)(proj + blk1024(r_, col0)); pwv[g][1] = *(const u32x2*)(proj + blk1024(r_, col0 + 16)); pwv[g][2] = *(const u32x2*)(proj + blk1024(r_, col0 + HALF)); pwv[g][3] = *(const u32x2*)(proj + blk1024(r_, col0 + HALF + 16)); } \
            { const int r_ = row0 + ((g) >> 2) * HALF + ((g) & 3) * 16; hwv[g][0] = *(const u32x2*)(h1b + blk1024(r_, col0)); hwv[g][1] = *(const u32x2*)(h1b + blk1024(r_, col0 + 16)); hwv[g][2] = *(const u32x2*)(h1b + blk1024(r_, col0 + HALF)); hwv[g][3] = *(const u32x2*)(h1b + blk1024(r_, col0 + HALF + 16)); } } while (0)
        EGN_LD(0); EGN_LD(1); EGN_LD(2); EGN_LD(3);
        { const int t_ = wid * 64 + lane; if (t_ < 256) { const f32x4* sp = (const f32x4*)(ssq1 + (size_t)(u.pm * BM + t_) * 16); const f32x4 s0 = sp[0], s1 = sp[1], s2 = sp[2], s3 = sp[3];
            const float st = ((s0[0] + s0[1]) + (s0[2] + s0[3])) + ((s1[0] + s1[1]) + (s1[2] + s1[3])) + ((s2[0] + s2[1]) + (s2[2] + s2[3])) + ((s3[0] + s3[1]) + (s3[2] + s3[3]));
            R1[t_] = __builtin_amdgcn_rsqf(st * (1.f / 1024.f) + 1e-6f); } }
        asm volatile("s_waitcnt vmcnt(0) lgkmcnt(0)" ::: "memory"); __builtin_amdgcn_s_barrier(); asm volatile("" ::: "memory");
#pragma unroll
        for (int g = 0; g < 8; ++g) { const int ai = g >> 2, m = g & 3;
            if (g + 4 < 8) EGN_LD(g + 4);
            const float rr = R1[ai * HALF + wr * 64 + m * 16 + fr]; float ss = 0.f;
#pragma unroll
            for (int bj = 0; bj < 2; ++bj)
#pragma unroll
                for (int n = 0; n < 2; ++n) { const f32x4 a = acc[ai][bj][m][n] * rr; const u32x2 pw = pwv[g][bj * 2 + n], hw = hwv[g][bj * 2 + n]; f32x4 h;
                    h[0] = bflo(hw.x) + sigm(a[0]) * bflo(pw.x); h[1] = bfhi(hw.x) + sigm(a[1]) * bfhi(pw.x); h[2] = bflo(hw.y) + sigm(a[2]) * bflo(pw.y); h[3] = bfhi(hw.y) + sigm(a[3]) * bfhi(pw.y);
                    acc[ai][bj][m][n] = h; ss += (h[0] * h[0] + h[1] * h[1]) + (h[2] * h[2] + h[3] * h[3]); }
            ss += bperm_f(((fq ^ 1) << 4) | fr, ss); ss += bperm_f(((fq ^ 2) << 4) | fr, ss);
            if (fq == 0) P[(ai * HALF + wr * 64 + m * 16 + fr) * 4 + wc] = ss; }
#undef EGN_LD
        asm volatile("s_waitcnt lgkmcnt(0)" ::: "memory"); __builtin_amdgcn_s_barrier(); asm volatile("" ::: "memory");
        const int row = wid * 32 + (lane & 31);
        if (lane < 32) { const float t = (P[row * 4 + 0] + P[row * 4 + 1]) + (P[row * 4 + 2] + P[row * 4 + 3]);
            __hip_atomic_store(slots + ((size_t)(u.pm * BM + row) * 4 + u.pn), t, __ATOMIC_RELAXED, __HIP_MEMORY_SCOPE_AGENT); }
        asm volatile("s_waitcnt vmcnt(0)" ::: "memory");
        if (lane == 0) __hip_atomic_fetch_add(cnt + 64 * u.pm, 1u, __ATOMIC_RELAXED, __HIP_MEMORY_SCOPE_AGENT);
        if (wid == 0) { unsigned spins = 0;
            while ((unsigned)__builtin_amdgcn_readfirstlane(__hip_atomic_load(cnt + 64 * u.pm, __ATOMIC_RELAXED, __HIP_MEMORY_SCOPE_AGENT)) < 32u) { __builtin_amdgcn_s_sleep(2); if (++spins > (1u << 22)) break; }
            __builtin_amdgcn_fence(__ATOMIC_ACQUIRE, "agent"); }
        asm volatile("s_waitcnt vmcnt(0) lgkmcnt(0)" ::: "memory"); __builtin_amdgcn_s_barrier(); asm volatile("" ::: "memory");
        if (lane < 32) { const float* sl = slots + (size_t)(u.pm * BM + row) * 4; float t = 0.f;
#pragma unroll
            for (int k = 0; k < 4; ++k) t += __hip_atomic_load(sl + k, __ATOMIC_RELAXED, __HIP_MEMORY_SCOPE_AGENT);
            S[row] = __builtin_amdgcn_rsqf(t * (1.f / 1024.f) + 1e-6f); }
        asm volatile("s_waitcnt vmcnt(0) lgkmcnt(0)" ::: "memory"); __builtin_amdgcn_s_barrier(); asm volatile("" ::: "memory");
        f32x4 gv[2][2];
#pragma unroll
        for (int bj = 0; bj < 2; ++bj)
#pragma unroll
            for (int n = 0; n < 2; ++n) gv[bj][n] = *(const f32x4*)(gfin + col0 + bj * HALF + n * 16);
#pragma unroll
        for (int ai = 0; ai < 2; ++ai)
#pragma unroll
            for (int m = 0; m < 4; ++m) { const int rl = ai * HALF + wr * 64 + m * 16 + fr; const float rs = S[rl]; const size_t off = (size_t)(u.pm * BM + rl) * 1024 + col0;
#pragma unroll
                for (int bj = 0; bj < 2; ++bj)
#pragma unroll
                    for (int n = 0; n < 2; ++n) __builtin_nontemporal_store(acc[ai][bj][m][n] * rs * gv[bj][n], (f32x4*)(out + off + bj * HALF + n * 16)); }
        asm volatile("s_waitcnt lgkmcnt(0)" ::: "memory"); __builtin_amdgcn_s_barrier(); asm volatile("" ::: "memory");
    }
};
template <class Epi, class Sched, bool ALIGN_EPI = false, bool SP2 = false>
__device__ __forceinline__ void gemm_phase(PG8_LAS unsigned char* lds, const Gemm g, const Sched& S, const Epi& E, const int wave_) {
    const int tid = opq_tid(wave_), wid = __builtin_amdgcn_readfirstlane(tid >> 6), lane = tid & 63, wr = wid >> 2, wc = wid & 3, fr = lane & 15, fq = lane >> 4;
    const int K = g.K, nt = K / BK;
    unsigned voffA[2], voffB[2];
#pragma unroll
    for (int i = 0; i < 2; ++i) { int R, C; stage_rc(tid * 16 + i * 8192, R, C); const int Rb = Epi::PERM ? ((R & ~31) + perm32(R & 31)) : R;
        voffA[i] = g.ablk ? (unsigned)(((R >> 4) * 32 + (C >> 5)) * 1024 + (R & 15) * 64 + (C & 31) * 2) : (unsigned)(R * g.ld + C) * 2u; voffB[i] = (unsigned)(Rb * g.ld + C) * 2u; }
    const size_t kstep = (size_t)(BK * 2);
    const size_t kstepA = g.ablk ? (size_t)2048 : kstep;
    const size_t hstep = (size_t)HALF * g.ld * 2;
    const size_t tstep = 2 * hstep;
    const unsigned ldsw = (unsigned)wid * 1024u;
    const int aoff = lds_byte(wr * 64 + fr, fq * 8), boff = lds_byte(wc * 32 + fr, fq * 8);
#define PG8_SA(b, h) (((b) * 2 + (h)) * HTB)
#define PG8_SB(b, h) ((4 + (b) * 2 + (h)) * HTB)
#define PG8_STAGE(bufoff, gbase, voff) do { unsigned long long gb_ = (unsigned long long)(gbase); asm volatile("" : "+s"(gb_)); _Pragma("unroll") for (int _i = 0; _i < 2; ++_i) { asm volatile("" : "+v"((voff)[_i])); \
        __builtin_amdgcn_global_load_lds((const unsigned*)((const char*)gb_ + (voff)[_i]), (PG8_LAS unsigned*)(lds + (bufoff) + ldsw + _i * 8192), 16, 0, 0); } } while (0)
#define PG8_LDA(dst, b, h) do { _Pragma("unroll") for (int m = 0; m < 4; ++m) _Pragma("unroll") for (int k = 0; k < 2; ++k) dst[m][k] = *(const PG8_LAS bf16x8*)(lds + PG8_SA(b, h) + aoff + m * 2048 + k * 1024); } while (0)
#define PG8_LDB(dst, b, h) do { _Pragma("unroll") for (int n = 0; n < 2; ++n) _Pragma("unroll") for (int k = 0; k < 2; ++k) dst[n][k] = *(const PG8_LAS bf16x8*)(lds + PG8_SB(b, h) + boff + n * 2048 + k * 1024); } while (0)
#define PG8_MMA(ai, bj, At, Bt) do { __builtin_amdgcn_s_setprio(1); _Pragma("unroll") for (int m = 0; m < 4; ++m) _Pragma("unroll") for (int n = 0; n < 2; ++n) _Pragma("unroll") for (int k = 0; k < 2; ++k) \
        acc[ai][bj][m][n] = __builtin_amdgcn_mfma_f32_16x16x32_bf16(Bt[n][k], At[m][k], acc[ai][bj][m][n], 0, 0, 0); __builtin_amdgcn_s_setprio(0); } while (0)
#define PG8_WAIT_V(n) asm volatile("s_waitcnt vmcnt(" #n ")" ::: "memory")
#define PG8_WAIT_L(n) asm volatile("s_waitcnt lgkmcnt(" #n ")" ::: "memory")
#define PG8_BAR __builtin_amdgcn_s_barrier()
#define PG8_SCHED __builtin_amdgcn_sched_barrier(0)
    Unit cur, nxt; int ui = 0;
    if (!S.next(0, cur)) return;
    f32x4 acc[2][2][4][2];
#pragma unroll
    for (int a = 0; a < 2; ++a)
#pragma unroll
        for (int b = 0; b < 2; ++b)
#pragma unroll
            for (int m = 0; m < 4; ++m)
#pragma unroll
                for (int n = 0; n < 2; ++n) acc[a][b][m][n] = (f32x4){0.f, 0.f, 0.f, 0.f};
    bf16x8 At[4][2], B0[2][2], B1[2][2];
    const char* cA = (const char*)g.A + (size_t)cur.pm * tstep + (size_t)(cur.pn * g.koff_pn) * 2; const char* cB = (const char*)g.Bt + (size_t)cur.pn * tstep + (size_t)(cur.pn * g.koff_pn) * 2;
    S.a_ready(cur);
    if constexpr (SP2) {
        PG8_STAGE(PG8_SB(0, 0), cB, voffB); PG8_STAGE(PG8_SB(0, 1), cB + hstep, voffB); PG8_STAGE(PG8_SA(0, 0), cA, voffA); PG8_STAGE(PG8_SA(0, 1), cA + hstep, voffA);
        if (wr == 1) PG8_BAR;
        PG8_WAIT_V(2); PG8_BAR;
        PG8_STAGE(PG8_SB(1, 0), cB + kstep, voffB); PG8_STAGE(PG8_SA(1, 0), cA + kstepA, voffA); PG8_STAGE(PG8_SB(1, 1), cB + hstep + kstep, voffB);
        PG8_WAIT_V(6); PG8_BAR;
    } else {
        PG8_STAGE(PG8_SB(0, 0), cB, voffB); PG8_STAGE(PG8_SA(0, 0), cA, voffA); PG8_STAGE(PG8_SB(0, 1), cB + hstep, voffB); PG8_STAGE(PG8_SA(0, 1), cA + hstep, voffA);
        if (wr == 1) PG8_BAR;
        PG8_WAIT_V(4); PG8_BAR;
        PG8_STAGE(PG8_SB(1, 0), cB + kstep, voffB); PG8_STAGE(PG8_SA(1, 0), cA + kstepA, voffA); PG8_STAGE(PG8_SB(1, 1), cB + hstep + kstep, voffB);
        PG8_WAIT_V(6); PG8_BAR;
    }
    for (;;) {
        const bool has_next = S.next(ui + 1, nxt);
        const char* nA = has_next ? (const char*)g.A + (size_t)nxt.pm * tstep + (size_t)(nxt.pn * g.koff_pn) * 2 : cA; const char* nB = has_next ? (const char*)g.Bt + (size_t)nxt.pn * tstep + (size_t)(nxt.pn * g.koff_pn) * 2 : cB;
        for (int t = 0; t < nt; t += 2) {
            const bool last = (t == nt - 2);
            const char* a1 = cA + (size_t)(t + 1) * kstepA;
            const char* a2 = last ? nA : cA + (size_t)(t + 2) * kstepA; const char* b2 = last ? nB : cB + (size_t)(t + 2) * kstep;
            const char* a3 = a2 + kstepA; const char* b3 = b2 + kstep;
            if (last && has_next) S.a_ready(nxt);
            if constexpr (SP2) {
            PG8_LDB(B0, 0, 0); PG8_LDB(B1, 0, 1); PG8_SCHED; PG8_LDA(At, 0, 0); PG8_STAGE(PG8_SA(1, 1), a1 + hstep, voffA);
            PG8_WAIT_V(8); PG8_WAIT_L(0); PG8_BAR; PG8_MMA(0, 0, At, B0); PG8_MMA(0, 1, At, B1); PG8_BAR; PG8_SCHED;
            PG8_LDA(At, 0, 1); PG8_STAGE(PG8_SB(0, 0), b2, voffB); PG8_STAGE(PG8_SB(0, 1), b2 + hstep, voffB); PG8_STAGE(PG8_SA(0, 0), a2, voffA);
            PG8_WAIT_V(8); PG8_WAIT_L(0); PG8_BAR; PG8_MMA(1, 0, At, B0); PG8_MMA(1, 1, At, B1); PG8_BAR; PG8_SCHED;
            PG8_LDB(B0, 1, 0); PG8_LDB(B1, 1, 1); PG8_SCHED; PG8_LDA(At, 1, 0); PG8_STAGE(PG8_SA(0, 1), a2 + hstep, voffA);
            PG8_WAIT_V(8); PG8_WAIT_L(0); PG8_BAR; PG8_MMA(0, 0, At, B0); PG8_MMA(0, 1, At, B1); PG8_BAR; PG8_SCHED;
            PG8_LDA(At, 1, 1); PG8_STAGE(PG8_SB(1, 0), b3, voffB); PG8_STAGE(PG8_SB(1, 1), b3 + hstep, voffB); PG8_STAGE(PG8_SA(1, 0), a3, voffA);
            PG8_WAIT_V(8); PG8_WAIT_L(0); PG8_BAR; PG8_MMA(1, 0, At, B0); PG8_MMA(1, 1, At, B1); PG8_BAR; PG8_SCHED;
            } else {
            PG8_LDB(B0, 0, 0); PG8_SCHED; PG8_LDA(At, 0, 0); PG8_STAGE(PG8_SA(1, 1), a1 + hstep, voffA);
            PG8_WAIT_L(8); PG8_BAR; PG8_WAIT_L(0); PG8_MMA(0, 0, At, B0); PG8_BAR; PG8_SCHED;
            PG8_LDB(B1, 0, 1); PG8_STAGE(PG8_SB(0, 0), b2, voffB);
            PG8_BAR; PG8_WAIT_L(0); PG8_MMA(0, 1, At, B1); PG8_BAR;
            PG8_LDA(At, 0, 1); PG8_STAGE(PG8_SA(0, 0), a2, voffA);
            PG8_BAR; PG8_WAIT_L(0); PG8_MMA(1, 0, At, B0); PG8_BAR; PG8_SCHED;
            PG8_STAGE(PG8_SB(0, 1), b2 + hstep, voffB);
            PG8_WAIT_V(6); PG8_BAR; PG8_MMA(1, 1, At, B1); PG8_BAR;
            PG8_LDB(B0, 1, 0); PG8_SCHED; PG8_LDA(At, 1, 0); PG8_STAGE(PG8_SA(0, 1), a2 + hstep, voffA);
            PG8_WAIT_L(8); PG8_BAR; PG8_WAIT_L(0); PG8_MMA(0, 0, At, B0); PG8_BAR; PG8_SCHED;
            PG8_LDB(B1, 1, 1); PG8_STAGE(PG8_SB(1, 0), b3, voffB);
            PG8_BAR; PG8_WAIT_L(0); PG8_MMA(0, 1, At, B1); PG8_BAR;
            PG8_LDA(At, 1, 1); PG8_STAGE(PG8_SA(1, 0), a3, voffA);
            PG8_BAR; PG8_WAIT_L(0); PG8_MMA(1, 0, At, B0); PG8_BAR; PG8_SCHED;
            PG8_STAGE(PG8_SB(1, 1), b3 + hstep, voffB);
            PG8_WAIT_V(6); PG8_BAR; PG8_MMA(1, 1, At, B1); PG8_BAR;
            }
        }
        if constexpr (ALIGN_EPI) { if (wr == 0) PG8_BAR; }
        if constexpr (!Epi::AFTER_DRAIN) { const int l2_ = opq_tid(wave_) & 63; E(acc, cur, wr, wc, l2_ & 15, l2_ >> 4); S.done(cur); }
        if (!has_next) break;
#pragma unroll
        for (int a = 0; a < 2; ++a)
#pragma unroll
            for (int b = 0; b < 2; ++b)
#pragma unroll
                for (int m = 0; m < 4; ++m)
#pragma unroll
                    for (int n = 0; n < 2; ++n) acc[a][b][m][n] = (f32x4){0.f, 0.f, 0.f, 0.f};
        cur = nxt; cA = nA; cB = nB; ++ui;
        if constexpr (ALIGN_EPI) { if (wr == 1) PG8_BAR; }
    }
    PG8_WAIT_V(0);
    if constexpr (!ALIGN_EPI) { if (wr == 0) PG8_BAR; }
    PG8_BAR;
    if constexpr (Epi::AFTER_DRAIN) { E.fused(acc, cur, wr, wc, fr, fq, lds, wid, lane); S.done(cur); }
#undef PG8_SA
#undef PG8_SB
#undef PG8_STAGE
#undef PG8_LDA
#undef PG8_LDB
#undef PG8_MMA
#undef PG8_WAIT_V
#undef PG8_WAIT_L
#undef PG8_BAR
#undef PG8_SCHED
}
}
constexpr int NWAVES = 8;
constexpr int DM = 1024, NTOK = 49152, TPR = 32768, SEQP = 4096, SEQS = 8192, NBP = 8, NBS = 2, NIN = 3072, PLED = 256;
constexpr float LOG2E = 1.4426950408889634f;
constexpr float QSCALE = 0.125f * LOG2E;
constexpr size_t MiB = 1u << 20;
constexpr size_t WS_CTL = 0, CTL_ZERO_BYTES = 128 * 1024;
constexpr size_t WS_TAB = 1 * MiB;
constexpr size_t WS_GINV = 1 * MiB + 8192;
constexpr size_t WS_RINV = 1 * MiB + 16384;
constexpr size_t WS_WIN = 2 * MiB;
constexpr size_t WS_WOUT = 8 * MiB;
constexpr size_t WS_WG = 10 * MiB;
constexpr size_t WS_WP = 12 * MiB;
constexpr size_t WS_GT = 12 * MiB + 512 * 1024;
constexpr size_t WS_H1A = 13 * MiB + 512 * 1024;
constexpr size_t WS_H1B = WS_H1A + 64 * 1024;
constexpr size_t WS_M2A = 14 * MiB;
constexpr size_t WS_M2B = 15 * MiB + 256 * 1024;
constexpr size_t WS_SSQ1 = 18 * MiB, WS_SSQ2 = 21 * MiB;
constexpr size_t WS_XN = 24 * MiB;
constexpr size_t WS_QU = 120 * MiB;
constexpr size_t WS_K = 216 * MiB, WS_V = 264 * MiB;
constexpr size_t WS_GA = 312 * MiB, WS_GF = 360 * MiB;
constexpr size_t WS_PROJ = 408 * MiB;
constexpr size_t WS_QB = 504 * MiB, WS_UB = 552 * MiB;
constexpr size_t WS_END = 600 * MiB;
static_assert(WS_M2A + 33 * 32768 <= WS_M2B && WS_M2B + 65 * 32768 <= WS_SSQ1 && WS_SSQ2 + (size_t)NTOK * 64 <= WS_XN, "d_ws map");
constexpr int RING_BYTES = 131072, LDSCTL_OFF = RING_BYTES, MISC_OFF = LDSCTL_OFF + 320, LDS_BYTES = 147456;
#define GAS __attribute__((address_space(1)))
#define LAS __attribute__((address_space(3)))
typedef unsigned short bf16;
typedef unsigned v4u __attribute__((ext_vector_type(4)));
typedef unsigned v2u __attribute__((ext_vector_type(2)));
typedef float f32x4 __attribute__((ext_vector_type(4)));
typedef short bf16x8 __attribute__((ext_vector_type(8)));
#define LDS_WAIT() asm volatile("s_waitcnt lgkmcnt(0)" ::: "memory")
#define VM_WAIT() asm volatile("s_waitcnt vmcnt(0)" ::: "memory")
__device__ __forceinline__ unsigned f2bf(float f) { unsigned u = __builtin_bit_cast(unsigned, f); return (u + 0x7fffu + ((u >> 16) & 1u)) >> 16; }
__device__ __forceinline__ unsigned pk2(float lo, float hi) { return f2bf(lo) | (f2bf(hi) << 16); }
#define XB_TMO      128
#define XB_XCNT(j)  (256  + 64 * (j))
#define XB_XSUB(j)  (1280 + 64 * (j))
#define XB_XGEN(j)  (2304 + 64 * (j))
#define XB_TOP      3328
#define XB_TOPGEN   3392
#define XCD_BAR_WORDS 3456
#define XB_SPIN_CAP (1u << 18)

__device__ __forceinline__ unsigned xb_ld(unsigned* p)              { return __hip_atomic_load(p, __ATOMIC_RELAXED, __HIP_MEMORY_SCOPE_AGENT); }
__device__ __forceinline__ unsigned xb_add(unsigned* p, unsigned v) { return __hip_atomic_fetch_add(p, v, __ATOMIC_RELAXED, __HIP_MEMORY_SCOPE_AGENT); }
__device__ __forceinline__ unsigned xb_xcc_id() { return (unsigned)__builtin_amdgcn_s_getreg((3 << 11) | 20) & 0xFu; }
#define XB_SPIN(cond, bar) do { unsigned _sp = 0; while (cond) { __builtin_amdgcn_s_sleep(1); \
    if ((++_sp & 255u) == 0u) { if (xb_ld(&(bar)[XB_TMO])) break; if (_sp > XB_SPIN_CAP) { atomicAdd(&(bar)[XB_TMO], 1u); break; } } } } while (0)

struct XcdBarrier {
    unsigned* bar; unsigned x;
    volatile LAS unsigned* st;
};

__device__ __forceinline__ XcdBarrier xcd_barrier_post(unsigned* bar, volatile LAS unsigned* st) {
    XcdBarrier b; b.bar = bar; b.x = xb_xcc_id(); b.st = st;
    if (threadIdx.x == 0) (void)xb_add(&bar[XB_XCNT(b.x)], 1u);
    return b;
}
__device__ __forceinline__ void xcd_barrier_complete(unsigned* bar, unsigned x, unsigned& nloc, unsigned& nx) {
    const unsigned G = gridDim.x * gridDim.y * gridDim.z;
    unsigned sum, cnt, mine, sp = 0u;
    for (;;) {
        sum = 0u; cnt = 0u; mine = 0u;
#pragma unroll
        for (unsigned j = 0; j < 16; ++j) { const unsigned c = xb_ld(&bar[XB_XCNT(j)]); sum += c; cnt += (c > 0u) ? 1u : 0u; mine = (j == x) ? c : mine; }
        if (sum == G) break;
        __builtin_amdgcn_s_sleep(1);
        if ((++sp & 255u) == 0u) { if (xb_ld(&bar[XB_TMO])) break; if (sp > XB_SPIN_CAP) { atomicAdd(&bar[XB_TMO], 1u); break; } }
    }
    nloc = mine > 0u ? mine : 1u; nx = cnt > 0u ? cnt : 1u;
}

__device__ __forceinline__ void xcd_barrier(const XcdBarrier& b) {
    asm volatile("s_waitcnt vmcnt(0)" ::: "memory");
    __syncthreads();
    if (threadIdx.x == 0) {
        unsigned* bar = b.bar;
        __builtin_amdgcn_s_waitcnt(0);
        unsigned nloc = b.st[0], nx = b.st[1];
        if (nloc == 0u) { xcd_barrier_complete(bar, b.x, nloc, nx); b.st[0] = nloc; b.st[1] = nx; }
        const unsigned old = xb_add(&bar[XB_XSUB(b.x)], 1u);
        const unsigned gen = old / nloc;
        if (old + 1u == (gen + 1u) * nloc) {
            __builtin_amdgcn_fence(__ATOMIC_RELEASE, "agent");
            asm volatile("s_waitcnt vmcnt(0)" ::: "memory");
            const unsigned og = xb_add(&bar[XB_TOP], 1u);
            const unsigned tg = og / nx;
            if (og + 1u == (tg + 1u) * nx) xb_add(&bar[XB_TOPGEN], 1u);
            else XB_SPIN(xb_ld(&bar[XB_TOPGEN]) == tg, bar);
            __builtin_amdgcn_fence(__ATOMIC_ACQUIRE, "agent");
            xb_add(&bar[XB_XGEN(b.x)], 1u);
            asm volatile("s_waitcnt vmcnt(0)" ::: "memory");
        } else {
            XB_SPIN(xb_ld(&bar[XB_XGEN(b.x)]) == gen, bar);
            __builtin_amdgcn_fence(__ATOMIC_ACQUIRE, "agent");
            asm volatile("s_waitcnt vmcnt(0)" ::: "memory");
        }
    }
    __syncthreads();
}
namespace att3 {
#ifndef ATT_REGSTAGE
#define ATT_REGSTAGE 0
#endif
#ifndef DMA_IN_VSEG
#define DMA_IN_VSEG 0
#endif
#ifndef QK_IN_VSEG
#define QK_IN_VSEG 0
#endif
#ifndef ATT_ONEBAR
#define ATT_ONEBAR 1
#endif
#ifndef ATT_LOCKSTEP
#define ATT_LOCKSTEP 0
#endif
typedef unsigned short bf16_t;
typedef short bf16x8 __attribute__((ext_vector_type(8)));
typedef short s16x4 __attribute__((ext_vector_type(4)));
typedef float f32x16 __attribute__((ext_vector_type(16)));
typedef float f32x4 __attribute__((ext_vector_type(4)));
typedef unsigned u32x4 __attribute__((ext_vector_type(4)));
#define A2_LAS __attribute__((address_space(3)))
#ifndef PRIO_MODE
#define PRIO_MODE 0
#endif
#if PRIO_MODE == 1
#define A3_PRIO_M(x) __builtin_amdgcn_s_setprio(x)
#define A3_PRIO_V(x) do { } while (0)
#elif PRIO_MODE == 2
#define A3_PRIO_M(x) do { } while (0)
#define A3_PRIO_V(x) __builtin_amdgcn_s_setprio(x)
#else
#define A3_PRIO_M(x) do { } while (0)
#define A3_PRIO_V(x) do { } while (0)
#endif
constexpr int KVBLK = 64, TILEB = 16384, KRING = 4, VRING = 3;
constexpr int OFF_K = 0, OFF_V = KRING * TILEB, OFF_WS = (KRING + VRING) * TILEB, OFF_TAB = OFF_WS + 8 * 256, A2_LDS_END = OFF_TAB + 2048;
constexpr float THR2 = 11.5f;
#define KSWZ(row, colB) ((row) * 256 + ((colB) ^ (((row) & 15) << 4)))
__device__ __forceinline__ int crow(int r, int hi) { return (r & 3) + 8 * (r >> 2) + 4 * hi; }
__device__ __forceinline__ unsigned cvtpk(float lo, float hi) { unsigned r; asm volatile("v_cvt_pk_bf16_f32 %0, %1, %2" : "=v"(r) : "v"(lo), "v"(hi)); return r; }
__device__ __forceinline__ float bflo(unsigned w) { return __uint_as_float(w << 16); }
__device__ __forceinline__ float bfhi(unsigned w) { return __uint_as_float(w & 0xffff0000u); }
__device__ __forceinline__ float silu(float a) { return a * __builtin_amdgcn_rcpf(1.f + __expf(-a)); }
__device__ __forceinline__ float max3f(float a, float b, float c) { float r; asm("v_max3_f32 %0, %1, %2, %3" : "=v"(r) : "v"(a), "v"(b), "v"(c)); return r; }
__device__ __forceinline__ float max2f(float a, float b) { float r; asm("v_max_f32_e32 %0, %1, %2" : "=v"(r) : "v"(a), "v"(b)); return r; }
__device__ __forceinline__ float fadd_s(float a, float b) { float r; asm("v_add_f32_e32 %0, %1, %2" : "=v"(r) : "v"(a), "v"(b)); return r; }
__device__ __forceinline__ float exp2_s(float a) { float r; asm("v_exp_f32_e32 %0, %1" : "=v"(r) : "v"(a)); return r; }
typedef short v4i16_t __attribute__((ext_vector_type(4)));
__device__ __forceinline__ s16x4 vtr(const A2_LAS char* p) { return __builtin_bit_cast(s16x4, __builtin_amdgcn_ds_read_tr16_b64_v4i16((A2_LAS v4i16_t*)p)); }
__device__ __forceinline__ int v_rd_base(int lane) { return ((lane & 3) << 3) | (((lane >> 2) & 3) << 6) | (((lane >> 4) & 1) << 5) | (((lane >> 5) & 1) << 11); }
constexpr int v_rd_off(int d0, int ks, int half) { return d0 * 512 + ks * 4096 + half * 256; }

#ifndef MFMA_GAP
#define MFMA_GAP 0
#endif
#if MFMA_GAP > 0
#define MGAP_STR2(x) #x
#define MGAP_STR(x) MGAP_STR2(x)
#define MGAP() asm volatile("s_nop " MGAP_STR(MFMA_GAP))
#else
#define MGAP() do { } while (0)
#endif
__device__ __forceinline__ void kload(bf16x8* kf, const A2_LAS char* Ks, int r32, int hi, int comp) {
#pragma unroll
  for (int d0 = 0; d0 < 4; ++d0) { const int cb = ((comp * 4 + d0) * 16 + hi * 8) * 2;
    kf[2 * d0] = *reinterpret_cast<const A2_LAS bf16x8*>(Ks + KSWZ(r32, cb)); kf[2 * d0 + 1] = *reinterpret_cast<const A2_LAS bf16x8*>(Ks + KSWZ(32 + r32, cb)); }
}
__device__ __forceinline__ void qkt_a(f32x16& p0, f32x16& p1, const bf16x8* kf, const bf16x8* qr, const f32x16& negm) {
  p0 = __builtin_amdgcn_mfma_f32_32x32x16_bf16(kf[0], qr[0], negm, 0, 0, 0); MGAP(); p1 = __builtin_amdgcn_mfma_f32_32x32x16_bf16(kf[1], qr[0], negm, 0, 0, 0); MGAP();
  p0 = __builtin_amdgcn_mfma_f32_32x32x16_bf16(kf[2], qr[1], p0, 0, 0, 0); MGAP(); p1 = __builtin_amdgcn_mfma_f32_32x32x16_bf16(kf[3], qr[1], p1, 0, 0, 0); MGAP();
}
__device__ __forceinline__ void qkt_b(f32x16& p0, f32x16& p1, const bf16x8* kf, const bf16x8* qr) {
  p0 = __builtin_amdgcn_mfma_f32_32x32x16_bf16(kf[4], qr[2], p0, 0, 0, 0); MGAP(); p1 = __builtin_amdgcn_mfma_f32_32x32x16_bf16(kf[5], qr[2], p1, 0, 0, 0); MGAP();
  p0 = __builtin_amdgcn_mfma_f32_32x32x16_bf16(kf[6], qr[3], p0, 0, 0, 0); MGAP(); p1 = __builtin_amdgcn_mfma_f32_32x32x16_bf16(kf[7], qr[3], p1, 0, 0, 0); MGAP();
}
struct VFrag { s16x4 lo[4], hh[4]; };
template <int D0> __device__ __forceinline__ void vload(VFrag& f, const A2_LAS char* vp) {
#pragma unroll
  for (int ks = 0; ks < 4; ++ks) { f.lo[ks] = vtr(vp + v_rd_off(D0, ks, 0)); f.hh[ks] = vtr(vp + v_rd_off(D0, ks, 1)); }
}
template <int D0> __device__ __forceinline__ void vload_a(VFrag& f, unsigned va) {
#define VTR_A(dst, off) asm volatile("ds_read_b64_tr_b16 %0, %1 offset:%2" : "=v"(dst) : "v"(va), "n"(off))
  VTR_A(f.lo[0], v_rd_off(D0, 0, 0)); VTR_A(f.hh[0], v_rd_off(D0, 0, 1)); VTR_A(f.lo[1], v_rd_off(D0, 1, 0)); VTR_A(f.hh[1], v_rd_off(D0, 1, 1));
  VTR_A(f.lo[2], v_rd_off(D0, 2, 0)); VTR_A(f.hh[2], v_rd_off(D0, 2, 1)); VTR_A(f.lo[3], v_rd_off(D0, 3, 0)); VTR_A(f.hh[3], v_rd_off(D0, 3, 1));
#undef VTR_A
}
#define VWAIT(n, f) asm volatile("s_waitcnt lgkmcnt(" #n ")" : "+v"(f.lo[0]), "+v"(f.lo[1]), "+v"(f.lo[2]), "+v"(f.lo[3]), "+v"(f.hh[0]), "+v"(f.hh[1]), "+v"(f.hh[2]), "+v"(f.hh[3]))
__device__ __forceinline__ void pvmma(f32x16& od, const VFrag& f, bf16x8 pa0, bf16x8 pa1, bf16x8 pa2, bf16x8 pa3) {
#define PK(k) (bf16x8){f.lo[k][0], f.lo[k][1], f.lo[k][2], f.lo[k][3], f.hh[k][0], f.hh[k][1], f.hh[k][2], f.hh[k][3]}
  od = __builtin_amdgcn_mfma_f32_32x32x16_bf16(PK(0), pa0, od, 0, 0, 0); MGAP();
  od = __builtin_amdgcn_mfma_f32_32x32x16_bf16(PK(1), pa1, od, 0, 0, 0); MGAP();
  od = __builtin_amdgcn_mfma_f32_32x32x16_bf16(PK(2), pa2, od, 0, 0, 0); MGAP();
  od = __builtin_amdgcn_mfma_f32_32x32x16_bf16(PK(3), pa3, od, 0, 0, 0); MGAP();
#undef PK
}
__device__ __forceinline__ float vtail(const f32x16& p0, const f32x16& p1, bf16x8& pa0, bf16x8& pa1, bf16x8& pa2, bf16x8& pa3) {
  float sa, sb, e0, e1, e2, e3, e4, e5, e6, e7; u32x4 w0, w1, w2, w3;
#define VT_BODY(ADD0, ADD1) "v_exp_f32_e32 %6, %14\n\tv_exp_f32_e32 %7, %15\n\tv_exp_f32_e32 %8, %16\n\tv_exp_f32_e32 %9, %17\n\t" ADD0 "v_exp_f32_e32 %10, %18\n\t" ADD1 "v_exp_f32_e32 %11, %19\n\t" \
    "v_cvt_pk_bf16_f32 %2, %6, %7\n\tv_exp_f32_e32 %12, %20\n\tv_cvt_pk_bf16_f32 %3, %8, %9\n\tv_exp_f32_e32 %13, %21\n\tv_add_f32_e32 %0, %0, %10\n\tv_add_f32_e32 %1, %1, %11\n\t" \
    "v_cvt_pk_bf16_f32 %4, %10, %11\n\tv_add_f32_e32 %0, %0, %12\n\tv_add_f32_e32 %1, %1, %13\n\tv_cvt_pk_bf16_f32 %5, %12, %13"
#define VT_OUT(W) "=&v"(W.x), "=&v"(W.y), "=&v"(W.z), "=&v"(W.w), "=&v"(e0), "=&v"(e1), "=&v"(e2), "=&v"(e3), "=&v"(e4), "=&v"(e5), "=&v"(e6), "=&v"(e7)
#define VT_IN(P, B) "v"(P[B + 0]), "v"(P[B + 1]), "v"(P[B + 2]), "v"(P[B + 3]), "v"(P[B + 4]), "v"(P[B + 5]), "v"(P[B + 6]), "v"(P[B + 7])
  asm(VT_BODY("v_add_f32_e32 %0, %6, %7\n\t", "v_add_f32_e32 %1, %8, %9\n\t") : "=&v"(sa), "=&v"(sb), VT_OUT(w0) : VT_IN(p0, 0));
  asm(VT_BODY("v_add_f32_e32 %0, %0, %6\n\tv_add_f32_e32 %1, %1, %7\n\t", "v_add_f32_e32 %0, %0, %8\n\tv_add_f32_e32 %1, %1, %9\n\t") : "+v"(sa), "+v"(sb), VT_OUT(w1) : VT_IN(p0, 8));
  asm(VT_BODY("v_add_f32_e32 %0, %0, %6\n\tv_add_f32_e32 %1, %1, %7\n\t", "v_add_f32_e32 %0, %0, %8\n\tv_add_f32_e32 %1, %1, %9\n\t") : "+v"(sa), "+v"(sb), VT_OUT(w2) : VT_IN(p1, 0));
  asm(VT_BODY("v_add_f32_e32 %0, %0, %6\n\tv_add_f32_e32 %1, %1, %7\n\t", "v_add_f32_e32 %0, %0, %8\n\tv_add_f32_e32 %1, %1, %9\n\t") : "+v"(sa), "+v"(sb), VT_OUT(w3) : VT_IN(p1, 8));
#undef VT_BODY
#undef VT_OUT
#undef VT_IN
  pa0 = *reinterpret_cast<bf16x8*>(&w0); pa1 = *reinterpret_cast<bf16x8*>(&w1); pa2 = *reinterpret_cast<bf16x8*>(&w2); pa3 = *reinterpret_cast<bf16x8*>(&w3);
  return sa + sb;
}
__device__ __forceinline__ float rowmax64(const f32x16& p0, const f32x16& p1) {
  float a, b;
  asm("v_max3_f32 %0, %2, %3, %4\n\tv_max3_f32 %1, %5, %6, %7\n\tv_max3_f32 %0, %0, %8, %9" : "=&v"(a), "=&v"(b) : "v"(p0[0]), "v"(p0[1]), "v"(p1[0]), "v"(p0[2]), "v"(p0[3]), "v"(p1[1]), "v"(p1[2]), "v"(p1[3]));
#define MAX8(r) asm("v_max3_f32 %0, %0, %2, %3\n\tv_max3_f32 %1, %1, %4, %5\n\tv_max3_f32 %0, %0, %6, %7\n\tv_max3_f32 %1, %1, %8, %9" : "+v"(a), "+v"(b) : "v"(p0[r]), "v"(p0[r + 1]), "v"(p0[r + 2]), "v"(p0[r + 3]), "v"(p1[r]), "v"(p1[r + 1]), "v"(p1[r + 2]), "v"(p1[r + 3]))
  MAX8(4); MAX8(8);
  asm("v_max3_f32 %0, %0, %2, %3\n\tv_max3_f32 %1, %1, %4, %5\n\tv_max3_f32 %0, %0, %6, %7\n\tv_max3_f32 %1, %1, %8, %9\n\tv_max_f32_e32 %0, %0, %1" : "+v"(a), "+v"(b) : "v"(p0[12]), "v"(p0[13]), "v"(p0[14]), "v"(p0[15]), "v"(p1[12]), "v"(p1[13]), "v"(p1[14]), "v"(p1[15]));
#undef MAX8
  float rm = a;
  { auto rr = __builtin_amdgcn_permlane32_swap(__float_as_uint(rm), __float_as_uint(rm), false, false); rm = max2f(__uint_as_float(rr[0]), __uint_as_float(rr[1])); }
  return rm;
}
constexpr float REFOFF = THR2 - 1.f;
template <bool NEAR>
__device__ __forceinline__ bool vseg(f32x16& p0, f32x16& p1, float& mhat, float& l_reg, const bool first, const A2_LAS float* tabp, float& fsc, int r32, int hi,
                                     bf16x8& pa0, bf16x8& pa1, bf16x8& pa2, bf16x8& pa3) {
  if (NEAR) {
#pragma unroll
    for (int r = 0; r < 16; ++r) { const int o_ = (r & 3) + 8 * (r >> 2); p0[r] = fadd_s(p0[r], tabp[o_]); p1[r] = fadd_s(p1[r], tabp[o_ + 32]); }
  }
  if (first) { const float d = rowmax64(p0, p1) + REFOFF; mhat += d;
#pragma unroll
    for (int r = 0; r < 16; ++r) { p0[r] -= d; p1[r] -= d; }
    l_reg += vtail(p0, p1, pa0, pa1, pa2, pa3); return false;
  }
  const float ts = vtail(p0, p1, pa0, pa1, pa2, pa3);
  if (__builtin_expect(__any(!(ts < 2.f)), 0)) {
    const float dl = __builtin_fmaxf(rowmax64(p0, p1) + REFOFF, 0.f); mhat += dl;
#pragma unroll
    for (int r = 0; r < 16; ++r) { p0[r] -= dl; p1[r] -= dl; }
    const float f = __builtin_amdgcn_exp2f(-dl); l_reg *= f; fsc = f;
    l_reg += vtail(p0, p1, pa0, pa1, pa2, pa3); return true;
  }
  l_reg += ts; return false;
}

template <int VAR>
__device__ __forceinline__ void attn_unit(const bf16_t* QU, bf16_t* OQ, const bf16_t* __restrict__ KB, const bf16_t* __restrict__ VB, const bf16_t* __restrict__ GA,
                                          const float* __restrict__ tabg, const float* __restrict__ subg, float lam, int tok0, int seq, int h, int q0, A2_LAS unsigned char* lds, const int wave_, const int role_) {
  const int tid = opq_tid(wave_), lane = tid & 63, r32 = lane & 31, hi = lane >> 5; const int wid = wave_;
  const int comp = role_ >> 2, rb = role_ & 3;
  const A2_LAS char* Kr = (const A2_LAS char*)lds + OFF_K; const A2_LAS char* Vr = (const A2_LAS char*)lds + OFF_V;
  A2_LAS float* wsf = (A2_LAS float*)(lds + OFF_WS) + wid * 64; A2_LAS float* li_l = wsf; A2_LAS float* al_l = wsf + 32;
  A2_LAS float* tab = (A2_LAS float*)(lds + OFF_TAB);
  unsigned koff[2], voff[2];
#pragma unroll
  for (int i = 0; i < 2; ++i) { const int pc = 2 * wid + i;
    { const int row = 4 * pc + (lane >> 4), c = (lane & 15) ^ (row & 15); koff[i] = (unsigned)((row >> 4) * 16384 + (c >> 2) * 1024 + (row & 15) * 64 + (c & 3) * 16); }
    { const int st = 2 * pc + (lane >> 5), kk = (st >> 2) * 8 + ((lane & 31) >> 2), key = (kk & ~0xC) | ((kk & 4) << 1) | ((kk & 8) >> 1), col = (st & 3) * 32 + (lane & 3) * 8;
      voff[i] = (unsigned)((key >> 4) * 16384 + (col >> 5) * 1024 + (key & 15) * 64 + (col & 31) * 2); } }
  const char* Kh = (const char*)(KB + blk512(tok0, h * 128)); const char* Vh = (const char*)(VB + blk512(tok0, h * 128));
  const int NT = seq / KVBLK;
#define DMA_K(t, slot) do { const int t_ = (t) < NT ? (t) : NT - 1; const char* g_ = Kh + (size_t)t_ * (KVBLK * 1024); \
    __builtin_amdgcn_global_load_lds((const unsigned*)(g_ + koff[0]), (A2_LAS unsigned*)(lds + OFF_K + (slot) * TILEB + (2 * wid) * 1024), 16, 0, 0); \
    __builtin_amdgcn_global_load_lds((const unsigned*)(g_ + koff[1]), (A2_LAS unsigned*)(lds + OFF_K + (slot) * TILEB + (2 * wid + 1) * 1024), 16, 0, 0); } while (0)
#define DMA_V(t, slot) do { const int t_ = (t) < NT ? (t) : NT - 1; const char* g_ = Vh + (size_t)t_ * (KVBLK * 1024); \
    __builtin_amdgcn_global_load_lds((const unsigned*)(g_ + voff[0]), (A2_LAS unsigned*)(lds + OFF_V + (slot) * TILEB + (2 * wid) * 1024), 16, 0, 0); \
    __builtin_amdgcn_global_load_lds((const unsigned*)(g_ + voff[1]), (A2_LAS unsigned*)(lds + OFF_V + (slot) * TILEB + (2 * wid + 1) * 1024), 16, 0, 0); } while (0)
#define STG_GEOM() int tid_s = tid; asm volatile("" : "+v"(tid_s)); const int sr = tid_s >> 4, sc = (tid_s & 15) * 8
#define STG_KOFF() const int kst0 = KSWZ(sr, sc * 2), kst1 = KSWZ(32 + sr, sc * 2)
#define STG_VOFF() const int kk0 = (sr & ~0xC) | ((sr & 4) << 1) | ((sr & 8) >> 1), kk1 = kk0 + 32; \
    const int vst0 = ((kk0 >> 3) * 4 + (sc >> 5)) * 512 + ((kk0 & 7) * 32 + (sc & 31)) * 2, vst1 = ((kk1 >> 3) * 4 + (sc >> 5)) * 512 + ((kk1 & 7) * 32 + (sc & 31)) * 2
#define STG_SOFF() const unsigned soff0 = (unsigned)(sr * 1024 + sc * 2), soff1 = soff0 + 32 * 1024
  bf16x8 kq0, kq1, vq0, vq1;
#define LD16(base, off) (*reinterpret_cast<const bf16x8*>((base) + (off)))
#define LOADK(t) do { STG_GEOM(); STG_SOFF(); const int t_ = (t) < NT ? (t) : NT - 1; const char* g_ = Kh + (size_t)t_ * (KVBLK * 1024); kq0 = LD16(g_, soff0); kq1 = LD16(g_, soff1); } while (0)
#define LOADV(t) do { STG_GEOM(); STG_SOFF(); const int t_ = (t) < NT ? (t) : NT - 1; const char* g_ = Vh + (size_t)t_ * (KVBLK * 1024); vq0 = LD16(g_, soff0); vq1 = LD16(g_, soff1); } while (0)
#define WRITEK(slot) do { STG_GEOM(); STG_KOFF(); A2_LAS char* d_ = (A2_LAS char*)lds + OFF_K + (slot) * TILEB; *(A2_LAS bf16x8*)(d_ + kst0) = kq0; *(A2_LAS bf16x8*)(d_ + kst1) = kq1; } while (0)
#define WRITEV(slot) do { STG_GEOM(); STG_VOFF(); A2_LAS char* d_ = (A2_LAS char*)lds + OFF_V + (slot) * TILEB; *(A2_LAS bf16x8*)(d_ + vst0) = vq0; *(A2_LAS bf16x8*)(d_ + vst1) = vq1; } while (0)
#define BAR() __builtin_amdgcn_s_barrier()
#define WAITV(n) asm volatile("s_waitcnt vmcnt(" #n ")" ::: "memory")
#define WAITL() asm volatile("s_waitcnt lgkmcnt(0)" ::: "memory")
  bf16x8 qr[4];
  {
#pragma unroll
    for (int d0 = 0; d0 < 4; ++d0) qr[d0] = *reinterpret_cast<const bf16x8*>(QU + blk512(tok0 + q0 + rb * 32 + r32, h * 128 + comp * 64 + hi * 8 + d0 * 16)); }
  { const int i = tid; int rel = i - 256; rel = rel < -128 ? -128 : (rel > 127 ? 127 : rel); tab[i] = tabg[h * 256 + rel + 128]; }
#if ATT_REGSTAGE
  { LOADK(0); LOADV(0); const bf16x8 a0 = kq0, a1 = kq1; LOADK(1); const bf16x8 b0 = kq0, b1 = kq1; LOADK(2); STG_GEOM(); STG_KOFF();
    A2_LAS char* d_ = (A2_LAS char*)lds + OFF_K; *(A2_LAS bf16x8*)(d_ + kst0) = a0; *(A2_LAS bf16x8*)(d_ + kst1) = a1; *(A2_LAS bf16x8*)(d_ + TILEB + kst0) = b0; *(A2_LAS bf16x8*)(d_ + TILEB + kst1) = b1;
    WRITEK(2); WRITEV(0); }
#else
  DMA_K(0, 0); DMA_K(1, 1); DMA_V(0, 0); DMA_K(2, 2);
#endif
  const int qw0 = q0 + rb * 32, qpos = qw0 + r32;
  float mhat = 0.f, l_reg = 0.f; f32x16 o[4];
#pragma unroll
  for (int d = 0; d < 4; ++d) o[d] = f32x16{};
  f32x16 p0, p1, negm; bf16x8 pa0, pa1, pa2, pa3; bf16x8 kf[8]; VFrag vfa, vfb;
#define SBAR() __builtin_amdgcn_sched_barrier(0)
  const int vbase = v_rd_base(lane);
  if (!ATT_REGSTAGE) WAITV(4);
  WAITL(); BAR();
  const float tabL = tab[128], tabR = tab[383];
  if (!ATT_LOCKSTEP && !ATT_ONEBAR && comp == 1) BAR();
#define CLS(j) ((64 * (j) + 63 - qw0 <= -91) ? 0 : ((64 * (j) - qw0 - 31 >= 91) ? 1 : 2))
#define CCONST(c) ((c) == 0 ? tabL : ((c) == 1 ? tabR : 0.f))
#define SETNEGM(c) do { const float v_ = CCONST(c) - mhat; _Pragma("unroll") for (int r = 0; r < 16; ++r) negm[r] = v_; } while (0)
#define RESC() do { _Pragma("unroll") for (int d = 0; d < 4; ++d) _Pragma("unroll") for (int r = 0; r < 16; ++r) o[d][r] *= fsc_; } while (0)
#define VSEG(j, FIRST) do { const int c_ = cls; bool rs_; float fsc_ = 1.f; \
    if (c_ == 2) rs_ = vseg<true>(p0, p1, mhat, l_reg, FIRST, tab + (64 * (j) - qpos + 256 + 4 * hi), fsc_, r32, hi, pa0, pa1, pa2, pa3); \
    else rs_ = vseg<false>(p0, p1, mhat, l_reg, FIRST, tab, fsc_, r32, hi, pa0, pa1, pa2, pa3); \
    if (rs_) RESC(); \
    const int cn_ = CLS((j) + 1); if (__builtin_expect(rs_ || (FIRST) || cn_ != c_, 0)) { SETNEGM(cn_); asm volatile("" : "+v"(negm)); } cls = cn_; } while (0)
#define PKONLY() do { u32x4 w0 = {cvtpk(p0[0], p0[1]), cvtpk(p0[2], p0[3]), cvtpk(p0[4], p0[5]), cvtpk(p0[6], p0[7])}, w1 = {cvtpk(p0[8], p0[9]), cvtpk(p0[10], p0[11]), cvtpk(p0[12], p0[13]), cvtpk(p0[14], p0[15])}; \
    u32x4 w2 = {cvtpk(p1[0], p1[1]), cvtpk(p1[2], p1[3]), cvtpk(p1[4], p1[5]), cvtpk(p1[6], p1[7])}, w3 = {cvtpk(p1[8], p1[9]), cvtpk(p1[10], p1[11]), cvtpk(p1[12], p1[13]), cvtpk(p1[14], p1[15])}; \
    pa0 = *reinterpret_cast<bf16x8*>(&w0); pa1 = *reinterpret_cast<bf16x8*>(&w1); pa2 = *reinterpret_cast<bf16x8*>(&w2); pa3 = *reinterpret_cast<bf16x8*>(&w3); } while (0)
  int cls = CLS(0); SETNEGM(cls);
  kload(kf, Kr, r32, hi, comp);
  A3_PRIO_M(1);
  qkt_a(p0, p1, kf, qr, negm); qkt_b(p0, p1, kf, qr);
  A3_PRIO_M(0);
  if (ATT_REGSTAGE) { SBAR(); LOADK(3); LOADV(1); } else if (!DMA_IN_VSEG) { DMA_K(3, 3); DMA_V(1, 1); }
  if (!ATT_LOCKSTEP && (!ATT_ONEBAR || comp == 1)) { if (comp == 1 && !ATT_REGSTAGE) { if (DMA_IN_VSEG) WAITV(0); else WAITV(4); } WAITL(); BAR(); }
  if (DMA_IN_VSEG && !ATT_REGSTAGE) { DMA_K(3, 3); DMA_V(1, 1); }
  A3_PRIO_V(1); kload(kf, Kr + TILEB, r32, hi, comp); SBAR();
  VSEG(0, true); A3_PRIO_V(0);
  if (QK_IN_VSEG) { qkt_a(p0, p1, kf, qr, negm); qkt_b(p0, p1, kf, qr); }
  if (ATT_REGSTAGE) { WRITEK(3); WRITEV(1); WAITL(); } else if (ATT_LOCKSTEP || comp == 0) WAITV(4);
  if (!ATT_ONEBAR || ATT_LOCKSTEP || comp == 0) BAR();
  int sk = 2, sv = 0;
  for (int j = 1; j < NT; ++j) {
    asm volatile("" : "+v"(koff[0]), "+v"(koff[1]), "+v"(voff[0]), "+v"(voff[1]));
    const A2_LAS char* vp = Vr + sv * TILEB + vbase;
    A3_PRIO_M(1);
    if (VAR == 8) {
#define FILL() do { fx0 = __builtin_amdgcn_exp2f(fx0); fy0 += fx1; fy1 += fx0; fy2 += fy0; asm volatile("" : "+v"(fx0), "+v"(fy0), "+v"(fy1), "+v"(fy2)); } while (0)
#define MF(dst, a, b, c) do { dst = __builtin_amdgcn_mfma_f32_32x32x16_bf16(a, b, c, 0, 0, 0); FILL(); } while (0)
      float fx0 = (float)j, fx1 = 1.f, fy0 = 0.f, fy1 = 0.f, fy2 = 0.f;
      MF(p0, kf[0], qr[0], negm); MF(p1, kf[1], qr[0], negm); MF(p0, kf[2], qr[1], p0); MF(p1, kf[3], qr[1], p1); MF(p0, kf[4], qr[2], p0); MF(p1, kf[5], qr[2], p1); MF(p0, kf[6], qr[3], p0); MF(p1, kf[7], qr[3], p1);
      const bf16x8 vb_ = kf[0];
      _Pragma("unroll") for (int d = 0; d < 4; ++d) { MF(o[d], pa0, vb_, o[d]); MF(o[d], pa1, vb_, o[d]); MF(o[d], pa2, vb_, o[d]); MF(o[d], pa3, vb_, o[d]); }
      l_reg += fy1 + fy2;
#undef MF
#undef FILL
    } else if (VAR == 4 || VAR == 6 || VAR == 7) {
      asm volatile("" : "+v"(vfa.lo[0]), "+v"(vfa.hh[0]), "+v"(vfb.lo[0]), "+v"(vfb.hh[0]));
      qkt_a(p0, p1, kf, qr, negm); qkt_b(p0, p1, kf, qr);
      pvmma(o[0], vfa, pa0, pa1, pa2, pa3); pvmma(o[1], vfb, pa0, pa1, pa2, pa3); pvmma(o[2], vfa, pa0, pa1, pa2, pa3); pvmma(o[3], vfb, pa0, pa1, pa2, pa3);
    } else if (VAR == 5) {
      vload<0>(vfa, vp); vload<1>(vfb, vp); asm volatile("" : "+v"(vfa.lo[0]), "+v"(vfa.lo[1]), "+v"(vfa.lo[2]), "+v"(vfa.lo[3]), "+v"(vfa.hh[0]), "+v"(vfa.hh[1]), "+v"(vfa.hh[2]), "+v"(vfa.hh[3]), "+v"(vfb.lo[0]), "+v"(vfb.lo[1]), "+v"(vfb.lo[2]), "+v"(vfb.lo[3]), "+v"(vfb.hh[0]), "+v"(vfb.hh[1]), "+v"(vfb.hh[2]), "+v"(vfb.hh[3]));
      vload<2>(vfa, vp); vload<3>(vfb, vp); asm volatile("" : "+v"(vfa.lo[0]), "+v"(vfa.lo[1]), "+v"(vfa.lo[2]), "+v"(vfa.lo[3]), "+v"(vfa.hh[0]), "+v"(vfa.hh[1]), "+v"(vfa.hh[2]), "+v"(vfa.hh[3]), "+v"(vfb.lo[0]), "+v"(vfb.lo[1]), "+v"(vfb.lo[2]), "+v"(vfb.lo[3]), "+v"(vfb.hh[0]), "+v"(vfb.hh[1]), "+v"(vfb.hh[2]), "+v"(vfb.hh[3]));
      asm volatile("" : "+v"(kf[0]), "+v"(kf[1]), "+v"(kf[2]), "+v"(kf[3]), "+v"(kf[4]), "+v"(kf[5]), "+v"(kf[6]), "+v"(kf[7]));
      p0 = negm; p1 = negm;
    } else {
    const unsigned va = (unsigned)(size_t)vp;
    if (!QK_IN_VSEG) { qkt_a(p0, p1, kf, qr, negm); SBAR(); }
    vload_a<0>(vfa, va); SBAR();
    if (!QK_IN_VSEG) qkt_b(p0, p1, kf, qr);
    vload_a<1>(vfb, va); SBAR();
    VWAIT(8, vfa); pvmma(o[0], vfa, pa0, pa1, pa2, pa3);
    vload_a<2>(vfa, va); SBAR();
    VWAIT(8, vfb); pvmma(o[1], vfb, pa0, pa1, pa2, pa3);
    vload_a<3>(vfb, va); SBAR();
    VWAIT(8, vfa); pvmma(o[2], vfa, pa0, pa1, pa2, pa3);
    VWAIT(0, vfb); pvmma(o[3], vfb, pa0, pa1, pa2, pa3);
    }
    A3_PRIO_M(0);
    { const int s3 = (sk + 2) & 3  , s1 = sv == 0 ? 2 : sv - 1  ; if (VAR != 3 && VAR != 7 && VAR != 8) { if (ATT_REGSTAGE) { SBAR(); LOADK(j + 3); LOADV(j + 1); } else if (!DMA_IN_VSEG) { DMA_K(j + 3, s3); DMA_V(j + 1, s1); } } }
    if (!ATT_LOCKSTEP && (!ATT_ONEBAR || comp == 1)) { if (comp == 1 && VAR != 3 && VAR != 7 && VAR != 8 && !ATT_REGSTAGE) { if (DMA_IN_VSEG) WAITV(0); else WAITV(4); } WAITL(); BAR(); }
    if (DMA_IN_VSEG && !ATT_REGSTAGE && VAR != 3 && VAR != 7 && VAR != 8) { const int s3 = (sk + 2) & 3, s1 = sv == 0 ? 2 : sv - 1; DMA_K(j + 3, s3); DMA_V(j + 1, s1); }
    A3_PRIO_V(1); if (VAR != 4 && VAR != 6 && VAR != 7 && VAR != 8) { kload(kf, Kr + sk * TILEB, r32, hi, comp); } SBAR();
    if (VAR != 1 && VAR != 6 && VAR != 7 && VAR != 8) { VSEG(j, false); } else { PKONLY(); } A3_PRIO_V(0);
    if (QK_IN_VSEG && VAR == 0) { qkt_a(p0, p1, kf, qr, negm); qkt_b(p0, p1, kf, qr); }
    if (ATT_REGSTAGE) { if (VAR != 3 && VAR != 7 && VAR != 8) { WRITEK((sk + 2) & 3); WRITEV(sv == 0 ? 2 : sv - 1); WAITL(); } }
    else if ((ATT_LOCKSTEP || comp == 0) && VAR != 3 && VAR != 7 && VAR != 8) WAITV(4);
    if (!ATT_ONEBAR || ATT_LOCKSTEP || comp == 0) BAR();
    sk = (sk + 1) & 3; sv = sv == 2 ? 0 : sv + 1;
  }
  { const A2_LAS char* vp = Vr + sv * TILEB + vbase;
    A3_PRIO_M(1);
    const unsigned va = (unsigned)(size_t)vp;
    vload_a<0>(vfa, va); vload_a<1>(vfb, va); SBAR(); VWAIT(8, vfa); pvmma(o[0], vfa, pa0, pa1, pa2, pa3); vload_a<2>(vfa, va); SBAR(); VWAIT(8, vfb); pvmma(o[1], vfb, pa0, pa1, pa2, pa3); vload_a<3>(vfb, va); SBAR();
    VWAIT(8, vfa); pvmma(o[2], vfa, pa0, pa1, pa2, pa3); VWAIT(0, vfb); pvmma(o[3], vfb, pa0, pa1, pa2, pa3);
    A3_PRIO_M(0); }
  WAITV(0); WAITL();
  if (!ATT_LOCKSTEP && !ATT_ONEBAR && comp == 0) BAR();
  { auto rr = __builtin_amdgcn_permlane32_swap(__float_as_uint(l_reg), __float_as_uint(l_reg), false, false); l_reg = __uint_as_float(rr[0]) + __uint_as_float(rr[1]); }
  const float rl = __builtin_amdgcn_rcpf(l_reg);
  u32x4 gq[4]; f32x4 sq[8];
  { const int row = tid >> 2, qt = tid & 3; const bf16_t* gp = GA + blk512(tok0 + q0 + row, h * 128 + qt * 32); const float* sg = subg + qt * 32;
#pragma unroll
    for (int i = 0; i < 4; ++i) { gq[i] = *(const u32x4*)(gp + 8 * i); sq[2 * i] = *(const f32x4*)(sg + 8 * i); sq[2 * i + 1] = *(const f32x4*)(sg + 8 * i + 4); } }
  WAITL(); BAR(); asm volatile("" ::: "memory");
  A2_LAS float* OC = (A2_LAS float*)lds; constexpr int OST = 129;
  if (comp == 0) {
#pragma unroll
    for (int r = 0; r < 16; ++r) {
#pragma unroll
      for (int d0 = 0; d0 < 4; ++d0) OC[(32 * d0 + crow(r, hi)) * OST + rb * 32 + r32] = o[d0][r] * rl; }
  }
  WAITL(); BAR(); asm volatile("" ::: "memory");
  if (comp == 1) { const float sl = lam * rl;
#pragma unroll
    for (int r = 0; r < 16; ++r) {
#pragma unroll
      for (int d0 = 0; d0 < 4; ++d0) OC[(32 * d0 + crow(r, hi)) * OST + rb * 32 + r32] -= o[d0][r] * sl; }
  }
  WAITL(); BAR(); asm volatile("" ::: "memory");
  { const int row = tid >> 2, qt = tid & 3; const A2_LAS float* rp = OC + (qt * 32) * OST + row;
    f32x4 v[8]; float ss = 0.f;
#pragma unroll
    for (int i = 0; i < 8; ++i) { v[i] = (f32x4){rp[(4 * i) * OST], rp[(4 * i + 1) * OST], rp[(4 * i + 2) * OST], rp[(4 * i + 3) * OST]}; ss += (v[i][0] * v[i][0] + v[i][1] * v[i][1]) + (v[i][2] * v[i][2] + v[i][3] * v[i][3]); }
    ss += bperm_f(lane ^ 1, ss); ss += bperm_f(lane ^ 2, ss);
    const float rstd = __builtin_amdgcn_rsqf(ss * (1.f / 128.f) + 1e-5f) * 0.8f;
    const size_t t = (size_t)(tok0 + q0 + row); bf16_t* op = OQ + t * 1024 + h * 128 + qt * 32;
#pragma unroll
    for (int i = 0; i < 4; ++i) { const u32x4 g = gq[i]; const f32x4 s0 = sq[2 * i], s1 = sq[2 * i + 1];
      const f32x4 a = v[2 * i] * rstd * s0, b = v[2 * i + 1] * rstd * s1; u32x4 w;
      w.x = cvtpk(a[0] * silu(bflo(g.x)), a[1] * silu(bfhi(g.x))); w.y = cvtpk(a[2] * silu(bflo(g.y)), a[3] * silu(bfhi(g.y)));
      w.z = cvtpk(b[0] * silu(bflo(g.z)), b[1] * silu(bfhi(g.z))); w.w = cvtpk(b[2] * silu(bflo(g.w)), b[3] * silu(bfhi(g.w)));
      *(u32x4*)(op + 8 * i) = w; }
  }
  asm volatile("s_waitcnt vmcnt(0)" ::: "memory");
  __syncthreads();
#undef DMA_K
#undef LD16
#undef STG_GEOM
#undef STG_KOFF
#undef STG_VOFF
#undef STG_SOFF
#undef LOADK
#undef LOADV
#undef WRITEK
#undef WRITEV
#undef DMA_V
#undef BAR
#undef WAITV
#undef WAITL
#undef CLS
#undef CCONST
#undef SETNEGM
#undef RESC
#undef VSEG
#undef PKONLY
#undef SBAR
#undef VWAIT
}
#undef KSWZ
}
struct Frame {
    LAS unsigned char* lds;
    volatile LAS unsigned* MISC;
    unsigned* ctl;
    int wave;
    int role;
    int vcu, G;
};
__device__ __forceinline__ float wave_sum(float v, int lane) {
#pragma unroll
    for (int o = 1; o < 64; o <<= 1) v += bperm_f(lane ^ o, v);
    return v;
}
__device__ __forceinline__ void p0_transpose_item(const float* W, int K, int N, bf16* WT, const float* kscale, LAS float* scr, int item, int lane) {
    const int nblk = N / 32, kb = item / nblk, nb = item % nblk, k0 = 64 * kb, n0 = 32 * nb;
#pragma unroll 8
    for (int i = 0; i < 32; ++i) { const int kk = 2 * i + (lane >> 5); float w = W[(size_t)(k0 + kk) * N + n0 + (lane & 31)]; if (kscale) w *= kscale[k0 + kk]; scr[kk * 33 + (lane & 31)] = w; }
    LDS_WAIT(); asm volatile("" ::: "memory");
    const int c = lane & 7;
#pragma unroll
    for (int j = 0; j < 4; ++j) { const int n = (lane >> 3) + 8 * j; const LAS float* s = scr + (8 * c) * 33 + n;
        v4u o; o.x = pk2(s[0 * 33], s[1 * 33]); o.y = pk2(s[2 * 33], s[3 * 33]); o.z = pk2(s[4 * 33], s[5 * 33]); o.w = pk2(s[6 * 33], s[7 * 33]);
        *(GAS v4u*)(WT + (size_t)(n0 + n) * K + k0 + 8 * c) = o; }
    LDS_WAIT(); asm volatile("" ::: "memory");
}
__device__ __forceinline__ void rms_row2_to_bf16(const float* xrow0, const float* xrow1, const float* g, bf16* orow0, bf16* orow1, int lane) {
    const GAS f32x4* xr0 = (const GAS f32x4*)xrow0 + lane; const GAS f32x4* xr1 = (const GAS f32x4*)xrow1 + lane; const GAS f32x4* gr = (const GAS f32x4*)g + lane;
    f32x4 v[4], u[4]; float s = 0.f, t = 0.f;
#pragma unroll
    for (int j = 0; j < 4; ++j) { v[j] = xr0[64 * j]; u[j] = xr1[64 * j]; }
#pragma unroll
    for (int j = 0; j < 4; ++j) { s += (v[j].x * v[j].x + v[j].y * v[j].y) + (v[j].z * v[j].z + v[j].w * v[j].w); t += (u[j].x * u[j].x + u[j].y * u[j].y) + (u[j].z * u[j].z + u[j].w * u[j].w); }
#pragma unroll
    for (int o = 1; o < 64; o <<= 1) { s += bperm_f(lane ^ o, s); t += bperm_f(lane ^ o, t); }
    const float r0 = __builtin_amdgcn_rsqf(s * (1.f / 1024.f) + 1e-6f), r1 = __builtin_amdgcn_rsqf(t * (1.f / 1024.f) + 1e-6f);
    GAS unsigned long long* o0 = (GAS unsigned long long*)orow0 + lane; GAS unsigned long long* o1 = (GAS unsigned long long*)orow1 + lane;
#pragma unroll
    for (int j = 0; j < 4; ++j) { const f32x4 gg = gr[64 * j];
        o0[64 * j] = (unsigned long long)pk2(v[j].x * r0 * gg.x, v[j].y * r0 * gg.y) | ((unsigned long long)pk2(v[j].z * r0 * gg.z, v[j].w * r0 * gg.w) << 32);
        o1[64 * j] = (unsigned long long)pk2(u[j].x * r1 * gg.x, u[j].y * r1 * gg.y) | ((unsigned long long)pk2(u[j].z * r1 * gg.z, u[j].w * r1 * gg.w) << 32); }
}
__device__ __forceinline__ int t5_bucket(int rel) {
    const int n = rel < 0 ? -rel : rel; int b;
    if (n < 8) b = n; else b = 8 + (n >= 12) + (n >= 16) + (n >= 23) + (n >= 32) + (n >= 46) + (n >= 64) + (n >= 91);
    return b + (rel > 0 ? 16 : 0);
}
struct Args { const float* in[15]; float* out; unsigned char* ws; };
__device__ __forceinline__ void rms_row4_to_bf16(const float* xrow0, const float* g, bf16* orow0, int lane) {
    const GAS f32x4* gr = (const GAS f32x4*)g + lane;
    f32x4 v[4][4]; float s[4];
#pragma unroll
    for (int r = 0; r < 4; ++r) { const GAS f32x4* xr = (const GAS f32x4*)(xrow0 + (size_t)r * 1024) + lane;
#pragma unroll
        for (int j = 0; j < 4; ++j) v[r][j] = xr[64 * j]; }
#pragma unroll
    for (int r = 0; r < 4; ++r) { s[r] = 0.f;
#pragma unroll
        for (int j = 0; j < 4; ++j) s[r] += (v[r][j].x * v[r][j].x + v[r][j].y * v[r][j].y) + (v[r][j].z * v[r][j].z + v[r][j].w * v[r][j].w); }
#pragma unroll
    for (int o = 1; o < 64; o <<= 1) {
#pragma unroll
        for (int r = 0; r < 4; ++r) s[r] += bperm_f(lane ^ o, s[r]); }
    f32x4 gg[4];
#pragma unroll
    for (int j = 0; j < 4; ++j) gg[j] = gr[64 * j];
#pragma unroll
    for (int r = 0; r < 4; ++r) { const float rs = __builtin_amdgcn_rsqf(s[r] * (1.f / 1024.f) + 1e-6f); GAS unsigned long long* o8 = (GAS unsigned long long*)(orow0 + (size_t)r * 1024) + lane;
#pragma unroll
        for (int j = 0; j < 4; ++j) o8[64 * j] = (unsigned long long)pk2(v[r][j].x * rs * gg[j].x, v[r][j].y * rs * gg[j].y) | ((unsigned long long)pk2(v[r][j].z * rs * gg[j].z, v[r][j].w * rs * gg[j].w) << 32); }
}
__device__ __forceinline__ void p0_prologue(Frame& F, const Args& a, const int parts = 3) {
    const int tid_ = opq_tid(F.wave), lane_ = tid_ & 63;
    const float* xp = a.in[0]; const float* xs = a.in[1]; const float* pp = a.in[2]; const float* ps = a.in[3]; const float* g_mix = a.in[4]; const float* w_in = a.in[5];
    const float* lamp = a.in[6]; const float* relb = a.in[8]; const float* wf = a.in[9]; const float* w_out = a.in[10]; const float* g_ple = a.in[11];
    const float* w_gate = a.in[12]; const float* w_proj = a.in[13];
    unsigned char* ws = a.ws;
    if (parts & 2) {
        LAS float* scr = (LAS float*)(F.lds + F.wave * 16384);
        const int gw = F.vcu * NWAVES + F.wave, NGW = F.G * NWAVES;
        constexpr int I_IN = (DM / 64) * (NIN / 32), I_SQ = (DM / 64) * (DM / 32), I_P = (PLED / 64) * (DM / 32);
        for (int it = gw; it < I_IN + 2 * I_SQ + I_P; it += NGW) {
            int r = it;
            if (r < I_IN) { p0_transpose_item(w_in, DM, NIN, (bf16*)(ws + WS_WIN), nullptr, scr, r, lane_); continue; } r -= I_IN;
            if (r < I_SQ) { p0_transpose_item(w_out, DM, DM, (bf16*)(ws + WS_WOUT), nullptr, scr, r, lane_); continue; } r -= I_SQ;
            if (r < I_SQ) { p0_transpose_item(w_gate, DM, DM, (bf16*)(ws + WS_WG), g_ple, scr, r, lane_); continue; } r -= I_SQ;
            p0_transpose_item(w_proj, PLED, DM, (bf16*)(ws + WS_WP), nullptr, scr, r, lane_);
        }
        const int gt = F.vcu * (NWAVES * 64) + tid_, NGT = F.G * (NWAVES * 64);
        { constexpr int E_H1A = 64 * 64, E_H1B = 128 * 128, E_M2A = 33 * 16384, E_M2B = 65 * 16384;
          for (int i = gt; i < E_H1A + E_H1B + E_M2A + E_M2B; i += NGT) {
              int e = i; float val; bf16* dst;
              if (e < E_H1A + E_H1B) {
                  int N1, r, s1; if (e < E_H1A) { N1 = 64; r = e >> 6; s1 = e & 63; dst = (bf16*)(ws + WS_H1A) + e; } else { e -= E_H1A; N1 = 128; r = e >> 7; s1 = e & 127; dst = (bf16*)(ws + WS_H1B) + e; }
                  if (r == 0) val = 1.f; else if (r == 1) val = (s1 & 1) ? -1.f : 1.f;
                  else { const int k = r >> 1, j = (k * s1) & (N1 - 1); const float x = 2.f * (float)j / (float)N1; val = (r & 1) ? -sinpif(x) : cospif(x); }
              } else {
                  e -= E_H1A + E_H1B; int S, N1; float norm;
                  if (e < E_M2A) { S = 4096; N1 = 64; norm = 0.0013810679320049757f; dst = (bf16*)(ws + WS_M2A) + e; } else { e -= E_M2A; S = 8192; N1 = 128; norm = 0.0009765625f; dst = (bf16*)(ws + WS_M2B) + e; }
                  const int kt = e >> 14, m = (e >> 7) & 127, kp = e & 127, ro = m >> 6, k2 = m & 63, ri = kp >> 6, s2 = kp & 63;
                  const int sp = kt + N1 * k2, j = (s2 * sp) & (S - 1); const float x = 2.f * (float)j / (float)S; const float c = cospif(x), s = sinpif(x);
                  if (kt == 0) val = (ri == 0) ? (ro == 0 ? c : -s) : 0.f;
                  else if (kt == N1 / 2) val = (ri == 1) ? (ro == 0 ? c : -s) : 0.f;
                  else val = (ro == ri) ? c : (ro == 0 ? s : -s);
                  val *= norm;
              }
              *dst = (bf16)f2bf(val);
          } }
        { bf16* Gt = (bf16*)(ws + WS_GT); LAS float* ct = scr + 2304; LAS float* st = ct + 128;
          for (int i = lane_; i < 128; i += 64) { const float x = (float)i * (1.f / 64.f); ct[i] = cospif(x); st[i] = sinpif(x); }
          LDS_WAIT(); asm volatile("" ::: "memory");
          for (int i = gt; i < 512 * 1024 / 8; i += NGT) { const int n = i >> 7, k8 = (i & 127) * 8; if ((k8 >> 8) != (n >> 7)) *(v4u*)(Gt + (size_t)n * 1024 + k8) = (v4u){0u, 0u, 0u, 0u}; }
          for (int i = gt; i < 4 * 128 * 128; i += NGT) { const int g = i >> 14, c = (i >> 7) & 127, d = i & 127; float are = 0.f, aim = 0.f; const float* wp = wf + (size_t)g * 16384 + d;
#pragma unroll 8
              for (int cp = 0; cp < 128; ++cp) { const int j = (c * cp) & 127; const float w = wp[cp * 128]; are += ct[j] * w; aim += st[j] * w; }
              bf16* o = Gt + (size_t)(g * 128 + d) * 1024 + g * 256 + c; o[0] = (bf16)f2bf(are); o[128] = (bf16)f2bf(aim); } }
        if (F.vcu == 0) {
            float* tab = (float*)(ws + WS_TAB);
            for (int i = tid_; i < 1024; i += NWAVES * 64) { const int h = i >> 8, rel = (i & 255) - 128; tab[i] = relb[t5_bucket(rel) * 4 + h] * LOG2E; }
            if (tid_ == 0) { float s01 = 0.f, s23 = 0.f; for (int d = 0; d < 64; ++d) { s01 += lamp[d] * lamp[64 + d]; s23 += lamp[128 + d] * lamp[192 + d]; }
                tab[1024] = __expf(s01) - __expf(s23) + 0.2f; }
        }
    }
    if (parts & 1) {
        const int gw = F.vcu * NWAVES + F.wave, NGW = F.G * NWAVES;
        for (int m = 4 * gw; m < NTOK; m += 4 * NGW) { const float* xrow0 = m < TPR ? xp + (size_t)m * DM : xs + (size_t)(m - TPR) * DM;
            rms_row4_to_bf16(xrow0, g_mix, (bf16*)(ws + WS_XN) + (size_t)m * DM, lane_); }
        const int gt = F.vcu * (NWAVES * 64) + tid_, NGT = F.G * (NWAVES * 64); bf16* PB = (bf16*)a.out;
        for (int i0 = gt; i0 + 3 * NGT < NTOK * (PLED / 8); i0 += 4 * NGT) { f32x4 v0[4], v1[4];
#pragma unroll
            for (int k = 0; k < 4; ++k) { const int i = i0 + k * NGT, row = i >> 5, c8 = (i & 31) * 8; const float* src = (row < TPR ? pp + (size_t)row * PLED : ps + (size_t)(row - TPR) * PLED) + c8;
                v0[k] = *(const f32x4*)src; v1[k] = *(const f32x4*)(src + 4); }
#pragma unroll
            for (int k = 0; k < 4; ++k) { const int i = i0 + k * NGT, row = i >> 5, c8 = (i & 31) * 8; v4u o; o.x = pk2(v0[k].x, v0[k].y); o.y = pk2(v0[k].z, v0[k].w); o.z = pk2(v1[k].x, v1[k].y); o.w = pk2(v1[k].z, v1[k].w);
                *(v4u*)(PB + (size_t)row * PLED + c8) = o; } }
    }
}
typedef short s16x4_t __attribute__((ext_vector_type(4)));
__device__ __forceinline__ s16x4_t trd(const LAS bf16* p) { return __builtin_bit_cast(s16x4_t, __builtin_amdgcn_ds_read_tr16_b64_v4i16((LAS s16x4_t*)p)); }
template <int MK> struct NNRegs { v4u ra[MK * MK / 8 / (NWAVES * 64)], rb[MK * 16 / (NWAVES * 64)]; };
template <int MK, bool BLK = false>
__device__ __forceinline__ void nn_load(NNRegs<MK>& R, const bf16* A, const bf16* B, size_t ldb, int tid) {
    constexpr int NA = MK * MK / 8 / (NWAVES * 64), NB = MK * 16 / (NWAVES * 64);
    static_assert(NA * NWAVES * 64 * 8 == MK * MK && NB * NWAVES * 64 == MK * 16, "staging trip counts");
#pragma unroll
    for (int i = 0; i < NA; ++i) { const int idx = tid + i * (NWAVES * 64), r = idx / (MK / 8), c = idx % (MK / 8); R.ra[i] = *(const v4u*)(A + r * MK + c * 8); }
#pragma unroll
    for (int i = 0; i < NB; ++i) { const int idx = tid + i * (NWAVES * 64), r = idx >> 4, c = idx & 15; R.rb[i] = *(const v4u*)(B + (size_t)r * ldb + (BLK ? (c >> 2) * 512 + (c & 3) * 8 : c * 8)); }
}
template <int MK>
__device__ __forceinline__ void nn_stage(LAS unsigned char* lds, const NNRegs<MK>& R, int tid) {
    constexpr int AST = MK + 8, BST = 136, NA = MK * MK / 8 / (NWAVES * 64), NB = MK * 16 / (NWAVES * 64);
    LAS bf16* As = (LAS bf16*)lds; LAS bf16* Bs = (LAS bf16*)(lds + 40960);
    LDS_WAIT(); __builtin_amdgcn_s_barrier(); asm volatile("" ::: "memory");
#pragma unroll
    for (int i = 0; i < NA; ++i) { const int idx = tid + i * (NWAVES * 64), r = idx / (MK / 8), c = idx % (MK / 8); *(LAS v4u*)(As + r * AST + c * 8) = R.ra[i]; }
#pragma unroll
    for (int i = 0; i < NB; ++i) { const int idx = tid + i * (NWAVES * 64), r = idx >> 4, c = idx & 15; *(LAS v4u*)(Bs + r * BST + c * 8) = R.rb[i]; }
    LDS_WAIT(); __builtin_amdgcn_s_barrier(); asm volatile("" ::: "memory");
}
template <int MK>
__device__ __forceinline__ void nn_mfma(LAS unsigned char* lds, int tid, f32x4 (&acc)[MK / 16]) {
    constexpr int AST = MK + 8, BST = 136;
    const LAS bf16* As = (const LAS bf16*)lds; const LAS bf16* Bs = (const LAS bf16*)(lds + 40960);
    const int w = tid >> 6, l = tid & 63, lr = l & 15, lq = l >> 4;
#pragma unroll
    for (int mt = 0; mt < MK / 16; ++mt) acc[mt] = (f32x4){0.f, 0.f, 0.f, 0.f};
#pragma unroll
    for (int ks = 0; ks < MK / 32; ++ks) {
        const LAS bf16* bp = Bs + (ks * 32 + 8 * lq + (lr >> 2)) * BST + 16 * w + 4 * (lr & 3);
        const s16x4_t blo = trd(bp), bhi = trd(bp + 4 * BST);
        const bf16x8 bfr = {blo[0], blo[1], blo[2], blo[3], bhi[0], bhi[1], bhi[2], bhi[3]};
#pragma unroll
        for (int mt = 0; mt < MK / 16; ++mt) { const bf16x8 afr = *(const LAS bf16x8*)(As + (mt * 16 + lr) * AST + ks * 32 + 8 * lq);
            acc[mt] = __builtin_amdgcn_mfma_f32_16x16x32_bf16(bfr, afr, acc[mt], 0, 0, 0); }
    }
}
template <int MK>
__device__ __forceinline__ void nn_tile(LAS unsigned char* lds, const bf16* A, const bf16* B, size_t ldb, int tid, f32x4 (&acc)[MK / 16]) {
    NNRegs<MK> R; nn_load<MK>(R, A, B, ldb, tid); nn_stage<MK>(lds, R, tid); nn_mfma<MK>(lds, tid, acc);
}
template <int MK>
__device__ __forceinline__ void fft_stage1_run(LAS unsigned char* lds, const bf16* H1, const bf16* QU, bf16* Y, int tokbase, int seqlen, int first, int nitems, int G, int tid) {
    if (first >= nitems) return;
    NNRegs<MK> R;
#define S1_SRC(it) (QU + blk512(tokbase + ((it) >> 8) * seqlen + (((it) & 255) >> 2), (((it) & 255) & 3) * 128))
    nn_load<MK, true>(R, H1, S1_SRC(first), (size_t)32768, tid);
    for (int it = first; it < nitems; it += G) {
        nn_stage<MK>(lds, R, tid);
        if (it + G < nitems) nn_load<MK, true>(R, H1, S1_SRC(it + G), (size_t)32768, tid);
        f32x4 acc[MK / 16]; nn_mfma<MK>(lds, tid, acc);
        const int tok0 = tokbase + (it >> 8) * seqlen, nt = it & 255, s2 = nt >> 2, ch0 = (nt & 3) * 128;
        const int w = tid >> 6, l = tid & 63, lr = l & 15, lq = l >> 4;
        bf16* yb = Y + (size_t)tok0 * 512 + (size_t)s2 * 512 + ch0 + 16 * w + 4 * lq;
#pragma unroll
        for (int mt = 0; mt < MK / 16; ++mt) { const int r = mt * 16 + lr; v2u o; o.x = pk2(acc[mt][0], acc[mt][1]); o.y = pk2(acc[mt][2], acc[mt][3]); *(v2u*)(yb + (size_t)r * (64 * 512)) = o; }
    }
#undef S1_SRC
}
template <int MK>
__device__ __forceinline__ void fft_stage1_item(LAS unsigned char* lds, const bf16* H1, const bf16* QU, bf16* Y, int tok0, int nt, int tid) {
    const int s2 = nt >> 2, ch0 = (nt & 3) * 128;
    f32x4 acc[MK / 16];
    nn_tile<MK>(lds, H1, QU + (size_t)(tok0 + s2) * 1024 + 512 + ch0, (size_t)64 * 1024, tid, acc);
    const int w = tid >> 6, l = tid & 63, lr = l & 15, lq = l >> 4;
    bf16* yb = Y + (size_t)tok0 * 512 + (size_t)s2 * 512 + ch0 + 16 * w + 4 * lq;
#pragma unroll
    for (int mt = 0; mt < MK / 16; ++mt) { const int r = mt * 16 + lr; v2u o; o.x = pk2(acc[mt][0], acc[mt][1]); o.y = pk2(acc[mt][2], acc[mt][3]); *(v2u*)(yb + (size_t)r * (64 * 512)) = o; }
}
__device__ __forceinline__ void fft_stage2_item(LAS unsigned char* lds, const bf16* M2, const bf16* Y, bf16* XP, int tok0, int S, int N1, int kt, int g, int tid) {
    const int p = (kt == 0 || kt == N1 / 2) ? 0 : kt;
    f32x4 acc[8];
    nn_tile<128>(lds, M2 + (size_t)kt * 16384, Y + (size_t)tok0 * 512 + (size_t)(2 * p * 64) * 512 + g * 128, (size_t)512, tid, acc);
    const int w = tid >> 6, l = tid & 63, lr = l & 15, lq = l >> 4; const int c = 16 * w + 4 * lq; const bool mir = (kt != 0 && kt != N1 / 2);
#pragma unroll
    for (int mt = 0; mt < 8; ++mt) { const int m = mt * 16 + lr, ro = m >> 6, k2 = m & 63, sp = kt + N1 * k2;
        v2u o; o.x = pk2(acc[mt][0], acc[mt][1]); o.y = pk2(acc[mt][2], acc[mt][3]);
        *(v2u*)(XP + (size_t)(tok0 + sp) * 1024 + g * 256 + ro * 128 + c) = o;
        if (mir) { if (ro) { o.x ^= 0x80008000u; o.y ^= 0x80008000u; } *(v2u*)(XP + (size_t)(tok0 + S - sp) * 1024 + g * 256 + ro * 128 + c) = o; } }
}

__device__ __forceinline__ void fft_stage2c_item(LAS unsigned char* lds, const bf16* M2, const bf16* Y, const bf16* Gt, const bf16* GF, bf16* QU, int tok0, int S, int N1, int kt, int g, int tid) {
    const int p = (kt == 0 || kt == N1 / 2) ? 0 : kt;
    const int w = tid >> 6, l = tid & 63, lr = l & 15, lq = l >> 4; const bool mir = (kt != 0 && kt != N1 / 2);
    bf16x8 gre[4], gim[4];
    { const bf16* gp = Gt + (size_t)(g * 128 + 16 * w + lr) * 1024 + g * 256 + 8 * lq;
#pragma unroll
      for (int ks = 0; ks < 4; ++ks) { gre[ks] = *(const bf16x8*)(gp + ks * 32); gim[ks] = *(const bf16x8*)(gp + 128 + ks * 32); } }
    const int d0 = g * 128 + 16 * w + 4 * lq;
    v2u gwa[4], gwb[4];
#pragma unroll
    for (int tb = 0; tb < 4; ++tb) { const int sp = kt + N1 * (16 * tb + lr); gwa[tb] = *(const v2u*)(GF + (size_t)(tok0 + sp) * 512 + d0);
        if (mir) gwb[tb] = *(const v2u*)(GF + (size_t)(tok0 + S - sp) * 512 + d0); else gwb[tb] = (v2u){0u, 0u}; }
    f32x4 acc[8];
    nn_tile<128>(lds, M2 + (size_t)kt * 16384, Y + (size_t)tok0 * 512 + (size_t)(2 * p * 64) * 512 + g * 128, (size_t)512, tid, acc);
    constexpr int XST = 136; LAS bf16* XL = (LAS bf16*)(lds + 81920);
#pragma unroll
    for (int mt = 0; mt < 8; ++mt) { v2u o; o.x = pk2(acc[mt][0], acc[mt][1]); o.y = pk2(acc[mt][2], acc[mt][3]); *(LAS v2u*)(XL + (mt * 16 + lr) * XST + 16 * w + 4 * lq) = o; }
    __syncthreads();
    f32x4 P[4], Q[4];
#pragma unroll
    for (int tb = 0; tb < 4; ++tb) { P[tb] = (f32x4){0.f, 0.f, 0.f, 0.f}; Q[tb] = (f32x4){0.f, 0.f, 0.f, 0.f};
#pragma unroll
        for (int ks = 0; ks < 4; ++ks) { const bf16x8 xre = *(const LAS bf16x8*)(XL + (16 * tb + lr) * XST + ks * 32 + 8 * lq), xim = *(const LAS bf16x8*)(XL + (64 + 16 * tb + lr) * XST + ks * 32 + 8 * lq);
            P[tb] = __builtin_amdgcn_mfma_f32_16x16x32_bf16(gre[ks], xre, P[tb], 0, 0, 0); Q[tb] = __builtin_amdgcn_mfma_f32_16x16x32_bf16(gim[ks], xim, Q[tb], 0, 0, 0); } }
#pragma unroll
    for (int tb = 0; tb < 4; ++tb) { const int sp = kt + N1 * (16 * tb + lr);
        { const size_t t = (size_t)(tok0 + sp); const v2u gw = gwa[tb]; const f32x4 f = P[tb] + Q[tb]; v2u o;
          o.x = pk2(f[0] * pg8::silu(pg8::bflo(gw.x)), f[1] * pg8::silu(pg8::bfhi(gw.x))); o.y = pk2(f[2] * pg8::silu(pg8::bflo(gw.y)), f[3] * pg8::silu(pg8::bfhi(gw.y)));
          *(v2u*)(QU + t * 1024 + 512 + d0) = o; }
        if (mir) { const size_t t = (size_t)(tok0 + S - sp); const v2u gw = gwb[tb]; const f32x4 f = P[tb] - Q[tb]; v2u o;
          o.x = pk2(f[0] * pg8::silu(pg8::bflo(gw.x)), f[1] * pg8::silu(pg8::bfhi(gw.x))); o.y = pk2(f[2] * pg8::silu(pg8::bflo(gw.y)), f[3] * pg8::silu(pg8::bfhi(gw.y)));
          *(v2u*)(QU + t * 1024 + 512 + d0) = o; } }
}
struct S2Regs { NNRegs<128> T; bf16x8 gre[4], gim[4]; v2u gwa[4], gwb[4]; };
__device__ __forceinline__ void s2c_load(S2Regs& R, const bf16* M2, const bf16* Y, const bf16* Gt, const bf16* GF, int tok0, int S, int N1, int kt, int g, int tid) {
    const int p = (kt == 0 || kt == N1 / 2) ? 0 : kt;
    const int w = tid >> 6, l = tid & 63, lr = l & 15, lq = l >> 4; const bool mir = (kt != 0 && kt != N1 / 2);
    { const bf16* gp = Gt + (size_t)(g * 128 + 16 * w + lr) * 1024 + g * 256 + 8 * lq;
#pragma unroll
      for (int ks = 0; ks < 4; ++ks) { R.gre[ks] = *(const bf16x8*)(gp + ks * 32); R.gim[ks] = *(const bf16x8*)(gp + 128 + ks * 32); } }
    const int d0 = g * 128 + 16 * w + 4 * lq;
#pragma unroll
    for (int tb = 0; tb < 4; ++tb) { const int sp = kt + N1 * (16 * tb + lr); R.gwa[tb] = *(const v2u*)(GF + blk512(tok0 + sp, d0));
        if (mir) R.gwb[tb] = *(const v2u*)(GF + blk512(tok0 + S - sp, d0)); else R.gwb[tb] = (v2u){0u, 0u}; }
    nn_load<128>(R.T, M2 + (size_t)kt * 16384, Y + (size_t)tok0 * 512 + (size_t)(2 * p * 64) * 512 + g * 128, (size_t)512, tid);
}
__device__ __forceinline__ void fft_stage2c_run(LAS unsigned char* lds, const bf16* M2, const bf16* Y, const bf16* Gt, const bf16* GF, bf16* QU, int tokbase, int S, int N1, int perb, int first, int nitems, int G, int tid) {
    if (first >= nitems) return;
    S2Regs R;
#define S2_ARGS(it) tokbase + ((it) / perb) * S, S, N1, ((it) % perb) >> 2, ((it) % perb) & 3
    s2c_load(R, M2, Y, Gt, GF, S2_ARGS(first), tid);
    for (int it = first; it < nitems; it += G) {
        const int tok0 = tokbase + (it / perb) * S, kt = (it % perb) >> 2, g = (it % perb) & 3;
        const int w = tid >> 6, l = tid & 63, lr = l & 15, lq = l >> 4; const bool mir = (kt != 0 && kt != N1 / 2);
        nn_stage<128>(lds, R.T, tid);
        bf16x8 gre[4], gim[4]; v2u gwa[4], gwb[4];
#pragma unroll
        for (int k = 0; k < 4; ++k) { gre[k] = R.gre[k]; gim[k] = R.gim[k]; gwa[k] = R.gwa[k]; gwb[k] = R.gwb[k]; }
        if (it + G < nitems) s2c_load(R, M2, Y, Gt, GF, S2_ARGS(it + G), tid);
        f32x4 acc[8]; nn_mfma<128>(lds, tid, acc);
        constexpr int XST = 136; LAS bf16* XL = (LAS bf16*)(lds + 81920);
#pragma unroll
        for (int mt = 0; mt < 8; ++mt) { v2u o; o.x = pk2(acc[mt][0], acc[mt][1]); o.y = pk2(acc[mt][2], acc[mt][3]); *(LAS v2u*)(XL + (mt * 16 + lr) * XST + 16 * w + 4 * lq) = o; }
        LDS_WAIT(); __builtin_amdgcn_s_barrier(); asm volatile("" ::: "memory");
        f32x4 P[4], Q[4];
#pragma unroll
        for (int tb = 0; tb < 4; ++tb) { P[tb] = (f32x4){0.f, 0.f, 0.f, 0.f}; Q[tb] = (f32x4){0.f, 0.f, 0.f, 0.f};
#pragma unroll
            for (int ks = 0; ks < 4; ++ks) { const bf16x8 xre = *(const LAS bf16x8*)(XL + (16 * tb + lr) * XST + ks * 32 + 8 * lq), xim = *(const LAS bf16x8*)(XL + (64 + 16 * tb + lr) * XST + ks * 32 + 8 * lq);
                P[tb] = __builtin_amdgcn_mfma_f32_16x16x32_bf16(gre[ks], xre, P[tb], 0, 0, 0); Q[tb] = __builtin_amdgcn_mfma_f32_16x16x32_bf16(gim[ks], xim, Q[tb], 0, 0, 0); } }
        const int d0 = g * 128 + 16 * w + 4 * lq;
#pragma unroll
        for (int tb = 0; tb < 4; ++tb) { const int sp = kt + N1 * (16 * tb + lr);
            { const size_t t = (size_t)(tok0 + sp); const v2u gw = gwa[tb]; const f32x4 f = P[tb] + Q[tb]; v2u o;
              o.x = pk2(f[0] * pg8::silu(pg8::bflo(gw.x)), f[1] * pg8::silu(pg8::bfhi(gw.x))); o.y = pk2(f[2] * pg8::silu(pg8::bflo(gw.y)), f[3] * pg8::silu(pg8::bfhi(gw.y)));
              *(v2u*)(QU + t * 1024 + 512 + d0) = o; }
            if (mir) { const size_t t = (size_t)(tok0 + S - sp); const v2u gw = gwb[tb]; const f32x4 f = P[tb] - Q[tb]; v2u o;
              o.x = pk2(f[0] * pg8::silu(pg8::bflo(gw.x)), f[1] * pg8::silu(pg8::bfhi(gw.x))); o.y = pk2(f[2] * pg8::silu(pg8::bflo(gw.y)), f[3] * pg8::silu(pg8::bfhi(gw.y)));
              *(v2u*)(QU + t * 1024 + 512 + d0) = o; } }
    }
#undef S2_ARGS
}
__global__ void __launch_bounds__(NWAVES * 64, 2) mk_fwd(Args args) {
    extern __shared__ __attribute__((aligned(16))) unsigned char lds[];
    Frame F;
    F.lds = (LAS unsigned char*)lds;
    F.MISC = (volatile LAS unsigned*)(F.lds + MISC_OFF);
    F.wave = __builtin_amdgcn_readfirstlane((int)threadIdx.x >> 6);
    F.G = gridDim.x; { const int bx = blockIdx.x; F.vcu = (F.G % 8 == 0) ? (bx % 8) * (F.G / 8) + bx / 8 : bx; }
    unsigned char* ws = args.ws;
    F.ctl = (unsigned*)(ws + WS_CTL);
    for (int u = threadIdx.x; u < (LDS_BYTES - LDSCTL_OFF) / 4; u += NWAVES * 64) ((LAS unsigned*)(F.lds + LDSCTL_OFF))[u] = 0u;
    __syncthreads();
    XcdBarrier bar = xcd_barrier_post(F.ctl + 1024, F.MISC + 8);
    { const unsigned simd = (unsigned)__builtin_amdgcn_s_getreg((1 << 11) | (4 << 6) | 4) & 3u;
      if ((threadIdx.x & 63) == 0) F.MISC[48 + F.wave] = simd;
      __syncthreads();
      unsigned cnt0 = 0, cnt1 = 0, cnt2 = 0, cnt3 = 0, rank = 0;
#pragma unroll
      for (int w = 0; w < NWAVES; ++w) { const unsigned sw = F.MISC[48 + w]; cnt0 += sw == 0u; cnt1 += sw == 1u; cnt2 += sw == 2u; cnt3 += sw == 3u; rank += (w < F.wave && sw == simd) ? 1u : 0u; }
      const bool ok = cnt0 == 2u && cnt1 == 2u && cnt2 == 2u && cnt3 == 2u;
      F.role = __builtin_amdgcn_readfirstlane(ok ? (int)((rank << 2) | simd) : (((F.wave >> 2) << 2) | (F.wave & 3)));
#if defined(ROLE_PARITY)
      F.role = ((F.wave & 1) << 2) | (F.wave >> 1);
#endif
    }
#define GRID_BAR() xcd_barrier(bar)
#define STAGGER(ticks) do { if ((ticks) > 0) { const unsigned long long t0_ = __builtin_amdgcn_s_memrealtime(); const unsigned long long d_ = (unsigned long long)(F.vcu & 3) * (unsigned long long)(ticks); \
    while (__builtin_amdgcn_s_memrealtime() - t0_ < d_) __builtin_amdgcn_s_sleep(8); } } while (0)
#if defined(PROBE_A)
#define STAMP(k) do { if (blockIdx.x == 0 && threadIdx.x == 0) { const unsigned long long t_ = __builtin_amdgcn_s_memrealtime(); F.MISC[16 + 2 * (k)] = (unsigned)t_; F.MISC[17 + 2 * (k)] = (unsigned)(t_ >> 32); } } while (0)
#else
#define STAMP(k) do { } while (0)
#endif
    STAMP(0);
    bf16* const Win_t = (bf16*)(ws + WS_WIN); bf16* const Wout_t = (bf16*)(ws + WS_WOUT); bf16* const Wg_t = (bf16*)(ws + WS_WG); bf16* const Wp_t = (bf16*)(ws + WS_WP);
    bf16* const Gt = (bf16*)(ws + WS_GT); bf16* const XN = (bf16*)(ws + WS_XN); bf16* const XP = (bf16*)(ws + WS_XN); bf16* const QU = (bf16*)(ws + WS_QU);
    bf16* const KB = (bf16*)(ws + WS_K); bf16* const VB = (bf16*)(ws + WS_V); bf16* const H1B = (bf16*)(ws + WS_K); bf16* const GA = (bf16*)(ws + WS_GA); bf16* const GF = (bf16*)(ws + WS_GF);
    bf16* const QB = (bf16*)(ws + WS_QB); bf16* const UB = (bf16*)(ws + WS_UB);
    bf16* const PROJ = (bf16*)(ws + WS_PROJ); bf16* const PB = (bf16*)args.out; bf16* const Y = (bf16*)args.out;
    float* const SSQ1 = (float*)(ws + WS_SSQ1); float* const SSQ2 = (float*)(ws + WS_SSQ2); const float* const TAB = (const float*)(ws + WS_TAB);

    p0_prologue(F, args);
#if defined(DUP_P0)
    p0_prologue(F, args, (DUP_P0 + 0) ? (DUP_P0 + 0) : 3);
#endif
    GRID_BAR(); STAMP(1);
#if defined(DUP_BAR)
    GRID_BAR(); GRID_BAR(); GRID_BAR(); GRID_BAR(); GRID_BAR();
#endif
#if defined(DUP_P1)
    if ((DUP_P1 + 0) == 4) { const unsigned long long t0_ = __builtin_amdgcn_s_memrealtime(); const unsigned long long d_ = (unsigned long long)(F.vcu & 3) * 800ull;
        while (__builtin_amdgcn_s_memrealtime() - t0_ < d_) __builtin_amdgcn_s_sleep(8); }
    { pg8::Gemm g{XN, Win_t, NTOK, NIN, DM, DM, 0}; pg8::StaticOrder S; S.init(NTOK, NIN, F.G, (int)blockIdx.x);
      pg8::EpiInProj E{QB, KB, VB, GA, UB, GF, QSCALE, ((DUP_P1 + 0) >= 2) ? (DUP_P1 + 0) : 0};
      pg8::gemm_phase<pg8::EpiInProj, pg8::StaticOrder, true, true>(F.lds, g, S, E, F.wave); }
    { pg8::Gemm g{PB, Wp_t, NTOK, DM, PLED, PLED, 0}; pg8::StaticOrder S; S.init(NTOK, DM, F.G, (int)blockIdx.x);
      pg8::EpiPlainBf16 E{PROJ, DM};
      pg8::gemm_phase<pg8::EpiPlainBf16, pg8::StaticOrder, true, true>(F.lds, g, S, E, F.wave); }
#endif
    STAGGER(STG_P1);
#if defined(DUP_PROJ)
    { pg8::Gemm g{PB, Wp_t, NTOK, DM, PLED, PLED, 0}; pg8::StaticOrder S; S.init(NTOK, DM, F.G, (int)blockIdx.x);
      pg8::EpiPlainBf16 E{PROJ, DM};
      pg8::gemm_phase<pg8::EpiPlainBf16, pg8::StaticOrder, true, true>(F.lds, g, S, E, F.wave); }
#endif
    if (PROJ_FIRST_MASK && (F.vcu & PROJ_FIRST_MASK) == 0) {
    { pg8::Gemm g{PB, Wp_t, NTOK, DM, PLED, PLED, 0}; pg8::StaticOrder S; S.init(NTOK, DM, F.G, (int)blockIdx.x);
      pg8::EpiPlainBf16 E{PROJ, DM};
      pg8::gemm_phase<pg8::EpiPlainBf16, pg8::StaticOrder, true, true>(F.lds, g, S, E, F.wave); }
    { pg8::Gemm g{XN, Win_t, NTOK, NIN, DM, DM, 0}; pg8::StaticOrder S; S.init(NTOK, NIN, F.G, (int)blockIdx.x);
      pg8::EpiInProj E{QB, KB, VB, GA, UB, GF, QSCALE, 0};
      pg8::gemm_phase<pg8::EpiInProj, pg8::StaticOrder, true, true>(F.lds, g, S, E, F.wave); }
    } else {
    { pg8::Gemm g{XN, Win_t, NTOK, NIN, DM, DM, 0}; pg8::StaticOrder S; S.init(NTOK, NIN, F.G, (int)blockIdx.x);
      pg8::EpiInProj E{QB, KB, VB, GA, UB, GF, QSCALE, 0};
      pg8::gemm_phase<pg8::EpiInProj, pg8::StaticOrder, true, true>(F.lds, g, S, E, F.wave); }
    { pg8::Gemm g{PB, Wp_t, NTOK, DM, PLED, PLED, 0}; pg8::StaticOrder S; S.init(NTOK, DM, F.G, (int)blockIdx.x);
      pg8::EpiPlainBf16 E{PROJ, DM};
      pg8::gemm_phase<pg8::EpiPlainBf16, pg8::StaticOrder, true, true>(F.lds, g, S, E, F.wave); }
    }
    GRID_BAR(); STAMP(2);
#if defined(DUP_FFT)
    { constexpr int NIT_P = NBP * 256, NIT_S = NBS * 256;
      for (int it = F.vcu; it < NIT_P + NIT_S; it += F.G) {
          if (it < NIT_P) fft_stage1_item<64>(F.lds, (const bf16*)(ws + WS_H1A), QU, Y, (it >> 8) * SEQP, it & 255, opq_tid(F.wave));
          else { const int r = it - NIT_P; fft_stage1_item<128>(F.lds, (const bf16*)(ws + WS_H1B), QU, Y, TPR + (r >> 8) * SEQS, r & 255, opq_tid(F.wave)); } } }
    GRID_BAR(); STAMP(10);
    { constexpr int NIT_P = NBP * 33 * 4, NIT_S = NBS * 65 * 4;
      for (int it = F.vcu; it < NIT_P + NIT_S; it += F.G) {
          if (it < NIT_P) { const int b = it / 132, r = it % 132; fft_stage2_item(F.lds, (const bf16*)(ws + WS_M2A), Y, XP, b * SEQP, SEQP, 64, r >> 2, r & 3, opq_tid(F.wave)); }
          else { const int q = it - NIT_P, b = q / 260, r = q % 260; fft_stage2_item(F.lds, (const bf16*)(ws + WS_M2B), Y, XP, TPR + b * SEQS, SEQS, 128, r >> 2, r & 3, opq_tid(F.wave)); } } }
    GRID_BAR(); STAMP(11);
#endif
    { constexpr int NIT_P = NBP * 256, NIT_S = NBS * 256;
      const int nP = F.vcu < NIT_P ? (NIT_P - F.vcu + F.G - 1) / F.G : 0, firstS = F.vcu + nP * F.G - NIT_P;
      fft_stage1_run<64>(F.lds, (const bf16*)(ws + WS_H1A), UB, Y, 0, SEQP, F.vcu, NIT_P, F.G, opq_tid(F.wave));
      fft_stage1_run<128>(F.lds, (const bf16*)(ws + WS_H1B), UB, Y, TPR, SEQS, firstS, NIT_S, F.G, opq_tid(F.wave)); }
    GRID_BAR(); STAMP(3);
    { constexpr int NIT_P = NBP * 33 * 4, NIT_S = NBS * 65 * 4;
      const int nP = F.vcu < NIT_P ? (NIT_P - F.vcu + F.G - 1) / F.G : 0, firstS = F.vcu + nP * F.G - NIT_P;
      fft_stage2c_run(F.lds, (const bf16*)(ws + WS_M2A), Y, Gt, GF, QU, 0, SEQP, 64, 132, F.vcu, NIT_P, F.G, opq_tid(F.wave));
      fft_stage2c_run(F.lds, (const bf16*)(ws + WS_M2B), Y, Gt, GF, QU, TPR, SEQS, 128, 260, firstS, NIT_S, F.G, opq_tid(F.wave));
      __syncthreads(); }
    STAMP(4); STAMP(5);
#if defined(PROBE_CLK)
    unsigned long long ck_c0 = 0, ck_r0 = 0, ck_c1 = 0, ck_r1 = 0;
    if (PROBE_CLK == 2) { ck_c0 = __builtin_amdgcn_s_memtime(); ck_r0 = __builtin_amdgcn_s_memrealtime(); }
#endif
    { const float lam = TAB[1024]; const float* subg = args.in[7];
      const int xl = F.vcu >> 5, cu = F.vcu & 31;
#if defined(DUP_ATT)
      for (int rep = 0; rep < 2; ++rep)
#endif
      for (int i = 0; i < 6; ++i) {
          int tok0, seq, h, q0;
          if (i < 2) { const int pr = xl; tok0 = TPR + (pr >> 2) * SEQS; seq = SEQS; h = pr & 3; q0 = (cu + 32 * i) * 128; }
          else { const int pr = xl + 8 * (i - 2); tok0 = (pr >> 2) * SEQP; seq = SEQP; h = pr & 3; q0 = cu * 128; }
#if defined(DUP_ATT)
          if (rep == 0) ATTNS::attn_unit<DUP_ATT>(QB, XP, KB, VB, GA, TAB, subg, lam, tok0, seq, h, q0, F.lds, F.wave, F.role); else ATTNS::attn_unit<0>(QB, QU, KB, VB, GA, TAB, subg, lam, tok0, seq, h, q0, F.lds, F.wave, F.role);
#else
          ATTNS::attn_unit<0>(QB, QU, KB, VB, GA, TAB, subg, lam, tok0, seq, h, q0, F.lds, F.wave, F.role);
#endif
      } }
#if defined(PROBE_CLK)
    if (PROBE_CLK == 2) { ck_c1 = __builtin_amdgcn_s_memtime(); ck_r1 = __builtin_amdgcn_s_memrealtime(); }
#endif
    GRID_BAR(); STAMP(6);
#if defined(DUP_P3)
    { pg8::Gemm g{QU, Wout_t, NTOK, DM, DM, DM, 0}; pg8::StaticOrder S; S.init(NTOK, DM, F.G, (int)blockIdx.x);
      pg8::EpiOutProj E{args.in[0], args.in[1], args.out, H1B, SSQ1};
      pg8::gemm_phase<pg8::EpiOutProj, pg8::StaticOrder, P3_ALIGN, true>(F.lds, g, S, E, F.wave); }
#endif
    STAGGER(STG_P3);
    { pg8::Gemm g{QU, Wout_t, NTOK, DM, DM, DM, 0}; pg8::StaticOrder S; S.init(NTOK, DM, F.G, (int)blockIdx.x);
      pg8::EpiOutProj E{args.in[0], args.in[1], args.out, H1B, SSQ1};
      pg8::gemm_phase<pg8::EpiOutProj, pg8::StaticOrder, P3_ALIGN, true>(F.lds, g, S, E, F.wave); }
    GRID_BAR(); STAMP(7);
    STAGGER(STG_P4);
    { pg8::Gemm g{H1B, Wg_t, NTOK, DM, DM, DM, 0, 1}; pg8::StaticOrder S; S.init(NTOK, DM, F.G, (int)blockIdx.x);
      pg8::EpiGateNorm E{args.out, H1B, PROJ, SSQ1, args.in[14], SSQ2, F.ctl + 16384, F.lds + RING_BYTES + 1024};
      pg8::gemm_phase<pg8::EpiGateNorm, pg8::StaticOrder, true, true>(F.lds, g, S, E, F.wave); }
    STAMP(8);
    STAMP(9);
#if defined(PROBE_CLK)
    GRID_BAR();
    if (blockIdx.x == 0 && threadIdx.x == 0) { const float ghz = 0.1f * (float)(ck_c1 - ck_c0) / (float)(ck_r1 - ck_r0); const float v = 20.f * rintf(ghz * 5.f); for (int i = 0; i < 8; ++i) args.out[i] = v; }
#endif
#if defined(PROBE_A)
    if (blockIdx.x == 0) { asm volatile("s_waitcnt vmcnt(0) lgkmcnt(0)" ::: "memory"); __syncthreads();
        const unsigned long long ta = ((unsigned long long)F.MISC[17 + 2 * PROBE_A] << 32) | F.MISC[16 + 2 * PROBE_A], tb = ((unsigned long long)F.MISC[17 + 2 * PROBE_B] << 32) | F.MISC[16 + 2 * PROBE_B];
        const float v = (float)(tb - ta) * 0.0001f; for (int i = 0; i < 8; ++i) args.out[threadIdx.x * 8 + i] = v; }
#endif
#undef GRID_BAR
}

extern "C" void kernel_launch(void* const* d_in, const int* in_sizes, int n_in, void* d_out, int out_size, void* d_ws, size_t ws_size, hipStream_t stream) {
    static int grid = 0;
    if (grid == 0) {
        if (n_in != 15 || in_sizes[0] != TPR * DM || out_size != NTOK * DM || ws_size < WS_END) {
            fprintf(stderr, "kernel_launch: shape mismatch: n_in %d in0 %d out %d ws %zu (need %zu)\n", n_in, n_in > 0 ? in_sizes[0] : -1, out_size, ws_size, (size_t)WS_END); grid = -1; return; }
        int dev = 0, cus = 0;
        if (hipGetDevice(&dev) != hipSuccess || hipDeviceGetAttribute(&cus, hipDeviceAttributeMultiprocessorCount, dev) != hipSuccess) { fprintf(stderr, "kernel_launch: device query failed\n"); grid = -1; return; }
        if (hipFuncSetAttribute((const void*)mk_fwd, hipFuncAttributeMaxDynamicSharedMemorySize, LDS_BYTES) != hipSuccess) { fprintf(stderr, "kernel_launch: hipFuncSetAttribute failed\n"); grid = -1; return; }
        (void)hipGetLastError();
        grid = cus;
        if (grid != 256) fprintf(stderr, "kernel_launch: %d CUs; this kernel's attention schedule assumes 256\n", grid);
    }
    if (grid < 0) return;
    if (hipMemsetAsync((char*)d_ws + WS_CTL, 0, CTL_ZERO_BYTES, stream) != hipSuccess) { fprintf(stderr, "kernel_launch: memset failed\n"); return; }
    Args a{};
    for (int i = 0; i < 15; ++i) a.in[i] = (const float*)d_in[i];
    a.out = (float*)d_out; a.ws = (unsigned char*)d_ws;
    hipLaunchKernelGGL(mk_fwd, dim3(grid), dim3(NWAVES * 64), LDS_BYTES, stream, a);
    const hipError_t le = hipPeekAtLastError();
    if (le != hipSuccess) fprintf(stderr, "kernel_launch: launch failed: %s\n", hipGetErrorName(le));
}
```

```cpp
#include <hip/hip_runtime.h>
#include <cstdio>
#include <cstdint>
#define PRIO_MODE 2
#define ATTNS att3
#define STG_P1 0
#define PROJ_FIRST_MASK 0
#define STG_P3 0
#define P3_ALIGN true
#define STG_P4 0
__device__ __forceinline__ int opq_tid(int wave) { int l; asm volatile("v_mbcnt_lo_u32_b32 %0, -1, 0\n\tv_mbcnt_hi_u32_b32 %0, -1, %0" : "=v"(l)); return wave * 64 + l; }
__device__ __forceinline__ float bperm_f(int srclane, float v) { return __int_as_float(__builtin_amdgcn_ds_bpermute(srclane << 2, __float_as_int(v))); }
__device__ __forceinline__ size_t blk512(int row, int col) { return ((size_t)(((row >> 4) << 4) + (col >> 5)) << 9) + (size_t)(((row & 15) << 5) + (col & 31)); }
__device__ __forceinline__ size_t blk1024(int row, int col) { return ((size_t)(((row >> 4) << 5) + (col >> 5)) << 9) + (size_t)(((row & 15) << 5) + (col & 31)); }
namespace pg8 {
#define PG8_LAS __attribute__((address_space(3)))
typedef unsigned short bf16_t;
typedef short bf16x8 __attribute__((ext_vector_type(8)));
typedef float f32x4 __attribute__((ext_vector_type(4)));
typedef unsigned u32x4 __attribute__((ext_vector_type(4)));
constexpr int BM = 256, BK = 64, HALF = 128, HTB = HALF * BK * 2  , STAGE_BYTES = 8 * HTB, NXCD = 8, WGM = 8;

__host__ __device__ __forceinline__ int lds_byte(int r, int c) { const int st = (r >> 4) * 2 + (c >> 5), rr = r & 15, cc = c & 31, ob = rr * 64 + cc * 2; return st * 1024 + (ob ^ (((ob >> 9) & 1) << 5)); }
__host__ __device__ __forceinline__ void stage_rc(int b, int& R, int& C) { const int st = b / 1024, sb = b % 1024, swz = sb ^ (((sb >> 9) & 1) << 5); R = (st >> 1) * 16 + swz / 64; C = (st & 1) * 32 + (swz % 64) / 2; }
__host__ __device__ __forceinline__ int perm32(int rho) { const int n = rho >> 4, i = rho & 15; return 8 * (i >> 2) + 4 * n + (i & 3); }

struct Unit { int pm, pn; };
struct Gemm { const bf16_t* A; const bf16_t* Bt; int M, N, K, ld, koff_pn, ablk; };

struct StaticOrder {
    int nM, nN, nwg, G, c;
    __host__ __device__ void init(int M, int N, int G_, int c_) { nM = M / BM; nN = N / BM; nwg = nM * nN; G = G_; c = c_; }
    __host__ __device__ bool next(int i, Unit& u) const {
        const long L = (long)i * G + c; if (L >= nwg) return false;
        int wgid = (int)L; { const int q = nwg / NXCD, r = nwg % NXCD, xcd = wgid % NXCD, off = wgid / NXCD; wgid = (xcd < r ? xcd * (q + 1) : r * (q + 1) + (xcd - r) * q) + off; }
        const int nig = WGM * nN, gid = wgid / nig, fm = gid * WGM, gsz = (nM - fm) < WGM ? (nM - fm) : WGM;
        u.pm = fm + ((wgid % nig) % gsz); u.pn = (wgid % nig) / gsz; return true;
    }
    __device__ __forceinline__ void a_ready(const Unit&) const {}
    __device__ __forceinline__ void done(const Unit&) const {}
};

__device__ __forceinline__ unsigned cvt_pk_bf16(float lo, float hi) { unsigned r; asm volatile("v_cvt_pk_bf16_f32 %0, %1, %2" : "=v"(r) : "v"(lo), "v"(hi)); return r; }
typedef float f32x2 __attribute__((ext_vector_type(2)));
typedef unsigned u32x2 __attribute__((ext_vector_type(2)));
__device__ __forceinline__ float bflo(unsigned w) { return __uint_as_float(w << 16); }
__device__ __forceinline__ float bfhi(unsigned w) { return __uint_as_float(w & 0xffff0000u); }
__device__ __forceinline__ float sigm(float a) { return __builtin_amdgcn_rcpf(1.f + __expf(-a)); }
__device__ __forceinline__ float silu(float a) { return a * sigm(a); }

struct EpiInProj {
    static constexpr bool PERM = true, AFTER_DRAIN = false;
    bf16_t* qb; bf16_t* kb; bf16_t* vb; bf16_t* ga; bf16_t* ub; bf16_t* gf; float qscale; int nostore;
    __device__ __forceinline__ void operator()(const f32x4 (&acc)[2][2][4][2], const Unit& u, int wr, int wc, int fr, int fq) const {
        const int seg = u.pn >> 1, colt = (u.pn & 1) * BM;
        bf16_t* base; float sc = 1.f;
        if (seg == 0) { base = qb; sc = qscale; } else if (seg == 1) base = kb; else if (seg == 2) base = vb; else if (seg == 3) base = ga; else if (seg == 4) base = ub; else base = gf;
        const int row0 = u.pm * BM + wr * 64 + fr, col0 = colt + wc * 32 + 8 * fq;
#pragma unroll
        for (int ai = 0; ai < 2; ++ai)
#pragma unroll
            for (int m = 0; m < 4; ++m) { const int row = row0 + ai * HALF + m * 16;
#pragma unroll
                for (int bj = 0; bj < 2; ++bj) { const f32x4 v0 = acc[ai][bj][m][0] * sc, v1 = acc[ai][bj][m][1] * sc;
                    u32x4 w; w.x = cvt_pk_bf16(v0[0], v0[1]); w.y = cvt_pk_bf16(v0[2], v0[3]); w.z = cvt_pk_bf16(v1[0], v1[1]); w.w = cvt_pk_bf16(v1[2], v1[3]);
                    if (nostore == 0) __builtin_nontemporal_store(w, (u32x4*)(base + blk512(row, col0 + bj * HALF))); else asm volatile("" :: "v"(w)); } }
    }
};
struct EpiPlainBf16 {
    static constexpr bool PERM = true, AFTER_DRAIN = false;
    bf16_t* O; int ldc;
    __device__ __forceinline__ void operator()(const f32x4 (&acc)[2][2][4][2], const Unit& u, int wr, int wc, int fr, int fq) const {
        const int row0 = u.pm * BM + wr * 64 + fr, col0 = u.pn * BM + wc * 32 + 8 * fq;
#pragma unroll
        for (int ai = 0; ai < 2; ++ai)
#pragma unroll
            for (int m = 0; m < 4; ++m) { const int row = row0 + ai * HALF + m * 16;
#pragma unroll
                for (int bj = 0; bj < 2; ++bj) { const f32x4 v0 = acc[ai][bj][m][0], v1 = acc[ai][bj][m][1];
                    u32x4 w; w.x = cvt_pk_bf16(v0[0], v0[1]); w.y = cvt_pk_bf16(v0[2], v0[3]); w.z = cvt_pk_bf16(v1[0], v1[1]); w.w = cvt_pk_bf16(v1[2], v1[3]);
                    __builtin_nontemporal_store(w, (u32x4*)(O + blk1024(row, col0 + bj * HALF))); } }
    }
};
struct EpiFno {
    static constexpr bool PERM = true, AFTER_DRAIN = false;
    const bf16_t* gf; bf16_t* qu;
    __device__ __forceinline__ void operator()(const f32x4 (&acc)[2][2][4][2], const Unit& u, int wr, int wc, int fr, int fq) const {
        const int row0 = u.pm * BM + wr * 64 + fr, col0 = u.pn * BM + wc * 32 + 8 * fq;
#pragma unroll
        for (int ai = 0; ai < 2; ++ai)
#pragma unroll
            for (int m = 0; m < 4; ++m) { const size_t r = (size_t)(row0 + ai * HALF + m * 16);
#pragma unroll
                for (int bj = 0; bj < 2; ++bj) { const int c = col0 + bj * HALF; const u32x4 g = *(const u32x4*)(gf + r * 512 + c);
                    const f32x4 v0 = acc[ai][bj][m][0], v1 = acc[ai][bj][m][1];
                    u32x4 w; w.x = cvt_pk_bf16(v0[0] * silu(bflo(g.x)), v0[1] * silu(bfhi(g.x))); w.y = cvt_pk_bf16(v0[2] * silu(bflo(g.y)), v0[3] * silu(bfhi(g.y)));
                    w.z = cvt_pk_bf16(v1[0] * silu(bflo(g.z)), v1[1] * silu(bfhi(g.z))); w.w = cvt_pk_bf16(v1[2] * silu(bflo(g.w)), v1[3] * silu(bfhi(g.w)));
                    *(u32x4*)(qu + r * 1024 + 512 + c) = w; } }
    }
};
struct EpiOutProj {
    static constexpr bool PERM = false, AFTER_DRAIN = false;
    const float* xp; const float* xs; float* out; bf16_t* h1b; float* ssq;
    __device__ __forceinline__ void operator()(const f32x4 (&acc)[2][2][4][2], const Unit& u, int wr, int wc, int fr, int fq) const {
        const int row0 = u.pm * BM + wr * 64 + fr, col0 = u.pn * BM + wc * 32 + 4 * fq;
        const float* xb = (u.pm < 128) ? xp : xs - (size_t)32768 * 1024;
        f32x4 xv[8][4]; float ssv[8];
#define EOP_LD(g) do { const float* xrow_ = xb + (size_t)(row0 + ((g) >> 2) * HALF + ((g) & 3) * 16) * 1024 + col0; \
            xv[g][0] = *(const f32x4*)(xrow_); xv[g][1] = *(const f32x4*)(xrow_ + 16); xv[g][2] = *(const f32x4*)(xrow_ + HALF); xv[g][3] = *(const f32x4*)(xrow_ + HALF + 16); } while (0)
        EOP_LD(0); EOP_LD(1); EOP_LD(2);
#pragma unroll
        for (int g = 0; g < 8; ++g) { const int ai = g >> 2, m = g & 3;
            if (g + 3 < 8) EOP_LD(g + 3);
            const int row = row0 + ai * HALF + m * 16; float ss = 0.f;
#pragma unroll
            for (int bj = 0; bj < 2; ++bj)
#pragma unroll
                for (int n = 0; n < 2; ++n) { const f32x4 h = xv[g][bj * 2 + n] + acc[ai][bj][m][n];
                    ss += (h[0] * h[0] + h[1] * h[1]) + (h[2] * h[2] + h[3] * h[3]);
                    u32x2 w; w.x = cvt_pk_bf16(h[0], h[1]); w.y = cvt_pk_bf16(h[2], h[3]); *(u32x2*)(h1b + blk1024(row, col0 + bj * HALF + n * 16)) = w; }
            ss += bperm_f(((fq ^ 1) << 4) | fr, ss); ss += bperm_f(((fq ^ 2) << 4) | fr, ss); ssv[g] = ss; }
#undef EOP_LD
        if (fq == 0) {
#pragma unroll
            for (int g = 0; g < 8; ++g) ssq[(size_t)(row0 + (g >> 2) * HALF + (g & 3) * 16) * 16 + u.pn * 4 + wc] = ssv[g]; }
    }
};
struct EpiGate {
    static constexpr bool PERM = false, AFTER_DRAIN = false;
    float* out; const bf16_t* proj; const float* ssq1; float* ssq2;
    __device__ __forceinline__ void operator()(const f32x4 (&acc)[2][2][4][2], const Unit& u, int wr, int wc, int fr, int fq) const {
        const int row0 = u.pm * BM + wr * 64 + fr, col0 = u.pn * BM + wc * 32 + 4 * fq;
#pragma unroll
        for (int ai = 0; ai < 2; ++ai)
#pragma unroll
            for (int m = 0; m < 4; ++m) { const int r = row0 + ai * HALF + m * 16; const size_t off = (size_t)r * 1024 + col0;
                const f32x4* sp = (const f32x4*)(ssq1 + (size_t)r * 16); const f32x4 s0 = sp[0], s1 = sp[1], s2 = sp[2], s3 = sp[3];
                const float st = ((s0[0] + s0[1]) + (s0[2] + s0[3])) + ((s1[0] + s1[1]) + (s1[2] + s1[3])) + ((s2[0] + s2[1]) + (s2[2] + s2[3])) + ((s3[0] + s3[1]) + (s3[2] + s3[3]));
                const float rr = __builtin_amdgcn_rsqf(st * (1.f / 1024.f) + 1e-6f); float ss = 0.f;
#pragma unroll
                for (int bj = 0; bj < 2; ++bj)
#pragma unroll
                    for (int n = 0; n < 2; ++n) { const f32x4 a = acc[ai][bj][m][n] * rr; const u32x2 pw = *(const u32x2*)(proj + off + bj * HALF + n * 16);
                        const f32x4 h1 = *(const f32x4*)(out + off + bj * HALF + n * 16); f32x4 h;
                        h[0] = h1[0] + sigm(a[0]) * bflo(pw.x); h[1] = h1[1] + sigm(a[1]) * bfhi(pw.x); h[2] = h1[2] + sigm(a[2]) * bflo(pw.y); h[3] = h1[3] + sigm(a[3]) * bfhi(pw.y);
                        *(f32x4*)(out + off + bj * HALF + n * 16) = h; ss += (h[0] * h[0] + h[1] * h[1]) + (h[2] * h[2] + h[3] * h[3]); }
                ss += bperm_f(((fq ^ 1) << 4) | fr, ss); ss += bperm_f(((fq ^ 2) << 4) | fr, ss);
                if (fq == 0) ssq2[(size_t)r * 16 + u.pn * 4 + wc] = ss; }
    }
};

struct EpiGateNorm {
    static constexpr bool PERM = false, AFTER_DRAIN = false;
    float* out; const bf16_t* h1b; const bf16_t* proj; const float* ssq1; const float* gfin; float* slots; unsigned* cnt; PG8_LAS unsigned char* xl;
    __device__ __forceinline__ void operator()(f32x4 (&acc)[2][2][4][2], const Unit& u, int wr, int wc, int fr, int fq) const {
        const int row0 = u.pm * BM + wr * 64 + fr, col0 = u.pn * BM + wc * 32 + 4 * fq; const int wid = wr * 4 + wc, lane = fq * 16 + fr;
        PG8_LAS float* P = (PG8_LAS float*)xl; PG8_LAS float* S = (PG8_LAS float*)(xl + 4096); PG8_LAS float* R1 = (PG8_LAS float*)(xl + 5120);
        u32x2 pwv[8][4], hwv[8][4];
#define EGN_LD(g) do { \
            { const int r_ = row0 + ((g) >> 2) * HALF + ((g) & 3) * 16; pwv[g][0] = *(const u32x2*)(proj + blk1024(r_, col0)); pwv[g][1] = *(const u32x2*)(proj + blk1024(r_, col0 + 16)); pwv[g][2] = *(const u32x2*)(proj + blk1024(r_, col0 + HALF)); pwv[g][3] = *(const u32x2*)(proj + blk1024(r_, col0 + HALF + 16)); } \
            { const int r_ = row0 + ((g) >> 2) * HALF + ((g) & 3) * 16; hwv[g][0] = *(const u32x2*)(h1b + blk1024(r_, col0)); hwv[g][1] = *(const u32x2*)(h1b + blk1024(r_, col0 + 16)); hwv[g][2] = *(const u32x2*)(h1b + blk1024(r_, col0 + HALF)); hwv[g][3] = *(const u32x2*)(h1b + blk1024(r_, col0 + HALF + 16)); } } while (0)
        EGN_LD(0); EGN_LD(1); EGN_LD(2); EGN_LD(3);
        { const int t_ = wid * 64 + lane; if (t_ < 256) { const f32x4* sp = (const f32x4*)(ssq1 + (size_t)(u.pm * BM + t_) * 16); const f32x4 s0 = sp[0], s1 = sp[1], s2 = sp[2], s3 = sp[3];
            const float st = ((s0[0] + s0[1]) + (s0[2] + s0[3])) + ((s1[0] + s1[1]) + (s1[2] + s1[3])) + ((s2[0] + s2[1]) + (s2[2] + s2[3])) + ((s3[0] + s3[1]) + (s3[2] + s3[3]));
            R1[t_] = __builtin_amdgcn_rsqf(st * (1.f / 1024.f) + 1e-6f); } }
        asm volatile("s_waitcnt vmcnt(0) lgkmcnt(0)" ::: "memory"); __builtin_amdgcn_s_barrier(); asm volatile("" ::: "memory");
#pragma unroll
        for (int g = 0; g < 8; ++g) { const int ai = g >> 2, m = g & 3;
            if (g + 4 < 8) EGN_LD(g + 4);
            const float rr = R1[ai * HALF + wr * 64 + m * 16 + fr]; float ss = 0.f;
#pragma unroll
            for (int bj = 0; bj < 2; ++bj)
#pragma unroll
                for (int n = 0; n < 2; ++n) { const f32x4 a = acc[ai][bj][m][n] * rr; const u32x2 pw = pwv[g][bj * 2 + n], hw = hwv[g][bj * 2 + n]; f32x4 h;
                    h[0] = bflo(hw.x) + sigm(a[0]) * bflo(pw.x); h[1] = bfhi(hw.x) + sigm(a[1]) * bfhi(pw.x); h[2] = bflo(hw.y) + sigm(a[2]) * bflo(pw.y); h[3] = bfhi(hw.y) + sigm(a[3]) * bfhi(pw.y);
                    acc[ai][bj][m][n] = h; ss += (h[0] * h[0] + h[1] * h[1]) + (h[2] * h[2] + h[3] * h[3]); }
            ss += bperm_f(((fq ^ 1) << 4) | fr, ss); ss += bperm_f(((fq ^ 2) << 4) | fr, ss);
            if (fq == 0) P[(ai * HALF + wr * 64 + m * 16 + fr) * 4 + wc] = ss; }
#undef EGN_LD
        asm volatile("s_waitcnt lgkmcnt(0)" ::: "memory"); __builtin_amdgcn_s_barrier(); asm volatile("" ::: "memory");
        const int row = wid * 32 + (lane & 31);
        if (lane < 32) { const float t = (P[row * 4 + 0] + P[row * 4 + 1]) + (P[row * 4 + 2] + P[row * 4 + 3]);
            __hip_atomic_store(slots + ((size_t)(u.pm * BM + row) * 4 + u.pn), t, __ATOMIC_RELAXED, __HIP_MEMORY_SCOPE_AGENT); }
        asm volatile("s_waitcnt vmcnt(0)" ::: "memory");
        if (lane == 0) __hip_atomic_fetch_add(cnt + 64 * u.pm, 1u, __ATOMIC_RELAXED, __HIP_MEMORY_SCOPE_AGENT);
        if (wid == 0) { unsigned spins = 0;
            while ((unsigned)__builtin_amdgcn_readfirstlane(__hip_atomic_load(cnt + 64 * u.pm, __ATOMIC_RELAXED, __HIP_MEMORY_SCOPE_AGENT)) < 32u) { __builtin_amdgcn_s_sleep(2); if (++spins > (1u << 22)) break; }
            __builtin_amdgcn_fence(__ATOMIC_ACQUIRE, "agent"); }
        asm volatile("s_waitcnt vmcnt(0) lgkmcnt(0)" ::: "memory"); __builtin_amdgcn_s_barrier(); asm volatile("" ::: "memory");
        if (lane < 32) { const float* sl = slots + (size_t)(u.pm * BM + row) * 4; float t = 0.f;
#pragma unroll
            for (int k = 0; k < 4; ++k) t += __hip_atomic_load(sl + k, __ATOMIC_RELAXED, __HIP_MEMORY_SCOPE_AGENT);
            S[row] = __builtin_amdgcn_rsqf(t * (1.f / 1024.f) + 1e-6f); }
        asm volatile("s_waitcnt vmcnt(0) lgkmcnt(0)" ::: "memory"); __builtin_amdgcn_s_barrier(); asm volatile("" ::: "memory");
        f32x4 gv[2][2];
#pragma unroll
        for (int bj = 0; bj < 2; ++bj)
#pragma unroll
            for (int n = 0; n < 2; ++n) gv[bj][n] = *(const f32x4*)(gfin + col0 + bj * HALF + n * 16);
#pragma unroll
        for (int ai = 0; ai < 2; ++ai)
#pragma unroll
            for (int m = 0; m < 4; ++m) { const int rl = ai * HALF + wr * 64 + m * 16 + fr; const float rs = S[rl]; const size_t off = (size_t)(u.pm * BM + rl) * 1024 + col0;
#pragma unroll
                for (int bj = 0; bj < 2; ++bj)
#pragma unroll
                    for (int n = 0; n < 2; ++n) __builtin_nontemporal_store(acc[ai][bj][m][n] * rs * gv[bj][n], (f32x4*)(out + off + bj * HALF + n * 16)); }
        asm volatile("s_waitcnt lgkmcnt(0)" ::: "memory"); __builtin_amdgcn_s_barrier(); asm volatile("" ::: "memory");
    }
};
template <class Epi, class Sched, bool ALIGN_EPI = false, bool SP2 = false>
__device__ __forceinline__ void gemm_phase(PG8_LAS unsigned char* lds, const Gemm g, const Sched& S, const Epi& E, const int wave_) {
    const int tid = opq_tid(wave_), wid = __builtin_amdgcn_readfirstlane(tid >> 6), lane = tid & 63, wr = wid >> 2, wc = wid & 3, fr = lane & 15, fq = lane >> 4;
    const int K = g.K, nt = K / BK;
    unsigned voffA[2], voffB[2];
#pragma unroll
    for (int i = 0; i < 2; ++i) { int R, C; stage_rc(tid * 16 + i * 8192, R, C); const int Rb = Epi::PERM ? ((R & ~31) + perm32(R & 31)) : R;
        voffA[i] = g.ablk ? (unsigned)(((R >> 4) * 32 + (C >> 5)) * 1024 + (R & 15) * 64 + (C & 31) * 2) : (unsigned)(R * g.ld + C) * 2u; voffB[i] = (unsigned)(Rb * g.ld + C) * 2u; }
    const size_t kstep = (size_t)(BK * 2);
    const size_t kstepA = g.ablk ? (size_t)2048 : kstep;
    const size_t hstep = (size_t)HALF * g.ld * 2;
    const size_t tstep = 2 * hstep;
    const unsigned ldsw = (unsigned)wid * 1024u;
    const int aoff = lds_byte(wr * 64 + fr, fq * 8), boff = lds_byte(wc * 32 + fr, fq * 8);
#define PG8_SA(b, h) (((b) * 2 + (h)) * HTB)
#define PG8_SB(b, h) ((4 + (b) * 2 + (h)) * HTB)
#define PG8_STAGE(bufoff, gbase, voff) do { unsigned long long gb_ = (unsigned long long)(gbase); asm volatile("" : "+s"(gb_)); _Pragma("unroll") for (int _i = 0; _i < 2; ++_i) { asm volatile("" : "+v"((voff)[_i])); \
        __builtin_amdgcn_global_load_lds((const unsigned*)((const char*)gb_ + (voff)[_i]), (PG8_LAS unsigned*)(lds + (bufoff) + ldsw + _i * 8192), 16, 0, 0); } } while (0)
#define PG8_LDA(dst, b, h) do { _Pragma("unroll") for (int m = 0; m < 4; ++m) _Pragma("unroll") for (int k = 0; k < 2; ++k) dst[m][k] = *(const PG8_LAS bf16x8*)(lds + PG8_SA(b, h) + aoff + m * 2048 + k * 1024); } while (0)
#define PG8_LDB(dst, b, h) do { _Pragma("unroll") for (int n = 0; n < 2; ++n) _Pragma("unroll") for (int k = 0; k < 2; ++k) dst[n][k] = *(const PG8_LAS bf16x8*)(lds + PG8_SB(b, h) + boff + n * 2048 + k * 1024); } while (0)
#define PG8_MMA(ai, bj, At, Bt) do { __builtin_amdgcn_s_setprio(1); _Pragma("unroll") for (int m = 0; m < 4; ++m) _Pragma("unroll") for (int n = 0; n < 2; ++n) _Pragma("unroll") for (int k = 0; k < 2; ++k) \
        acc[ai][bj][m][n] = __builtin_amdgcn_mfma_f32_16x16x32_bf16(Bt[n][k], At[m][k], acc[ai][bj][m][n], 0, 0, 0); __builtin_amdgcn_s_setprio(0); } while (0)
#define PG8_WAIT_V(n) asm volatile("s_waitcnt vmcnt(" #n ")" ::: "memory")
#define PG8_WAIT_L(n) asm volatile("s_waitcnt lgkmcnt(" #n ")" ::: "memory")
#define PG8_BAR __builtin_amdgcn_s_barrier()
#define PG8_SCHED __builtin_amdgcn_sched_barrier(0)
    Unit cur, nxt; int ui = 0;
    if (!S.next(0, cur)) return;
    f32x4 acc[2][2][4][2];
#pragma unroll
    for (int a = 0; a < 2; ++a)
#pragma unroll
        for (int b = 0; b < 2; ++b)
#pragma unroll
            for (int m = 0; m < 4; ++m)
#pragma unroll
                for (int n = 0; n < 2; ++n) acc[a][b][m][n] = (f32x4){0.f, 0.f, 0.f, 0.f};
    bf16x8 At[4][2], B0[2][2], B1[2][2];
    const char* cA = (const char*)g.A + (size_t)cur.pm * tstep + (size_t)(cur.pn * g.koff_pn) * 2; const char* cB = (const char*)g.Bt + (size_t)cur.pn * tstep + (size_t)(cur.pn * g.koff_pn) * 2;
    S.a_ready(cur);
    if constexpr (SP2) {
        PG8_STAGE(PG8_SB(0, 0), cB, voffB); PG8_STAGE(PG8_SB(0, 1), cB + hstep, voffB); PG8_STAGE(PG8_SA(0, 0), cA, voffA); PG8_STAGE(PG8_SA(0, 1), cA + hstep, voffA);
        if (wr == 1) PG8_BAR;
        PG8_WAIT_V(2); PG8_BAR;
        PG8_STAGE(PG8_SB(1, 0), cB + kstep, voffB); PG8_STAGE(PG8_SA(1, 0), cA + kstepA, voffA); PG8_STAGE(PG8_SB(1, 1), cB + hstep + kstep, voffB);
        PG8_WAIT_V(6); PG8_BAR;
    } else {
        PG8_STAGE(PG8_SB(0, 0), cB, voffB); PG8_STAGE(PG8_SA(0, 0), cA, voffA); PG8_STAGE(PG8_SB(0, 1), cB + hstep, voffB); PG8_STAGE(PG8_SA(0, 1), cA + hstep, voffA);
        if (wr == 1) PG8_BAR;
        PG8_WAIT_V(4); PG8_BAR;
        PG8_STAGE(PG8_SB(1, 0), cB + kstep, voffB); PG8_STAGE(PG8_SA(1, 0), cA + kstepA, voffA); PG8_STAGE(PG8_SB(1, 1), cB + hstep + kstep, voffB);
        PG8_WAIT_V(6); PG8_BAR;
    }
    for (;;) {
        const bool has_next = S.next(ui + 1, nxt);
        const char* nA = has_next ? (const char*)g.A + (size_t)nxt.pm * tstep + (size_t)(nxt.pn * g.koff_pn) * 2 : cA; const char* nB = has_next ? (const char*)g.Bt + (size_t)nxt.pn * tstep + (size_t)(nxt.pn * g.koff_pn) * 2 : cB;
        for (int t = 0; t < nt; t += 2) {
            const bool last = (t == nt - 2);
            const char* a1 = cA + (size_t)(t + 1) * kstepA;
            const char* a2 = last ? nA : cA + (size_t)(t + 2) * kstepA; const char* b2 = last ? nB : cB + (size_t)(t + 2) * kstep;
            const char* a3 = a2 + kstepA; const char* b3 = b2 + kstep;
            if (last && has_next) S.a_ready(nxt);
            if constexpr (SP2) {
            PG8_LDB(B0, 0, 0); PG8_LDB(B1, 0, 1); PG8_SCHED; PG8_LDA(At, 0, 0); PG8_STAGE(PG8_SA(1, 1), a1 + hstep, voffA);
            PG8_WAIT_V(8); PG8_WAIT_L(0); PG8_BAR; PG8_MMA(0, 0, At, B0); PG8_MMA(0, 1, At, B1); PG8_BAR; PG8_SCHED;
            PG8_LDA(At, 0, 1); PG8_STAGE(PG8_SB(0, 0), b2, voffB); PG8_STAGE(PG8_SB(0, 1), b2 + hstep, voffB); PG8_STAGE(PG8_SA(0, 0), a2, voffA);
            PG8_WAIT_V(8); PG8_WAIT_L(0); PG8_BAR; PG8_MMA(1, 0, At, B0); PG8_MMA(1, 1, At, B1); PG8_BAR; PG8_SCHED;
            PG8_LDB(B0, 1, 0); PG8_LDB(B1, 1, 1); PG8_SCHED; PG8_LDA(At, 1, 0); PG8_STAGE(PG8_SA(0, 1), a2 + hstep, voffA);
            PG8_WAIT_V(8); PG8_WAIT_L(0); PG8_BAR; PG8_MMA(0, 0, At, B0); PG8_MMA(0, 1, At, B1); PG8_BAR; PG8_SCHED;
            PG8_LDA(At, 1, 1); PG8_STAGE(PG8_SB(1, 0), b3, voffB); PG8_STAGE(PG8_SB(1, 1), b3 + hstep, voffB); PG8_STAGE(PG8_SA(1, 0), a3, voffA);
            PG8_WAIT_V(8); PG8_WAIT_L(0); PG8_BAR; PG8_MMA(1, 0, At, B0); PG8_MMA(1, 1, At, B1); PG8_BAR; PG8_SCHED;
            } else {
            PG8_LDB(B0, 0, 0); PG8_SCHED; PG8_LDA(At, 0, 0); PG8_STAGE(PG8_SA(1, 1), a1 + hstep, voffA);
            PG8_WAIT_L(8); PG8_BAR; PG8_WAIT_L(0); PG8_MMA(0, 0, At, B0); PG8_BAR; PG8_SCHED;
            PG8_LDB(B1, 0, 1); PG8_STAGE(PG8_SB(0, 0), b2, voffB);
            PG8_BAR; PG8_WAIT_L(0); PG8_MMA(0, 1, At, B1); PG8_BAR;
            PG8_LDA(At, 0, 1); PG8_STAGE(PG8_SA(0, 0), a2, voffA);
            PG8_BAR; PG8_WAIT_L(0); PG8_MMA(1, 0, At, B0); PG8_BAR; PG8_SCHED;
            PG8_STAGE(PG8_SB(0, 1), b2 + hstep, voffB);
            PG8_WAIT_V(6); PG8_BAR; PG8_MMA(1, 1, At, B1); PG8_BAR;
            PG8_LDB(B0, 1, 0); PG8_SCHED; PG8_LDA(At, 1, 0); PG8_STAGE(PG8_SA(0, 1), a2 + hstep, voffA);
            PG8_WAIT_L(8); PG8_BAR; PG8_WAIT_L(0); PG8_MMA(0, 0, At, B0); PG8_BAR; PG8_SCHED;
            PG8_LDB(B1, 1, 1); PG8_STAGE(PG8_SB(1, 0), b3, voffB);
            PG8_BAR; PG8_WAIT_L(0); PG8_MMA(0, 1, At, B1); PG8_BAR;
            PG8_LDA(At, 1, 1); PG8_STAGE(PG8_SA(1, 0), a3, voffA);
            PG8_BAR; PG8_WAIT_L(0); PG8_MMA(1, 0, At, B0); PG8_BAR; PG8_SCHED;
            PG8_STAGE(PG8_SB(1, 1), b3 + hstep, voffB);
            PG8_WAIT_V(6); PG8_BAR; PG8_MMA(1, 1, At, B1); PG8_BAR;
            }
        }
        if constexpr (ALIGN_EPI) { if (wr == 0) PG8_BAR; }
        if constexpr (!Epi::AFTER_DRAIN) { const int l2_ = opq_tid(wave_) & 63; E(acc, cur, wr, wc, l2_ & 15, l2_ >> 4); S.done(cur); }
        if (!has_next) break;
#pragma unroll
        for (int a = 0; a < 2; ++a)
#pragma unroll
            for (int b = 0; b < 2; ++b)
#pragma unroll
                for (int m = 0; m < 4; ++m)
#pragma unroll
                    for (int n = 0; n < 2; ++n) acc[a][b][m][n] = (f32x4){0.f, 0.f, 0.f, 0.f};
        cur = nxt; cA = nA; cB = nB; ++ui;
        if constexpr (ALIGN_EPI) { if (wr == 1) PG8_BAR; }
    }
    PG8_WAIT_V(0);
    if constexpr (!ALIGN_EPI) { if (wr == 0) PG8_BAR; }
    PG8_BAR;
    if constexpr (Epi::AFTER_DRAIN) { E.fused(acc, cur, wr, wc, fr, fq, lds, wid, lane); S.done(cur); }
#undef PG8_SA
#undef PG8_SB
#undef PG8_STAGE
#undef PG8_LDA
#undef PG8_LDB
#undef PG8_MMA
#undef PG8_WAIT_V
#undef PG8_WAIT_L
#undef PG8_BAR
#undef PG8_SCHED
}
}
constexpr int NWAVES = 8;
constexpr int DM = 1024, NTOK = 49152, TPR = 32768, SEQP = 4096, SEQS = 8192, NBP = 8, NBS = 2, NIN = 3072, PLED = 256;
constexpr float LOG2E = 1.4426950408889634f;
constexpr float QSCALE = 0.125f * LOG2E;
constexpr size_t MiB = 1u << 20;
constexpr size_t WS_CTL = 0, CTL_ZERO_BYTES = 128 * 1024;
constexpr size_t WS_TAB = 1 * MiB;
constexpr size_t WS_GINV = 1 * MiB + 8192;
constexpr size_t WS_RINV = 1 * MiB + 16384;
constexpr size_t WS_WIN = 2 * MiB;
constexpr size_t WS_WOUT = 8 * MiB;
constexpr size_t WS_WG = 10 * MiB;
constexpr size_t WS_WP = 12 * MiB;
constexpr size_t WS_GT = 12 * MiB + 512 * 1024;
constexpr size_t WS_H1A = 13 * MiB + 512 * 1024;
constexpr size_t WS_H1B = WS_H1A + 64 * 1024;
constexpr size_t WS_M2A = 14 * MiB;
constexpr size_t WS_M2B = 15 * MiB + 256 * 1024;
constexpr size_t WS_SSQ1 = 18 * MiB, WS_SSQ2 = 21 * MiB;
constexpr size_t WS_XN = 24 * MiB;
constexpr size_t WS_QU = 120 * MiB;
constexpr size_t WS_K = 216 * MiB, WS_V = 264 * MiB;
constexpr size_t WS_GA = 312 * MiB, WS_GF = 360 * MiB;
constexpr size_t WS_PROJ = 408 * MiB;
constexpr size_t OUT_QB = 96 * MiB, OUT_UB = 144 * MiB;
constexpr size_t WS_END = 504 * MiB;
static_assert(WS_M2A + 33 * 32768 <= WS_M2B && WS_M2B + 65 * 32768 <= WS_SSQ1 && WS_SSQ2 + (size_t)NTOK * 64 <= WS_XN, "d_ws map");
constexpr int RING_BYTES = 131072, LDSCTL_OFF = RING_BYTES, MISC_OFF = LDSCTL_OFF + 320, LDS_BYTES = 147456;
#define GAS __attribute__((address_space(1)))
#define LAS __attribute__((address_space(3)))
typedef unsigned short bf16;
typedef unsigned v4u __attribute__((ext_vector_type(4)));
typedef unsigned v2u __attribute__((ext_vector_type(2)));
typedef float f32x4 __attribute__((ext_vector_type(4)));
typedef short bf16x8 __attribute__((ext_vector_type(8)));
#define LDS_WAIT() asm volatile("s_waitcnt lgkmcnt(0)" ::: "memory")
#define VM_WAIT() asm volatile("s_waitcnt vmcnt(0)" ::: "memory")
__device__ __forceinline__ unsigned f2bf(float f) { unsigned u = __builtin_bit_cast(unsigned, f); return (u + 0x7fffu + ((u >> 16) & 1u)) >> 16; }
__device__ __forceinline__ unsigned pk2(float lo, float hi) { return f2bf(lo) | (f2bf(hi) << 16); }
#define XB_TMO      128
#define XB_XCNT(j)  (256  + 64 * (j))
#define XB_XSUB(j)  (1280 + 64 * (j))
#define XB_XGEN(j)  (2304 + 64 * (j))
#define XB_TOP      3328
#define XB_TOPGEN   3392
#define XCD_BAR_WORDS 3456
#define XB_SPIN_CAP (1u << 18)

__device__ __forceinline__ unsigned xb_ld(unsigned* p)              { return __hip_atomic_load(p, __ATOMIC_RELAXED, __HIP_MEMORY_SCOPE_AGENT); }
__device__ __forceinline__ unsigned xb_add(unsigned* p, unsigned v) { return __hip_atomic_fetch_add(p, v, __ATOMIC_RELAXED, __HIP_MEMORY_SCOPE_AGENT); }
__device__ __forceinline__ unsigned xb_xcc_id() { return (unsigned)__builtin_amdgcn_s_getreg((3 << 11) | 20) & 0xFu; }
#define XB_SPIN(cond, bar) do { unsigned _sp = 0; while (cond) { __builtin_amdgcn_s_sleep(1); \
    if ((++_sp & 255u) == 0u) { if (xb_ld(&(bar)[XB_TMO])) break; if (_sp > XB_SPIN_CAP) { atomicAdd(&(bar)[XB_TMO], 1u); break; } } } } while (0)

struct XcdBarrier {
    unsigned* bar; unsigned x;
    volatile LAS unsigned* st;
};

__device__ __forceinline__ XcdBarrier xcd_barrier_post(unsigned* bar, volatile LAS unsigned* st) {
    XcdBarrier b; b.bar = bar; b.x = xb_xcc_id(); b.st = st;
    if (threadIdx.x == 0) (void)xb_add(&bar[XB_XCNT(b.x)], 1u);
    return b;
}
__device__ __forceinline__ void xcd_barrier_complete(unsigned* bar, unsigned x, unsigned& nloc, unsigned& nx) {
    const unsigned G = gridDim.x * gridDim.y * gridDim.z;
    unsigned sum, cnt, mine, sp = 0u;
    for (;;) {
        sum = 0u; cnt = 0u; mine = 0u;
#pragma unroll
        for (unsigned j = 0; j < 16; ++j) { const unsigned c = xb_ld(&bar[XB_XCNT(j)]); sum += c; cnt += (c > 0u) ? 1u : 0u; mine = (j == x) ? c : mine; }
        if (sum == G) break;
        __builtin_amdgcn_s_sleep(1);
        if ((++sp & 255u) == 0u) { if (xb_ld(&bar[XB_TMO])) break; if (sp > XB_SPIN_CAP) { atomicAdd(&bar[XB_TMO], 1u); break; } }
    }
    nloc = mine > 0u ? mine : 1u; nx = cnt > 0u ? cnt : 1u;
}

__device__ __forceinline__ void xcd_barrier(const XcdBarrier& b) {
    asm volatile("s_waitcnt vmcnt(0)" ::: "memory");
    __syncthreads();
    if (threadIdx.x == 0) {
        unsigned* bar = b.bar;
        __builtin_amdgcn_s_waitcnt(0);
        unsigned nloc = b.st[0], nx = b.st[1];
        if (nloc == 0u) { xcd_barrier_complete(bar, b.x, nloc, nx); b.st[0] = nloc; b.st[1] = nx; }
        const unsigned old = xb_add(&bar[XB_XSUB(b.x)], 1u);
        const unsigned gen = old / nloc;
        if (old + 1u == (gen + 1u) * nloc) {
            __builtin_amdgcn_fence(__ATOMIC_RELEASE, "agent");
            asm volatile("s_waitcnt vmcnt(0)" ::: "memory");
            const unsigned og = xb_add(&bar[XB_TOP], 1u);
            const unsigned tg = og / nx;
            if (og + 1u == (tg + 1u) * nx) xb_add(&bar[XB_TOPGEN], 1u);
            else XB_SPIN(xb_ld(&bar[XB_TOPGEN]) == tg, bar);
            __builtin_amdgcn_fence(__ATOMIC_ACQUIRE, "agent");
            xb_add(&bar[XB_XGEN(b.x)], 1u);
            asm volatile("s_waitcnt vmcnt(0)" ::: "memory");
        } else {
            XB_SPIN(xb_ld(&bar[XB_XGEN(b.x)]) == gen, bar);
            __builtin_amdgcn_fence(__ATOMIC_ACQUIRE, "agent");
            asm volatile("s_waitcnt vmcnt(0)" ::: "memory");
        }
    }
    __syncthreads();
}
namespace att3 {
#ifndef ATT_REGSTAGE
#define ATT_REGSTAGE 0
#endif
#ifndef DMA_IN_VSEG
#define DMA_IN_VSEG 0
#endif
#ifndef QK_IN_VSEG
#define QK_IN_VSEG 0
#endif
#ifndef ATT_ONEBAR
#define ATT_ONEBAR 1
#endif
#ifndef ATT_LOCKSTEP
#define ATT_LOCKSTEP 0
#endif
typedef unsigned short bf16_t;
typedef short bf16x8 __attribute__((ext_vector_type(8)));
typedef short s16x4 __attribute__((ext_vector_type(4)));
typedef float f32x16 __attribute__((ext_vector_type(16)));
typedef float f32x4 __attribute__((ext_vector_type(4)));
typedef unsigned u32x4 __attribute__((ext_vector_type(4)));
#define A2_LAS __attribute__((address_space(3)))
#ifndef PRIO_MODE
#define PRIO_MODE 0
#endif
#if PRIO_MODE == 1
#define A3_PRIO_M(x) __builtin_amdgcn_s_setprio(x)
#define A3_PRIO_V(x) do { } while (0)
#elif PRIO_MODE == 2
#define A3_PRIO_M(x) do { } while (0)
#define A3_PRIO_V(x) __builtin_amdgcn_s_setprio(x)
#else
#define A3_PRIO_M(x) do { } while (0)
#define A3_PRIO_V(x) do { } while (0)
#endif
constexpr int KVBLK = 64, TILEB = 16384, KRING = 4, VRING = 3;
constexpr int OFF_K = 0, OFF_V = KRING * TILEB, OFF_WS = (KRING + VRING) * TILEB, OFF_TAB = OFF_WS + 8 * 256, A2_LDS_END = OFF_TAB + 2048;
constexpr float THR2 = 11.5f;
#define KSWZ(row, colB) ((row) * 256 + ((colB) ^ (((row) & 15) << 4)))
__device__ __forceinline__ int crow(int r, int hi) { return (r & 3) + 8 * (r >> 2) + 4 * hi; }
__device__ __forceinline__ unsigned cvtpk(float lo, float hi) { unsigned r; asm volatile("v_cvt_pk_bf16_f32 %0, %1, %2" : "=v"(r) : "v"(lo), "v"(hi)); return r; }
__device__ __forceinline__ float bflo(unsigned w) { return __uint_as_float(w << 16); }
__device__ __forceinline__ float bfhi(unsigned w) { return __uint_as_float(w & 0xffff0000u); }
__device__ __forceinline__ float silu(float a) { return a * __builtin_amdgcn_rcpf(1.f + __expf(-a)); }
__device__ __forceinline__ float max3f(float a, float b, float c) { float r; asm("v_max3_f32 %0, %1, %2, %3" : "=v"(r) : "v"(a), "v"(b), "v"(c)); return r; }
__device__ __forceinline__ float max2f(float a, float b) { float r; asm("v_max_f32_e32 %0, %1, %2" : "=v"(r) : "v"(a), "v"(b)); return r; }
__device__ __forceinline__ float fadd_s(float a, float b) { float r; asm("v_add_f32_e32 %0, %1, %2" : "=v"(r) : "v"(a), "v"(b)); return r; }
__device__ __forceinline__ float exp2_s(float a) { float r; asm("v_exp_f32_e32 %0, %1" : "=v"(r) : "v"(a)); return r; }
typedef short v4i16_t __attribute__((ext_vector_type(4)));
__device__ __forceinline__ s16x4 vtr(const A2_LAS char* p) { return __builtin_bit_cast(s16x4, __builtin_amdgcn_ds_read_tr16_b64_v4i16((A2_LAS v4i16_t*)p)); }
__device__ __forceinline__ int v_rd_base(int lane) { return ((lane & 3) << 3) | (((lane >> 2) & 3) << 6) | (((lane >> 4) & 1) << 5) | (((lane >> 5) & 1) << 11); }
constexpr int v_rd_off(int d0, int ks, int half) { return d0 * 512 + ks * 4096 + half * 256; }

#ifndef MFMA_GAP
#define MFMA_GAP 0
#endif
#if MFMA_GAP > 0
#define MGAP_STR2(x) #x
#define MGAP_STR(x) MGAP_STR2(x)
#define MGAP() asm volatile("s_nop " MGAP_STR(MFMA_GAP))
#else
#define MGAP() do { } while (0)
#endif
__device__ __forceinline__ void kload(bf16x8* kf, const A2_LAS char* Ks, int r32, int hi, int comp) {
#pragma unroll
  for (int d0 = 0; d0 < 4; ++d0) { const int cb = ((comp * 4 + d0) * 16 + hi * 8) * 2;
    kf[2 * d0] = *reinterpret_cast<const A2_LAS bf16x8*>(Ks + KSWZ(r32, cb)); kf[2 * d0 + 1] = *reinterpret_cast<const A2_LAS bf16x8*>(Ks + KSWZ(32 + r32, cb)); }
}
__device__ __forceinline__ void qkt_a(f32x16& p0, f32x16& p1, const bf16x8* kf, const bf16x8* qr, const f32x16& negm) {
  p0 = __builtin_amdgcn_mfma_f32_32x32x16_bf16(kf[0], qr[0], negm, 0, 0, 0); MGAP(); p1 = __builtin_amdgcn_mfma_f32_32x32x16_bf16(kf[1], qr[0], negm, 0, 0, 0); MGAP();
  p0 = __builtin_amdgcn_mfma_f32_32x32x16_bf16(kf[2], qr[1], p0, 0, 0, 0); MGAP(); p1 = __builtin_amdgcn_mfma_f32_32x32x16_bf16(kf[3], qr[1], p1, 0, 0, 0); MGAP();
}
__device__ __forceinline__ void qkt_b(f32x16& p0, f32x16& p1, const bf16x8* kf, const bf16x8* qr) {
  p0 = __builtin_amdgcn_mfma_f32_32x32x16_bf16(kf[4], qr[2], p0, 0, 0, 0); MGAP(); p1 = __builtin_amdgcn_mfma_f32_32x32x16_bf16(kf[5], qr[2], p1, 0, 0, 0); MGAP();
  p0 = __builtin_amdgcn_mfma_f32_32x32x16_bf16(kf[6], qr[3], p0, 0, 0, 0); MGAP(); p1 = __builtin_amdgcn_mfma_f32_32x32x16_bf16(kf[7], qr[3], p1, 0, 0, 0); MGAP();
}
struct VFrag { s16x4 lo[4], hh[4]; };
template <int D0> __device__ __forceinline__ void vload(VFrag& f, const A2_LAS char* vp) {
#pragma unroll
  for (int ks = 0; ks < 4; ++ks) { f.lo[ks] = vtr(vp + v_rd_off(D0, ks, 0)); f.hh[ks] = vtr(vp + v_rd_off(D0, ks, 1)); }
}
template <int D0> __device__ __forceinline__ void vload_a(VFrag& f, unsigned va) {
#define VTR_A(dst, off) asm volatile("ds_read_b64_tr_b16 %0, %1 offset:%2" : "=v"(dst) : "v"(va), "n"(off))
  VTR_A(f.lo[0], v_rd_off(D0, 0, 0)); VTR_A(f.hh[0], v_rd_off(D0, 0, 1)); VTR_A(f.lo[1], v_rd_off(D0, 1, 0)); VTR_A(f.hh[1], v_rd_off(D0, 1, 1));
  VTR_A(f.lo[2], v_rd_off(D0, 2, 0)); VTR_A(f.hh[2], v_rd_off(D0, 2, 1)); VTR_A(f.lo[3], v_rd_off(D0, 3, 0)); VTR_A(f.hh[3], v_rd_off(D0, 3, 1));
#undef VTR_A
}
#define VWAIT(n, f) asm volatile("s_waitcnt lgkmcnt(" #n ")" : "+v"(f.lo[0]), "+v"(f.lo[1]), "+v"(f.lo[2]), "+v"(f.lo[3]), "+v"(f.hh[0]), "+v"(f.hh[1]), "+v"(f.hh[2]), "+v"(f.hh[3]))
__device__ __forceinline__ void pvmma(f32x16& od, const VFrag& f, bf16x8 pa0, bf16x8 pa1, bf16x8 pa2, bf16x8 pa3) {
#define PK(k) (bf16x8){f.lo[k][0], f.lo[k][1], f.lo[k][2], f.lo[k][3], f.hh[k][0], f.hh[k][1], f.hh[k][2], f.hh[k][3]}
  od = __builtin_amdgcn_mfma_f32_32x32x16_bf16(PK(0), pa0, od, 0, 0, 0); MGAP();
  od = __builtin_amdgcn_mfma_f32_32x32x16_bf16(PK(1), pa1, od, 0, 0, 0); MGAP();
  od = __builtin_amdgcn_mfma_f32_32x32x16_bf16(PK(2), pa2, od, 0, 0, 0); MGAP();
  od = __builtin_amdgcn_mfma_f32_32x32x16_bf16(PK(3), pa3, od, 0, 0, 0); MGAP();
#undef PK
}
__device__ __forceinline__ float vtail(const f32x16& p0, const f32x16& p1, bf16x8& pa0, bf16x8& pa1, bf16x8& pa2, bf16x8& pa3) {
  float sa, sb, e0, e1, e2, e3, e4, e5, e6, e7; u32x4 w0, w1, w2, w3;
#define VT_BODY(ADD0, ADD1) "v_exp_f32_e32 %6, %14\n\tv_exp_f32_e32 %7, %15\n\tv_exp_f32_e32 %8, %16\n\tv_exp_f32_e32 %9, %17\n\t" ADD0 "v_exp_f32_e32 %10, %18\n\t" ADD1 "v_exp_f32_e32 %11, %19\n\t" \
    "v_cvt_pk_bf16_f32 %2, %6, %7\n\tv_exp_f32_e32 %12, %20\n\tv_cvt_pk_bf16_f32 %3, %8, %9\n\tv_exp_f32_e32 %13, %21\n\tv_add_f32_e32 %0, %0, %10\n\tv_add_f32_e32 %1, %1, %11\n\t" \
    "v_cvt_pk_bf16_f32 %4, %10, %11\n\tv_add_f32_e32 %0, %0, %12\n\tv_add_f32_e32 %1, %1, %13\n\tv_cvt_pk_bf16_f32 %5, %12, %13"
#define VT_OUT(W) "=&v"(W.x), "=&v"(W.y), "=&v"(W.z), "=&v"(W.w), "=&v"(e0), "=&v"(e1), "=&v"(e2), "=&v"(e3), "=&v"(e4), "=&v"(e5), "=&v"(e6), "=&v"(e7)
#define VT_IN(P, B) "v"(P[B + 0]), "v"(P[B + 1]), "v"(P[B + 2]), "v"(P[B + 3]), "v"(P[B + 4]), "v"(P[B + 5]), "v"(P[B + 6]), "v"(P[B + 7])
  asm(VT_BODY("v_add_f32_e32 %0, %6, %7\n\t", "v_add_f32_e32 %1, %8, %9\n\t") : "=&v"(sa), "=&v"(sb), VT_OUT(w0) : VT_IN(p0, 0));
  asm(VT_BODY("v_add_f32_e32 %0, %0, %6\n\tv_add_f32_e32 %1, %1, %7\n\t", "v_add_f32_e32 %0, %0, %8\n\tv_add_f32_e32 %1, %1, %9\n\t") : "+v"(sa), "+v"(sb), VT_OUT(w1) : VT_IN(p0, 8));
  asm(VT_BODY("v_add_f32_e32 %0, %0, %6\n\tv_add_f32_e32 %1, %1, %7\n\t", "v_add_f32_e32 %0, %0, %8\n\tv_add_f32_e32 %1, %1, %9\n\t") : "+v"(sa), "+v"(sb), VT_OUT(w2) : VT_IN(p1, 0));
  asm(VT_BODY("v_add_f32_e32 %0, %0, %6\n\tv_add_f32_e32 %1, %1, %7\n\t", "v_add_f32_e32 %0, %0, %8\n\tv_add_f32_e32 %1, %1, %9\n\t") : "+v"(sa), "+v"(sb), VT_OUT(w3) : VT_IN(p1, 8));
#undef VT_BODY
#undef VT_OUT
#undef VT_IN
  pa0 = *reinterpret_cast<bf16x8*>(&w0); pa1 = *reinterpret_cast<bf16x8*>(&w1); pa2 = *reinterpret_cast<bf16x8*>(&w2); pa3 = *reinterpret_cast<bf16x8*>(&w3);
  return sa + sb;
}
__device__ __forceinline__ float rowmax64(const f32x16& p0, const f32x16& p1) {
  float a, b;
  asm("v_max3_f32 %0, %2, %3, %4\n\tv_max3_f32 %1, %5, %6, %7\n\tv_max3_f32 %0, %0, %8, %9" : "=&v"(a), "=&v"(b) : "v"(p0[0]), "v"(p0[1]), "v"(p1[0]), "v"(p0[2]), "v"(p0[3]), "v"(p1[1]), "v"(p1[2]), "v"(p1[3]));
#define MAX8(r) asm("v_max3_f32 %0, %0, %2, %3\n\tv_max3_f32 %1, %1, %4, %5\n\tv_max3_f32 %0, %0, %6, %7\n\tv_max3_f32 %1, %1, %8, %9" : "+v"(a), "+v"(b) : "v"(p0[r]), "v"(p0[r + 1]), "v"(p0[r + 2]), "v"(p0[r + 3]), "v"(p1[r]), "v"(p1[r + 1]), "v"(p1[r + 2]), "v"(p1[r + 3]))
  MAX8(4); MAX8(8);
  asm("v_max3_f32 %0, %0, %2, %3\n\tv_max3_f32 %1, %1, %4, %5\n\tv_max3_f32 %0, %0, %6, %7\n\tv_max3_f32 %1, %1, %8, %9\n\tv_max_f32_e32 %0, %0, %1" : "+v"(a), "+v"(b) : "v"(p0[12]), "v"(p0[13]), "v"(p0[14]), "v"(p0[15]), "v"(p1[12]), "v"(p1[13]), "v"(p1[14]), "v"(p1[15]));
#undef MAX8
  float rm = a;
  { auto rr = __builtin_amdgcn_permlane32_swap(__float_as_uint(rm), __float_as_uint(rm), false, false); rm = max2f(__uint_as_float(rr[0]), __uint_as_float(rr[1])); }
  return rm;
}
constexpr float REFOFF = THR2 - 1.f;
template <bool NEAR>
__device__ __forceinline__ bool vseg(f32x16& p0, f32x16& p1, float& mhat, float& l_reg, const bool first, const A2_LAS float* tabp, float& fsc, int r32, int hi,
                                     bf16x8& pa0, bf16x8& pa1, bf16x8& pa2, bf16x8& pa3) {
  if (NEAR) {
#pragma unroll
    for (int r = 0; r < 16; ++r) { const int o_ = (r & 3) + 8 * (r >> 2); p0[r] = fadd_s(p0[r], tabp[o_]); p1[r] = fadd_s(p1[r], tabp[o_ + 32]); }
  }
  if (first) { const float d = rowmax64(p0, p1) + REFOFF; mhat += d;
#pragma unroll
    for (int r = 0; r < 16; ++r) { p0[r] -= d; p1[r] -= d; }
    l_reg += vtail(p0, p1, pa0, pa1, pa2, pa3); return false;
  }
  const float ts = vtail(p0, p1, pa0, pa1, pa2, pa3);
  if (__builtin_expect(__any(!(ts < 2.f)), 0)) {
    const float dl = __builtin_fmaxf(rowmax64(p0, p1) + REFOFF, 0.f); mhat += dl;
#pragma unroll
    for (int r = 0; r < 16; ++r) { p0[r] -= dl; p1[r] -= dl; }
    const float f = __builtin_amdgcn_exp2f(-dl); l_reg *= f; fsc = f;
    l_reg += vtail(p0, p1, pa0, pa1, pa2, pa3); return true;
  }
  l_reg += ts; return false;
}

template <int VAR>
__device__ __forceinline__ void attn_unit(const bf16_t* QU, bf16_t* OQ, const bf16_t* __restrict__ KB, const bf16_t* __restrict__ VB, const bf16_t* __restrict__ GA,
                                          const float* __restrict__ tabg, const float* __restrict__ subg, float lam, int tok0, int seq, int h, int q0, A2_LAS unsigned char* lds, const int wave_, const int role_) {
  const int tid = opq_tid(wave_), lane = tid & 63, r32 = lane & 31, hi = lane >> 5; const int wid = wave_;
  const int comp = role_ >> 2, rb = role_ & 3;
  const A2_LAS char* Kr = (const A2_LAS char*)lds + OFF_K; const A2_LAS char* Vr = (const A2_LAS char*)lds + OFF_V;
  A2_LAS float* wsf = (A2_LAS float*)(lds + OFF_WS) + wid * 64; A2_LAS float* li_l = wsf; A2_LAS float* al_l = wsf + 32;
  A2_LAS float* tab = (A2_LAS float*)(lds + OFF_TAB);
  unsigned koff[2], voff[2];
#pragma unroll
  for (int i = 0; i < 2; ++i) { const int pc = 2 * wid + i;
    { const int row = 4 * pc + (lane >> 4), c = (lane & 15) ^ (row & 15); koff[i] = (unsigned)((row >> 4) * 16384 + (c >> 2) * 1024 + (row & 15) * 64 + (c & 3) * 16); }
    { const int st = 2 * pc + (lane >> 5), kk = (st >> 2) * 8 + ((lane & 31) >> 2), key = (kk & ~0xC) | ((kk & 4) << 1) | ((kk & 8) >> 1), col = (st & 3) * 32 + (lane & 3) * 8;
      voff[i] = (unsigned)((key >> 4) * 16384 + (col >> 5) * 1024 + (key & 15) * 64 + (col & 31) * 2); } }
  const char* Kh = (const char*)(KB + blk512(tok0, h * 128)); const char* Vh = (const char*)(VB + blk512(tok0, h * 128));
  const int NT = seq / KVBLK;
#define DMA_K(t, slot) do { const int t_ = (t) < NT ? (t) : NT - 1; const char* g_ = Kh + (size_t)t_ * (KVBLK * 1024); \
    __builtin_amdgcn_global_load_lds((const unsigned*)(g_ + koff[0]), (A2_LAS unsigned*)(lds + OFF_K + (slot) * TILEB + (2 * wid) * 1024), 16, 0, 0); \
    __builtin_amdgcn_global_load_lds((const unsigned*)(g_ + koff[1]), (A2_LAS unsigned*)(lds + OFF_K + (slot) * TILEB + (2 * wid + 1) * 1024), 16, 0, 0); } while (0)
#define DMA_V(t, slot) do { const int t_ = (t) < NT ? (t) : NT - 1; const char* g_ = Vh + (size_t)t_ * (KVBLK * 1024); \
    __builtin_amdgcn_global_load_lds((const unsigned*)(g_ + voff[0]), (A2_LAS unsigned*)(lds + OFF_V + (slot) * TILEB + (2 * wid) * 1024), 16, 0, 0); \
    __builtin_amdgcn_global_load_lds((const unsigned*)(g_ + voff[1]), (A2_LAS unsigned*)(lds + OFF_V + (slot) * TILEB + (2 * wid + 1) * 1024), 16, 0, 0); } while (0)
#define STG_GEOM() int tid_s = tid; asm volatile("" : "+v"(tid_s)); const int sr = tid_s >> 4, sc = (tid_s & 15) * 8
#define STG_KOFF() const int kst0 = KSWZ(sr, sc * 2), kst1 = KSWZ(32 + sr, sc * 2)
#define STG_VOFF() const int kk0 = (sr & ~0xC) | ((sr & 4) << 1) | ((sr & 8) >> 1), kk1 = kk0 + 32; \
    const int vst0 = ((kk0 >> 3) * 4 + (sc >> 5)) * 512 + ((kk0 & 7) * 32 + (sc & 31)) * 2, vst1 = ((kk1 >> 3) * 4 + (sc >> 5)) * 512 + ((kk1 & 7) * 32 + (sc & 31)) * 2
#define STG_SOFF() const unsigned soff0 = (unsigned)(sr * 1024 + sc * 2), soff1 = soff0 + 32 * 1024
  bf16x8 kq0, kq1, vq0, vq1;
#define LD16(base, off) (*reinterpret_cast<const bf16x8*>((base) + (off)))
#define LOADK(t) do { STG_GEOM(); STG_SOFF(); const int t_ = (t) < NT ? (t) : NT - 1; const char* g_ = Kh + (size_t)t_ * (KVBLK * 1024); kq0 = LD16(g_, soff0); kq1 = LD16(g_, soff1); } while (0)
#define LOADV(t) do { STG_GEOM(); STG_SOFF(); const int t_ = (t) < NT ? (t) : NT - 1; const char* g_ = Vh + (size_t)t_ * (KVBLK * 1024); vq0 = LD16(g_, soff0); vq1 = LD16(g_, soff1); } while (0)
#define WRITEK(slot) do { STG_GEOM(); STG_KOFF(); A2_LAS char* d_ = (A2_LAS char*)lds + OFF_K + (slot) * TILEB; *(A2_LAS bf16x8*)(d_ + kst0) = kq0; *(A2_LAS bf16x8*)(d_ + kst1) = kq1; } while (0)
#define WRITEV(slot) do { STG_GEOM(); STG_VOFF(); A2_LAS char* d_ = (A2_LAS char*)lds + OFF_V + (slot) * TILEB; *(A2_LAS bf16x8*)(d_ + vst0) = vq0; *(A2_LAS bf16x8*)(d_ + vst1) = vq1; } while (0)
#define BAR() __builtin_amdgcn_s_barrier()
#define WAITV(n) asm volatile("s_waitcnt vmcnt(" #n ")" ::: "memory")
#define WAITL() asm volatile("s_waitcnt lgkmcnt(0)" ::: "memory")
  bf16x8 qr[4];
  {
#pragma unroll
    for (int d0 = 0; d0 < 4; ++d0) qr[d0] = *reinterpret_cast<const bf16x8*>(QU + blk512(tok0 + q0 + rb * 32 + r32, h * 128 + comp * 64 + hi * 8 + d0 * 16)); }
  { const int i = tid; int rel = i - 256; rel = rel < -128 ? -128 : (rel > 127 ? 127 : rel); tab[i] = tabg[h * 256 + rel + 128]; }
#if ATT_REGSTAGE
  { LOADK(0); LOADV(0); const bf16x8 a0 = kq0, a1 = kq1; LOADK(1); const bf16x8 b0 = kq0, b1 = kq1; LOADK(2); STG_GEOM(); STG_KOFF();
    A2_LAS char* d_ = (A2_LAS char*)lds + OFF_K; *(A2_LAS bf16x8*)(d_ + kst0) = a0; *(A2_LAS bf16x8*)(d_ + kst1) = a1; *(A2_LAS bf16x8*)(d_ + TILEB + kst0) = b0; *(A2_LAS bf16x8*)(d_ + TILEB + kst1) = b1;
    WRITEK(2); WRITEV(0); }
#else
  DMA_K(0, 0); DMA_K(1, 1); DMA_V(0, 0); DMA_K(2, 2);
#endif
  const int qw0 = q0 + rb * 32, qpos = qw0 + r32;
  float mhat = 0.f, l_reg = 0.f; f32x16 o[4];
#pragma unroll
  for (int d = 0; d < 4; ++d) o[d] = f32x16{};
  f32x16 p0, p1, negm; bf16x8 pa0, pa1, pa2, pa3; bf16x8 kf[8]; VFrag vfa, vfb;
#define SBAR() __builtin_amdgcn_sched_barrier(0)
  const int vbase = v_rd_base(lane);
  if (!ATT_REGSTAGE) WAITV(4);
  WAITL(); BAR();
  const float tabL = tab[128], tabR = tab[383];
  if (!ATT_LOCKSTEP && !ATT_ONEBAR && comp == 1) BAR();
#define CLS(j) ((64 * (j) + 63 - qw0 <= -91) ? 0 : ((64 * (j) - qw0 - 31 >= 91) ? 1 : 2))
#define CCONST(c) ((c) == 0 ? tabL : ((c) == 1 ? tabR : 0.f))
#define SETNEGM(c) do { const float v_ = CCONST(c) - mhat; _Pragma("unroll") for (int r = 0; r < 16; ++r) negm[r] = v_; } while (0)
#define RESC() do { _Pragma("unroll") for (int d = 0; d < 4; ++d) _Pragma("unroll") for (int r = 0; r < 16; ++r) o[d][r] *= fsc_; } while (0)
#define VSEG(j, FIRST) do { const int c_ = cls; bool rs_; float fsc_ = 1.f; \
    if (c_ == 2) rs_ = vseg<true>(p0, p1, mhat, l_reg, FIRST, tab + (64 * (j) - qpos + 256 + 4 * hi), fsc_, r32, hi, pa0, pa1, pa2, pa3); \
    else rs_ = vseg<false>(p0, p1, mhat, l_reg, FIRST, tab, fsc_, r32, hi, pa0, pa1, pa2, pa3); \
    if (rs_) RESC(); \
    const int cn_ = CLS((j) + 1); if (__builtin_expect(rs_ || (FIRST) || cn_ != c_, 0)) { SETNEGM(cn_); asm volatile("" : "+v"(negm)); } cls = cn_; } while (0)
#define PKONLY() do { u32x4 w0 = {cvtpk(p0[0], p0[1]), cvtpk(p0[2], p0[3]), cvtpk(p0[4], p0[5]), cvtpk(p0[6], p0[7])}, w1 = {cvtpk(p0[8], p0[9]), cvtpk(p0[10], p0[11]), cvtpk(p0[12], p0[13]), cvtpk(p0[14], p0[15])}; \
    u32x4 w2 = {cvtpk(p1[0], p1[1]), cvtpk(p1[2], p1[3]), cvtpk(p1[4], p1[5]), cvtpk(p1[6], p1[7])}, w3 = {cvtpk(p1[8], p1[9]), cvtpk(p1[10], p1[11]), cvtpk(p1[12], p1[13]), cvtpk(p1[14], p1[15])}; \
    pa0 = *reinterpret_cast<bf16x8*>(&w0); pa1 = *reinterpret_cast<bf16x8*>(&w1); pa2 = *reinterpret_cast<bf16x8*>(&w2); pa3 = *reinterpret_cast<bf16x8*>(&w3); } while (0)
  int cls = CLS(0); SETNEGM(cls);
  kload(kf, Kr, r32, hi, comp);
  A3_PRIO_M(1);
  qkt_a(p0, p1, kf, qr, negm); qkt_b(p0, p1, kf, qr);
  A3_PRIO_M(0);
  if (ATT_REGSTAGE) { SBAR(); LOADK(3); LOADV(1); } else if (!DMA_IN_VSEG) { DMA_K(3, 3); DMA_V(1, 1); }
  if (!ATT_LOCKSTEP && (!ATT_ONEBAR || comp == 1)) { if (comp == 1 && !ATT_REGSTAGE) { if (DMA_IN_VSEG) WAITV(0); else WAITV(4); } WAITL(); BAR(); }
  if (DMA_IN_VSEG && !ATT_REGSTAGE) { DMA_K(3, 3); DMA_V(1, 1); }
  A3_PRIO_V(1); kload(kf, Kr + TILEB, r32, hi, comp); SBAR();
  VSEG(0, true); A3_PRIO_V(0);
  if (QK_IN_VSEG) { qkt_a(p0, p1, kf, qr, negm); qkt_b(p0, p1, kf, qr); }
  if (ATT_REGSTAGE) { WRITEK(3); WRITEV(1); WAITL(); } else if (ATT_LOCKSTEP || comp == 0) WAITV(4);
  if (!ATT_ONEBAR || ATT_LOCKSTEP || comp == 0) BAR();
  int sk = 2, sv = 0;
  for (int j = 1; j < NT; ++j) {
    asm volatile("" : "+v"(koff[0]), "+v"(koff[1]), "+v"(voff[0]), "+v"(voff[1]));
    const A2_LAS char* vp = Vr + sv * TILEB + vbase;
    A3_PRIO_M(1);
    if (VAR == 8) {
#define FILL() do { fx0 = __builtin_amdgcn_exp2f(fx0); fy0 += fx1; fy1 += fx0; fy2 += fy0; asm volatile("" : "+v"(fx0), "+v"(fy0), "+v"(fy1), "+v"(fy2)); } while (0)
#define MF(dst, a, b, c) do { dst = __builtin_amdgcn_mfma_f32_32x32x16_bf16(a, b, c, 0, 0, 0); FILL(); } while (0)
      float fx0 = (float)j, fx1 = 1.f, fy0 = 0.f, fy1 = 0.f, fy2 = 0.f;
      MF(p0, kf[0], qr[0], negm); MF(p1, kf[1], qr[0], negm); MF(p0, kf[2], qr[1], p0); MF(p1, kf[3], qr[1], p1); MF(p0, kf[4], qr[2], p0); MF(p1, kf[5], qr[2], p1); MF(p0, kf[6], qr[3], p0); MF(p1, kf[7], qr[3], p1);
      const bf16x8 vb_ = kf[0];
      _Pragma("unroll") for (int d = 0; d < 4; ++d) { MF(o[d], pa0, vb_, o[d]); MF(o[d], pa1, vb_, o[d]); MF(o[d], pa2, vb_, o[d]); MF(o[d], pa3, vb_, o[d]); }
      l_reg += fy1 + fy2;
#undef MF
#undef FILL
    } else if (VAR == 4 || VAR == 6 || VAR == 7) {
      asm volatile("" : "+v"(vfa.lo[0]), "+v"(vfa.hh[0]), "+v"(vfb.lo[0]), "+v"(vfb.hh[0]));
      qkt_a(p0, p1, kf, qr, negm); qkt_b(p0, p1, kf, qr);
      pvmma(o[0], vfa, pa0, pa1, pa2, pa3); pvmma(o[1], vfb, pa0, pa1, pa2, pa3); pvmma(o[2], vfa, pa0, pa1, pa2, pa3); pvmma(o[3], vfb, pa0, pa1, pa2, pa3);
    } else if (VAR == 5) {
      vload<0>(vfa, vp); vload<1>(vfb, vp); asm volatile("" : "+v"(vfa.lo[0]), "+v"(vfa.lo[1]), "+v"(vfa.lo[2]), "+v"(vfa.lo[3]), "+v"(vfa.hh[0]), "+v"(vfa.hh[1]), "+v"(vfa.hh[2]), "+v"(vfa.hh[3]), "+v"(vfb.lo[0]), "+v"(vfb.lo[1]), "+v"(vfb.lo[2]), "+v"(vfb.lo[3]), "+v"(vfb.hh[0]), "+v"(vfb.hh[1]), "+v"(vfb.hh[2]), "+v"(vfb.hh[3]));
      vload<2>(vfa, vp); vload<3>(vfb, vp); asm volatile("" : "+v"(vfa.lo[0]), "+v"(vfa.lo[1]), "+v"(vfa.lo[2]), "+v"(vfa.lo[3]), "+v"(vfa.hh[0]), "+v"(vfa.hh[1]), "+v"(vfa.hh[2]), "+v"(vfa.hh[3]), "+v"(vfb.lo[0]), "+v"(vfb.lo[1]), "+v"(vfb.lo[2]), "+v"(vfb.lo[3]), "+v"(vfb.hh[0]), "+v"(vfb.hh[1]), "+v"(vfb.hh[2]), "+v"(vfb.hh[3]));
      asm volatile("" : "+v"(kf[0]), "+v"(kf[1]), "+v"(kf[2]), "+v"(kf[3]), "+v"(kf[4]), "+v"(kf[5]), "+v"(kf[6]), "+v"(kf[7]));
      p0 = negm; p1 = negm;
    } else {
    const unsigned va = (unsigned)(size_t)vp;
    if (!QK_IN_VSEG) { qkt_a(p0, p1, kf, qr, negm); SBAR(); }
    vload_a<0>(vfa, va); SBAR();
    if (!QK_IN_VSEG) qkt_b(p0, p1, kf, qr);
    vload_a<1>(vfb, va); SBAR();
    VWAIT(8, vfa); pvmma(o[0], vfa, pa0, pa1, pa2, pa3);
    vload_a<2>(vfa, va); SBAR();
    VWAIT(8, vfb); pvmma(o[1], vfb, pa0, pa1, pa2, pa3);
    vload_a<3>(vfb, va); SBAR();
    VWAIT(8, vfa); pvmma(o[2], vfa, pa0, pa1, pa2, pa3);
    VWAIT(0, vfb); pvmma(o[3], vfb, pa0, pa1, pa2, pa3);
    }
    A3_PRIO_M(0);
    { const int s3 = (sk + 2) & 3  , s1 = sv == 0 ? 2 : sv - 1  ; if (VAR != 3 && VAR != 7 && VAR != 8) { if (ATT_REGSTAGE) { SBAR(); LOADK(j + 3); LOADV(j + 1); } else if (!DMA_IN_VSEG) { DMA_K(j + 3, s3); DMA_V(j + 1, s1); } } }
    if (!ATT_LOCKSTEP && (!ATT_ONEBAR || comp == 1)) { if (comp == 1 && VAR != 3 && VAR != 7 && VAR != 8 && !ATT_REGSTAGE) { if (DMA_IN_VSEG) WAITV(0); else WAITV(4); } WAITL(); BAR(); }
    if (DMA_IN_VSEG && !ATT_REGSTAGE && VAR != 3 && VAR != 7 && VAR != 8) { const int s3 = (sk + 2) & 3, s1 = sv == 0 ? 2 : sv - 1; DMA_K(j + 3, s3); DMA_V(j + 1, s1); }
    A3_PRIO_V(1); if (VAR != 4 && VAR != 6 && VAR != 7 && VAR != 8) { kload(kf, Kr + sk * TILEB, r32, hi, comp); } SBAR();
    if (VAR != 1 && VAR != 6 && VAR != 7 && VAR != 8) { VSEG(j, false); } else { PKONLY(); } A3_PRIO_V(0);
    if (QK_IN_VSEG && VAR == 0) { qkt_a(p0, p1, kf, qr, negm); qkt_b(p0, p1, kf, qr); }
    if (ATT_REGSTAGE) { if (VAR != 3 && VAR != 7 && VAR != 8) { WRITEK((sk + 2) & 3); WRITEV(sv == 0 ? 2 : sv - 1); WAITL(); } }
    else if ((ATT_LOCKSTEP || comp == 0) && VAR != 3 && VAR != 7 && VAR != 8) WAITV(4);
    if (!ATT_ONEBAR || ATT_LOCKSTEP || comp == 0) BAR();
    sk = (sk + 1) & 3; sv = sv == 2 ? 0 : sv + 1;
  }
  { const A2_LAS char* vp = Vr + sv * TILEB + vbase;
    A3_PRIO_M(1);
    const unsigned va = (unsigned)(size_t)vp;
    vload_a<0>(vfa, va); vload_a<1>(vfb, va); SBAR(); VWAIT(8, vfa); pvmma(o[0], vfa, pa0, pa1, pa2, pa3); vload_a<2>(vfa, va); SBAR(); VWAIT(8, vfb); pvmma(o[1], vfb, pa0, pa1, pa2, pa3); vload_a<3>(vfb, va); SBAR();
    VWAIT(8, vfa); pvmma(o[2], vfa, pa0, pa1, pa2, pa3); VWAIT(0, vfb); pvmma(o[3], vfb, pa0, pa1, pa2, pa3);
    A3_PRIO_M(0); }
  WAITV(0); WAITL();
  if (!ATT_LOCKSTEP && !ATT_ONEBAR && comp == 0) BAR();
  { auto rr = __builtin_amdgcn_permlane32_swap(__float_as_uint(l_reg), __float_as_uint(l_reg), false, false); l_reg = __uint_as_float(rr[0]) + __uint_as_float(rr[1]); }
  const float rl = __builtin_amdgcn_rcpf(l_reg);
  u32x4 gq[4]; f32x4 sq[8];
  { const int row = tid >> 2, qt = tid & 3; const bf16_t* gp = GA + blk512(tok0 + q0 + row, h * 128 + qt * 32); const float* sg = subg + qt * 32;
#pragma unroll
    for (int i = 0; i < 4; ++i) { gq[i] = *(const u32x4*)(gp + 8 * i); sq[2 * i] = *(const f32x4*)(sg + 8 * i); sq[2 * i + 1] = *(const f32x4*)(sg + 8 * i + 4); } }
  WAITL(); BAR(); asm volatile("" ::: "memory");
  A2_LAS float* OC = (A2_LAS float*)lds; constexpr int OST = 129;
  if (comp == 0) {
#pragma unroll
    for (int r = 0; r < 16; ++r) {
#pragma unroll
      for (int d0 = 0; d0 < 4; ++d0) OC[(32 * d0 + crow(r, hi)) * OST + rb * 32 + r32] = o[d0][r] * rl; }
  }
  WAITL(); BAR(); asm volatile("" ::: "memory");
  if (comp == 1) { const float sl = lam * rl;
#pragma unroll
    for (int r = 0; r < 16; ++r) {
#pragma unroll
      for (int d0 = 0; d0 < 4; ++d0) OC[(32 * d0 + crow(r, hi)) * OST + rb * 32 + r32] -= o[d0][r] * sl; }
  }
  WAITL(); BAR(); asm volatile("" ::: "memory");
  { const int row = tid >> 2, qt = tid & 3; const A2_LAS float* rp = OC + (qt * 32) * OST + row;
    f32x4 v[8]; float ss = 0.f;
#pragma unroll
    for (int i = 0; i < 8; ++i) { v[i] = (f32x4){rp[(4 * i) * OST], rp[(4 * i + 1) * OST], rp[(4 * i + 2) * OST], rp[(4 * i + 3) * OST]}; ss += (v[i][0] * v[i][0] + v[i][1] * v[i][1]) + (v[i][2] * v[i][2] + v[i][3] * v[i][3]); }
    ss += bperm_f(lane ^ 1, ss); ss += bperm_f(lane ^ 2, ss);
    const float rstd = __builtin_amdgcn_rsqf(ss * (1.f / 128.f) + 1e-5f) * 0.8f;
    const size_t t = (size_t)(tok0 + q0 + row); bf16_t* op = OQ + t * 1024 + h * 128 + qt * 32;
#pragma unroll
    for (int i = 0; i < 4; ++i) { const u32x4 g = gq[i]; const f32x4 s0 = sq[2 * i], s1 = sq[2 * i + 1];
      const f32x4 a = v[2 * i] * rstd * s0, b = v[2 * i + 1] * rstd * s1; u32x4 w;
      w.x = cvtpk(a[0] * silu(bflo(g.x)), a[1] * silu(bfhi(g.x))); w.y = cvtpk(a[2] * silu(bflo(g.y)), a[3] * silu(bfhi(g.y)));
      w.z = cvtpk(b[0] * silu(bflo(g.z)), b[1] * silu(bfhi(g.z))); w.w = cvtpk(b[2] * silu(bflo(g.w)), b[3] * silu(bfhi(g.w)));
      *(u32x4*)(op + 8 * i) = w; }
  }
  asm volatile("s_waitcnt vmcnt(0)" ::: "memory");
  __syncthreads();
#undef DMA_K
#undef LD16
#undef STG_GEOM
#undef STG_KOFF
#undef STG_VOFF
#undef STG_SOFF
#undef LOADK
#undef LOADV
#undef WRITEK
#undef WRITEV
#undef DMA_V
#undef BAR
#undef WAITV
#undef WAITL
#undef CLS
#undef CCONST
#undef SETNEGM
#undef RESC
#undef VSEG
#undef PKONLY
#undef SBAR
#undef VWAIT
}
#undef KSWZ
}
struct Frame {
    LAS unsigned char* lds;
    volatile LAS unsigned* MISC;
    unsigned* ctl;
    int wave;
    int role;
    int vcu, G;
};
__device__ __forceinline__ float wave_sum(float v, int lane) {
#pragma unroll
    for (int o = 1; o < 64; o <<= 1) v += bperm_f(lane ^ o, v);
    return v;
}
__device__ __forceinline__ void p0_transpose_item(const float* W, int K, int N, bf16* WT, const float* kscale, LAS float* scr, int item, int lane) {
    const int nblk = N / 32, kb = item / nblk, nb = item % nblk, k0 = 64 * kb, n0 = 32 * nb;
#pragma unroll 8
    for (int i = 0; i < 32; ++i) { const int kk = 2 * i + (lane >> 5); float w = W[(size_t)(k0 + kk) * N + n0 + (lane & 31)]; if (kscale) w *= kscale[k0 + kk]; scr[kk * 33 + (lane & 31)] = w; }
    LDS_WAIT(); asm volatile("" ::: "memory");
    const int c = lane & 7;
#pragma unroll
    for (int j = 0; j < 4; ++j) { const int n = (lane >> 3) + 8 * j; const LAS float* s = scr + (8 * c) * 33 + n;
        v4u o; o.x = pk2(s[0 * 33], s[1 * 33]); o.y = pk2(s[2 * 33], s[3 * 33]); o.z = pk2(s[4 * 33], s[5 * 33]); o.w = pk2(s[6 * 33], s[7 * 33]);
        *(GAS v4u*)(WT + (size_t)(n0 + n) * K + k0 + 8 * c) = o; }
    LDS_WAIT(); asm volatile("" ::: "memory");
}
__device__ __forceinline__ void rms_row2_to_bf16(const float* xrow0, const float* xrow1, const float* g, bf16* orow0, bf16* orow1, int lane) {
    const GAS f32x4* xr0 = (const GAS f32x4*)xrow0 + lane; const GAS f32x4* xr1 = (const GAS f32x4*)xrow1 + lane; const GAS f32x4* gr = (const GAS f32x4*)g + lane;
    f32x4 v[4], u[4]; float s = 0.f, t = 0.f;
#pragma unroll
    for (int j = 0; j < 4; ++j) { v[j] = xr0[64 * j]; u[j] = xr1[64 * j]; }
#pragma unroll
    for (int j = 0; j < 4; ++j) { s += (v[j].x * v[j].x + v[j].y * v[j].y) + (v[j].z * v[j].z + v[j].w * v[j].w); t += (u[j].x * u[j].x + u[j].y * u[j].y) + (u[j].z * u[j].z + u[j].w * u[j].w); }
#pragma unroll
    for (int o = 1; o < 64; o <<= 1) { s += bperm_f(lane ^ o, s); t += bperm_f(lane ^ o, t); }
    const float r0 = __builtin_amdgcn_rsqf(s * (1.f / 1024.f) + 1e-6f), r1 = __builtin_amdgcn_rsqf(t * (1.f / 1024.f) + 1e-6f);
    GAS unsigned long long* o0 = (GAS unsigned long long*)orow0 + lane; GAS unsigned long long* o1 = (GAS unsigned long long*)orow1 + lane;
#pragma unroll
    for (int j = 0; j < 4; ++j) { const f32x4 gg = gr[64 * j];
        o0[64 * j] = (unsigned long long)pk2(v[j].x * r0 * gg.x, v[j].y * r0 * gg.y) | ((unsigned long long)pk2(v[j].z * r0 * gg.z, v[j].w * r0 * gg.w) << 32);
        o1[64 * j] = (unsigned long long)pk2(u[j].x * r1 * gg.x, u[j].y * r1 * gg.y) | ((unsigned long long)pk2(u[j].z * r1 * gg.z, u[j].w * r1 * gg.w) << 32); }
}
__device__ __forceinline__ int t5_bucket(int rel) {
    const int n = rel < 0 ? -rel : rel; int b;
    if (n < 8) b = n; else b = 8 + (n >= 12) + (n >= 16) + (n >= 23) + (n >= 32) + (n >= 46) + (n >= 64) + (n >= 91);
    return b + (rel > 0 ? 16 : 0);
}
struct Args { const float* in[15]; float* out; unsigned char* ws; };
__device__ __forceinline__ void rms_row4_to_bf16(const float* xrow0, const float* g, bf16* orow0, int lane) {
    const GAS f32x4* gr = (const GAS f32x4*)g + lane;
    f32x4 v[4][4]; float s[4];
#pragma unroll
    for (int r = 0; r < 4; ++r) { const GAS f32x4* xr = (const GAS f32x4*)(xrow0 + (size_t)r * 1024) + lane;
#pragma unroll
        for (int j = 0; j < 4; ++j) v[r][j] = xr[64 * j]; }
#pragma unroll
    for (int r = 0; r < 4; ++r) { s[r] = 0.f;
#pragma unroll
        for (int j = 0; j < 4; ++j) s[r] += (v[r][j].x * v[r][j].x + v[r][j].y * v[r][j].y) + (v[r][j].z * v[r][j].z + v[r][j].w * v[r][j].w); }
#pragma unroll
    for (int o = 1; o < 64; o <<= 1) {
#pragma unroll
        for (int r = 0; r < 4; ++r) s[r] += bperm_f(lane ^ o, s[r]); }
    f32x4 gg[4];
#pragma unroll
    for (int j = 0; j < 4; ++j) gg[j] = gr[64 * j];
#pragma unroll
    for (int r = 0; r < 4; ++r) { const float rs = __builtin_amdgcn_rsqf(s[r] * (1.f / 1024.f) + 1e-6f); GAS unsigned long long* o8 = (GAS unsigned long long*)(orow0 + (size_t)r * 1024) + lane;
#pragma unroll
        for (int j = 0; j < 4; ++j) o8[64 * j] = (unsigned long long)pk2(v[r][j].x * rs * gg[j].x, v[r][j].y * rs * gg[j].y) | ((unsigned long long)pk2(v[r][j].z * rs * gg[j].z, v[r][j].w * rs * gg[j].w) << 32); }
}
__device__ __forceinline__ void p0_prologue(Frame& F, const Args& a, const int parts = 3) {
    const int tid_ = opq_tid(F.wave), lane_ = tid_ & 63;
    const float* xp = a.in[0]; const float* xs = a.in[1]; const float* pp = a.in[2]; const float* ps = a.in[3]; const float* g_mix = a.in[4]; const float* w_in = a.in[5];
    const float* lamp = a.in[6]; const float* relb = a.in[8]; const float* wf = a.in[9]; const float* w_out = a.in[10]; const float* g_ple = a.in[11];
    const float* w_gate = a.in[12]; const float* w_proj = a.in[13];
    unsigned char* ws = a.ws;
    if (parts & 2) {
        LAS float* scr = (LAS float*)(F.lds + F.wave * 16384);
        const int gw = F.vcu * NWAVES + F.wave, NGW = F.G * NWAVES;
        constexpr int I_IN = (DM / 64) * (NIN / 32), I_SQ = (DM / 64) * (DM / 32), I_P = (PLED / 64) * (DM / 32);
        for (int it = gw; it < I_IN + 2 * I_SQ + I_P; it += NGW) {
            int r = it;
            if (r < I_IN) { p0_transpose_item(w_in, DM, NIN, (bf16*)(ws + WS_WIN), nullptr, scr, r, lane_); continue; } r -= I_IN;
            if (r < I_SQ) { p0_transpose_item(w_out, DM, DM, (bf16*)(ws + WS_WOUT), nullptr, scr, r, lane_); continue; } r -= I_SQ;
            if (r < I_SQ) { p0_transpose_item(w_gate, DM, DM, (bf16*)(ws + WS_WG), g_ple, scr, r, lane_); continue; } r -= I_SQ;
            p0_transpose_item(w_proj, PLED, DM, (bf16*)(ws + WS_WP), nullptr, scr, r, lane_);
        }
        const int gt = F.vcu * (NWAVES * 64) + tid_, NGT = F.G * (NWAVES * 64);
        { constexpr int E_H1A = 64 * 64, E_H1B = 128 * 128, E_M2A = 33 * 16384, E_M2B = 65 * 16384;
          for (int i = gt; i < E_H1A + E_H1B + E_M2A + E_M2B; i += NGT) {
              int e = i; float val; bf16* dst;
              if (e < E_H1A + E_H1B) {
                  int N1, r, s1; if (e < E_H1A) { N1 = 64; r = e >> 6; s1 = e & 63; dst = (bf16*)(ws + WS_H1A) + e; } else { e -= E_H1A; N1 = 128; r = e >> 7; s1 = e & 127; dst = (bf16*)(ws + WS_H1B) + e; }
                  if (r == 0) val = 1.f; else if (r == 1) val = (s1 & 1) ? -1.f : 1.f;
                  else { const int k = r >> 1, j = (k * s1) & (N1 - 1); const float x = 2.f * (float)j / (float)N1; val = (r & 1) ? -sinpif(x) : cospif(x); }
              } else {
                  e -= E_H1A + E_H1B; int S, N1; float norm;
                  if (e < E_M2A) { S = 4096; N1 = 64; norm = 0.0013810679320049757f; dst = (bf16*)(ws + WS_M2A) + e; } else { e -= E_M2A; S = 8192; N1 = 128; norm = 0.0009765625f; dst = (bf16*)(ws + WS_M2B) + e; }
                  const int kt = e >> 14, m = (e >> 7) & 127, kp = e & 127, ro = m >> 6, k2 = m & 63, ri = kp >> 6, s2 = kp & 63;
                  const int sp = kt + N1 * k2, j = (s2 * sp) & (S - 1); const float x = 2.f * (float)j / (float)S; const float c = cospif(x), s = sinpif(x);
                  if (kt == 0) val = (ri == 0) ? (ro == 0 ? c : -s) : 0.f;
                  else if (kt == N1 / 2) val = (ri == 1) ? (ro == 0 ? c : -s) : 0.f;
                  else val = (ro == ri) ? c : (ro == 0 ? s : -s);
                  val *= norm;
              }
              *dst = (bf16)f2bf(val);
          } }
        { bf16* Gt = (bf16*)(ws + WS_GT); LAS float* ct = scr + 2304; LAS float* st = ct + 128;
          for (int i = lane_; i < 128; i += 64) { const float x = (float)i * (1.f / 64.f); ct[i] = cospif(x); st[i] = sinpif(x); }
          LDS_WAIT(); asm volatile("" ::: "memory");
          for (int i = gt; i < 512 * 1024 / 8; i += NGT) { const int n = i >> 7, k8 = (i & 127) * 8; if ((k8 >> 8) != (n >> 7)) *(v4u*)(Gt + (size_t)n * 1024 + k8) = (v4u){0u, 0u, 0u, 0u}; }
          for (int i = gt; i < 4 * 128 * 128; i += NGT) { const int g = i >> 14, c = (i >> 7) & 127, d = i & 127; float are = 0.f, aim = 0.f; const float* wp = wf + (size_t)g * 16384 + d;
#pragma unroll 8
              for (int cp = 0; cp < 128; ++cp) { const int j = (c * cp) & 127; const float w = wp[cp * 128]; are += ct[j] * w; aim += st[j] * w; }
              bf16* o = Gt + (size_t)(g * 128 + d) * 1024 + g * 256 + c; o[0] = (bf16)f2bf(are); o[128] = (bf16)f2bf(aim); } }
        if (F.vcu == 0) {
            float* tab = (float*)(ws + WS_TAB);
            for (int i = tid_; i < 1024; i += NWAVES * 64) { const int h = i >> 8, rel = (i & 255) - 128; tab[i] = relb[t5_bucket(rel) * 4 + h] * LOG2E; }
            if (tid_ == 0) { float s01 = 0.f, s23 = 0.f; for (int d = 0; d < 64; ++d) { s01 += lamp[d] * lamp[64 + d]; s23 += lamp[128 + d] * lamp[192 + d]; }
                tab[1024] = __expf(s01) - __expf(s23) + 0.2f; }
        }
    }
    if (parts & 1) {
        const int gw = F.vcu * NWAVES + F.wave, NGW = F.G * NWAVES;
        for (int m = 4 * gw; m < NTOK; m += 4 * NGW) { const float* xrow0 = m < TPR ? xp + (size_t)m * DM : xs + (size_t)(m - TPR) * DM;
            rms_row4_to_bf16(xrow0, g_mix, (bf16*)(ws + WS_XN) + (size_t)m * DM, lane_); }
        const int gt = F.vcu * (NWAVES * 64) + tid_, NGT = F.G * (NWAVES * 64); bf16* PB = (bf16*)a.out;
        for (int i0 = gt; i0 + 3 * NGT < NTOK * (PLED / 8); i0 += 4 * NGT) { f32x4 v0[4], v1[4];
#pragma unroll
            for (int k = 0; k < 4; ++k) { const int i = i0 + k * NGT, row = i >> 5, c8 = (i & 31) * 8; const float* src = (row < TPR ? pp + (size_t)row * PLED : ps + (size_t)(row - TPR) * PLED) + c8;
                v0[k] = *(const f32x4*)src; v1[k] = *(const f32x4*)(src + 4); }
#pragma unroll
            for (int k = 0; k < 4; ++k) { const int i = i0 + k * NGT, row = i >> 5, c8 = (i & 31) * 8; v4u o; o.x = pk2(v0[k].x, v0[k].y); o.y = pk2(v0[k].z, v0[k].w); o.z = pk2(v1[k].x, v1[k].y); o.w = pk2(v1[k].z, v1[k].w);
                *(v4u*)(PB + (size_t)row * PLED + c8) = o; } }
    }
}
typedef short s16x4_t __attribute__((ext_vector_type(4)));
__device__ __forceinline__ s16x4_t trd(const LAS bf16* p) { return __builtin_bit_cast(s16x4_t, __builtin_amdgcn_ds_read_tr16_b64_v4i16((LAS s16x4_t*)p)); }
template <int MK> struct NNRegs { v4u ra[MK * MK / 8 / (NWAVES * 64)], rb[MK * 16 / (NWAVES * 64)]; };
template <int MK, bool BLK = false>
__device__ __forceinline__ void nn_load(NNRegs<MK>& R, const bf16* A, const bf16* B, size_t ldb, int tid) {
    constexpr int NA = MK * MK / 8 / (NWAVES * 64), NB = MK * 16 / (NWAVES * 64);
    static_assert(NA * NWAVES * 64 * 8 == MK * MK && NB * NWAVES * 64 == MK * 16, "staging trip counts");
#pragma unroll
    for (int i = 0; i < NA; ++i) { const int idx = tid + i * (NWAVES * 64), r = idx / (MK / 8), c = idx % (MK / 8); R.ra[i] = *(const v4u*)(A + r * MK + c * 8); }
#pragma unroll
    for (int i = 0; i < NB; ++i) { const int idx = tid + i * (NWAVES * 64), r = idx >> 4, c = idx & 15; R.rb[i] = *(const v4u*)(B + (size_t)r * ldb + (BLK ? (c >> 2) * 512 + (c & 3) * 8 : c * 8)); }
}
template <int MK>
__device__ __forceinline__ void nn_stage(LAS unsigned char* lds, const NNRegs<MK>& R, int tid) {
    constexpr int AST = MK + 8, BST = 136, NA = MK * MK / 8 / (NWAVES * 64), NB = MK * 16 / (NWAVES * 64);
    LAS bf16* As = (LAS bf16*)lds; LAS bf16* Bs = (LAS bf16*)(lds + 40960);
    LDS_WAIT(); __builtin_amdgcn_s_barrier(); asm volatile("" ::: "memory");
#pragma unroll
    for (int i = 0; i < NA; ++i) { const int idx = tid + i * (NWAVES * 64), r = idx / (MK / 8), c = idx % (MK / 8); *(LAS v4u*)(As + r * AST + c * 8) = R.ra[i]; }
#pragma unroll
    for (int i = 0; i < NB; ++i) { const int idx = tid + i * (NWAVES * 64), r = idx >> 4, c = idx & 15; *(LAS v4u*)(Bs + r * BST + c * 8) = R.rb[i]; }
    LDS_WAIT(); __builtin_amdgcn_s_barrier(); asm volatile("" ::: "memory");
}
template <int MK>
__device__ __forceinline__ void nn_mfma(LAS unsigned char* lds, int tid, f32x4 (&acc)[MK / 16]) {
    constexpr int AST = MK + 8, BST = 136;
    const LAS bf16* As = (const LAS bf16*)lds; const LAS bf16* Bs = (const LAS bf16*)(lds + 40960);
    const int w = tid >> 6, l = tid & 63, lr = l & 15, lq = l >> 4;
#pragma unroll
    for (int mt = 0; mt < MK / 16; ++mt) acc[mt] = (f32x4){0.f, 0.f, 0.f, 0.f};
#pragma unroll
    for (int ks = 0; ks < MK / 32; ++ks) {
        const LAS bf16* bp = Bs + (ks * 32 + 8 * lq + (lr >> 2)) * BST + 16 * w + 4 * (lr & 3);
        const s16x4_t blo = trd(bp), bhi = trd(bp + 4 * BST);
        const bf16x8 bfr = {blo[0], blo[1], blo[2], blo[3], bhi[0], bhi[1], bhi[2], bhi[3]};
#pragma unroll
        for (int mt = 0; mt < MK / 16; ++mt) { const bf16x8 afr = *(const LAS bf16x8*)(As + (mt * 16 + lr) * AST + ks * 32 + 8 * lq);
            acc[mt] = __builtin_amdgcn_mfma_f32_16x16x32_bf16(bfr, afr, acc[mt], 0, 0, 0); }
    }
}
template <int MK>
__device__ __forceinline__ void nn_tile(LAS unsigned char* lds, const bf16* A, const bf16* B, size_t ldb, int tid, f32x4 (&acc)[MK / 16]) {
    NNRegs<MK> R; nn_load<MK>(R, A, B, ldb, tid); nn_stage<MK>(lds, R, tid); nn_mfma<MK>(lds, tid, acc);
}
template <int MK>
__device__ __forceinline__ void fft_stage1_run(LAS unsigned char* lds, const bf16* H1, const bf16* QU, bf16* Y, int tokbase, int seqlen, int first, int nitems, int G, int tid) {
    if (first >= nitems) return;
    NNRegs<MK> R;
#define S1_SRC(it) (QU + blk512(tokbase + ((it) >> 8) * seqlen + (((it) & 255) >> 2), (((it) & 255) & 3) * 128))
    nn_load<MK, true>(R, H1, S1_SRC(first), (size_t)32768, tid);
    for (int it = first; it < nitems; it += G) {
        nn_stage<MK>(lds, R, tid);
        if (it + G < nitems) nn_load<MK, true>(R, H1, S1_SRC(it + G), (size_t)32768, tid);
        f32x4 acc[MK / 16]; nn_mfma<MK>(lds, tid, acc);
        const int tok0 = tokbase + (it >> 8) * seqlen, nt = it & 255, s2 = nt >> 2, ch0 = (nt & 3) * 128;
        const int w = tid >> 6, l = tid & 63, lr = l & 15, lq = l >> 4;
        bf16* yb = Y + (size_t)tok0 * 512 + (size_t)s2 * 512 + ch0 + 16 * w + 4 * lq;
#pragma unroll
        for (int mt = 0; mt < MK / 16; ++mt) { const int r = mt * 16 + lr; v2u o; o.x = pk2(acc[mt][0], acc[mt][1]); o.y = pk2(acc[mt][2], acc[mt][3]); *(v2u*)(yb + (size_t)r * (64 * 512)) = o; }
    }
#undef S1_SRC
}
template <int MK>
__device__ __forceinline__ void fft_stage1_item(LAS unsigned char* lds, const bf16* H1, const bf16* QU, bf16* Y, int tok0, int nt, int tid) {
    const int s2 = nt >> 2, ch0 = (nt & 3) * 128;
    f32x4 acc[MK / 16];
    nn_tile<MK>(lds, H1, QU + (size_t)(tok0 + s2) * 1024 + 512 + ch0, (size_t)64 * 1024, tid, acc);
    const int w = tid >> 6, l = tid & 63, lr = l & 15, lq = l >> 4;
    bf16* yb = Y + (size_t)tok0 * 512 + (size_t)s2 * 512 + ch0 + 16 * w + 4 * lq;
#pragma unroll
    for (int mt = 0; mt < MK / 16; ++mt) { const int r = mt * 16 + lr; v2u o; o.x = pk2(acc[mt][0], acc[mt][1]); o.y = pk2(acc[mt][2], acc[mt][3]); *(v2u*)(yb + (size_t)r * (64 * 512)) = o; }
}
__device__ __forceinline__ void fft_stage2_item(LAS unsigned char* lds, const bf16* M2, const bf16* Y, bf16* XP, int tok0, int S, int N1, int kt, int g, int tid) {
    const int p = (kt == 0 || kt == N1 / 2) ? 0 : kt;
    f32x4 acc[8];
    nn_tile<128>(lds, M2 + (size_t)kt * 16384, Y + (size_t)tok0 * 512 + (size_t)(2 * p * 64) * 512 + g * 128, (size_t)512, tid, acc);
    const int w = tid >> 6, l = tid & 63, lr = l & 15, lq = l >> 4; const int c = 16 * w + 4 * lq; const bool mir = (kt != 0 && kt != N1 / 2);
#pragma unroll
    for (int mt = 0; mt < 8; ++mt) { const int m = mt * 16 + lr, ro = m >> 6, k2 = m & 63, sp = kt + N1 * k2;
        v2u o; o.x = pk2(acc[mt][0], acc[mt][1]); o.y = pk2(acc[mt][2], acc[mt][3]);
        *(v2u*)(XP + (size_t)(tok0 + sp) * 1024 + g * 256 + ro * 128 + c) = o;
        if (mir) { if (ro) { o.x ^= 0x80008000u; o.y ^= 0x80008000u; } *(v2u*)(XP + (size_t)(tok0 + S - sp) * 1024 + g * 256 + ro * 128 + c) = o; } }
}

__device__ __forceinline__ void fft_stage2c_item(LAS unsigned char* lds, const bf16* M2, const bf16* Y, const bf16* Gt, const bf16* GF, bf16* QU, int tok0, int S, int N1, int kt, int g, int tid) {
    const int p = (kt == 0 || kt == N1 / 2) ? 0 : kt;
    const int w = tid >> 6, l = tid & 63, lr = l & 15, lq = l >> 4; const bool mir = (kt != 0 && kt != N1 / 2);
    bf16x8 gre[4], gim[4];
    { const bf16* gp = Gt + (size_t)(g * 128 + 16 * w + lr) * 1024 + g * 256 + 8 * lq;
#pragma unroll
      for (int ks = 0; ks < 4; ++ks) { gre[ks] = *(const bf16x8*)(gp + ks * 32); gim[ks] = *(const bf16x8*)(gp + 128 + ks * 32); } }
    const int d0 = g * 128 + 16 * w + 4 * lq;
    v2u gwa[4], gwb[4];
#pragma unroll
    for (int tb = 0; tb < 4; ++tb) { const int sp = kt + N1 * (16 * tb + lr); gwa[tb] = *(const v2u*)(GF + (size_t)(tok0 + sp) * 512 + d0);
        if (mir) gwb[tb] = *(const v2u*)(GF + (size_t)(tok0 + S - sp) * 512 + d0); else gwb[tb] = (v2u){0u, 0u}; }
    f32x4 acc[8];
    nn_tile<128>(lds, M2 + (size_t)kt * 16384, Y + (size_t)tok0 * 512 + (size_t)(2 * p * 64) * 512 + g * 128, (size_t)512, tid, acc);
    constexpr int XST = 136; LAS bf16* XL = (LAS bf16*)(lds + 81920);
#pragma unroll
    for (int mt = 0; mt < 8; ++mt) { v2u o; o.x = pk2(acc[mt][0], acc[mt][1]); o.y = pk2(acc[mt][2], acc[mt][3]); *(LAS v2u*)(XL + (mt * 16 + lr) * XST + 16 * w + 4 * lq) = o; }
    __syncthreads();
    f32x4 P[4], Q[4];
#pragma unroll
    for (int tb = 0; tb < 4; ++tb) { P[tb] = (f32x4){0.f, 0.f, 0.f, 0.f}; Q[tb] = (f32x4){0.f, 0.f, 0.f, 0.f};
#pragma unroll
        for (int ks = 0; ks < 4; ++ks) { const bf16x8 xre = *(const LAS bf16x8*)(XL + (16 * tb + lr) * XST + ks * 32 + 8 * lq), xim = *(const LAS bf16x8*)(XL + (64 + 16 * tb + lr) * XST + ks * 32 + 8 * lq);
            P[tb] = __builtin_amdgcn_mfma_f32_16x16x32_bf16(gre[ks], xre, P[tb], 0, 0, 0); Q[tb] = __builtin_amdgcn_mfma_f32_16x16x32_bf16(gim[ks], xim, Q[tb], 0, 0, 0); } }
#pragma unroll
    for (int tb = 0; tb < 4; ++tb) { const int sp = kt + N1 * (16 * tb + lr);
        { const size_t t = (size_t)(tok0 + sp); const v2u gw = gwa[tb]; const f32x4 f = P[tb] + Q[tb]; v2u o;
          o.x = pk2(f[0] * pg8::silu(pg8::bflo(gw.x)), f[1] * pg8::silu(pg8::bfhi(gw.x))); o.y = pk2(f[2] * pg8::silu(pg8::bflo(gw.y)), f[3] * pg8::silu(pg8::bfhi(gw.y)));
          *(v2u*)(QU + t * 1024 + 512 + d0) = o; }
        if (mir) { const size_t t = (size_t)(tok0 + S - sp); const v2u gw = gwb[tb]; const f32x4 f = P[tb] - Q[tb]; v2u o;
          o.x = pk2(f[0] * pg8::silu(pg8::bflo(gw.x)), f[1] * pg8::silu(pg8::bfhi(gw.x))); o.y = pk2(f[2] * pg8::silu(pg8::bflo(gw.y)), f[3] * pg8::silu(pg8::bfhi(gw.y)));
          *(v2u*)(QU + t * 1024 + 512 + d0) = o; } }
}
struct S2Regs { NNRegs<128> T; bf16x8 gre[4], gim[4]; v2u gwa[4], gwb[4]; };
__device__ __forceinline__ void s2c_load(S2Regs& R, const bf16* M2, const bf16* Y, const bf16* Gt, const bf16* GF, int tok0, int S, int N1, int kt, int g, int tid) {
    const int p = (kt == 0 || kt == N1 / 2) ? 0 : kt;
    const int w = tid >> 6, l = tid & 63, lr = l & 15, lq = l >> 4; const bool mir = (kt != 0 && kt != N1 / 2);
    { const bf16* gp = Gt + (size_t)(g * 128 + 16 * w + lr) * 1024 + g * 256 + 8 * lq;
#pragma unroll
      for (int ks = 0; ks < 4; ++ks) { R.gre[ks] = *(const bf16x8*)(gp + ks * 32); R.gim[ks] = *(const bf16x8*)(gp + 128 + ks * 32); } }
    const int d0 = g * 128 + 16 * w + 4 * lq;
#pragma unroll
    for (int tb = 0; tb < 4; ++tb) { const int sp = kt + N1 * (16 * tb + lr); R.gwa[tb] = *(const v2u*)(GF + blk512(tok0 + sp, d0));
        if (mir) R.gwb[tb] = *(const v2u*)(GF + blk512(tok0 + S - sp, d0)); else R.gwb[tb] = (v2u){0u, 0u}; }
    nn_load<128>(R.T, M2 + (size_t)kt * 16384, Y + (size_t)tok0 * 512 + (size_t)(2 * p * 64) * 512 + g * 128, (size_t)512, tid);
}
__device__ __forceinline__ void fft_stage2c_run(LAS unsigned char* lds, const bf16* M2, const bf16* Y, const bf16* Gt, const bf16* GF, bf16* QU, int tokbase, int S, int N1, int perb, int first, int nitems, int G, int tid) {
    if (first >= nitems) return;
    S2Regs R;
#define S2_ARGS(it) tokbase + ((it) / perb) * S, S, N1, ((it) % perb) >> 2, ((it) % perb) & 3
    s2c_load(R, M2, Y, Gt, GF, S2_ARGS(first), tid);
    for (int it = first; it < nitems; it += G) {
        const int tok0 = tokbase + (it / perb) * S, kt = (it % perb) >> 2, g = (it % perb) & 3;
        const int w = tid >> 6, l = tid & 63, lr = l & 15, lq = l >> 4; const bool mir = (kt != 0 && kt != N1 / 2);
        nn_stage<128>(lds, R.T, tid);
        bf16x8 gre[4], gim[4]; v2u gwa[4], gwb[4];
#pragma unroll
        for (int k = 0; k < 4; ++k) { gre[k] = R.gre[k]; gim[k] = R.gim[k]; gwa[k] = R.gwa[k]; gwb[k] = R.gwb[k]; }
        if (it + G < nitems) s2c_load(R, M2, Y, Gt, GF, S2_ARGS(it + G), tid);
        f32x4 acc[8]; nn_mfma<128>(lds, tid, acc);
        constexpr int XST = 136; LAS bf16* XL = (LAS bf16*)(lds + 81920);
#pragma unroll
        for (int mt = 0; mt < 8; ++mt) { v2u o; o.x = pk2(acc[mt][0], acc[mt][1]); o.y = pk2(acc[mt][2], acc[mt][3]); *(LAS v2u*)(XL + (mt * 16 + lr) * XST + 16 * w + 4 * lq) = o; }
        LDS_WAIT(); __builtin_amdgcn_s_barrier(); asm volatile("" ::: "memory");
        f32x4 P[4], Q[4];
#pragma unroll
        for (int tb = 0; tb < 4; ++tb) { P[tb] = (f32x4){0.f, 0.f, 0.f, 0.f}; Q[tb] = (f32x4){0.f, 0.f, 0.f, 0.f};
#pragma unroll
            for (int ks = 0; ks < 4; ++ks) { const bf16x8 xre = *(const LAS bf16x8*)(XL + (16 * tb + lr) * XST + ks * 32 + 8 * lq), xim = *(const LAS bf16x8*)(XL + (64 + 16 * tb + lr) * XST + ks * 32 + 8 * lq);
                P[tb] = __builtin_amdgcn_mfma_f32_16x16x32_bf16(gre[ks], xre, P[tb], 0, 0, 0); Q[tb] = __builtin_amdgcn_mfma_f32_16x16x32_bf16(gim[ks], xim, Q[tb], 0, 0, 0); } }
        const int d0 = g * 128 + 16 * w + 4 * lq;
#pragma unroll
        for (int tb = 0; tb < 4; ++tb) { const int sp = kt + N1 * (16 * tb + lr);
            { const size_t t = (size_t)(tok0 + sp); const v2u gw = gwa[tb]; const f32x4 f = P[tb] + Q[tb]; v2u o;
              o.x = pk2(f[0] * pg8::silu(pg8::bflo(gw.x)), f[1] * pg8::silu(pg8::bfhi(gw.x))); o.y = pk2(f[2] * pg8::silu(pg8::bflo(gw.y)), f[3] * pg8::silu(pg8::bfhi(gw.y)));
              *(v2u*)(QU + t * 1024 + 512 + d0) = o; }
            if (mir) { const size_t t = (size_t)(tok0 + S - sp); const v2u gw = gwb[tb]; const f32x4 f = P[tb] - Q[tb]; v2u o;
              o.x = pk2(f[0] * pg8::silu(pg8::bflo(gw.x)), f[1] * pg8::silu(pg8::bfhi(gw.x))); o.y = pk2(f[2] * pg8::silu(pg8::bflo(gw.y)), f[3] * pg8::silu(pg8::bfhi(gw.y)));
              *(v2u*)(QU + t * 1024 + 512 + d0) = o; } }
    }
#undef S2_ARGS
}
__global__ void __launch_bounds__(NWAVES * 64, 2) mk_fwd(Args args) {
    extern __shared__ __attribute__((aligned(16))) unsigned char lds[];
    Frame F;
    F.lds = (LAS unsigned char*)lds;
    F.MISC = (volatile LAS unsigned*)(F.lds + MISC_OFF);
    F.wave = __builtin_amdgcn_readfirstlane((int)threadIdx.x >> 6);
    F.G = gridDim.x; { const int bx = blockIdx.x; F.vcu = (F.G % 8 == 0) ? (bx % 8) * (F.G / 8) + bx / 8 : bx; }
    unsigned char* ws = args.ws;
    F.ctl = (unsigned*)(ws + WS_CTL);
    for (int u = threadIdx.x; u < (LDS_BYTES - LDSCTL_OFF) / 4; u += NWAVES * 64) ((LAS unsigned*)(F.lds + LDSCTL_OFF))[u] = 0u;
    __syncthreads();
    XcdBarrier bar = xcd_barrier_post(F.ctl + 1024, F.MISC + 8);
    { const unsigned simd = (unsigned)__builtin_amdgcn_s_getreg((1 << 11) | (4 << 6) | 4) & 3u;
      if ((threadIdx.x & 63) == 0) F.MISC[48 + F.wave] = simd;
      __syncthreads();
      unsigned cnt0 = 0, cnt1 = 0, cnt2 = 0, cnt3 = 0, rank = 0;
#pragma unroll
      for (int w = 0; w < NWAVES; ++w) { const unsigned sw = F.MISC[48 + w]; cnt0 += sw == 0u; cnt1 += sw == 1u; cnt2 += sw == 2u; cnt3 += sw == 3u; rank += (w < F.wave && sw == simd) ? 1u : 0u; }
      const bool ok = cnt0 == 2u && cnt1 == 2u && cnt2 == 2u && cnt3 == 2u;
      F.role = __builtin_amdgcn_readfirstlane(ok ? (int)((rank << 2) | simd) : (((F.wave >> 2) << 2) | (F.wave & 3)));
#if defined(ROLE_PARITY)
      F.role = ((F.wave & 1) << 2) | (F.wave >> 1);
#endif
    }
#define GRID_BAR() xcd_barrier(bar)
#define STAGGER(ticks) do { if ((ticks) > 0) { const unsigned long long t0_ = __builtin_amdgcn_s_memrealtime(); const unsigned long long d_ = (unsigned long long)(F.vcu & 3) * (unsigned long long)(ticks); \
    while (__builtin_amdgcn_s_memrealtime() - t0_ < d_) __builtin_amdgcn_s_sleep(8); } } while (0)
#if defined(PROBE_A)
#define STAMP(k) do { if (blockIdx.x == 0 && threadIdx.x == 0) { const unsigned long long t_ = __builtin_amdgcn_s_memrealtime(); F.MISC[16 + 2 * (k)] = (unsigned)t_; F.MISC[17 + 2 * (k)] = (unsigned)(t_ >> 32); } } while (0)
#else
#define STAMP(k) do { } while (0)
#endif
    STAMP(0);
    bf16* const Win_t = (bf16*)(ws + WS_WIN); bf16* const Wout_t = (bf16*)(ws + WS_WOUT); bf16* const Wg_t = (bf16*)(ws + WS_WG); bf16* const Wp_t = (bf16*)(ws + WS_WP);
    bf16* const Gt = (bf16*)(ws + WS_GT); bf16* const XN = (bf16*)(ws + WS_XN); bf16* const XP = (bf16*)(ws + WS_XN); bf16* const QU = (bf16*)(ws + WS_QU);
    bf16* const KB = (bf16*)(ws + WS_K); bf16* const VB = (bf16*)(ws + WS_V); bf16* const H1B = (bf16*)(ws + WS_K); bf16* const GA = (bf16*)(ws + WS_GA); bf16* const GF = (bf16*)(ws + WS_GF);
    bf16* const QB = (bf16*)((unsigned char*)args.out + OUT_QB); bf16* const UB = (bf16*)((unsigned char*)args.out + OUT_UB);
    bf16* const PROJ = (bf16*)(ws + WS_PROJ); bf16* const PB = (bf16*)args.out; bf16* const Y = (bf16*)args.out;
    float* const SSQ1 = (float*)(ws + WS_SSQ1); float* const SSQ2 = (float*)(ws + WS_SSQ2); const float* const TAB = (const float*)(ws + WS_TAB);

    p0_prologue(F, args);
#if defined(DUP_P0)
    p0_prologue(F, args, (DUP_P0 + 0) ? (DUP_P0 + 0) : 3);
#endif
    GRID_BAR(); STAMP(1);
#if defined(DUP_BAR)
    GRID_BAR(); GRID_BAR(); GRID_BAR(); GRID_BAR(); GRID_BAR();
#endif
#if defined(DUP_P1)
    if ((DUP_P1 + 0) == 4) { const unsigned long long t0_ = __builtin_amdgcn_s_memrealtime(); const unsigned long long d_ = (unsigned long long)(F.vcu & 3) * 800ull;
        while (__builtin_amdgcn_s_memrealtime() - t0_ < d_) __builtin_amdgcn_s_sleep(8); }
    { pg8::Gemm g{XN, Win_t, NTOK, NIN, DM, DM, 0}; pg8::StaticOrder S; S.init(NTOK, NIN, F.G, (int)blockIdx.x);
      pg8::EpiInProj E{QB, KB, VB, GA, UB, GF, QSCALE, ((DUP_P1 + 0) >= 2) ? (DUP_P1 + 0) : 0};
      pg8::gemm_phase<pg8::EpiInProj, pg8::StaticOrder, true, true>(F.lds, g, S, E, F.wave); }
    { pg8::Gemm g{PB, Wp_t, NTOK, DM, PLED, PLED, 0}; pg8::StaticOrder S; S.init(NTOK, DM, F.G, (int)blockIdx.x);
      pg8::EpiPlainBf16 E{PROJ, DM};
      pg8::gemm_phase<pg8::EpiPlainBf16, pg8::StaticOrder, true, true>(F.lds, g, S, E, F.wave); }
#endif
    STAGGER(STG_P1);
#if defined(DUP_PROJ)
    { pg8::Gemm g{PB, Wp_t, NTOK, DM, PLED, PLED, 0}; pg8::StaticOrder S; S.init(NTOK, DM, F.G, (int)blockIdx.x);
      pg8::EpiPlainBf16 E{PROJ, DM};
      pg8::gemm_phase<pg8::EpiPlainBf16, pg8::StaticOrder, true, true>(F.lds, g, S, E, F.wave); }
#endif
    if (PROJ_FIRST_MASK && (F.vcu & PROJ_FIRST_MASK) == 0) {
    { pg8::Gemm g{PB, Wp_t, NTOK, DM, PLED, PLED, 0}; pg8::StaticOrder S; S.init(NTOK, DM, F.G, (int)blockIdx.x);
      pg8::EpiPlainBf16 E{PROJ, DM};
      pg8::gemm_phase<pg8::EpiPlainBf16, pg8::StaticOrder, true, true>(F.lds, g, S, E, F.wave); }
    { pg8::Gemm g{XN, Win_t, NTOK, NIN, DM, DM, 0}; pg8::StaticOrder S; S.init(NTOK, NIN, F.G, (int)blockIdx.x);
      pg8::EpiInProj E{QB, KB, VB, GA, UB, GF, QSCALE, 0};
      pg8::gemm_phase<pg8::EpiInProj, pg8::StaticOrder, true, true>(F.lds, g, S, E, F.wave); }
    } else {
    { pg8::Gemm g{XN, Win_t, NTOK, NIN, DM, DM, 0}; pg8::StaticOrder S; S.init(NTOK, NIN, F.G, (int)blockIdx.x);
      pg8::EpiInProj E{QB, KB, VB, GA, UB, GF, QSCALE, 0};
      pg8::gemm_phase<pg8::EpiInProj, pg8::StaticOrder, true, true>(F.lds, g, S, E, F.wave); }
    { pg8::Gemm g{PB, Wp_t, NTOK, DM, PLED, PLED, 0}; pg8::StaticOrder S; S.init(NTOK, DM, F.G, (int)blockIdx.x);
      pg8::EpiPlainBf16 E{PROJ, DM};
      pg8::gemm_phase<pg8::EpiPlainBf16, pg8::StaticOrder, true, true>(F.lds, g, S, E, F.wave); }
    }
    GRID_BAR(); STAMP(2);
#if defined(DUP_FFT)
    { constexpr int NIT_P = NBP * 256, NIT_S = NBS * 256;
      for (int it = F.vcu; it < NIT_P + NIT_S; it += F.G) {
          if (it < NIT_P) fft_stage1_item<64>(F.lds, (const bf16*)(ws + WS_H1A), QU, Y, (it >> 8) * SEQP, it & 255, opq_tid(F.wave));
          else { const int r = it - NIT_P; fft_stage1_item<128>(F.lds, (const bf16*)(ws + WS_H1B), QU, Y, TPR + (r >> 8) * SEQS, r & 255, opq_tid(F.wave)); } } }
    GRID_BAR(); STAMP(10);
    { constexpr int NIT_P = NBP * 33 * 4, NIT_S = NBS * 65 * 4;
      for (int it = F.vcu; it < NIT_P + NIT_S; it += F.G) {
          if (it < NIT_P) { const int b = it / 132, r = it % 132; fft_stage2_item(F.lds, (const bf16*)(ws + WS_M2A), Y, XP, b * SEQP, SEQP, 64, r >> 2, r & 3, opq_tid(F.wave)); }
          else { const int q = it - NIT_P, b = q / 260, r = q % 260; fft_stage2_item(F.lds, (const bf16*)(ws + WS_M2B), Y, XP, TPR + b * SEQS, SEQS, 128, r >> 2, r & 3, opq_tid(F.wave)); } } }
    GRID_BAR(); STAMP(11);
#endif
    { constexpr int NIT_P = NBP * 256, NIT_S = NBS * 256;
      const int nP = F.vcu < NIT_P ? (NIT_P - F.vcu + F.G - 1) / F.G : 0, firstS = F.vcu + nP * F.G - NIT_P;
      fft_stage1_run<64>(F.lds, (const bf16*)(ws + WS_H1A), UB, Y, 0, SEQP, F.vcu, NIT_P, F.G, opq_tid(F.wave));
      fft_stage1_run<128>(F.lds, (const bf16*)(ws + WS_H1B), UB, Y, TPR, SEQS, firstS, NIT_S, F.G, opq_tid(F.wave)); }
    GRID_BAR(); STAMP(3);
    { constexpr int NIT_P = NBP * 33 * 4, NIT_S = NBS * 65 * 4;
      const int nP = F.vcu < NIT_P ? (NIT_P - F.vcu + F.G - 1) / F.G : 0, firstS = F.vcu + nP * F.G - NIT_P;
      fft_stage2c_run(F.lds, (const bf16*)(ws + WS_M2A), Y, Gt, GF, QU, 0, SEQP, 64, 132, F.vcu, NIT_P, F.G, opq_tid(F.wave));
      fft_stage2c_run(F.lds, (const bf16*)(ws + WS_M2B), Y, Gt, GF, QU, TPR, SEQS, 128, 260, firstS, NIT_S, F.G, opq_tid(F.wave));
      __syncthreads(); }
    STAMP(4); STAMP(5);
#if defined(PROBE_CLK)
    unsigned long long ck_c0 = 0, ck_r0 = 0, ck_c1 = 0, ck_r1 = 0;
    if (PROBE_CLK == 2) { ck_c0 = __builtin_amdgcn_s_memtime(); ck_r0 = __builtin_amdgcn_s_memrealtime(); }
#endif
    { const float lam = TAB[1024]; const float* subg = args.in[7];
      const int xl = F.vcu >> 5, cu = F.vcu & 31;
#if defined(DUP_ATT)
      for (int rep = 0; rep < 2; ++rep)
#endif
      for (int i = 0; i < 6; ++i) {
          int tok0, seq, h, q0;
          if (i < 2) { const int pr = xl; tok0 = TPR + (pr >> 2) * SEQS; seq = SEQS; h = pr & 3; q0 = (cu + 32 * i) * 128; }
          else { const int pr = xl + 8 * (i - 2); tok0 = (pr >> 2) * SEQP; seq = SEQP; h = pr & 3; q0 = cu * 128; }
#if defined(DUP_ATT)
          if (rep == 0) ATTNS::attn_unit<DUP_ATT>(QB, XP, KB, VB, GA, TAB, subg, lam, tok0, seq, h, q0, F.lds, F.wave, F.role); else ATTNS::attn_unit<0>(QB, QU, KB, VB, GA, TAB, subg, lam, tok0, seq, h, q0, F.lds, F.wave, F.role);
#else
          ATTNS::attn_unit<0>(QB, QU, KB, VB, GA, TAB, subg, lam, tok0, seq, h, q0, F.lds, F.wave, F.role);
#endif
      } }
#if defined(PROBE_CLK)
    if (PROBE_CLK == 2) { ck_c1 = __builtin_amdgcn_s_memtime(); ck_r1 = __builtin_amdgcn_s_memrealtime(); }
#endif
    GRID_BAR(); STAMP(6);
#if defined(DUP_P3)
    { pg8::Gemm g{QU, Wout_t, NTOK, DM, DM, DM, 0}; pg8::StaticOrder S; S.init(NTOK, DM, F.G, (int)blockIdx.x);
      pg8::EpiOutProj E{args.in[0], args.in[1], args.out, H1B, SSQ1};
      pg8::gemm_phase<pg8::EpiOutProj, pg8::StaticOrder, P3_ALIGN, true>(F.lds, g, S, E, F.wave); }
#endif
    STAGGER(STG_P3);
    { pg8::Gemm g{QU, Wout_t, NTOK, DM, DM, DM, 0}; pg8::StaticOrder S; S.init(NTOK, DM, F.G, (int)blockIdx.x);
      pg8::EpiOutProj E{args.in[0], args.in[1], args.out, H1B, SSQ1};
      pg8::gemm_phase<pg8::EpiOutProj, pg8::StaticOrder, P3_ALIGN, true>(F.lds, g, S, E, F.wave); }
    GRID_BAR(); STAMP(7);
    STAGGER(STG_P4);
    { pg8::Gemm g{H1B, Wg_t, NTOK, DM, DM, DM, 0, 1}; pg8::StaticOrder S; S.init(NTOK, DM, F.G, (int)blockIdx.x);
      pg8::EpiGateNorm E{args.out, H1B, PROJ, SSQ1, args.in[14], SSQ2, F.ctl + 16384, F.lds + RING_BYTES + 1024};
      pg8::gemm_phase<pg8::EpiGateNorm, pg8::StaticOrder, true, true>(F.lds, g, S, E, F.wave); }
    STAMP(8);
    STAMP(9);
#if defined(PROBE_CLK)
    GRID_BAR();
    if (blockIdx.x == 0 && threadIdx.x == 0) { const float ghz = 0.1f * (float)(ck_c1 - ck_c0) / (float)(ck_r1 - ck_r0); const float v = 20.f * rintf(ghz * 5.f); for (int i = 0; i < 8; ++i) args.out[i] = v; }
#endif
#if defined(PROBE_A)
    if (blockIdx.x == 0) { asm volatile("s_waitcnt vmcnt(0) lgkmcnt(0)" ::: "memory"); __syncthreads();
        const unsigned long long ta = ((unsigned long long)F.MISC[17 + 2 * PROBE_A] << 32) | F.MISC[16 + 2 * PROBE_A], tb = ((unsigned long long)F.MISC[17 + 2 * PROBE_B] << 32) | F.MISC[16 + 2 * PROBE_B];
        const float v = (float)(tb - ta) * 0.0001f; for (int i = 0; i < 8; ++i) args.out[threadIdx.x * 8 + i] = v; }
#endif
#undef GRID_BAR
}

extern "C" void kernel_launch(void* const* d_in, const int* in_sizes, int n_in, void* d_out, int out_size, void* d_ws, size_t ws_size, hipStream_t stream) {
    static int grid = 0;
    if (grid == 0) {
        if (n_in != 15 || in_sizes[0] != TPR * DM || out_size != NTOK * DM || ws_size < WS_END) {
            fprintf(stderr, "kernel_launch: shape mismatch: n_in %d in0 %d out %d ws %zu (need %zu)\n", n_in, n_in > 0 ? in_sizes[0] : -1, out_size, ws_size, (size_t)WS_END); grid = -1; return; }
        int dev = 0, cus = 0;
        if (hipGetDevice(&dev) != hipSuccess || hipDeviceGetAttribute(&cus, hipDeviceAttributeMultiprocessorCount, dev) != hipSuccess) { fprintf(stderr, "kernel_launch: device query failed\n"); grid = -1; return; }
        if (hipFuncSetAttribute((const void*)mk_fwd, hipFuncAttributeMaxDynamicSharedMemorySize, LDS_BYTES) != hipSuccess) { fprintf(stderr, "kernel_launch: hipFuncSetAttribute failed\n"); grid = -1; return; }
        (void)hipGetLastError();
        grid = cus;
        if (grid != 256) fprintf(stderr, "kernel_launch: %d CUs; this kernel's attention schedule assumes 256\n", grid);
    }
    if (grid < 0) return;
    if (hipMemsetAsync((char*)d_ws + WS_CTL, 0, CTL_ZERO_BYTES, stream) != hipSuccess) { fprintf(stderr, "kernel_launch: memset failed\n"); return; }
    Args a{};
    for (int i = 0; i < 15; ++i) a.in[i] = (const float*)d_in[i];
    a.out = (float*)d_out; a.ws = (unsigned char*)d_ws;
    hipLaunchKernelGGL(mk_fwd, dim3(grid), dim3(NWAVES * 64), LDS_BYTES, stream, a);
    const hipError_t le = hipPeekAtLastError();
    if (le != hipSuccess) fprintf(stderr, "kernel_launch: launch failed: %s\n", hipGetErrorName(le));
}
```
